# Optimizing an MI355X kernel written in HIP

```python
import jax, jax.numpy as jnp
from jax import lax
import numpy as np

D_MODEL = 2048
BATCH = 4
SEQ = 4096
DEPTH = 1

GRID_W = 64
CTX_LEN = 256
EPS = 1e-6
N_MOD = 6
MLA_HEADS = D_MODEL // 256
Q_LORA = D_MODEL // 4
KV_LORA = D_MODEL // 4
QK_NOPE = 128
QK_ROPE = 64
V_HEAD = 128
ROPE_THETA = 10000.0
Q_BLOCK = 128
ATTN_SCALE = (QK_NOPE + QK_ROPE) ** -0.5
SGU_HEADS = D_MODEL // 256
SGU_HEAD_DIM = 128
CHUNK = 128
MLA_WIDTH = MLA_HEADS * V_HEAD
SGU_WIDTH = SGU_HEADS * SGU_HEAD_DIM
MIX_WIDTH = MLA_WIDTH + SGU_WIDTH
OFF_KV = Q_LORA
OFF_KPE = OFF_KV + KV_LORA
OFF_U = OFF_KPE + QK_ROPE
OFF_V = OFF_U + SGU_WIDTH
IN_COLS = OFF_V + SGU_WIDTH
N_EXPERTS = 16
CAP_FACTOR = 2
EXPERT_FF = D_MODEL

kernel_name = "hybrid_mla_sgu_ecmoe_diffusion_block"


def rmsnorm(x, w):
    xf = x.astype(jnp.float32)
    y = xf * lax.rsqrt(jnp.mean(xf * xf, axis=-1, keepdims=True) + EPS)
    return (y * w.astype(jnp.float32)).astype(x.dtype)


def modulate(h, shift, scale):
    return h * (1 + scale) + shift


def axial_angles(length):
    rows = length // GRID_W
    row = jnp.repeat(jnp.arange(rows, dtype=jnp.int32), GRID_W)
    col = jnp.tile(jnp.arange(GRID_W, dtype=jnp.int32), rows)
    half = QK_ROPE // 2
    inv = 1.0 / (ROPE_THETA ** (jnp.arange(0, half, 2, dtype=jnp.float32) / half))
    return row.astype(jnp.float32)[:, None] * inv, col.astype(jnp.float32)[:, None] * inv


def rope_1d(x, ang):
    xf = x.astype(jnp.float32)
    x1, x2 = jnp.split(xf, 2, axis=-1)
    cos, sin = jnp.cos(ang), jnp.sin(ang)
    return jnp.concatenate([x1 * cos - x2 * sin, x2 * cos + x1 * sin], axis=-1).astype(x.dtype)


def axial_rope(x, ang_r, ang_c):
    xr, xc = jnp.split(x, 2, axis=-1)
    return jnp.concatenate([rope_1d(xr, ang_r), rope_1d(xc, ang_c)], axis=-1)


def mla_q(c_q, q_norm_w, w_uq, angles):
    B, L, _ = c_q.shape
    q = (rmsnorm(c_q, q_norm_w) @ w_uq).reshape(B, L, MLA_HEADS, QK_NOPE + QK_ROPE)
    q_nope, q_pe = jnp.split(q, [QK_NOPE], axis=-1)
    if angles is not None:
        q_pe = axial_rope(q_pe, angles[0][:, None], angles[1][:, None])
    return jnp.concatenate([q_nope, q_pe], axis=-1)


def mla_kv(c_kv, k_pe, kv_norm_w, w_ukv, angles):
    B, L, _ = c_kv.shape
    kv = (rmsnorm(c_kv, kv_norm_w) @ w_ukv).reshape(B, L, MLA_HEADS, QK_NOPE + V_HEAD)
    k_nope, v = jnp.split(kv, [QK_NOPE], axis=-1)
    if angles is not None:
        k_pe = axial_rope(k_pe, angles[0], angles[1])
    k_pe = jnp.broadcast_to(k_pe[:, :, None, :], (B, L, MLA_HEADS, QK_ROPE))
    return jnp.concatenate([k_nope, k_pe], axis=-1), v


def attend(q, k, v):
    s = jnp.einsum('bqhd,bkhd->bhqk', q, k, preferred_element_type=jnp.float32) * ATTN_SCALE
    p = jax.nn.softmax(s, axis=-1).astype(v.dtype)
    return jnp.einsum('bhqk,bkhd->bqhd', p, v)


def blocked_attention(q, k, v):
    B, L, H, dq = q.shape
    nb = L // Q_BLOCK
    qb = q.reshape(B, nb, Q_BLOCK, H, dq).transpose(1, 0, 2, 3, 4)
    out = lax.map(lambda qi: attend(qi, k, v), qb)
    return out.transpose(1, 0, 2, 3, 4).reshape(B, L, H, v.shape[-1])


def spatial_gating(u, v, sgu_norm_w, sgu_w, sgu_b):
    B, L, _ = u.shape
    n = L // CHUNK
    u = jax.nn.gelu(u).reshape(B, n, CHUNK, SGU_HEADS, SGU_HEAD_DIM)
    vf = jax.nn.gelu(v).reshape(B, n, CHUNK, SGU_HEADS, SGU_HEAD_DIM).astype(jnp.float32)
    mu = jnp.mean(vf, axis=-1, keepdims=True)
    var = jnp.mean(jnp.square(vf - mu), axis=-1, keepdims=True)
    vn = ((vf - mu) * lax.rsqrt(var + EPS)
          * sgu_norm_w.astype(jnp.float32).reshape(SGU_HEADS, SGU_HEAD_DIM)).astype(u.dtype)
    mixed = jnp.einsum('gpq,bnqgc->bnpgc', sgu_w, vn) + sgu_b.T[:, :, None]
    return (u * mixed).reshape(B, L, SGU_WIDTH)


def ec_moe(h, w_router, b_router, w_gate, w_up, w_down):
    B, L, D = h.shape
    cap = CAP_FACTOR * L // N_EXPERTS
    logits = jnp.einsum('bld,de->ble', h, w_router).astype(jnp.float32) + b_router.astype(jnp.float32)
    aff = jax.nn.softmax(logits, axis=-1)
    gate, idx = lax.top_k(jnp.swapaxes(aff, 1, 2), cap)
    xs = jax.vmap(lambda hb, ib: hb[ib])(h, idx)
    a = jnp.einsum('becd,edf->becf', xs, w_gate)
    g = jnp.einsum('becd,edf->becf', xs, w_up)
    ye = jnp.einsum('becf,efd->becd', jax.nn.silu(a) * g, w_down) * gate[..., None].astype(h.dtype)
    scatter = lambda ib, yb: jnp.zeros((L, D), yb.dtype).at[ib.reshape(-1)].add(yb.reshape(-1, D))
    return jax.vmap(scatter)(idx, ye)


def setup_inputs(seed: int = 0) -> dict:
    key = jax.random.key(seed)
    ks = iter(jax.random.split(key, 32))
    nrm = lambda shape, scale: jax.random.normal(next(ks), shape, jnp.float32) * scale
    gain = lambda shape: 1.0 + nrm(shape, 0.05)
    return {
        "x": nrm((BATCH, SEQ, D_MODEL), 1.0),
        "c": nrm((BATCH, D_MODEL), 1.0),
        "ctx": nrm((BATCH, CTX_LEN, D_MODEL), 1.0),
        "c_ctx": nrm((D_MODEL,), 1.0),
        "w_ada": nrm((DEPTH, D_MODEL, N_MOD * D_MODEL), 0.5 * D_MODEL ** -0.5),
        "b_ada": nrm((DEPTH, N_MOD * D_MODEL), 0.02),
        "pre_norm1": gain((DEPTH, D_MODEL)),
        "w_in": nrm((DEPTH, D_MODEL, IN_COLS), D_MODEL ** -0.5),
        "q_norm_w": gain((DEPTH, Q_LORA)),
        "w_uq": nrm((DEPTH, Q_LORA, MLA_HEADS * (QK_NOPE + QK_ROPE)), Q_LORA ** -0.5),
        "kv_norm_w": gain((DEPTH, KV_LORA)),
        "w_ukv": nrm((DEPTH, KV_LORA, MLA_HEADS * (QK_NOPE + V_HEAD)), KV_LORA ** -0.5),
        "sgu_norm_w": gain((DEPTH, SGU_WIDTH)),
        "sgu_w": nrm((DEPTH, SGU_HEADS, CHUNK, CHUNK), CHUNK ** -0.5),
        "sgu_b": 1.0 + nrm((DEPTH, SGU_HEADS, CHUNK), 0.1),
        "w_out": nrm((DEPTH, MIX_WIDTH, D_MODEL), MIX_WIDTH ** -0.5),
        "post_norm1": gain((DEPTH, D_MODEL)),
        "pre_norm2": gain((DEPTH, D_MODEL)),
        "w_router": nrm((DEPTH, D_MODEL, N_EXPERTS), D_MODEL ** -0.5),
        "b_router": nrm((DEPTH, N_EXPERTS), 0.01),
        "w_e_gate": nrm((DEPTH, N_EXPERTS, D_MODEL, EXPERT_FF), D_MODEL ** -0.5),
        "w_e_up": nrm((DEPTH, N_EXPERTS, D_MODEL, EXPERT_FF), D_MODEL ** -0.5),
        "w_e_down": nrm((DEPTH, N_EXPERTS, EXPERT_FF, D_MODEL), EXPERT_FF ** -0.5),
        "post_norm2": gain((DEPTH, D_MODEL)),
    }


def reference(x, c, ctx, c_ctx, w_ada, b_ada, pre_norm1, w_in, q_norm_w, w_uq, kv_norm_w,
              w_ukv, sgu_norm_w, sgu_w, sgu_b, w_out, post_norm1, pre_norm2, w_router,
              b_router, w_e_gate, w_e_up, w_e_down, post_norm2):
    B, L, _ = x.shape
    angles = axial_angles(L)
    for l in range(DEPTH):
        last = l == DEPTH - 1
        mod = jax.nn.silu(c) @ w_ada[l] + b_ada[l]
        mod_c = jax.nn.silu(c_ctx) @ w_ada[l] + b_ada[l]
        sh1, sc1, g1, sh2, sc2, g2 = jnp.split(mod[:, None, :], N_MOD, axis=-1)
        sh1c, sc1c, g1c, sh2c, sc2c, g2c = jnp.split(mod_c, N_MOD, axis=-1)

        h = modulate(rmsnorm(x, pre_norm1[l]), sh1, sc1)
        hc = modulate(rmsnorm(ctx, pre_norm1[l]), sh1c, sc1c)
        p = h @ w_in[l]
        c_q, c_kv, k_pe, u, v_s = jnp.split(p, [OFF_KV, OFF_KPE, OFF_U, OFF_V], axis=-1)
        pc_kv = hc @ w_in[l][:, OFF_KV:OFF_U]
        c_kv_c, k_pe_c = jnp.split(pc_kv, [KV_LORA], axis=-1)

        q = mla_q(c_q, q_norm_w[l], w_uq[l], angles)
        k, v = mla_kv(c_kv, k_pe, kv_norm_w[l], w_ukv[l], angles)
        k_c, v_c = mla_kv(c_kv_c, k_pe_c, kv_norm_w[l], w_ukv[l], None)
        attn = blocked_attention(q, jnp.concatenate([k, k_c], axis=1),
                                 jnp.concatenate([v, v_c], axis=1))
        sgu = spatial_gating(u, v_s, sgu_norm_w[l], sgu_w[l], sgu_b[l])
        y = jnp.concatenate([attn.reshape(B, L, MLA_WIDTH), sgu], axis=-1) @ w_out[l]
        x_new = x + g1 * rmsnorm(y, post_norm1[l])

        if not last:
            pc = hc @ w_in[l]
            c_q_c, _, _, u_c, v_sc = jnp.split(pc, [OFF_KV, OFF_KPE, OFF_U, OFF_V], axis=-1)
            q_c = mla_q(c_q_c, q_norm_w[l], w_uq[l], None)
            attn_c = attend(q_c, k_c, v_c)
            sgu_c = spatial_gating(u_c, v_sc, sgu_norm_w[l], sgu_w[l], sgu_b[l])
            y_c = jnp.concatenate([attn_c.reshape(B, CTX_LEN, MLA_WIDTH), sgu_c], axis=-1) @ w_out[l]
            ctx = ctx + g1c * rmsnorm(y_c, post_norm1[l])
            h2c = modulate(rmsnorm(ctx, pre_norm2[l]), sh2c, sc2c)
            y2c = ec_moe(h2c, w_router[l], b_router[l], w_e_gate[l], w_e_up[l], w_e_down[l])
            ctx = ctx + g2c * rmsnorm(y2c, post_norm2[l])

        x = x_new
        h2 = modulate(rmsnorm(x, pre_norm2[l]), sh2, sc2)
        y2 = ec_moe(h2, w_router[l], b_router[l], w_e_gate[l], w_e_up[l], w_e_down[l])
        x = x + g2 * rmsnorm(y2, post_norm2[l])
    return x
```

```cpp
#define PHASE_MODE "FFFFFFFFFFFF"
#define MERGE 1
#include <hip/hip_runtime.h>
#include <cstdio>
#include <cstdint>

typedef unsigned short bf16;
namespace cfg {
constexpr int B = 4, L = 4096, D = 2048, CTX = 256, H = 8, LK = L + CTX;
constexpr int M = B * L;
constexpr int MC = B * CTX;
constexpr int MALL = M + MC;
constexpr int QL = 512, KVL = 512, NOPE = 128, ROPE = 64, VH = 128, DQK = 192;
constexpr int SGW = 1024, INC = 3136, OFF_KPE = 1024, OFF_U = 1088, OFF_V = 2112;
constexpr int NE = 16, CAP = 512, FF = 2048;
constexpr float EPS = 1e-6f;
constexpr float ATT_SCALE = 0.07216878364870322f;
constexpr size_t MiB = 1u << 20;
constexpr size_t WS_CTL = 0;
constexpr size_t WS_MOD = 1 * MiB;
constexpr size_t WS_SSQQ = 2 * MiB;
constexpr size_t WS_SSQKV = 3 * MiB;
constexpr size_t WS_SSQY = 4 * MiB;
constexpr size_t WS_AFF = 6 * MiB;
constexpr size_t WS_INV = 7 * MiB;
constexpr size_t WS_IDX = 8 * MiB;
constexpr size_t WS_WIN_T = 16 * MiB;
constexpr size_t WS_WQKV_T = 30 * MiB;
constexpr size_t WS_WOUT_T = 34 * MiB;
constexpr size_t WS_SGUW = 42 * MiB;
constexpr size_t WS_WGU_T = 64 * MiB;
constexpr size_t WS_WD_T = 320 * MiB;
constexpr size_t WS_H = 448 * MiB;
constexpr size_t WS_CQKV = 516 * MiB;
constexpr size_t WS_U = 549 * MiB;
constexpr size_t WS_VS = 581 * MiB;
constexpr size_t WS_Q = 613 * MiB;
constexpr size_t WS_K = 661 * MiB;
constexpr size_t WS_V = 712 * MiB;
constexpr size_t WS_CAT = 746 * MiB;
constexpr size_t WS_Y = 810 * MiB;
constexpr size_t WS_H2 = WS_CAT;
constexpr size_t WS_ACT = WS_H;
constexpr size_t WS_YE = WS_Q;
constexpr size_t WS_S = 874 * MiB;
constexpr size_t WS_VN = 942 * MiB;
constexpr size_t WS_ROPE = 9 * MiB;
constexpr size_t WS_PART = WS_S;
constexpr size_t WS_END = 974 * MiB;
}
using namespace cfg;

__device__ __forceinline__ float bf2f(bf16 v) { return __uint_as_float(((unsigned)v) << 16); }
__device__ __forceinline__ bf16 f2bf(float f) { unsigned u = __float_as_uint(f); return (bf16)((u + 0x7fffu + ((u >> 16) & 1u)) >> 16); }
__device__ __forceinline__ float silu_f(float x) { return x / (1.f + __expf(-x)); }
__device__ __forceinline__ float gelu_tanh(float x) { const float z = 0.7978845608028654f * (x + 0.044715f * x * x * x); return 0.5f * x * (1.f + tanhf(z)); }
__device__ __forceinline__ float wave_sum(float v) {
#pragma unroll
    for (int o = 1; o < 64; o <<= 1) v += __shfl_xor(v, o);
    return v;
}
__device__ __forceinline__ float rope_inv(int ii) { return __expf(-(float)ii * (9.210340371976184f / 16.f)); }

struct Ptrs {
    const float *x, *c, *ctx, *c_ctx, *w_ada, *b_ada, *pre_norm1, *w_in, *q_norm_w, *w_uq, *kv_norm_w, *w_ukv, *sgu_norm_w, *sgu_w, *sgu_b, *w_out,
        *post_norm1, *pre_norm2, *w_router, *b_router, *w_e_gate, *w_e_up, *w_e_down, *post_norm2;
    float* out; unsigned char* ws;
};

__global__ void n_mod(Ptrs p) {
    const int j = blockIdx.x * 256 + threadIdx.x, r = blockIdx.y;
    const float* cv = r < 4 ? p.c + r * D : p.c_ctx;
    float s = 0.f;
    for (int k = 0; k < D; ++k) s += silu_f(cv[k]) * p.w_ada[(size_t)k * 12288 + j];
    ((float*)(p.ws + WS_MOD))[r * 12288 + j] = s + p.b_ada[j];
}
__global__ __launch_bounds__(256) void n_hrows(Ptrs p) {
    const int row = blockIdx.x * 4 + (threadIdx.x >> 6), lane = threadIdx.x & 63;
    if (row >= MALL) return;
    const float* src = row < M ? p.x + (size_t)row * D : p.ctx + (size_t)(row - M) * D;
    const int mr = row < M ? row >> 12 : 4;
    const float* mod = (const float*)(p.ws + WS_MOD) + mr * 12288;
    float v[32]; float s = 0.f;
    for (int j = 0; j < 32; ++j) { v[j] = src[j * 64 + lane]; s += v[j] * v[j]; }
    const float rs = rsqrtf(wave_sum(s) * (1.f / D) + EPS);
    bf16* o = (bf16*)(p.ws + WS_H) + (size_t)row * D;
    for (int j = 0; j < 32; ++j) { const int c = j * 64 + lane; o[c] = f2bf(v[j] * rs * p.pre_norm1[c] * (1.f + mod[2048 + c]) + mod[c]); }
}
template <class P> __global__ __launch_bounds__(256) void ngemm(P p) {
    __shared__ float As[16][65], Bs[16][65];
    const int tx = threadIdx.x & 15, ty = threadIdx.x >> 4, z = blockIdx.z;
    const int m0 = blockIdx.y * 64, n0 = blockIdx.x * 64;
    float acc[4][4] = {};
    for (int k0 = 0; k0 < p.K; k0 += 16) {
        for (int j = 0; j < 4; ++j) { const int idx = threadIdx.x + 256 * j; const int kk = idx & 15, mm = idx >> 4; As[kk][mm] = p.a(z, m0 + mm, k0 + kk); }
        for (int j = 0; j < 4; ++j) { const int idx = threadIdx.x + 256 * j; const int nn = idx & 63, kk = idx >> 6; Bs[kk][nn] = p.b(z, k0 + kk, n0 + nn); }
        __syncthreads();
#pragma unroll
        for (int kk = 0; kk < 16; ++kk) {
            float a[4], b[4];
#pragma unroll
            for (int i = 0; i < 4; ++i) { a[i] = As[kk][ty * 4 + i]; b[i] = Bs[kk][tx * 4 + i]; }
#pragma unroll
            for (int i = 0; i < 4; ++i)
#pragma unroll
                for (int j = 0; j < 4; ++j) acc[i][j] += a[i] * b[j];
        }
        __syncthreads();
    }
    for (int i = 0; i < 4; ++i) p.epi(z, m0 + ty * 4 + i, n0 + tx * 4, acc[i]);
}
__device__ __forceinline__ void rope_pair(float& x1, float& x2, int i, int pos) {
    const int ii = i & 15; const float ax = (float)((i >> 4) ? (pos & 63) : (pos >> 6));
    float s, c; sincosf(ax * rope_inv(ii), &s, &c);
    const float r1 = x1 * c - x2 * s, r2 = x2 * c + x1 * s; x1 = r1; x2 = r2;
}
struct GIn {
    Ptrs p; int K;
    __device__ float a(int, int m, int k) const { return bf2f(((const bf16*)(p.ws + WS_H))[(size_t)m * D + k]); }
    __device__ float b(int, int k, int n) const {
        int o; if (n < 1024) o = n; else if (n < 3072) o = n + 64; else { const int j = n - 3072, i = j >> 1, s = j & 1; o = OFF_KPE + (i >> 4) * 32 + s * 16 + (i & 15); }
        return p.w_in[(size_t)k * INC + o];
    }
    __device__ void epi(int, int m, int n0, const float* v) const {
        bf16* CQ = (bf16*)(p.ws + WS_CQKV); bf16* CKV = CQ + (size_t)M * 512;
        if (n0 < 512) { if (m < M) for (int j = 0; j < 4; ++j) CQ[(size_t)m * 512 + n0 + j] = f2bf(v[j]); }
        else if (n0 < 1024) { for (int j = 0; j < 4; ++j) CKV[(size_t)m * 512 + n0 - 512 + j] = f2bf(v[j]); }
        else if (n0 < 2048) { if (m < M) for (int j = 0; j < 4; ++j) ((bf16*)(p.ws + WS_U))[(size_t)m * 1024 + n0 - 1024 + j] = f2bf(gelu_tanh(v[j])); }
        else if (n0 < 3072) { if (m < M) for (int j = 0; j < 4; ++j) ((bf16*)(p.ws + WS_VS))[(size_t)m * 1024 + n0 - 2048 + j] = f2bf(gelu_tanh(v[j])); }
        else {
            const int jj = n0 - 3072; bf16* Kb = (bf16*)(p.ws + WS_K);
            for (int q = 0; q < 2; ++q) {
                const int i = (jj >> 1) + q; float x1 = v[2 * q], x2 = v[2 * q + 1]; int b, kpos;
                if (m < M) { b = m >> 12; kpos = m & 4095; rope_pair(x1, x2, i, kpos); } else { b = (m - M) >> 8; kpos = L + ((m - M) & 255); }
                for (int hh = 0; hh < H; ++hh) { bf16* d = Kb + ((size_t)(b * H + hh) * LK + kpos) * DQK + 128 + 2 * i; d[0] = f2bf(x1); d[1] = f2bf(x2); }
            }
        }
    }
};
__global__ void n_ssq(const bf16* T, int rows, int cols, float* out, int nslots) {
    const int row = blockIdx.x * 4 + (threadIdx.x >> 6), lane = threadIdx.x & 63;
    if (row >= rows) return;
    float s = 0.f; for (int c = lane; c < cols; c += 64) { const float v = bf2f(T[(size_t)row * cols + c]); s += v * v; }
    s = wave_sum(s);
    if (lane < nslots) out[(size_t)row * nslots + lane] = lane == 0 ? s : 0.f;
}
__device__ __forceinline__ float sum_slots(const float* s, int n) { float t = 0.f; for (int i = 0; i < n; ++i) t += s[i]; return t; }
struct GQ {
    Ptrs p; int K;
    __device__ float a(int, int m, int k) const { return bf2f(((const bf16*)(p.ws + WS_CQKV))[(size_t)m * 512 + k]); }
    __device__ float b(int, int k, int n) const {
        int o; if (n < 1024) o = (n >> 7) * DQK + (n & 127); else { const int jj = n - 1024, hd = jj >> 6, j6 = jj & 63, i = j6 >> 1, s = j6 & 1; o = hd * DQK + 128 + (i >> 4) * 32 + s * 16 + (i & 15); }
        return p.w_uq[(size_t)k * 1536 + o] * p.q_norm_w[k];
    }
    __device__ void epi(int, int m, int n0, const float* v) const {
        const float rs = rsqrtf(sum_slots((const float*)(p.ws + WS_SSQQ) + (size_t)m * 8, 8) * (1.f / 512.f) + EPS);
        const int b = m >> 12, t = m & 4095; bf16* Qb = (bf16*)(p.ws + WS_Q);
        if (n0 < 1024) { const int hd = n0 >> 7, d = n0 & 127; for (int j = 0; j < 4; ++j) Qb[((size_t)(b * H + hd) * L + t) * DQK + d + j] = f2bf(v[j] * rs); }
        else { const int jj = n0 - 1024, hd = jj >> 6, j6 = jj & 63;
            for (int q = 0; q < 2; ++q) { const int i = (j6 >> 1) + q; float x1 = v[2 * q] * rs, x2 = v[2 * q + 1] * rs; rope_pair(x1, x2, i, t);
                bf16* d = Qb + ((size_t)(b * H + hd) * L + t) * DQK + 128 + 2 * i; d[0] = f2bf(x1); d[1] = f2bf(x2); } }
    }
};
struct GKV {
    Ptrs p; int K;
    __device__ float a(int, int m, int k) const { return bf2f(((const bf16*)(p.ws + WS_CQKV))[(size_t)(M + m) * 512 + k]); }
    __device__ float b(int, int k, int n) const { return p.w_ukv[(size_t)k * 2048 + n] * p.kv_norm_w[k]; }
    __device__ void epi(int, int m, int n0, const float* v) const {
        const float rs = rsqrtf(sum_slots((const float*)(p.ws + WS_SSQKV) + (size_t)m * 8, 8) * (1.f / 512.f) + EPS);
        int b, kpos; if (m < M) { b = m >> 12; kpos = m & 4095; } else { b = (m - M) >> 8; kpos = L + ((m - M) & 255); }
        const int hd = n0 >> 8, c = n0 & 255;
        if (c < 128) { bf16* d = (bf16*)(p.ws + WS_K) + ((size_t)(b * H + hd) * LK + kpos) * DQK + c; for (int j = 0; j < 4; ++j) d[j] = f2bf(v[j] * rs); }
        else { bf16* d = (bf16*)(p.ws + WS_V) + ((size_t)(b * H + hd) * LK + kpos) * VH + c - 128; for (int j = 0; j < 4; ++j) d[j] = f2bf(v[j] * rs); }
    }
};
__global__ void n_vn(Ptrs p) {
    const int w = blockIdx.x * 4 + (threadIdx.x >> 6), lane = threadIdx.x & 63;
    const int tok = w >> 3, g = w & 7;
    const bf16* s = (const bf16*)(p.ws + WS_VS) + (size_t)tok * 1024 + g * 128;
    const float a = bf2f(s[lane]), b = bf2f(s[lane + 64]);
    const float mu = wave_sum(a + b) * (1.f / 128.f);
    const float da = a - mu, db = b - mu;
    const float rs = rsqrtf(wave_sum(da * da + db * db) * (1.f / 128.f) + EPS);
    bf16* o = (bf16*)(p.ws + WS_VN) + (size_t)tok * 1024 + g * 128;
    o[lane] = f2bf(da * rs * p.sgu_norm_w[g * 128 + lane]); o[lane + 64] = f2bf(db * rs * p.sgu_norm_w[g * 128 + lane + 64]);
}
struct GSgu {
    Ptrs p; int K;
    __device__ float a(int z, int m, int k) const { return p.sgu_w[((size_t)(z & 7) * 128 + m) * 128 + k]; }
    __device__ float b(int z, int k, int n) const { return bf2f(((const bf16*)(p.ws + WS_VN))[(size_t)((z >> 3) * 128 + k) * 1024 + (z & 7) * 128 + n]); }
    __device__ void epi(int z, int m, int n0, const float* v) const {
        const int g = z & 7; const size_t row = (size_t)(z >> 3) * 128 + m; const float bias = p.sgu_b[g * 128 + m];
        for (int j = 0; j < 4; ++j) { const float u = bf2f(((const bf16*)(p.ws + WS_U))[row * 1024 + g * 128 + n0 + j]);
            ((bf16*)(p.ws + WS_CAT))[row * D + 1024 + g * 128 + n0 + j] = f2bf(u * (v[j] + bias)); }
    }
};
struct GScore {
    Ptrs p; int K; int bh;
    __device__ float a(int, int m, int k) const { return bf2f(((const bf16*)(p.ws + WS_Q))[((size_t)bh * L + m) * DQK + k]); }
    __device__ float b(int, int k, int n) const { return bf2f(((const bf16*)(p.ws + WS_K))[((size_t)bh * LK + n) * DQK + k]); }
    __device__ void epi(int, int m, int n0, const float* v) const { float* S = (float*)(p.ws + WS_S) + (size_t)m * LK + n0; for (int j = 0; j < 4; ++j) S[j] = v[j] * ATT_SCALE; }
};
__global__ void n_softmax(float* S, int cols) {
    float* r = S + (size_t)blockIdx.x * cols; __shared__ float red[4];
    float mx = -1e30f; for (int c = threadIdx.x; c < cols; c += 256) mx = fmaxf(mx, r[c]);
    for (int o = 1; o < 64; o <<= 1) mx = fmaxf(mx, __shfl_xor(mx, o));
    if ((threadIdx.x & 63) == 0) red[threadIdx.x >> 6] = mx; __syncthreads();
    mx = fmaxf(fmaxf(red[0], red[1]), fmaxf(red[2], red[3])); __syncthreads();
    float s = 0.f; for (int c = threadIdx.x; c < cols; c += 256) { const float e = __expf(r[c] - mx); r[c] = e; s += e; }
    s = wave_sum(s); if ((threadIdx.x & 63) == 0) red[threadIdx.x >> 6] = s; __syncthreads();
    s = (red[0] + red[1]) + (red[2] + red[3]); const float inv = 1.f / s;
    for (int c = threadIdx.x; c < cols; c += 256) r[c] *= inv;
}
struct GPV {
    Ptrs p; int K; int bh;
    __device__ float a(int, int m, int k) const { return ((const float*)(p.ws + WS_S))[(size_t)m * LK + k]; }
    __device__ float b(int, int k, int n) const { return bf2f(((const bf16*)(p.ws + WS_V))[((size_t)bh * LK + k) * VH + n]); }
    __device__ void epi(int, int m, int n0, const float* v) const { bf16* d = (bf16*)(p.ws + WS_CAT) + ((size_t)(bh >> 3) * L + m) * D + (bh & 7) * 128 + n0; for (int j = 0; j < 4; ++j) d[j] = f2bf(v[j]); }
};
struct GOut {
    Ptrs p; int K;
    __device__ float a(int, int m, int k) const { return bf2f(((const bf16*)(p.ws + WS_CAT))[(size_t)m * D + k]); }
    __device__ float b(int, int k, int n) const { return p.w_out[(size_t)k * D + n]; }
    __device__ void epi(int, int m, int n0, const float* v) const { bf16* d = (bf16*)(p.ws + WS_Y) + (size_t)m * D + n0; for (int j = 0; j < 4; ++j) d[j] = f2bf(v[j]); }
};
__device__ __forceinline__ void row_pass_mid(const Ptrs& p, int row, int lane) {
    const int b = row >> 12; const float* mod = (const float*)(p.ws + WS_MOD) + b * 12288;
    const float ssq = wave_sum(lane < 32 ? ((const float*)(p.ws + WS_SSQY))[(size_t)row * 32 + lane] : 0.f);
    const float rsy = rsqrtf(ssq * (1.f / D) + EPS);
    const bf16* y = (const bf16*)(p.ws + WS_Y) + (size_t)row * D; const float* xr = p.x + (size_t)row * D; float* o = p.out + (size_t)row * D;
    float v[32]; float s = 0.f;
    for (int j = 0; j < 32; ++j) { const int c = j * 64 + lane; v[j] = xr[c] + mod[4096 + c] * (bf2f(y[c]) * rsy * p.post_norm1[c]); o[c] = v[j]; s += v[j] * v[j]; }
    const float rs = rsqrtf(wave_sum(s) * (1.f / D) + EPS);
    bf16* h2 = (bf16*)(p.ws + WS_H2) + (size_t)row * D; float lg[16];
    for (int e = 0; e < 16; ++e) lg[e] = 0.f;
    for (int j = 0; j < 32; ++j) { const int c = j * 64 + lane; const float h = v[j] * rs * p.pre_norm2[c] * (1.f + mod[8192 + c]) + mod[6144 + c]; h2[c] = f2bf(h);
        const float* wr = p.w_router + (size_t)c * 16; for (int e = 0; e < 16; ++e) lg[e] += h * wr[e]; }
    float mx = -1e30f;
    for (int e = 0; e < 16; ++e) { lg[e] = wave_sum(lg[e]) + p.b_router[e]; mx = fmaxf(mx, lg[e]); }
    float se = 0.f; for (int e = 0; e < 16; ++e) { lg[e] = __expf(lg[e] - mx); se += lg[e]; }
    const float inv = 1.f / se;
    if (lane < 16) { float val = 0.f; for (int e = 0; e < 16; ++e) val = (lane == e) ? lg[e] * inv : val; ((float*)(p.ws + WS_AFF))[(size_t)row * 16 + lane] = val; }
}
__global__ __launch_bounds__(256) void n_rowmid(Ptrs p) { const int row = blockIdx.x * 4 + (threadIdx.x >> 6); row_pass_mid(p, row, threadIdx.x & 63); }
__global__ void n_topk(Ptrs p) {
    __shared__ float vals[L];
    const int e = blockIdx.x >> 2, b = blockIdx.x & 3;
    const float* aff = (const float*)(p.ws + WS_AFF) + (size_t)b * L * 16 + e;
    for (int t = threadIdx.x; t < L; t += blockDim.x) vals[t] = aff[(size_t)t * 16];
    __syncthreads();
    for (int t = threadIdx.x; t < L; t += blockDim.x) {
        const float v = vals[t]; int rank = 0;
        for (int u = 0; u < L; ++u) { const float w = vals[u]; rank += (w > v || (w == v && u < t)) ? 1 : 0; }
        ((int*)(p.ws + WS_INV))[(size_t)(b * L + t) * 16 + e] = rank < CAP ? rank : -1;
        if (rank < CAP) ((int*)(p.ws + WS_IDX))[(size_t)(e * 4 + b) * CAP + rank] = t;
    }
}
struct GE1 {
    Ptrs p; int K;
    __device__ float a(int z, int m, int k) const { const int b = m >> 9; const int tok = ((const int*)(p.ws + WS_IDX))[(size_t)(z * 4 + b) * CAP + (m & 511)];
        return bf2f(((const bf16*)(p.ws + WS_H2))[((size_t)b * L + tok) * D + k]); }
    __device__ float b(int z, int k, int n) const { const float* w = (n & 1) ? p.w_e_up : p.w_e_gate; return w[((size_t)z * D + k) * FF + (n >> 1)]; }
    __device__ void epi(int z, int m, int n0, const float* v) const { bf16* d = (bf16*)(p.ws + WS_ACT) + ((size_t)z * 2048 + m) * FF + (n0 >> 1);
        d[0] = f2bf(silu_f(v[0]) * v[1]); d[1] = f2bf(silu_f(v[2]) * v[3]); }
};
struct GE2 {
    Ptrs p; int K;
    __device__ float a(int z, int m, int k) const { return bf2f(((const bf16*)(p.ws + WS_ACT))[((size_t)z * 2048 + m) * FF + k]); }
    __device__ float b(int z, int k, int n) const { return p.w_e_down[((size_t)z * FF + k) * D + n]; }
    __device__ void epi(int z, int m, int n0, const float* v) const { bf16* d = (bf16*)(p.ws + WS_YE) + ((size_t)z * 2048 + m) * D + n0; for (int j = 0; j < 4; ++j) d[j] = f2bf(v[j]); }
};
__device__ __forceinline__ void row_pass_final(const Ptrs& p, int row, int lane) {
    const int b = row >> 12; const float* mod = (const float*)(p.ws + WS_MOD) + b * 12288;
    const int* inv = (const int*)(p.ws + WS_INV) + (size_t)row * 16; const float* aff = (const float*)(p.ws + WS_AFF) + (size_t)row * 16;
    float v[32]; for (int j = 0; j < 32; ++j) v[j] = 0.f;
    for (int e = 0; e < 16; ++e) { const int sl = inv[e]; if (sl >= 0) { const float g = aff[e]; const bf16* ye = (const bf16*)(p.ws + WS_YE) + ((size_t)(e * 4 + b) * CAP + sl) * D;
            for (int j = 0; j < 32; ++j) v[j] += g * bf2f(ye[j * 64 + lane]); } }
    float s = 0.f; for (int j = 0; j < 32; ++j) s += v[j] * v[j];
    const float rs = rsqrtf(wave_sum(s) * (1.f / D) + EPS);
    float* o = p.out + (size_t)row * D;
    for (int j = 0; j < 32; ++j) { const int c = j * 64 + lane; o[c] = o[c] + mod[10240 + c] * (v[j] * rs * p.post_norm2[c]); }
}
__global__ __launch_bounds__(256) void n_rowfinal(Ptrs p) { const int row = blockIdx.x * 4 + (threadIdx.x >> 6); row_pass_final(p, row, threadIdx.x & 63); }


namespace pg8 {
#define PG8_LAS __attribute__((address_space(3)))
typedef short bf16x8 __attribute__((ext_vector_type(8)));
typedef float f32x4 __attribute__((ext_vector_type(4)));
typedef float f32x2 __attribute__((ext_vector_type(2)));
typedef unsigned u32x4 __attribute__((ext_vector_type(4)));
constexpr int BM = 256, BK = 64, HALF = 128, HTB = HALF * BK * 2, STAGE_BYTES = 8 * HTB, NXCD = 8, WGM = 8;

__host__ __device__ __forceinline__ int lds_byte(int r, int c) { const int st = (r >> 4) * 2 + (c >> 5), rr = r & 15, cc = c & 31, ob = rr * 64 + cc * 2; return st * 1024 + (ob ^ (((ob >> 9) & 1) << 5)); }
__host__ __device__ __forceinline__ void stage_rc(int b, int& R, int& C) { const int st = b / 1024, sb = b % 1024, swz = sb ^ (((sb >> 9) & 1) << 5); R = (st >> 1) * 16 + swz / 64; C = (st & 1) * 32 + (swz % 64) / 2; }
__host__ __device__ __forceinline__ int perm32(int rho) { const int n = rho >> 4, i = rho & 15; return 8 * (i >> 2) + 4 * n + (i & 3); }

struct Unit { int pm, pn; };
__device__ __forceinline__ void rect_unit(int L, int nM, int nN, Unit& u) {
    const int nwg = nM * nN; int wgid = L;
    { const int q = nwg / NXCD, r = nwg % NXCD, xcd = wgid % NXCD, off = wgid / NXCD; wgid = (xcd < r ? xcd * (q + 1) : r * (q + 1) + (xcd - r) * q) + off; }
    const int nig = WGM * nN, gid = wgid / nig, fm = gid * WGM, gsz = (nM - fm) < WGM ? (nM - fm) : WGM;
    u.pm = fm + ((wgid % nig) % gsz); u.pn = (wgid % nig) / gsz;
}
__device__ __forceinline__ void dense_voff(int K, int tid, unsigned (&v)[2][2]) {
#pragma unroll
    for (int i = 0; i < 2; ++i) { int R, C; stage_rc(tid * 16 + i * 8192, R, C); v[0][i] = (unsigned)(R * K + C) * 2u; v[1][i] = (unsigned)((R + HALF) * K + C) * 2u; }
}

__device__ __forceinline__ unsigned cvt_pk_bf16(float lo, float hi) { unsigned r; asm volatile("v_cvt_pk_bf16_f32 %0, %1, %2" : "=v"(r) : "v"(lo), "v"(hi)); return r; }
__device__ __forceinline__ u32x4 pack8(const f32x4& a, const f32x4& b) { u32x4 w; w.x = cvt_pk_bf16(a[0], a[1]); w.y = cvt_pk_bf16(a[2], a[3]); w.z = cvt_pk_bf16(b[0], b[1]); w.w = cvt_pk_bf16(b[2], b[3]); return w; }

template <class Epi, class Sched>
__device__ __forceinline__ void gemm_phase(PG8_LAS unsigned char* lds, const int K, const Sched& S, const Epi& E) {
    const int tid = threadIdx.x, wid = __builtin_amdgcn_readfirstlane(tid >> 6), lane = tid & 63, wr = wid >> 2, wc = wid & 3, fr = lane & 15, fq = lane >> 4;
    const int nt = K / BK;
    unsigned voffB[2];
#pragma unroll
    for (int i = 0; i < 2; ++i) { int R, C; stage_rc(tid * 16 + i * 8192, R, C); const int Rb = Epi::PERM ? ((R & ~31) + perm32(R & 31)) : R; voffB[i] = (unsigned)(Rb * K + C) * 2u; }
    const size_t kstep = (size_t)(BK * 2);
    const size_t hstep = (size_t)HALF * K * 2;
    const unsigned ldsw = (unsigned)wid * 1024u;
    const int aoff = lds_byte(wr * 64 + fr, fq * 8), boff = lds_byte(wc * 32 + fr, fq * 8);
#define PG8_SA(b, h) (((b) * 2 + (h)) * HTB)
#define PG8_SB(b, h) ((4 + (b) * 2 + (h)) * HTB)
#define PG8_STAGE(bufoff, gbase, voff) do { _Pragma("unroll") for (int _i = 0; _i < 2; ++_i) \
        __builtin_amdgcn_global_load_lds((const unsigned*)((const char*)(gbase) + (voff)[_i]), (PG8_LAS unsigned*)(lds + (bufoff) + ldsw + _i * 8192), 16, 0, 0); } while (0)
#define PG8_LDA(dst, b, h) do { _Pragma("unroll") for (int m = 0; m < 4; ++m) _Pragma("unroll") for (int k = 0; k < 2; ++k) dst[m][k] = *(const PG8_LAS bf16x8*)(lds + PG8_SA(b, h) + aoff + m * 2048 + k * 1024); } while (0)
#define PG8_LDB(dst, b, h) do { _Pragma("unroll") for (int n = 0; n < 2; ++n) _Pragma("unroll") for (int k = 0; k < 2; ++k) dst[n][k] = *(const PG8_LAS bf16x8*)(lds + PG8_SB(b, h) + boff + n * 2048 + k * 1024); } while (0)
#define PG8_MMA(ai, bj, At, Bt) do { __builtin_amdgcn_s_setprio(1); _Pragma("unroll") for (int m = 0; m < 4; ++m) _Pragma("unroll") for (int n = 0; n < 2; ++n) _Pragma("unroll") for (int k = 0; k < 2; ++k) \
        acc[ai][bj][m][n] = __builtin_amdgcn_mfma_f32_16x16x32_bf16(Bt[n][k], At[m][k], acc[ai][bj][m][n], 0, 0, 0); __builtin_amdgcn_s_setprio(0); } while (0)
#define PG8_WAIT_V(n) asm volatile("s_waitcnt vmcnt(" #n ")" ::: "memory")
#define PG8_WAIT_L(n) asm volatile("s_waitcnt lgkmcnt(" #n ")" ::: "memory")
#define PG8_BAR __builtin_amdgcn_s_barrier()
#define PG8_SCHED __builtin_amdgcn_sched_barrier(0)
    Unit cur, nxt; int ui = 0;
    if (!S.next(0, cur)) return;
    f32x4 acc[2][2][4][2];
#pragma unroll
    for (int a = 0; a < 2; ++a)
#pragma unroll
        for (int b = 0; b < 2; ++b)
#pragma unroll
            for (int m = 0; m < 4; ++m)
#pragma unroll
                for (int n = 0; n < 2; ++n) acc[a][b][m][n] = (f32x4){0.f, 0.f, 0.f, 0.f};
    bf16x8 At[4][2], B0[2][2], B1[2][2];
    unsigned vA[2][2], vN[2][2];
    S.a_voff(0, cur, tid, vA);
    const char* cA = S.a_base(cur); const char* cB = S.b_base(cur);
    PG8_STAGE(PG8_SB(0, 0), cB, voffB); PG8_STAGE(PG8_SB(0, 1), cB + hstep, voffB); PG8_STAGE(PG8_SA(0, 0), cA, vA[0]); PG8_STAGE(PG8_SA(0, 1), cA, vA[1]);
    if (wr == 1) PG8_BAR;
    PG8_WAIT_V(2); PG8_BAR;
    PG8_STAGE(PG8_SB(1, 0), cB + kstep, voffB); PG8_STAGE(PG8_SA(1, 0), cA + kstep, vA[0]); PG8_STAGE(PG8_SB(1, 1), cB + hstep + kstep, voffB);
    PG8_WAIT_V(6); PG8_BAR;
    for (;;) {
        const bool has_next = S.next(ui + 1, nxt);
        if (has_next) S.a_voff(ui + 1, nxt, tid, vN);
        const char* nA = has_next ? S.a_base(nxt) : cA; const char* nB = has_next ? S.b_base(nxt) : cB;
        for (int t = 0; t < nt; t += 2) {
            const bool last = (t == nt - 2);
            const char* a1 = cA + (size_t)(t + 1) * kstep;
            const char* a2 = last ? nA : cA + (size_t)(t + 2) * kstep; const char* b2 = last ? nB : cB + (size_t)(t + 2) * kstep;
            const char* a3 = a2 + kstep; const char* b3 = b2 + kstep;
            PG8_LDB(B0, 0, 0); PG8_LDB(B1, 0, 1); PG8_SCHED; PG8_LDA(At, 0, 0); PG8_STAGE(PG8_SA(1, 1), a1, vA[1]);
            if (last && has_next) {
#pragma unroll
                for (int h = 0; h < 2; ++h)
#pragma unroll
                    for (int i = 0; i < 2; ++i) vA[h][i] = vN[h][i];
            }
            PG8_WAIT_V(8); PG8_WAIT_L(0); PG8_BAR; PG8_MMA(0, 0, At, B0); PG8_MMA(0, 1, At, B1); PG8_BAR; PG8_SCHED;
            PG8_LDA(At, 0, 1); PG8_STAGE(PG8_SB(0, 0), b2, voffB); PG8_STAGE(PG8_SB(0, 1), b2 + hstep, voffB); PG8_STAGE(PG8_SA(0, 0), a2, vA[0]);
            PG8_WAIT_V(8); PG8_WAIT_L(0); PG8_BAR; PG8_MMA(1, 0, At, B0); PG8_MMA(1, 1, At, B1); PG8_BAR; PG8_SCHED;
            PG8_LDB(B0, 1, 0); PG8_LDB(B1, 1, 1); PG8_SCHED; PG8_LDA(At, 1, 0); PG8_STAGE(PG8_SA(0, 1), a2, vA[1]);
            PG8_WAIT_V(8); PG8_WAIT_L(0); PG8_BAR; PG8_MMA(0, 0, At, B0); PG8_MMA(0, 1, At, B1); PG8_BAR; PG8_SCHED;
            PG8_LDA(At, 1, 1); PG8_STAGE(PG8_SB(1, 0), b3, voffB); PG8_STAGE(PG8_SB(1, 1), b3 + hstep, voffB); PG8_STAGE(PG8_SA(1, 0), a3, vA[0]);
            PG8_WAIT_V(8); PG8_WAIT_L(0); PG8_BAR; PG8_MMA(1, 0, At, B0); PG8_MMA(1, 1, At, B1); PG8_BAR; PG8_SCHED;
        }
        if (wr == 0) PG8_BAR;
        E(acc, cur, wr, wc, fr, fq);
        if (!has_next) break;
#pragma unroll
        for (int a = 0; a < 2; ++a)
#pragma unroll
            for (int b = 0; b < 2; ++b)
#pragma unroll
                for (int m = 0; m < 4; ++m)
#pragma unroll
                    for (int n = 0; n < 2; ++n) acc[a][b][m][n] = (f32x4){0.f, 0.f, 0.f, 0.f};
        cur = nxt; cA = nA; cB = nB; ++ui;
        if (wr == 1) PG8_BAR;
    }
    PG8_WAIT_V(0);
    PG8_BAR;
#undef PG8_SA
#undef PG8_SB
#undef PG8_STAGE
#undef PG8_LDA
#undef PG8_LDB
#undef PG8_MMA
#undef PG8_WAIT_V
#undef PG8_WAIT_L
#undef PG8_BAR
#undef PG8_SCHED
}
}

#define LAS __attribute__((address_space(3)))
typedef pg8::f32x4 f32x4; typedef pg8::u32x4 u32x4; typedef pg8::Unit Unit;
constexpr size_t TSTEP2K = (size_t)256 * 2048 * 2, TSTEP512 = (size_t)256 * 512 * 2;

struct SchedIn {
    const char *A, *Bt; int G, c;
    __device__ __forceinline__ bool next(int i, Unit& u) const { const int Lx = i * G + c; if (Lx >= 844) return false;
        if (Lx < 832) pg8::rect_unit(Lx, 64, 13, u); else { const int r = Lx - 832; u.pm = 64 + (r & 3); const int q = r >> 2; u.pn = q == 2 ? 12 : 2 + q; } return true; }
    __device__ __forceinline__ const char* a_base(const Unit& u) const { return A + (size_t)u.pm * TSTEP2K; }
    __device__ __forceinline__ const char* b_base(const Unit& u) const { return Bt + (size_t)u.pn * TSTEP2K; }
    __device__ __forceinline__ void a_voff(int, const Unit&, int tid, unsigned (&v)[2][2]) const { pg8::dense_voff(2048, tid, v); }
};
struct SchedQKV {
    const char *A, *Bt; int G, c;
    __device__ __forceinline__ bool next(int i, Unit& u) const { const int Lx = i * G + c; if (Lx >= 928) return false;
        if (Lx < 384) pg8::rect_unit(Lx, 64, 6, u); else { pg8::rect_unit(Lx - 384, 68, 8, u); u.pm += 64; u.pn += 6; } return true; }
    __device__ __forceinline__ const char* a_base(const Unit& u) const { return A + (size_t)u.pm * TSTEP512; }
    __device__ __forceinline__ const char* b_base(const Unit& u) const { return Bt + (size_t)u.pn * TSTEP512; }
    __device__ __forceinline__ void a_voff(int, const Unit&, int tid, unsigned (&v)[2][2]) const { pg8::dense_voff(512, tid, v); }
};
struct SchedDense {
    const char *A, *Bt; int G, c, nM, nN, bshift;
    __device__ __forceinline__ bool next(int i, Unit& u) const { const int Lx = i * G + c; if (Lx >= nM * nN) return false; pg8::rect_unit(Lx, nM, nN, u); return true; }
    __device__ __forceinline__ const char* a_base(const Unit& u) const { return A + (size_t)u.pm * TSTEP2K; }
    __device__ __forceinline__ const char* b_base(const Unit& u) const { return Bt + (size_t)((u.pm >> bshift) * nN + u.pn) * TSTEP2K; }
    __device__ __forceinline__ void a_voff(int, const Unit&, int tid, unsigned (&v)[2][2]) const { pg8::dense_voff(2048, tid, v); }
};
struct SchedGather {
    const char *A, *Bt; int G, c; const LAS unsigned* tab;
    __device__ __forceinline__ bool next(int i, Unit& u) const { const int Lx = i * G + c; if (Lx >= 2048) return false; pg8::rect_unit(Lx, 128, 16, u); return true; }
    __device__ __forceinline__ const char* a_base(const Unit&) const { return A; }
    __device__ __forceinline__ const char* b_base(const Unit& u) const { return Bt + (size_t)((u.pm >> 3) * 16 + u.pn) * TSTEP2K; }
    __device__ __forceinline__ void a_voff(int i, const Unit&, int tid, unsigned (&v)[2][2]) const {
#pragma unroll
        for (int p = 0; p < 2; ++p) { int R, C; pg8::stage_rc(tid * 16 + p * 8192, R, C); v[0][p] = tab[i * 256 + R] + (unsigned)C * 2u; v[1][p] = tab[i * 256 + 128 + R] + (unsigned)C * 2u; }
    }
};

__device__ __forceinline__ float gelu_fast(float x) {
    const float z2 = -2.302208198f * (x + 0.044715f * x * x * x);
    return x * __builtin_amdgcn_rcpf(1.f + __builtin_amdgcn_exp2f(z2));
}
__device__ __forceinline__ float silu_fast(float x) { return x * __builtin_amdgcn_rcpf(1.f + __builtin_amdgcn_exp2f(-1.4426950408889634f * x)); }
__device__ __forceinline__ float dot4(const f32x4& a) { return (a[0] * a[0] + a[1] * a[1]) + (a[2] * a[2] + a[3] * a[3]); }
__device__ __forceinline__ void rope8(f32x4& a, f32x4& b, const float* tabrow  , int fq) {
    const f32x4 t0 = *(const f32x4*)(tabrow + 8 * fq), t1 = *(const f32x4*)(tabrow + 8 * fq + 4);
    f32x4 ra, rb;
    ra[0] = a[0] * t0[0] - a[1] * t0[1]; ra[1] = a[1] * t0[0] + a[0] * t0[1]; ra[2] = a[2] * t0[2] - a[3] * t0[3]; ra[3] = a[3] * t0[2] + a[2] * t0[3];
    rb[0] = b[0] * t1[0] - b[1] * t1[1]; rb[1] = b[1] * t1[0] + b[0] * t1[1]; rb[2] = b[2] * t1[2] - b[3] * t1[3]; rb[3] = b[3] * t1[2] + b[2] * t1[3];
    a = ra; b = rb;
}
struct EpiIn {
    static constexpr bool PERM = true; unsigned char* ws;
    __device__ __forceinline__ void operator()(const f32x4 (&acc)[2][2][4][2], const Unit& u, int wr, int wc, int fr, int fq) const {
        const int pn = u.pn, row0 = u.pm * 256 + wr * 64 + fr, c8 = wc * 32 + 8 * fq;
        if (pn < 4) {
            bf16* base = (bf16*)(ws + WS_CQKV) + (pn >= 2 ? (size_t)M * 512 : 0) + (pn & 1) * 256 + c8;
            float* ssq = (float*)(ws + (pn >= 2 ? WS_SSQKV : WS_SSQQ)) + (pn & 1) * 4 + wc;
#pragma unroll
            for (int ai = 0; ai < 2; ++ai)
#pragma unroll
                for (int m = 0; m < 4; ++m) { const int row = row0 + ai * 128 + m * 16; float s = 0.f;
#pragma unroll
                    for (int bj = 0; bj < 2; ++bj) { s += dot4(acc[ai][bj][m][0]) + dot4(acc[ai][bj][m][1]); *(u32x4*)(base + (size_t)row * 512 + bj * 128) = pg8::pack8(acc[ai][bj][m][0], acc[ai][bj][m][1]); }
                    s += __shfl_xor(s, 16); s += __shfl_xor(s, 32);
                    if (fq == 0) ssq[(size_t)row * 8] = s; }
        } else if (pn < 12) {
            bf16* base = (bf16*)(ws + (pn < 8 ? WS_U : WS_VS)) + ((pn - 4) & 3) * 256 + c8;
#pragma unroll
            for (int ai = 0; ai < 2; ++ai)
#pragma unroll
                for (int m = 0; m < 4; ++m) { const int row = row0 + ai * 128 + m * 16;
#pragma unroll
                    for (int bj = 0; bj < 2; ++bj) { f32x4 a = acc[ai][bj][m][0], b = acc[ai][bj][m][1];
#pragma unroll
                        for (int j = 0; j < 4; ++j) { a[j] = gelu_fast(a[j]); b[j] = gelu_fast(b[j]); }
                        *(u32x4*)(base + (size_t)row * 1024 + bj * 128) = pg8::pack8(a, b); } }
        } else if (wc < 2) {
            const float* tab = (const float*)(ws + WS_ROPE);
#pragma unroll
            for (int ai = 0; ai < 2; ++ai)
#pragma unroll
                for (int m = 0; m < 4; ++m) { const int row = row0 + ai * 128 + m * 16; f32x4 a = acc[ai][0][m][0], b = acc[ai][0][m][1]; int bb, kpos;
                    if (row < M) { bb = row >> 12; kpos = row & 4095; const int ax = wc ? (kpos & 63) : (kpos >> 6); rope8(a, b, tab + ax * 32, fq); }
                    else { bb = (row - M) >> 8; kpos = L + ((row - M) & 255); }
                    const u32x4 w = pg8::pack8(a, b); bf16* d = (bf16*)(ws + WS_K) + ((size_t)(bb * H) * LK + kpos) * DQK + 128 + c8;
#pragma unroll
                    for (int hh = 0; hh < H; ++hh) *(u32x4*)(d + (size_t)hh * LK * DQK) = w; }
        }
    }
};
struct EpiQKV {
    static constexpr bool PERM = true; unsigned char* ws;
    __device__ __forceinline__ void operator()(const f32x4 (&acc)[2][2][4][2], const Unit& u, int wr, int wc, int fr, int fq) const {
        const int c8 = wc * 32 + 8 * fq;
        if (u.pn < 6) {
            const int pn = u.pn, row0 = u.pm * 256 + wr * 64 + fr; const float* tab = (const float*)(ws + WS_ROPE);
#pragma unroll
            for (int ai = 0; ai < 2; ++ai)
#pragma unroll
                for (int m = 0; m < 4; ++m) { const int row = row0 + ai * 128 + m * 16; const int bb = row >> 12, t = row & 4095;
                    const f32x4 s0 = *(const f32x4*)((const float*)(ws + WS_SSQQ) + (size_t)row * 8), s1 = *(const f32x4*)((const float*)(ws + WS_SSQQ) + (size_t)row * 8 + 4);
                    const float rs = rsqrtf((((s0[0] + s0[1]) + (s0[2] + s0[3])) + ((s1[0] + s1[1]) + (s1[2] + s1[3]))) * (1.f / 512.f) + EPS);
#pragma unroll
                    for (int bj = 0; bj < 2; ++bj) { f32x4 a = acc[ai][bj][m][0] * rs, b = acc[ai][bj][m][1] * rs; bf16* d;
                        if (pn < 4) d = (bf16*)(ws + WS_Q) + ((size_t)(bb * H + pn * 2 + bj) * L + t) * DQK + c8;
                        else { const int hd = (pn - 4) * 4 + bj * 2 + (wc >> 1), ax = (wc & 1) ? (t & 63) : (t >> 6); rope8(a, b, tab + ax * 32, fq);
                            d = (bf16*)(ws + WS_Q) + ((size_t)(bb * H + hd) * L + t) * DQK + 128 + (wc & 1) * 32 + 8 * fq; }
                        *(u32x4*)d = pg8::pack8(a, b); } }
        } else {
            const int hd = u.pn - 6, row0 = (u.pm - 64) * 256 + wr * 64 + fr;
#pragma unroll
            for (int ai = 0; ai < 2; ++ai)
#pragma unroll
                for (int m = 0; m < 4; ++m) { const int row = row0 + ai * 128 + m * 16; int bb, kpos;
                    if (row < M) { bb = row >> 12; kpos = row & 4095; } else { bb = (row - M) >> 8; kpos = L + ((row - M) & 255); }
                    const f32x4 s0 = *(const f32x4*)((const float*)(ws + WS_SSQKV) + (size_t)row * 8), s1 = *(const f32x4*)((const float*)(ws + WS_SSQKV) + (size_t)row * 8 + 4);
                    const float rs = rsqrtf((((s0[0] + s0[1]) + (s0[2] + s0[3])) + ((s1[0] + s1[1]) + (s1[2] + s1[3]))) * (1.f / 512.f) + EPS);
                    const size_t kr = (size_t)(bb * H + hd) * LK + kpos;
                    *(u32x4*)((bf16*)(ws + WS_K) + kr * DQK + c8) = pg8::pack8(acc[ai][0][m][0] * rs, acc[ai][0][m][1] * rs);
                    *(u32x4*)((bf16*)(ws + WS_V) + kr * VH + c8) = pg8::pack8(acc[ai][1][m][0] * rs, acc[ai][1][m][1] * rs); }
        }
    }
};
struct EpiY {
    static constexpr bool PERM = true; unsigned char* ws;
    __device__ __forceinline__ void operator()(const f32x4 (&acc)[2][2][4][2], const Unit& u, int wr, int wc, int fr, int fq) const {
        const int row0 = u.pm * 256 + wr * 64 + fr; bf16* base = (bf16*)(ws + WS_Y) + u.pn * 256 + wc * 32 + 8 * fq; float* ssq = (float*)(ws + WS_SSQY) + u.pn * 4 + wc;
#pragma unroll
        for (int ai = 0; ai < 2; ++ai)
#pragma unroll
            for (int m = 0; m < 4; ++m) { const int row = row0 + ai * 128 + m * 16; float s = 0.f;
#pragma unroll
                for (int bj = 0; bj < 2; ++bj) { s += dot4(acc[ai][bj][m][0]) + dot4(acc[ai][bj][m][1]); *(u32x4*)(base + (size_t)row * D + bj * 128) = pg8::pack8(acc[ai][bj][m][0], acc[ai][bj][m][1]); }
                s += __shfl_xor(s, 16); s += __shfl_xor(s, 32);
                if (fq == 0) ssq[(size_t)row * 32] = s; }
    }
};
struct EpiAct {
    static constexpr bool PERM = true; unsigned char* ws;
    __device__ __forceinline__ void operator()(const f32x4 (&acc)[2][2][4][2], const Unit& u, int wr, int wc, int fr, int fq) const {
        const int row0 = u.pm * 256 + wr * 64 + fr; bf16* base = (bf16*)(ws + WS_ACT) + u.pn * 128 + wc * 32 + 8 * fq;
#pragma unroll
        for (int ai = 0; ai < 2; ++ai)
#pragma unroll
            for (int m = 0; m < 4; ++m) { const int row = row0 + ai * 128 + m * 16; f32x4 a, b;
#pragma unroll
                for (int j = 0; j < 4; ++j) { a[j] = silu_fast(acc[ai][0][m][0][j]) * acc[ai][1][m][0][j]; b[j] = silu_fast(acc[ai][0][m][1][j]) * acc[ai][1][m][1][j]; }
                *(u32x4*)(base + (size_t)row * FF) = pg8::pack8(a, b); }
    }
};
struct EpiYE {
    static constexpr bool PERM = true; unsigned char* ws;
    __device__ __forceinline__ void operator()(const f32x4 (&acc)[2][2][4][2], const Unit& u, int wr, int wc, int fr, int fq) const {
        const int row0 = u.pm * 256 + wr * 64 + fr; bf16* base = (bf16*)(ws + WS_YE) + u.pn * 256 + wc * 32 + 8 * fq;
#pragma unroll
        for (int ai = 0; ai < 2; ++ai)
#pragma unroll
            for (int m = 0; m < 4; ++m) { const int row = row0 + ai * 128 + m * 16;
#pragma unroll
                for (int bj = 0; bj < 2; ++bj) *(u32x4*)(base + (size_t)row * D + bj * 128) = pg8::pack8(acc[ai][bj][m][0], acc[ai][bj][m][1]); }
    }
};

namespace att {
using bf16x8 = __attribute__((ext_vector_type(8))) short;
using s16x4  = __attribute__((ext_vector_type(4))) short;
using f32x16 = __attribute__((ext_vector_type(16))) float;
using u32x4  = __attribute__((ext_vector_type(4))) unsigned;
constexpr int QBLK = 32, KVBLK = 64, NW = 8;
constexpr float SCALE = cfg::ATT_SCALE, THR = 8.f;
constexpr int LDQ = 192, LDKK = 192, LDV = 128, LDO = 2048;
constexpr int SHM_V = KVBLK * 128 * 2, SHM_K = KVBLK * 192 * 2, SHM_ATTN = 2 * SHM_V + 2 * SHM_K + NW * 64 * 4;
#define KSWZ(row, colB) ((row) * 384 + ((colB) ^ (((row) & 7) << 4)))
#define SBAR() __builtin_amdgcn_sched_barrier(0)
__device__ __forceinline__ int crow(int r, int hi) { return (r & 3) + 8 * (r >> 2) + 4 * hi; }
__device__ __forceinline__ unsigned cvtpk(float lo, float hi) { unsigned r; asm volatile("v_cvt_pk_bf16_f32 %0, %1, %2" : "=v"(r) : "v"(lo), "v"(hi)); return r; }

__device__ __forceinline__ void partialSM(f32x16& p0, f32x16& p1, float& m_reg, float& mn, float& alpha) {
  constexpr float C = SCALE * 1.4426950408889634f;
  float pmax = p0[0];
#pragma unroll
  for (int r = 1; r < 16; ++r) pmax = fmaxf(pmax, p0[r]);
#pragma unroll
  for (int r = 0; r < 16; ++r) pmax = fmaxf(pmax, p1[r]);
  { auto rr = __builtin_amdgcn_permlane32_swap(__float_as_uint(pmax), __float_as_uint(pmax), false, false);
    pmax = fmaxf(__uint_as_float(rr[0]), __uint_as_float(rr[1])); }
  if (__builtin_expect(__all(pmax - m_reg <= THR / SCALE), 1)) { mn = m_reg; alpha = 1.f; }
  else { mn = fmaxf(m_reg, pmax); alpha = __builtin_amdgcn_exp2f((m_reg - mn) * C); m_reg = mn; }
  float mnC = -mn * C;
#pragma unroll
  for (int r = 0; r < 16; ++r) p0[r] = fmaf(p0[r], C, mnC);
#pragma unroll
  for (int r = 0; r < 16; ++r) p1[r] = fmaf(p1[r], C, mnC);
#pragma unroll
  for (int r = 0; r < 16; ++r) p0[r] = __builtin_amdgcn_exp2f(p0[r]);
}
__device__ __forceinline__ void finishSM(f32x16& p0, f32x16& p1, float alpha, float& l_reg, bf16x8& pa0, bf16x8& pa1, bf16x8& pa2, bf16x8& pa3) {
#pragma unroll
  for (int r = 0; r < 16; ++r) p1[r] = __builtin_amdgcn_exp2f(p1[r]);
  float ps = 0;
#pragma unroll
  for (int r = 0; r < 16; ++r) ps += p0[r];
#pragma unroll
  for (int r = 0; r < 16; ++r) ps += p1[r];
  { auto rr = __builtin_amdgcn_permlane32_swap(__float_as_uint(ps), __float_as_uint(ps), false, false);
    ps = __uint_as_float(rr[0]) + __uint_as_float(rr[1]); }
  l_reg = l_reg * alpha + ps;
#define PK4(P, BASE, OUT) do { unsigned a0 = cvtpk(P[BASE + 0], P[BASE + 1]), a1 = cvtpk(P[BASE + 2], P[BASE + 3]);   \
    unsigned b0 = cvtpk(P[BASE + 4], P[BASE + 5]), b1 = cvtpk(P[BASE + 6], P[BASE + 7]);                              \
    auto r0 = __builtin_amdgcn_permlane32_swap(a0, b0, false, false); auto r1 = __builtin_amdgcn_permlane32_swap(a1, b1, false, false); \
    u32x4 w = {r0[0], r1[0], r0[1], r1[1]}; OUT = *reinterpret_cast<bf16x8*>(&w); } while (0)
  PK4(p0, 0, pa0); PK4(p0, 8, pa1); PK4(p1, 0, pa2); PK4(p1, 8, pa3);
#undef PK4
}
__device__ __forceinline__ void qkt(f32x16& p0, f32x16& p1, const char* Ks, const bf16x8* qr, int r32, int hi) {
  p0 = f32x16{}; p1 = f32x16{};
#pragma unroll
  for (int d0 = 0; d0 < 12; ++d0) { const int cb = (d0 * 16 + hi * 8) * 2;
    bf16x8 b0 = *reinterpret_cast<const bf16x8*>(Ks + KSWZ(r32, cb));
    bf16x8 b1 = *reinterpret_cast<const bf16x8*>(Ks + KSWZ(32 + r32, cb));
    p0 = __builtin_amdgcn_mfma_f32_32x32x16_bf16(b0, qr[d0], p0, 0, 0, 0);
    p1 = __builtin_amdgcn_mfma_f32_32x32x16_bf16(b1, qr[d0], p1, 0, 0, 0); }
}
__device__ __forceinline__ int v_st(int k, int c) { const int kk = (k & ~0xC) | ((k & 4) << 1) | ((k & 8) >> 1); return ((kk >> 3) * 4 + (c >> 5)) * 512 + ((kk & 7) * 32 + (c & 31)) * 2; }
__device__ __forceinline__ int v_rd_base(int lane) { return ((lane & 3) << 3) | (((lane >> 2) & 3) << 6) | (((lane >> 4) & 1) << 5) | (((lane >> 5) & 1) << 8); }
constexpr int v_rd_off(int d0, int ks, int half) { return d0 * 512 + ks * 4096 + half * 2048; }
template <int OFF> __device__ __forceinline__ s16x4 tr_read(int vb) {
  s16x4 r; asm volatile("ds_read_b64_tr_b16 %0, %1 offset:%2" : "=&v"(r) : "v"(vb), "i"(OFF) : "memory"); return r;
}
template <int D0> __device__ __forceinline__ void pv_one(f32x16& od, int vb, bf16x8 pa0, bf16x8 pa1, bf16x8 pa2, bf16x8 pa3) {
  const s16x4 l0 = tr_read<v_rd_off(D0, 0, 0)>(vb), h0 = tr_read<v_rd_off(D0, 0, 1)>(vb), l1 = tr_read<v_rd_off(D0, 1, 0)>(vb), h1 = tr_read<v_rd_off(D0, 1, 1)>(vb);
  const s16x4 l2 = tr_read<v_rd_off(D0, 2, 0)>(vb), h2 = tr_read<v_rd_off(D0, 2, 1)>(vb), l3 = tr_read<v_rd_off(D0, 3, 0)>(vb), h3 = tr_read<v_rd_off(D0, 3, 1)>(vb);
  asm volatile("s_waitcnt lgkmcnt(0)" ::: "memory"); SBAR();
#define PK(L, H) (bf16x8){L[0], L[1], L[2], L[3], H[0], H[1], H[2], H[3]}
  od = __builtin_amdgcn_mfma_f32_32x32x16_bf16(pa0, PK(l0, h0), od, 0, 0, 0);
  od = __builtin_amdgcn_mfma_f32_32x32x16_bf16(pa1, PK(l1, h1), od, 0, 0, 0);
  od = __builtin_amdgcn_mfma_f32_32x32x16_bf16(pa2, PK(l2, h2), od, 0, 0, 0);
  od = __builtin_amdgcn_mfma_f32_32x32x16_bf16(pa3, PK(l3, h3), od, 0, 0, 0);
#undef PK
}
__device__ __forceinline__ void pv_d0(f32x16* o, int vb, bf16x8 pa0, bf16x8 pa1, bf16x8 pa2, bf16x8 pa3) {
  pv_one<0>(o[0], vb, pa0, pa1, pa2, pa3); pv_one<1>(o[1], vb, pa0, pa1, pa2, pa3); pv_one<2>(o[2], vb, pa0, pa1, pa2, pa3); pv_one<3>(o[3], vb, pa0, pa1, pa2, pa3);
}
__device__ __forceinline__ void attn_unit(const bf16* __restrict__ Qb, const bf16* __restrict__ Kh, const bf16* __restrict__ Vh, bf16* __restrict__ Ob, int seq, char* lds) {
  const int tid = threadIdx.x, wid = tid >> 6, lane = tid & 63, r32 = lane & 31, hi = lane >> 5;
  char* V_lds = lds; char* K_lds = lds + 2 * SHM_V;
  float* ws = (float*)(lds + 2 * SHM_V + 2 * SHM_K) + wid * 64; float* li_l = ws; float* al_l = ws + 32;
  float m_reg = -1e30f, l_reg = 0; f32x16 o[4] = {}; bf16x8 qr[12];
  const bf16* Qw = Qb + (long)(wid * QBLK + r32) * LDQ + hi * 8;
#pragma unroll
  for (int d0 = 0; d0 < 12; ++d0) qr[d0] = *reinterpret_cast<const bf16x8*>(Qw + d0 * 16);
  const int sr = tid >> 4, sc = (tid & 15) * 8, vst0 = v_st(sr, sc), vst1 = v_st(32 + sr, sc);
  int kro[3], kst[3];
#pragma unroll
  for (int j = 0; j < 3; ++j) { const int p = tid + 512 * j, row = p / 24, pc = p - row * 24; kro[j] = row * LDKK + pc * 8; kst[j] = KSWZ(row, pc * 16); }
  const int vb0 = (int)(uintptr_t)V_lds + v_rd_base(lane);
  bf16x8 vs0, vs1, ks0, ks1, ks2;
#define SLOAD(k0) do { vs0 = *reinterpret_cast<const bf16x8*>(&Vh[(long)((k0) + sr) * LDV + sc]); vs1 = *reinterpret_cast<const bf16x8*>(&Vh[(long)((k0) + 32 + sr) * LDV + sc]); \
    ks0 = *reinterpret_cast<const bf16x8*>(&Kh[(long)(k0) * LDKK + kro[0]]); ks1 = *reinterpret_cast<const bf16x8*>(&Kh[(long)(k0) * LDKK + kro[1]]); ks2 = *reinterpret_cast<const bf16x8*>(&Kh[(long)(k0) * LDKK + kro[2]]); } while (0)
#define SWRITE(b) do { *(bf16x8*)(V_lds + (b) * SHM_V + vst0) = vs0; *(bf16x8*)(V_lds + (b) * SHM_V + vst1) = vs1; \
    *(bf16x8*)(K_lds + (b) * SHM_K + kst[0]) = ks0; *(bf16x8*)(K_lds + (b) * SHM_K + kst[1]) = ks1; *(bf16x8*)(K_lds + (b) * SHM_K + kst[2]) = ks2; } while (0)
#define SWAIT() asm volatile("s_waitcnt vmcnt(0)" ::: "memory")
#define RESC(a) do { if (__any((a) < 1.f)) { if (hi == 0) al_l[r32] = (a); asm volatile("s_waitcnt lgkmcnt(0)" ::: "memory"); \
    _Pragma("unroll") for (int d = 0; d < 4; ++d) _Pragma("unroll") for (int r = 0; r < 16; ++r) o[d][r] *= al_l[crow(r, hi)]; } } while (0)
  f32x16 pA0, pA1; float mnA, alA; bf16x8 pa0, pa1, pa2, pa3; const int NT = seq / KVBLK;
  SLOAD(0); SWAIT(); SWRITE(0); __syncthreads();
  for (int j = 0; j < NT; ++j) {
    const int bsel = j & 1;
    SBAR(); qkt(pA0, pA1, K_lds + bsel * SHM_K, qr, r32, hi);
    partialSM(pA0, pA1, m_reg, mnA, alA);
    RESC(alA);
    finishSM(pA0, pA1, alA, l_reg, pa0, pa1, pa2, pa3); SBAR();
    if (j + 1 < NT) SLOAD((j + 1) * KVBLK);
    SBAR();
    pv_d0(o, vb0 + bsel * (int)SHM_V, pa0, pa1, pa2, pa3);
    if (j + 1 < NT) { SWAIT(); if (bsel) SWRITE(0); else SWRITE(1); }
    __syncthreads();
  }
  if (hi == 0) li_l[r32] = l_reg; asm volatile("s_waitcnt lgkmcnt(0)" ::: "memory");
  float rli[16];
#pragma unroll
  for (int r = 0; r < 16; ++r) rli[r] = __builtin_amdgcn_rcpf(li_l[crow(r, hi)]);
  bf16* Ow = Ob + (long)(wid * QBLK) * LDO;
#pragma unroll
  for (int r = 0; r < 16; ++r) { const int orow = crow(r, hi);
#pragma unroll
    for (int d0 = 0; d0 < 4; ++d0) Ow[(long)orow * LDO + d0 * 32 + r32] = f2bf(o[d0][r] * rli[r]); }
#undef SLOAD
#undef SWRITE
#undef SWAIT
#undef RESC
}
#undef KSWZ
#undef SBAR
}

#define XB_TMO      128
#define XB_XCNT(j)  (256  + 64 * (j))
#define XB_XSUB(j)  (1280 + 64 * (j))
#define XB_XGEN(j)  (2304 + 64 * (j))
#define XB_TOP      3328
#define XB_TOPGEN   3392
#define XCD_BAR_WORDS 3456
#define XB_SPIN_CAP (1u << 18)
__device__ __forceinline__ unsigned xb_ld(unsigned* p)              { return __hip_atomic_load(p, __ATOMIC_RELAXED, __HIP_MEMORY_SCOPE_AGENT); }
__device__ __forceinline__ unsigned xb_add(unsigned* p, unsigned v) { return __hip_atomic_fetch_add(p, v, __ATOMIC_RELAXED, __HIP_MEMORY_SCOPE_AGENT); }
__device__ __forceinline__ unsigned xb_xcc_id() { return (unsigned)__builtin_amdgcn_s_getreg((3 << 11) | 20) & 0xFu; }
#define XB_SPIN(cond, bar) do { unsigned _sp = 0; while (cond) { __builtin_amdgcn_s_sleep(1); \
    if ((++_sp & 255u) == 0u) { if (xb_ld(&(bar)[XB_TMO])) break; if (_sp > XB_SPIN_CAP) { atomicAdd(&(bar)[XB_TMO], 1u); break; } } } } while (0)
struct XcdBarrier { unsigned* bar; unsigned x; volatile LAS unsigned* st; };
__device__ __forceinline__ XcdBarrier xcd_barrier_post(unsigned* bar, volatile LAS unsigned* st) {
    XcdBarrier b; b.bar = bar; b.x = xb_xcc_id(); b.st = st;
    if (threadIdx.x == 0) (void)xb_add(&bar[XB_XCNT(b.x)], 1u);
    return b;
}
__device__ __forceinline__ void xcd_barrier_complete(unsigned* bar, unsigned x, unsigned& nloc, unsigned& nx) {
    const unsigned G = gridDim.x * gridDim.y * gridDim.z;
    unsigned sum, cnt, mine, sp = 0u;
    for (;;) {
        sum = 0u; cnt = 0u; mine = 0u;
#pragma unroll
        for (unsigned j = 0; j < 16; ++j) { const unsigned c = xb_ld(&bar[XB_XCNT(j)]); sum += c; cnt += (c > 0u) ? 1u : 0u; mine = (j == x) ? c : mine; }
        if (sum == G) break;
        __builtin_amdgcn_s_sleep(1);
        if ((++sp & 255u) == 0u) { if (xb_ld(&bar[XB_TMO])) break; if (sp > XB_SPIN_CAP) { atomicAdd(&bar[XB_TMO], 1u); break; } }
    }
    nloc = mine > 0u ? mine : 1u; nx = cnt > 0u ? cnt : 1u;
}
__device__ __forceinline__ void xcd_barrier(const XcdBarrier& b) {
    asm volatile("s_waitcnt vmcnt(0)" ::: "memory");
    __syncthreads();
    if (threadIdx.x == 0) {
        unsigned* bar = b.bar;
        __builtin_amdgcn_s_waitcnt(0);
        unsigned nloc = b.st[0], nx = b.st[1];
        if (nloc == 0u) { xcd_barrier_complete(bar, b.x, nloc, nx); b.st[0] = nloc; b.st[1] = nx; }
        const unsigned old = xb_add(&bar[XB_XSUB(b.x)], 1u);
        const unsigned gen = old / nloc;
        if (old + 1u == (gen + 1u) * nloc) {
            __builtin_amdgcn_fence(__ATOMIC_RELEASE, "agent");
            asm volatile("s_waitcnt vmcnt(0)" ::: "memory");
            const unsigned og = xb_add(&bar[XB_TOP], 1u);
            const unsigned tg = og / nx;
            if (og + 1u == (tg + 1u) * nx) xb_add(&bar[XB_TOPGEN], 1u);
            else XB_SPIN(xb_ld(&bar[XB_TOPGEN]) == tg, bar);
            __builtin_amdgcn_fence(__ATOMIC_ACQUIRE, "agent");
            xb_add(&bar[XB_XGEN(b.x)], 1u);
            asm volatile("s_waitcnt vmcnt(0)" ::: "memory");
        } else {
            XB_SPIN(xb_ld(&bar[XB_XGEN(b.x)]) == gen, bar);
            __builtin_amdgcn_fence(__ATOMIC_ACQUIRE, "agent");
            asm volatile("s_waitcnt vmcnt(0)" ::: "memory");
        }
    }
    __syncthreads();
}

constexpr int NWAVES = 8, NTHREADS = 512;
constexpr int RING_BYTES = 131072, TAB_OFF = RING_BYTES, TAB_BYTES = 8192, MISC_OFF = TAB_OFF + TAB_BYTES, LDS_BYTES = 147456;
constexpr int CW_BAR = 4096;
#define LDS_WAIT() asm volatile("s_waitcnt lgkmcnt(0)" ::: "memory")
typedef unsigned v4u __attribute__((ext_vector_type(4)));
__device__ __forceinline__ unsigned pk2(float lo, float hi) { return (unsigned)f2bf(lo) | ((unsigned)f2bf(hi) << 16); }

__device__ __forceinline__ void p0_mod_item(const Ptrs& p, int it, int lane) {
    const int kc = it / 48, cc = it - kc * 48, k0 = kc * 64, c0 = cc * 256 + lane * 4;
    float sv[5];
#pragma unroll
    for (int r = 0; r < 5; ++r) { const float* cv = r < 4 ? p.c + r * D : p.c_ctx; sv[r] = silu_f(cv[k0 + lane]); }
    f32x4 acc[5];
#pragma unroll
    for (int r = 0; r < 5; ++r) acc[r] = (f32x4){0.f, 0.f, 0.f, 0.f};
    const float* w = p.w_ada + (size_t)k0 * 12288 + c0;
#pragma unroll 8
    for (int k = 0; k < 64; ++k) { const f32x4 wv = *(const f32x4*)(w + (size_t)k * 12288);
#pragma unroll
        for (int r = 0; r < 5; ++r) acc[r] += __int_as_float(__builtin_amdgcn_readlane(__float_as_int(sv[r]), k)) * wv; }
    float* part = (float*)(p.ws + WS_PART) + (size_t)kc * 5 * 12288 + c0;
#pragma unroll
    for (int r = 0; r < 5; ++r) *(f32x4*)(part + (size_t)r * 12288) = acc[r];
}
__device__ __forceinline__ void cvt_item(const float* src, int ldw, bf16* dst, int ldk, bool rope, const float* kscale, LAS float* scr, int lane) {
    const int cs = lane & 31, nn = rope ? ((cs & 15) * 2 + (cs >> 4)) : cs;
#pragma unroll 8
    for (int i = 0; i < 32; ++i) { const int kk = 2 * i + (lane >> 5); float v = src[(size_t)kk * ldw + cs]; if (kscale) v *= kscale[kk]; scr[kk * 33 + nn] = v; }
    LDS_WAIT(); asm volatile("" ::: "memory");
    const int c = lane & 7;
#pragma unroll
    for (int j = 0; j < 4; ++j) { const int n = (lane >> 3) + 8 * j; const LAS float* s = scr + (8 * c) * 33 + n;
        v4u o; o.x = pk2(s[0 * 33], s[1 * 33]); o.y = pk2(s[2 * 33], s[3 * 33]); o.z = pk2(s[4 * 33], s[5 * 33]); o.w = pk2(s[6 * 33], s[7 * 33]);
        *(v4u*)(dst + (size_t)n * ldk + 8 * c) = o; }
    LDS_WAIT(); asm volatile("" ::: "memory");
}
constexpr int I_MOD = 1536, I_WIN = 32 * 98, I_WQ = 8 * 48, I_WKV = 8 * 64, I_WOUT = 32 * 64, I_GU = 16 * 32 * 128, I_DN = 16 * 32 * 64, I_SGU = 256, I_ZERO = 768, I_ROPE = 1;
constexpr int P0_ITEMS = I_MOD + I_WIN + I_WQ + I_WKV + I_WOUT + I_GU + I_DN + I_SGU + I_ZERO + I_ROPE;
__device__ __forceinline__ void p0_item(const Ptrs& p, int it, LAS float* scr, int lane) {
    if (it < I_MOD) { p0_mod_item(p, it, lane); return; } it -= I_MOD;
    if (it < I_WIN) { const int kb = it / 98, nb = it - kb * 98, n0 = nb * 32; int col0; bool rope = false;
        if (n0 < 1024) col0 = n0; else if (n0 < 3072) col0 = n0 + 64; else { col0 = OFF_KPE + (nb - 96) * 32; rope = true; }
        cvt_item(p.w_in + (size_t)kb * 64 * INC + col0, INC, (bf16*)(p.ws + WS_WIN_T) + (size_t)n0 * D + kb * 64, D, rope, nullptr, scr, lane); return; } it -= I_WIN;
    if (it < I_WQ) { const int kb = it / 48, nb = it - kb * 48, n0 = nb * 32; int col0; bool rope = false;
        if (n0 < 1024) col0 = (n0 >> 7) * DQK + (n0 & 127); else { const int jj = n0 - 1024; col0 = (jj >> 6) * DQK + 128 + ((jj & 63) >> 5) * 32; rope = true; }
        cvt_item(p.w_uq + (size_t)kb * 64 * 1536 + col0, 1536, (bf16*)(p.ws + WS_WQKV_T) + (size_t)n0 * 512 + kb * 64, 512, rope, p.q_norm_w + kb * 64, scr, lane); return; } it -= I_WQ;
    if (it < I_WKV) { const int kb = it / 64, nb = it - kb * 64, n0 = nb * 32;
        cvt_item(p.w_ukv + (size_t)kb * 64 * 2048 + n0, 2048, (bf16*)(p.ws + WS_WQKV_T) + (size_t)(1536 + n0) * 512 + kb * 64, 512, false, p.kv_norm_w + kb * 64, scr, lane); return; } it -= I_WKV;
    if (it < I_WOUT) { const int kb = it / 64, nb = it - kb * 64, n0 = nb * 32;
        cvt_item(p.w_out + (size_t)kb * 64 * D + n0, D, (bf16*)(p.ws + WS_WOUT_T) + (size_t)n0 * D + kb * 64, D, false, nullptr, scr, lane); return; } it -= I_WOUT;
    if (it < I_GU) { const int e = it >> 12, r = it & 4095, kb = r >> 7, nb = r & 127, n0 = nb * 32, pn = n0 >> 8, within = n0 & 255;
        const float* src = (within < 128 ? p.w_e_gate : p.w_e_up) + ((size_t)e * D + kb * 64) * FF + pn * 128 + (within & 127);
        cvt_item(src, FF, (bf16*)(p.ws + WS_WGU_T) + ((size_t)e * 4096 + n0) * D + kb * 64, D, false, nullptr, scr, lane); return; } it -= I_GU;
    if (it < I_DN) { const int e = it >> 11, r = it & 2047, kb = r >> 6, nb = r & 63, n0 = nb * 32;
        cvt_item(p.w_e_down + ((size_t)e * FF + kb * 64) * D + n0, D, (bf16*)(p.ws + WS_WD_T) + ((size_t)e * D + n0) * FF + kb * 64, FF, false, nullptr, scr, lane); return; } it -= I_DN;
    if (it < I_SGU) { const float* s = p.sgu_w + (size_t)it * 512 + lane * 8; const f32x4 a = *(const f32x4*)s, b = *(const f32x4*)(s + 4);
        v4u o; o.x = pk2(a[0], a[1]); o.y = pk2(a[2], a[3]); o.z = pk2(b[0], b[1]); o.w = pk2(b[2], b[3]); *(v4u*)((bf16*)(p.ws + WS_SGUW) + (size_t)it * 512 + lane * 8) = o; return; } it -= I_SGU;
    if (it < I_ZERO) { *(v4u*)((bf16*)(p.ws + WS_WIN_T) + (size_t)3136 * D + (size_t)it * 512 + lane * 8) = (v4u){0u, 0u, 0u, 0u}; return; }
    float* tab = (float*)(p.ws + WS_ROPE);
    for (int j = 0; j < 16; ++j) { const int idx = j * 64 + lane, ax = idx >> 4, ii = idx & 15; float s, c; sincosf((float)ax * rope_inv(ii), &s, &c); tab[idx * 2] = c; tab[idx * 2 + 1] = s; }
}
__device__ __forceinline__ void p1_row(const Ptrs& p, int row, int lane) {
    const float* src = row < M ? p.x + (size_t)row * D : p.ctx + (size_t)(row - M) * D;
    const float* mod = (const float*)(p.ws + WS_MOD) + (row < M ? row >> 12 : 4) * 12288;
    f32x4 v[8]; float s = 0.f;
#pragma unroll
    for (int j = 0; j < 8; ++j) { v[j] = *(const f32x4*)(src + j * 256 + lane * 4); s += dot4(v[j]); }
    const float rs = rsqrtf(wave_sum(s) * (1.f / D) + EPS);
    bf16* o = (bf16*)(p.ws + WS_H) + (size_t)row * D;
#pragma unroll
    for (int j = 0; j < 8; ++j) { const int c = j * 256 + lane * 4; const f32x4 g = *(const f32x4*)(p.pre_norm1 + c), sc = *(const f32x4*)(mod + 2048 + c), sh = *(const f32x4*)(mod + c);
        const f32x4 h = v[j] * rs * g * (1.f + sc) + sh; *(unsigned long long*)(o + c) = (unsigned long long)pk2(h[0], h[1]) | ((unsigned long long)pk2(h[2], h[3]) << 32); }
}
typedef float f32x16 __attribute__((ext_vector_type(16)));
typedef short bf16x8v __attribute__((ext_vector_type(8)));
__device__ __forceinline__ void sgu_unit(const Ptrs& p, int chunk, int g, LAS unsigned char* lds, int tid) {
    constexpr int VROW = 272;
    const int lane = tid & 63, wid = tid >> 6;
    {
        const int q = tid >> 2, cg = tid & 3;
        const bf16* src = (const bf16*)(p.ws + WS_VS) + (size_t)(chunk * 128 + q) * 1024 + g * 128 + cg * 32;
        float x[32];
#pragma unroll
        for (int j = 0; j < 4; ++j) { const v4u w = *(const v4u*)(src + j * 8);
#pragma unroll
            for (int t = 0; t < 4; ++t) { x[j * 8 + 2 * t] = __uint_as_float(w[t] << 16); x[j * 8 + 2 * t + 1] = __uint_as_float(w[t] & 0xffff0000u); } }
        float s = 0.f;
#pragma unroll
        for (int j = 0; j < 32; ++j) s += x[j];
        s += __shfl_xor(s, 1); s += __shfl_xor(s, 2);
        const float mu = s * (1.f / 128.f); float vq = 0.f;
#pragma unroll
        for (int j = 0; j < 32; ++j) { x[j] -= mu; vq += x[j] * x[j]; }
        vq += __shfl_xor(vq, 1); vq += __shfl_xor(vq, 2);
        const float rs = rsqrtf(vq * (1.f / 128.f) + EPS);
        const float* gw = p.sgu_norm_w + g * 128 + cg * 32;
#pragma unroll
        for (int j = 0; j < 32; ++j) *(LAS bf16*)(lds + (cg * 32 + j) * VROW + q * 2) = f2bf(x[j] * rs * gw[j]);
    }
    LDS_WAIT(); __syncthreads();
    const int pb = wid >> 1, ch = wid & 1, r32 = lane & 31, hi = lane >> 5;
    f32x16 acc0 = {}, acc1 = {};
    const bf16* wrow = (const bf16*)(p.ws + WS_SGUW) + ((size_t)g * 128 + pb * 32 + r32) * 128 + hi * 8;
#pragma unroll
    for (int ks = 0; ks < 8; ++ks) {
        const bf16x8v a = *(const bf16x8v*)(wrow + ks * 16);
        const bf16x8v b0 = *(const LAS bf16x8v*)(lds + (ch * 64 + r32) * VROW + (ks * 16 + hi * 8) * 2);
        const bf16x8v b1 = *(const LAS bf16x8v*)(lds + (ch * 64 + 32 + r32) * VROW + (ks * 16 + hi * 8) * 2);
        acc0 = __builtin_amdgcn_mfma_f32_32x32x16_bf16(a, b0, acc0, 0, 0, 0);
        acc1 = __builtin_amdgcn_mfma_f32_32x32x16_bf16(a, b1, acc1, 0, 0, 0);
    }
#pragma unroll
    for (int r = 0; r < 16; ++r) { const int pr = pb * 32 + (r & 3) + 8 * (r >> 2) + 4 * hi; const size_t tok = (size_t)chunk * 128 + pr; const float bias = p.sgu_b[g * 128 + pr];
        const bf16* ur = (const bf16*)(p.ws + WS_U) + tok * 1024 + g * 128 + ch * 64 + r32; bf16* orow = (bf16*)(p.ws + WS_CAT) + tok * D + 1024 + g * 128 + ch * 64 + r32;
        orow[0] = f2bf(bf2f(ur[0]) * (acc0[r] + bias)); orow[32] = f2bf(bf2f(ur[32]) * (acc1[r] + bias)); }
    __syncthreads();
}
__device__ __forceinline__ void topk_unit(const Ptrs& p, int e, int b, LAS unsigned* sh, int tid) {
    const int lane = tid & 63, wid = tid >> 6;
    const float* aff = (const float*)(p.ws + WS_AFF) + (size_t)b * L * 16 + e;
    unsigned key[8];
#pragma unroll
    for (int j = 0; j < 8; ++j) key[j] = __float_as_uint(aff[(size_t)(tid * 8 + j) * 16]);
    unsigned prefix = 0u, mask = 0u, need = CAP;
    for (int shift = 24; shift >= 0; shift -= 8) {
        if (tid < 256) sh[tid] = 0u;
        __syncthreads();
#pragma unroll
        for (int j = 0; j < 8; ++j) if ((key[j] & mask) == prefix) atomicAdd((unsigned*)&sh[(key[j] >> shift) & 255u], 1u);
        __syncthreads();
        if (wid == 0) {
            const unsigned c0 = sh[4 * lane], c1 = sh[4 * lane + 1], c2 = sh[4 * lane + 2], c3 = sh[4 * lane + 3];
            const unsigned s = c0 + c1 + c2 + c3; unsigned S = s;
#pragma unroll
            for (int d = 1; d < 64; d <<= 1) { const unsigned v = __shfl_down(S, d); if (lane + d < 64) S += v; }
            const unsigned above = S - s;
            if (S >= need && above < need) { unsigned cum = above, bin, nd;
                if (cum + c3 >= need) { bin = 3; nd = need - cum; } else { cum += c3;
                if (cum + c2 >= need) { bin = 2; nd = need - cum; } else { cum += c2;
                if (cum + c1 >= need) { bin = 1; nd = need - cum; } else { cum += c1; bin = 0; nd = need - cum; } } }
                sh[256] = 4u * lane + bin; sh[257] = nd; }
        }
        __syncthreads();
        prefix |= sh[256] << shift; mask |= 255u << shift; need = sh[257];
        __syncthreads();
    }
    unsigned cg = 0u, ce = 0u;
#pragma unroll
    for (int j = 0; j < 8; ++j) { cg += key[j] > prefix ? 1u : 0u; ce += key[j] == prefix ? 1u : 0u; }
    unsigned pk = (cg << 16) | ce, inc = pk;
#pragma unroll
    for (int d = 1; d < 64; d <<= 1) { const unsigned v = __shfl_up(inc, d); if (lane >= d) inc += v; }
    if (lane == 63) sh[264 + wid] = inc;
    __syncthreads();
    unsigned off = 0u;
#pragma unroll
    for (int w = 0; w < 8; ++w) off += (w < wid) ? sh[264 + w] : 0u;
    unsigned ex = off + inc - pk; unsigned gtb = ex >> 16, eqb = ex & 0xffffu;
    int* inv = (int*)(p.ws + WS_INV) + (size_t)(b * L + tid * 8) * 16 + e; int* idx = (int*)(p.ws + WS_IDX) + (size_t)(e * 4 + b) * CAP;
#pragma unroll
    for (int j = 0; j < 8; ++j) { const bool gt = key[j] > prefix, eq = key[j] == prefix; const bool sel = gt || (eq && eqb < need);
        const unsigned slot = gtb + (eqb < need ? eqb : need);
        inv[(size_t)j * 16] = sel ? (int)slot : -1; if (sel) idx[slot] = tid * 8 + j;
        gtb += gt ? 1u : 0u; eqb += eq ? 1u : 0u; }
    __syncthreads();
}

__device__ __forceinline__ f32x4 ld_bf16x4(const bf16* s) { const unsigned long long w = *(const unsigned long long*)s; const unsigned lo = (unsigned)w, hi2 = (unsigned)(w >> 32);
    return (f32x4){__uint_as_float(lo << 16), __uint_as_float(lo & 0xffff0000u), __uint_as_float(hi2 << 16), __uint_as_float(hi2 & 0xffff0000u)}; }
__device__ __forceinline__ void st_bf16x4(bf16* d, const f32x4& h) { *(unsigned long long*)d = (unsigned long long)pk2(h[0], h[1]) | ((unsigned long long)pk2(h[2], h[3]) << 32); }
__device__ __forceinline__ void p6_row(const Ptrs& p, int row, int lane) {
    const int b = row >> 12; const float* mod = (const float*)(p.ws + WS_MOD) + b * 12288;
    const float ssq = wave_sum(lane < 32 ? ((const float*)(p.ws + WS_SSQY))[(size_t)row * 32 + lane] : 0.f);
    const float rsy = rsqrtf(ssq * (1.f / D) + EPS);
    const bf16* y = (const bf16*)(p.ws + WS_Y) + (size_t)row * D; const float* xr = p.x + (size_t)row * D; float* o = p.out + (size_t)row * D;
    f32x4 v[8]; float s = 0.f;
#pragma unroll
    for (int j = 0; j < 8; ++j) { const int c = j * 256 + lane * 4;
        v[j] = *(const f32x4*)(xr + c) + *(const f32x4*)(mod + 4096 + c) * (ld_bf16x4(y + c) * rsy * *(const f32x4*)(p.post_norm1 + c));
        *(f32x4*)(o + c) = v[j]; s += dot4(v[j]); }
    const float rs = rsqrtf(wave_sum(s) * (1.f / D) + EPS);
    bf16* h2 = (bf16*)(p.ws + WS_H2) + (size_t)row * D;
    f32x4 lg[4];
#pragma unroll
    for (int e = 0; e < 4; ++e) lg[e] = (f32x4){0.f, 0.f, 0.f, 0.f};
#pragma unroll
    for (int j = 0; j < 8; ++j) { const int c = j * 256 + lane * 4;
        const f32x4 h = v[j] * rs * *(const f32x4*)(p.pre_norm2 + c) * (1.f + *(const f32x4*)(mod + 8192 + c)) + *(const f32x4*)(mod + 6144 + c);
        st_bf16x4(h2 + c, h);
        const float* wr = p.w_router + (size_t)c * 16;
#pragma unroll
        for (int q = 0; q < 4; ++q)
#pragma unroll
            for (int e = 0; e < 4; ++e) lg[e] += h[q] * *(const f32x4*)(wr + q * 16 + e * 4);
        asm volatile("" ::: "memory"); }
    float l16[16]; float mx = -1e30f;
#pragma unroll
    for (int e = 0; e < 16; ++e) { l16[e] = wave_sum(lg[e >> 2][e & 3]) + p.b_router[e]; mx = fmaxf(mx, l16[e]); }
    float se = 0.f;
#pragma unroll
    for (int e = 0; e < 16; ++e) { l16[e] = __expf(l16[e] - mx); se += l16[e]; }
    const float inv = 1.f / se; float val = 0.f;
#pragma unroll
    for (int e = 0; e < 16; ++e) val = (lane == e) ? l16[e] * inv : val;
    if (lane < 16) ((float*)(p.ws + WS_AFF))[(size_t)row * 16 + lane] = val;
}
__device__ __forceinline__ void p11_row(const Ptrs& p, int row, int lane) {
    const int b = row >> 12; const float* mod = (const float*)(p.ws + WS_MOD) + b * 12288;
    const int* inv = (const int*)(p.ws + WS_INV) + (size_t)row * 16; const float* aff = (const float*)(p.ws + WS_AFF) + (size_t)row * 16;
    f32x4 v[8];
#pragma unroll
    for (int j = 0; j < 8; ++j) v[j] = (f32x4){0.f, 0.f, 0.f, 0.f};
    for (int e = 0; e < 16; ++e) { const int sl = inv[e]; if (sl >= 0) { const float g = aff[e]; const bf16* ye = (const bf16*)(p.ws + WS_YE) + ((size_t)(e * 4 + b) * CAP + sl) * D + lane * 4;
#pragma unroll
            for (int j = 0; j < 8; ++j) v[j] += g * ld_bf16x4(ye + j * 256); } }
    float s = 0.f;
#pragma unroll
    for (int j = 0; j < 8; ++j) s += dot4(v[j]);
    const float rs = rsqrtf(wave_sum(s) * (1.f / D) + EPS);
    float* o = p.out + (size_t)row * D;
#pragma unroll
    for (int j = 0; j < 8; ++j) { const int c = j * 256 + lane * 4; *(f32x4*)(o + c) = *(const f32x4*)(o + c) + *(const f32x4*)(mod + 10240 + c) * (v[j] * rs * *(const f32x4*)(p.post_norm2 + c)); }
}

struct Args { Ptrs p; int ph_lo, ph_hi, bar_idx, pad; };
__global__ void __launch_bounds__(NTHREADS, 2) fwd(Args args) {
    extern __shared__ __attribute__((aligned(16))) unsigned char lds_raw[];
    LAS unsigned char* lds = (LAS unsigned char*)lds_raw;
#if defined(__HIP_DEVICE_COMPILE__)
    typedef __attribute__((address_space(4))) const Args CArgs;
#define LOADP() Ptrs p; { const CArgs* kp_ = (const CArgs*)__builtin_amdgcn_kernarg_segment_ptr(); asm volatile("" : "+s"(kp_)); p = kp_->p; }
#else
#define LOADP() Ptrs p = args.p;
#endif
    const int tid = threadIdx.x, lane = tid & 63, wave = __builtin_amdgcn_readfirstlane(tid >> 6);
    const int G = gridDim.x, bx = blockIdx.x, vcu = (G % 8 == 0) ? (bx % 8) * (G / 8) + bx / 8 : bx;
    const int gw = vcu * NWAVES + wave, NGW = G * NWAVES;
    volatile LAS unsigned* MISC = (volatile LAS unsigned*)(lds + MISC_OFF);
    if (tid < 64) MISC[tid] = 0u;
    __syncthreads();
    const int lo = args.ph_lo, hi = args.ph_hi;
    XcdBarrier bar; { LOADP(); bar.bar = (unsigned*)(p.ws + WS_CTL) + CW_BAR + args.bar_idx * 4096; bar.x = 0; bar.st = nullptr;
    if (hi - lo > 1) bar = xcd_barrier_post((unsigned*)(p.ws + WS_CTL) + CW_BAR + args.bar_idx * 4096, MISC + 8); }
#ifdef ONLY_PHASE
#define IN(k) ((k) == ONLY_PHASE && lo <= (k) && (k) < hi)
#else
#define IN(k) (lo <= (k) && (k) < hi)
#endif
#define SEAM(k) do { if (IN(k) && IN((k) + 1)) xcd_barrier(bar); } while (0)

    if (IN(0)) { LOADP();
        LAS float* scr = (LAS float*)(lds + wave * 8448);
        for (int it = gw; it < P0_ITEMS; it += NGW) p0_item(p, it, scr, lane);
    }
    SEAM(0);
    if (IN(1)) { LOADP();
        const int gid = bx * NTHREADS + tid;
        if (gid < 5 * 12288) { const int r = gid / 12288, j = gid - r * 12288; float s = p.b_ada[j]; const float* part = (const float*)(p.ws + WS_PART) + (size_t)r * 12288 + j;
            for (int kc = 0; kc < 32; ++kc) s += part[(size_t)kc * 5 * 12288];
            ((float*)(p.ws + WS_MOD))[gid] = s; }
    }
    SEAM(1);
    if (IN(2)) { LOADP(); for (int row = gw; row < MALL; row += NGW) p1_row(p, row, lane); }
    SEAM(2);
    if (IN(3)) { LOADP();
        SchedIn S{(const char*)(p.ws + WS_H), (const char*)(p.ws + WS_WIN_T), G, bx}; EpiIn E{p.ws};
        pg8::gemm_phase<EpiIn, SchedIn>(lds, 2048, S, E);
    }
    SEAM(3);
    if (IN(4)) { LOADP();
        SchedQKV S{(const char*)(p.ws + WS_CQKV), (const char*)(p.ws + WS_WQKV_T), G, bx}; EpiQKV E{p.ws};
        pg8::gemm_phase<EpiQKV, SchedQKV>(lds, 512, S, E);
        __syncthreads();
        for (int u = vcu; u < 1024; u += G) sgu_unit(p, u >> 3, u & 7, lds, tid);
    }
    SEAM(4);
    if (IN(5)) { LOADP();
        for (int u = vcu; u < 512; u += G) { const int bh = u >> 4, qb = u & 15;
            __syncthreads();
            att::attn_unit((const bf16*)(p.ws + WS_Q) + ((size_t)bh * L + qb * 256) * DQK, (const bf16*)(p.ws + WS_K) + (size_t)bh * LK * DQK, (const bf16*)(p.ws + WS_V) + (size_t)bh * LK * VH,
                           (bf16*)(p.ws + WS_CAT) + ((size_t)(bh >> 3) * L + qb * 256) * D + (bh & 7) * 128, LK, (char*)lds_raw); }
        __syncthreads();
    }
    SEAM(5);
    if (IN(6)) { LOADP();
        SchedDense S{(const char*)(p.ws + WS_CAT), (const char*)(p.ws + WS_WOUT_T), G, bx, 64, 8, 31}; EpiY E{p.ws};
        pg8::gemm_phase<EpiY, SchedDense>(lds, 2048, S, E);
    }
    SEAM(6);
    if (IN(7)) { LOADP(); for (int row = gw; row < M; row += NGW) p6_row(p, row, lane); }
    SEAM(7);
    if (IN(8)) { LOADP(); for (int u = bx; u < 64; u += G) topk_unit(p, u >> 2, u & 3, (LAS unsigned*)lds, tid); }
    SEAM(8);
    if (IN(9)) { LOADP();
        SchedGather S{(const char*)(p.ws + WS_H2), (const char*)(p.ws + WS_WGU_T), G, bx, (const LAS unsigned*)(lds + TAB_OFF)};
        for (int q = tid; q < 2048; q += NTHREADS) { const int i = q >> 8, r = q & 255; Unit u;
            if (S.next(i, u)) { const int e = u.pm >> 3, m = (u.pm & 7) * 256 + r, b = m >> 9; const int tok = ((const int*)(p.ws + WS_IDX))[(size_t)(e * 4 + b) * CAP + (m & 511)];
                ((LAS unsigned*)(lds + TAB_OFF))[q] = (unsigned)(b * L + tok) * (unsigned)(D * 2); } }
        LDS_WAIT(); __syncthreads();
        EpiAct E{p.ws};
        pg8::gemm_phase<EpiAct, SchedGather>(lds, 2048, S, E);
    }
    SEAM(9);
    if (IN(10)) { LOADP();
        SchedDense S{(const char*)(p.ws + WS_ACT), (const char*)(p.ws + WS_WD_T), G, bx, 128, 8, 3}; EpiYE E{p.ws};
        pg8::gemm_phase<EpiYE, SchedDense>(lds, 2048, S, E);
    }
    SEAM(10);
    if (IN(11)) { LOADP(); for (int row = gw; row < M; row += NGW) p11_row(p, row, lane); }
#undef IN
#undef SEAM
}

#ifndef PHASE_MODE
#define PHASE_MODE "FFFFFFFFFFFF"
#endif
#ifndef MERGE
#define MERGE 1
#endif
template <class P> static void launch_ngemm(const P& f, int Mr, int Nr, int Z, hipStream_t s) { hipLaunchKernelGGL((ngemm<P>), dim3(Nr / 64, Mr / 64, Z), dim3(256), 0, s, f); }
static void naive_phase(int ph, const Ptrs& p, hipStream_t stream) {
    switch (ph) {
    case 0: hipLaunchKernelGGL(n_mod, dim3(48, 5), dim3(256), 0, stream, p); break;
    case 1: break;
    case 2: hipLaunchKernelGGL(n_hrows, dim3(MALL / 4), dim3(256), 0, stream, p); break;
    case 3: launch_ngemm(GIn{p, D}, MALL, 3136, 1, stream);
        hipLaunchKernelGGL(n_ssq, dim3(M / 4), dim3(256), 0, stream, (const bf16*)(p.ws + WS_CQKV), M, 512, (float*)(p.ws + WS_SSQQ), 8);
        hipLaunchKernelGGL(n_ssq, dim3(MALL / 4), dim3(256), 0, stream, (const bf16*)(p.ws + WS_CQKV) + (size_t)M * 512, MALL, 512, (float*)(p.ws + WS_SSQKV), 8); break;
    case 4: launch_ngemm(GQ{p, 512}, M, 1536, 1, stream); launch_ngemm(GKV{p, 512}, MALL, 2048, 1, stream);
        hipLaunchKernelGGL(n_vn, dim3(M * 8 / 4), dim3(256), 0, stream, p); launch_ngemm(GSgu{p, 128}, 128, 128, 1024, stream); break;
    case 5: for (int bh = 0; bh < B * H; ++bh) { launch_ngemm(GScore{p, DQK, bh}, L, LK, 1, stream);
            hipLaunchKernelGGL(n_softmax, dim3(L), dim3(256), 0, stream, (float*)(p.ws + WS_S), LK); launch_ngemm(GPV{p, LK, bh}, L, VH, 1, stream); } break;
    case 6: launch_ngemm(GOut{p, D}, M, D, 1, stream);
        hipLaunchKernelGGL(n_ssq, dim3(M / 4), dim3(256), 0, stream, (const bf16*)(p.ws + WS_Y), M, D, (float*)(p.ws + WS_SSQY), 32); break;
    case 7: hipLaunchKernelGGL(n_rowmid, dim3(M / 4), dim3(256), 0, stream, p); break;
    case 8: hipLaunchKernelGGL(n_topk, dim3(64), dim3(1024), 0, stream, p); break;
    case 9: launch_ngemm(GE1{p, D}, 2048, 4096, 16, stream); break;
    case 10: launch_ngemm(GE2{p, FF}, 2048, 2048, 16, stream); break;
    case 11: hipLaunchKernelGGL(n_rowfinal, dim3(M / 4), dim3(256), 0, stream, p); break;
    }
}
extern "C" void kernel_launch(void* const* d_in, const int* in_sizes, int n_in, void* d_out, int out_size, void* d_ws, size_t ws_size, hipStream_t stream) {
    static int grid = 0;
    if (grid == 0) {
        if (n_in != 24 || ws_size < WS_END || out_size != M * D) { fprintf(stderr, "kernel_launch: unexpected shapes n_in %d ws %zu out %d\n", n_in, ws_size, out_size); grid = -1; return; }
        int dev = 0, cus = 0, per_cu = 0;
        if (hipGetDevice(&dev) != hipSuccess || hipDeviceGetAttribute(&cus, hipDeviceAttributeMultiprocessorCount, dev) != hipSuccess) { grid = -1; return; }
        if (hipFuncSetAttribute((const void*)fwd, hipFuncAttributeMaxDynamicSharedMemorySize, LDS_BYTES) != hipSuccess) { fprintf(stderr, "kernel_launch: hipFuncSetAttribute failed\n"); grid = -1; return; }
        if (hipOccupancyMaxActiveBlocksPerMultiprocessor(&per_cu, (const void*)fwd, NTHREADS, LDS_BYTES) != hipSuccess || per_cu < 1) fprintf(stderr, "kernel_launch: occupancy query says %d\n", per_cu);
        (void)hipGetLastError();
        grid = cus;
    }
    if (grid < 0) return;
    Ptrs p{};
    const float** f = (const float**)&p;
    for (int i = 0; i < 24; ++i) f[i] = (const float*)d_in[i];
    p.out = (float*)d_out; p.ws = (unsigned char*)d_ws;
    (void)hipMemsetAsync(p.ws + WS_CTL, 0, 1 * MiB, stream);
    const char* mode = PHASE_MODE; int nbar = 0;
    for (int ph = 0; ph < 12;) {
        if (mode[ph] == 'F') { int e = ph + 1; if (MERGE) while (e < 12 && mode[e] == 'F') ++e;
            Args a{}; a.p = p; a.ph_lo = ph; a.ph_hi = e; a.bar_idx = nbar++; a.pad = 0;
            hipLaunchKernelGGL(fwd, dim3(grid), dim3(NTHREADS), LDS_BYTES, stream, a);
            const hipError_t le = hipPeekAtLastError(); if (le != hipSuccess) fprintf(stderr, "kernel_launch: launch failed: %s\n", hipGetErrorName(le));
            ph = e; }
        else { naive_phase(ph, p, stream); ++ph; }
    }
}
```

```cpp
#define PHASE_MODE "FFFFFFFFFFFF"
#define MERGE 1
#include <hip/hip_runtime.h>
#include <cstdio>
#include <cstdint>

typedef unsigned short bf16;
#ifndef FP8_MOE
#define FP8_MOE 1
#endif
namespace cfg {
constexpr int B = 4, L = 4096, D = 2048, CTX = 256, H = 8, LK = L + CTX;
constexpr int M = B * L;
constexpr int MC = B * CTX;
constexpr int MALL = M + MC;
constexpr int QL = 512, KVL = 512, NOPE = 128, ROPE = 64, VH = 128, DQK = 192;
constexpr int SGW = 1024, INC = 3136, OFF_KPE = 1024, OFF_U = 1088, OFF_V = 2112;
constexpr int NE = 16, CAP = 512, FF = 2048;
constexpr float EPS = 1e-6f;
constexpr float ATT_SCALE = 0.07216878364870322f;
constexpr size_t MiB = 1u << 20;
constexpr size_t WS_CTL = 0;
constexpr size_t WS_MOD = 1 * MiB;
constexpr size_t WS_SSQQ = 2 * MiB;
constexpr size_t WS_SSQKV = 3 * MiB;
constexpr size_t WS_SSQY = 4 * MiB;
constexpr size_t WS_AFF = 6 * MiB;
constexpr size_t WS_INV = 7 * MiB;
constexpr size_t WS_IDX = 8 * MiB;
constexpr size_t WS_WIN_T = 16 * MiB;
constexpr size_t WS_WQKV_T = 30 * MiB;
constexpr size_t WS_WOUT_T = 34 * MiB;
constexpr size_t WS_SGUW = 42 * MiB;
constexpr size_t WS_WGU_T = 64 * MiB;
constexpr size_t WS_WD_T = 320 * MiB;
constexpr size_t WS_H = 448 * MiB;
constexpr size_t WS_CQKV = 516 * MiB;
constexpr size_t WS_U = 549 * MiB;
constexpr size_t WS_VS = 581 * MiB;
constexpr size_t WS_Q = 613 * MiB;
constexpr size_t WS_K = 661 * MiB;
constexpr size_t WS_V = 712 * MiB;
constexpr size_t WS_CAT = 746 * MiB;
constexpr size_t WS_Y = 810 * MiB;
constexpr size_t WS_H2 = WS_CAT;
constexpr size_t WS_ACT = WS_H;
constexpr size_t WS_YE = WS_Q;
constexpr size_t WS_S = 874 * MiB;
constexpr size_t WS_VN = 942 * MiB;
constexpr size_t WS_ROPE = 9 * MiB;
constexpr size_t WS_PART = WS_S;
constexpr size_t WS_END = 974 * MiB;
}
using namespace cfg;

__device__ __forceinline__ float bf2f(bf16 v) { return __uint_as_float(((unsigned)v) << 16); }
__device__ __forceinline__ bf16 f2bf(float f) { unsigned u = __float_as_uint(f); return (bf16)((u + 0x7fffu + ((u >> 16) & 1u)) >> 16); }
__device__ __forceinline__ float silu_f(float x) { return x / (1.f + __expf(-x)); }
__device__ __forceinline__ float gelu_tanh(float x) { const float z = 0.7978845608028654f * (x + 0.044715f * x * x * x); return 0.5f * x * (1.f + tanhf(z)); }
__device__ __forceinline__ float wave_sum(float v) {
#pragma unroll
    for (int o = 1; o < 64; o <<= 1) v += __shfl_xor(v, o);
    return v;
}
__device__ __forceinline__ float rope_inv(int ii) { return __expf(-(float)ii * (9.210340371976184f / 16.f)); }

struct Ptrs {
    const float *x, *c, *ctx, *c_ctx, *w_ada, *b_ada, *pre_norm1, *w_in, *q_norm_w, *w_uq, *kv_norm_w, *w_ukv, *sgu_norm_w, *sgu_w, *sgu_b, *w_out,
        *post_norm1, *pre_norm2, *w_router, *b_router, *w_e_gate, *w_e_up, *w_e_down, *post_norm2;
    float* out; unsigned char* ws;
};

__global__ void n_mod(Ptrs p) {
    const int j = blockIdx.x * 256 + threadIdx.x, r = blockIdx.y;
    const float* cv = r < 4 ? p.c + r * D : p.c_ctx;
    float s = 0.f;
    for (int k = 0; k < D; ++k) s += silu_f(cv[k]) * p.w_ada[(size_t)k * 12288 + j];
    ((float*)(p.ws + WS_MOD))[r * 12288 + j] = s + p.b_ada[j];
}
__global__ __launch_bounds__(256) void n_hrows(Ptrs p) {
    const int row = blockIdx.x * 4 + (threadIdx.x >> 6), lane = threadIdx.x & 63;
    if (row >= MALL) return;
    const float* src = row < M ? p.x + (size_t)row * D : p.ctx + (size_t)(row - M) * D;
    const int mr = row < M ? row >> 12 : 4;
    const float* mod = (const float*)(p.ws + WS_MOD) + mr * 12288;
    float v[32]; float s = 0.f;
    for (int j = 0; j < 32; ++j) { v[j] = src[j * 64 + lane]; s += v[j] * v[j]; }
    const float rs = rsqrtf(wave_sum(s) * (1.f / D) + EPS);
    bf16* o = (bf16*)(p.ws + WS_H) + (size_t)row * D;
    for (int j = 0; j < 32; ++j) { const int c = j * 64 + lane; o[c] = f2bf(v[j] * rs * p.pre_norm1[c] * (1.f + mod[2048 + c]) + mod[c]); }
}
template <class P> __global__ __launch_bounds__(256) void ngemm(P p) {
    __shared__ float As[16][65], Bs[16][65];
    const int tx = threadIdx.x & 15, ty = threadIdx.x >> 4, z = blockIdx.z;
    const int m0 = blockIdx.y * 64, n0 = blockIdx.x * 64;
    float acc[4][4] = {};
    for (int k0 = 0; k0 < p.K; k0 += 16) {
        for (int j = 0; j < 4; ++j) { const int idx = threadIdx.x + 256 * j; const int kk = idx & 15, mm = idx >> 4; As[kk][mm] = p.a(z, m0 + mm, k0 + kk); }
        for (int j = 0; j < 4; ++j) { const int idx = threadIdx.x + 256 * j; const int nn = idx & 63, kk = idx >> 6; Bs[kk][nn] = p.b(z, k0 + kk, n0 + nn); }
        __syncthreads();
#pragma unroll
        for (int kk = 0; kk < 16; ++kk) {
            float a[4], b[4];
#pragma unroll
            for (int i = 0; i < 4; ++i) { a[i] = As[kk][ty * 4 + i]; b[i] = Bs[kk][tx * 4 + i]; }
#pragma unroll
            for (int i = 0; i < 4; ++i)
#pragma unroll
                for (int j = 0; j < 4; ++j) acc[i][j] += a[i] * b[j];
        }
        __syncthreads();
    }
    for (int i = 0; i < 4; ++i) p.epi(z, m0 + ty * 4 + i, n0 + tx * 4, acc[i]);
}
__device__ __forceinline__ void rope_pair(float& x1, float& x2, int i, int pos) {
    const int ii = i & 15; const float ax = (float)((i >> 4) ? (pos & 63) : (pos >> 6));
    float s, c; sincosf(ax * rope_inv(ii), &s, &c);
    const float r1 = x1 * c - x2 * s, r2 = x2 * c + x1 * s; x1 = r1; x2 = r2;
}
struct GIn {
    Ptrs p; int K;
    __device__ float a(int, int m, int k) const { return bf2f(((const bf16*)(p.ws + WS_H))[(size_t)m * D + k]); }
    __device__ float b(int, int k, int n) const {
        int o; if (n < 1024) o = n; else if (n < 3072) o = n + 64; else { const int j = n - 3072, i = j >> 1, s = j & 1; o = OFF_KPE + (i >> 4) * 32 + s * 16 + (i & 15); }
        return p.w_in[(size_t)k * INC + o];
    }
    __device__ void epi(int, int m, int n0, const float* v) const {
        bf16* CQ = (bf16*)(p.ws + WS_CQKV); bf16* CKV = CQ + (size_t)M * 512;
        if (n0 < 512) { if (m < M) for (int j = 0; j < 4; ++j) CQ[(size_t)m * 512 + n0 + j] = f2bf(v[j]); }
        else if (n0 < 1024) { for (int j = 0; j < 4; ++j) CKV[(size_t)m * 512 + n0 - 512 + j] = f2bf(v[j]); }
        else if (n0 < 2048) { if (m < M) for (int j = 0; j < 4; ++j) ((bf16*)(p.ws + WS_U))[(size_t)m * 1024 + n0 - 1024 + j] = f2bf(gelu_tanh(v[j])); }
        else if (n0 < 3072) { if (m < M) for (int j = 0; j < 4; ++j) ((bf16*)(p.ws + WS_VS))[(size_t)m * 1024 + n0 - 2048 + j] = f2bf(gelu_tanh(v[j])); }
        else {
            const int jj = n0 - 3072; bf16* Kb = (bf16*)(p.ws + WS_K);
            for (int q = 0; q < 2; ++q) {
                const int i = (jj >> 1) + q; float x1 = v[2 * q], x2 = v[2 * q + 1]; int b, kpos;
                if (m < M) { b = m >> 12; kpos = m & 4095; rope_pair(x1, x2, i, kpos); } else { b = (m - M) >> 8; kpos = L + ((m - M) & 255); }
                for (int hh = 0; hh < H; ++hh) { bf16* d = Kb + ((size_t)(b * H + hh) * LK + kpos) * DQK + 128 + 2 * i; d[0] = f2bf(x1); d[1] = f2bf(x2); }
            }
        }
    }
};
__global__ void n_ssq(const bf16* T, int rows, int cols, float* out, int nslots) {
    const int row = blockIdx.x * 4 + (threadIdx.x >> 6), lane = threadIdx.x & 63;
    if (row >= rows) return;
    float s = 0.f; for (int c = lane; c < cols; c += 64) { const float v = bf2f(T[(size_t)row * cols + c]); s += v * v; }
    s = wave_sum(s);
    if (lane < nslots) out[(size_t)row * nslots + lane] = lane == 0 ? s : 0.f;
}
__device__ __forceinline__ float sum_slots(const float* s, int n) { float t = 0.f; for (int i = 0; i < n; ++i) t += s[i]; return t; }
struct GQ {
    Ptrs p; int K;
    __device__ float a(int, int m, int k) const { return bf2f(((const bf16*)(p.ws + WS_CQKV))[(size_t)m * 512 + k]); }
    __device__ float b(int, int k, int n) const {
        int o; if (n < 1024) o = (n >> 7) * DQK + (n & 127); else { const int jj = n - 1024, hd = jj >> 6, j6 = jj & 63, i = j6 >> 1, s = j6 & 1; o = hd * DQK + 128 + (i >> 4) * 32 + s * 16 + (i & 15); }
        return p.w_uq[(size_t)k * 1536 + o] * p.q_norm_w[k];
    }
    __device__ void epi(int, int m, int n0, const float* v) const {
        const float rs = rsqrtf(sum_slots((const float*)(p.ws + WS_SSQQ) + (size_t)m * 8, 8) * (1.f / 512.f) + EPS);
        const int b = m >> 12, t = m & 4095; bf16* Qb = (bf16*)(p.ws + WS_Q);
        if (n0 < 1024) { const int hd = n0 >> 7, d = n0 & 127; for (int j = 0; j < 4; ++j) Qb[((size_t)(b * H + hd) * L + t) * DQK + d + j] = f2bf(v[j] * rs); }
        else { const int jj = n0 - 1024, hd = jj >> 6, j6 = jj & 63;
            for (int q = 0; q < 2; ++q) { const int i = (j6 >> 1) + q; float x1 = v[2 * q] * rs, x2 = v[2 * q + 1] * rs; rope_pair(x1, x2, i, t);
                bf16* d = Qb + ((size_t)(b * H + hd) * L + t) * DQK + 128 + 2 * i; d[0] = f2bf(x1); d[1] = f2bf(x2); } }
    }
};
struct GKV {
    Ptrs p; int K;
    __device__ float a(int, int m, int k) const { return bf2f(((const bf16*)(p.ws + WS_CQKV))[(size_t)(M + m) * 512 + k]); }
    __device__ float b(int, int k, int n) const { return p.w_ukv[(size_t)k * 2048 + n] * p.kv_norm_w[k]; }
    __device__ void epi(int, int m, int n0, const float* v) const {
        const float rs = rsqrtf(sum_slots((const float*)(p.ws + WS_SSQKV) + (size_t)m * 8, 8) * (1.f / 512.f) + EPS);
        int b, kpos; if (m < M) { b = m >> 12; kpos = m & 4095; } else { b = (m - M) >> 8; kpos = L + ((m - M) & 255); }
        const int hd = n0 >> 8, c = n0 & 255;
        if (c < 128) { bf16* d = (bf16*)(p.ws + WS_K) + ((size_t)(b * H + hd) * LK + kpos) * DQK + c; for (int j = 0; j < 4; ++j) d[j] = f2bf(v[j] * rs); }
        else { bf16* d = (bf16*)(p.ws + WS_V) + ((size_t)(b * H + hd) * LK + kpos) * VH + c - 128; for (int j = 0; j < 4; ++j) d[j] = f2bf(v[j] * rs); }
    }
};
__global__ void n_vn(Ptrs p) {
    const int w = blockIdx.x * 4 + (threadIdx.x >> 6), lane = threadIdx.x & 63;
    const int tok = w >> 3, g = w & 7;
    const bf16* s = (const bf16*)(p.ws + WS_VS) + (size_t)tok * 1024 + g * 128;
    const float a = bf2f(s[lane]), b = bf2f(s[lane + 64]);
    const float mu = wave_sum(a + b) * (1.f / 128.f);
    const float da = a - mu, db = b - mu;
    const float rs = rsqrtf(wave_sum(da * da + db * db) * (1.f / 128.f) + EPS);
    bf16* o = (bf16*)(p.ws + WS_VN) + (size_t)tok * 1024 + g * 128;
    o[lane] = f2bf(da * rs * p.sgu_norm_w[g * 128 + lane]); o[lane + 64] = f2bf(db * rs * p.sgu_norm_w[g * 128 + lane + 64]);
}
struct GSgu {
    Ptrs p; int K;
    __device__ float a(int z, int m, int k) const { return p.sgu_w[((size_t)(z & 7) * 128 + m) * 128 + k]; }
    __device__ float b(int z, int k, int n) const { return bf2f(((const bf16*)(p.ws + WS_VN))[(size_t)((z >> 3) * 128 + k) * 1024 + (z & 7) * 128 + n]); }
    __device__ void epi(int z, int m, int n0, const float* v) const {
        const int g = z & 7; const size_t row = (size_t)(z >> 3) * 128 + m; const float bias = p.sgu_b[g * 128 + m];
        for (int j = 0; j < 4; ++j) { const float u = bf2f(((const bf16*)(p.ws + WS_U))[row * 1024 + g * 128 + n0 + j]);
            ((bf16*)(p.ws + WS_CAT))[row * D + 1024 + g * 128 + n0 + j] = f2bf(u * (v[j] + bias)); }
    }
};
struct GScore {
    Ptrs p; int K; int bh;
    __device__ float a(int, int m, int k) const { return bf2f(((const bf16*)(p.ws + WS_Q))[((size_t)bh * L + m) * DQK + k]); }
    __device__ float b(int, int k, int n) const { return bf2f(((const bf16*)(p.ws + WS_K))[((size_t)bh * LK + n) * DQK + k]); }
    __device__ void epi(int, int m, int n0, const float* v) const { float* S = (float*)(p.ws + WS_S) + (size_t)m * LK + n0; for (int j = 0; j < 4; ++j) S[j] = v[j] * ATT_SCALE; }
};
__global__ void n_softmax(float* S, int cols) {
    float* r = S + (size_t)blockIdx.x * cols; __shared__ float red[4];
    float mx = -1e30f; for (int c = threadIdx.x; c < cols; c += 256) mx = fmaxf(mx, r[c]);
    for (int o = 1; o < 64; o <<= 1) mx = fmaxf(mx, __shfl_xor(mx, o));
    if ((threadIdx.x & 63) == 0) red[threadIdx.x >> 6] = mx; __syncthreads();
    mx = fmaxf(fmaxf(red[0], red[1]), fmaxf(red[2], red[3])); __syncthreads();
    float s = 0.f; for (int c = threadIdx.x; c < cols; c += 256) { const float e = __expf(r[c] - mx); r[c] = e; s += e; }
    s = wave_sum(s); if ((threadIdx.x & 63) == 0) red[threadIdx.x >> 6] = s; __syncthreads();
    s = (red[0] + red[1]) + (red[2] + red[3]); const float inv = 1.f / s;
    for (int c = threadIdx.x; c < cols; c += 256) r[c] *= inv;
}
struct GPV {
    Ptrs p; int K; int bh;
    __device__ float a(int, int m, int k) const { return ((const float*)(p.ws + WS_S))[(size_t)m * LK + k]; }
    __device__ float b(int, int k, int n) const { return bf2f(((const bf16*)(p.ws + WS_V))[((size_t)bh * LK + k) * VH + n]); }
    __device__ void epi(int, int m, int n0, const float* v) const { bf16* d = (bf16*)(p.ws + WS_CAT) + ((size_t)(bh >> 3) * L + m) * D + (bh & 7) * 128 + n0; for (int j = 0; j < 4; ++j) d[j] = f2bf(v[j]); }
};
struct GOut {
    Ptrs p; int K;
    __device__ float a(int, int m, int k) const { return bf2f(((const bf16*)(p.ws + WS_CAT))[(size_t)m * D + k]); }
    __device__ float b(int, int k, int n) const { return p.w_out[(size_t)k * D + n]; }
    __device__ void epi(int, int m, int n0, const float* v) const { bf16* d = (bf16*)(p.ws + WS_Y) + (size_t)m * D + n0; for (int j = 0; j < 4; ++j) d[j] = f2bf(v[j]); }
};
__device__ __forceinline__ void row_pass_mid(const Ptrs& p, int row, int lane) {
    const int b = row >> 12; const float* mod = (const float*)(p.ws + WS_MOD) + b * 12288;
    const float ssq = wave_sum(lane < 32 ? ((const float*)(p.ws + WS_SSQY))[(size_t)row * 32 + lane] : 0.f);
    const float rsy = rsqrtf(ssq * (1.f / D) + EPS);
    const bf16* y = (const bf16*)(p.ws + WS_Y) + (size_t)row * D; const float* xr = p.x + (size_t)row * D; float* o = p.out + (size_t)row * D;
    float v[32]; float s = 0.f;
    for (int j = 0; j < 32; ++j) { const int c = j * 64 + lane; v[j] = xr[c] + mod[4096 + c] * (bf2f(y[c]) * rsy * p.post_norm1[c]); o[c] = v[j]; s += v[j] * v[j]; }
    const float rs = rsqrtf(wave_sum(s) * (1.f / D) + EPS);
    bf16* h2 = (bf16*)(p.ws + WS_H2) + (size_t)row * D; float lg[16];
    for (int e = 0; e < 16; ++e) lg[e] = 0.f;
    for (int j = 0; j < 32; ++j) { const int c = j * 64 + lane; const float h = v[j] * rs * p.pre_norm2[c] * (1.f + mod[8192 + c]) + mod[6144 + c]; h2[c] = f2bf(h);
        const float* wr = p.w_router + (size_t)c * 16; for (int e = 0; e < 16; ++e) lg[e] += h * wr[e]; }
    float mx = -1e30f;
    for (int e = 0; e < 16; ++e) { lg[e] = wave_sum(lg[e]) + p.b_router[e]; mx = fmaxf(mx, lg[e]); }
    float se = 0.f; for (int e = 0; e < 16; ++e) { lg[e] = __expf(lg[e] - mx); se += lg[e]; }
    const float inv = 1.f / se;
    if (lane < 16) { float val = 0.f; for (int e = 0; e < 16; ++e) val = (lane == e) ? lg[e] * inv : val; ((float*)(p.ws + WS_AFF))[(size_t)row * 16 + lane] = val; }
}
__global__ __launch_bounds__(256) void n_rowmid(Ptrs p) { const int row = blockIdx.x * 4 + (threadIdx.x >> 6); row_pass_mid(p, row, threadIdx.x & 63); }
__global__ void n_topk(Ptrs p) {
    __shared__ float vals[L];
    const int e = blockIdx.x >> 2, b = blockIdx.x & 3;
    const float* aff = (const float*)(p.ws + WS_AFF) + (size_t)b * L * 16 + e;
    for (int t = threadIdx.x; t < L; t += blockDim.x) vals[t] = aff[(size_t)t * 16];
    __syncthreads();
    for (int t = threadIdx.x; t < L; t += blockDim.x) {
        const float v = vals[t]; int rank = 0;
        for (int u = 0; u < L; ++u) { const float w = vals[u]; rank += (w > v || (w == v && u < t)) ? 1 : 0; }
        ((int*)(p.ws + WS_INV))[(size_t)(b * L + t) * 16 + e] = rank < CAP ? rank : -1;
        if (rank < CAP) ((int*)(p.ws + WS_IDX))[(size_t)(e * 4 + b) * CAP + rank] = t;
    }
}
struct GE1 {
    Ptrs p; int K;
    __device__ float a(int z, int m, int k) const { const int b = m >> 9; const int tok = ((const int*)(p.ws + WS_IDX))[(size_t)(z * 4 + b) * CAP + (m & 511)];
        return bf2f(((const bf16*)(p.ws + WS_H2))[((size_t)b * L + tok) * D + k]); }
    __device__ float b(int z, int k, int n) const { const float* w = (n & 1) ? p.w_e_up : p.w_e_gate; return w[((size_t)z * D + k) * FF + (n >> 1)]; }
    __device__ void epi(int z, int m, int n0, const float* v) const { bf16* d = (bf16*)(p.ws + WS_ACT) + ((size_t)z * 2048 + m) * FF + (n0 >> 1);
        d[0] = f2bf(silu_f(v[0]) * v[1]); d[1] = f2bf(silu_f(v[2]) * v[3]); }
};
struct GE2 {
    Ptrs p; int K;
    __device__ float a(int z, int m, int k) const { return bf2f(((const bf16*)(p.ws + WS_ACT))[((size_t)z * 2048 + m) * FF + k]); }
    __device__ float b(int z, int k, int n) const { return p.w_e_down[((size_t)z * FF + k) * D + n]; }
    __device__ void epi(int z, int m, int n0, const float* v) const { bf16* d = (bf16*)(p.ws + WS_YE) + ((size_t)z * 2048 + m) * D + n0; for (int j = 0; j < 4; ++j) d[j] = f2bf(v[j]); }
};
__device__ __forceinline__ void row_pass_final(const Ptrs& p, int row, int lane) {
    const int b = row >> 12; const float* mod = (const float*)(p.ws + WS_MOD) + b * 12288;
    const int* inv = (const int*)(p.ws + WS_INV) + (size_t)row * 16; const float* aff = (const float*)(p.ws + WS_AFF) + (size_t)row * 16;
    float v[32]; for (int j = 0; j < 32; ++j) v[j] = 0.f;
    for (int e = 0; e < 16; ++e) { const int sl = inv[e]; if (sl >= 0) { const float g = aff[e]; const bf16* ye = (const bf16*)(p.ws + WS_YE) + ((size_t)(e * 4 + b) * CAP + sl) * D;
            for (int j = 0; j < 32; ++j) v[j] += g * bf2f(ye[j * 64 + lane]); } }
    float s = 0.f; for (int j = 0; j < 32; ++j) s += v[j] * v[j];
    const float rs = rsqrtf(wave_sum(s) * (1.f / D) + EPS);
    float* o = p.out + (size_t)row * D;
    for (int j = 0; j < 32; ++j) { const int c = j * 64 + lane; o[c] = o[c] + mod[10240 + c] * (v[j] * rs * p.post_norm2[c]); }
}
__global__ __launch_bounds__(256) void n_rowfinal(Ptrs p) { const int row = blockIdx.x * 4 + (threadIdx.x >> 6); row_pass_final(p, row, threadIdx.x & 63); }


namespace pg8 {
#define PG8_LAS __attribute__((address_space(3)))
typedef short bf16x8 __attribute__((ext_vector_type(8)));
typedef float f32x4 __attribute__((ext_vector_type(4)));
typedef float f32x2 __attribute__((ext_vector_type(2)));
typedef unsigned u32x4 __attribute__((ext_vector_type(4)));
constexpr int BM = 256, BK = 64, HALF = 128, HTB = HALF * BK * 2, STAGE_BYTES = 8 * HTB, NXCD = 8, WGM = 8;

__host__ __device__ __forceinline__ int lds_byte(int r, int c) { const int st = (r >> 4) * 2 + (c >> 5), rr = r & 15, cc = c & 31, ob = rr * 64 + cc * 2; return st * 1024 + (ob ^ (((ob >> 9) & 1) << 5)); }
__host__ __device__ __forceinline__ void stage_rc(int b, int& R, int& C) { const int st = b / 1024, sb = b % 1024, swz = sb ^ (((sb >> 9) & 1) << 5); R = (st >> 1) * 16 + swz / 64; C = (st & 1) * 32 + (swz % 64) / 2; }
__host__ __device__ __forceinline__ int perm32(int rho) { const int n = rho >> 4, i = rho & 15; return 8 * (i >> 2) + 4 * n + (i & 3); }

struct Unit { int pm, pn; };
__device__ __forceinline__ void rect_unit(int L, int nM, int nN, Unit& u) {
    const int nwg = nM * nN; int wgid = L;
    { const int q = nwg / NXCD, r = nwg % NXCD, xcd = wgid % NXCD, off = wgid / NXCD; wgid = (xcd < r ? xcd * (q + 1) : r * (q + 1) + (xcd - r) * q) + off; }
    const int nig = WGM * nN, gid = wgid / nig, fm = gid * WGM, gsz = (nM - fm) < WGM ? (nM - fm) : WGM;
    u.pm = fm + ((wgid % nig) % gsz); u.pn = (wgid % nig) / gsz;
}
__device__ __forceinline__ void dense_voff(int K, int tid, unsigned (&v)[2][2]) {
#pragma unroll
    for (int i = 0; i < 2; ++i) { int R, C; stage_rc(tid * 16 + i * 8192, R, C); v[0][i] = (unsigned)(R * K + C) * 2u; v[1][i] = (unsigned)((R + HALF) * K + C) * 2u; }
}

__device__ __forceinline__ unsigned cvt_pk_bf16(float lo, float hi) { unsigned r; asm volatile("v_cvt_pk_bf16_f32 %0, %1, %2" : "=v"(r) : "v"(lo), "v"(hi)); return r; }
__device__ __forceinline__ u32x4 pack8(const f32x4& a, const f32x4& b) { u32x4 w; w.x = cvt_pk_bf16(a[0], a[1]); w.y = cvt_pk_bf16(a[2], a[3]); w.z = cvt_pk_bf16(b[0], b[1]); w.w = cvt_pk_bf16(b[2], b[3]); return w; }

typedef int i32x4 __attribute__((ext_vector_type(4)));
typedef int i32x8 __attribute__((ext_vector_type(8)));
template <class Epi, class Sched, bool FP8 = false>
__device__ __forceinline__ void gemm_phase(PG8_LAS unsigned char* lds, const int K, const Sched& S, const Epi& E) {
    const int tid = threadIdx.x, wid = __builtin_amdgcn_readfirstlane(tid >> 6), lane = tid & 63, wr = wid >> 2, wc = wid & 3, fr = lane & 15, fq = lane >> 4;
    const int nt = K / BK;
    unsigned voffB[2];
#pragma unroll
    for (int i = 0; i < 2; ++i) { int R, C; stage_rc(tid * 16 + i * 8192, R, C); const int Rb = Epi::PERM ? ((R & ~31) + perm32(R & 31)) : R; voffB[i] = (unsigned)(Rb * K + C) * 2u; }
    const size_t kstep = (size_t)(BK * 2);
    const size_t hstep = (size_t)HALF * K * 2;
    const unsigned ldsw = (unsigned)wid * 1024u;
    const int aoff = lds_byte(wr * 64 + fr, fq * 8), boff = lds_byte(wc * 32 + fr, fq * 8);
#define PG8_SA(b, h) (((b) * 2 + (h)) * HTB)
#define PG8_SB(b, h) ((4 + (b) * 2 + (h)) * HTB)
#define PG8_STAGE(bufoff, gbase, voff) do { _Pragma("unroll") for (int _i = 0; _i < 2; ++_i) \
        __builtin_amdgcn_global_load_lds((const unsigned*)((const char*)(gbase) + (voff)[_i]), (PG8_LAS unsigned*)(lds + (bufoff) + ldsw + _i * 8192), 16, 0, 0); } while (0)
#define PG8_LDA(dst, b, h) do { _Pragma("unroll") for (int m = 0; m < 4; ++m) _Pragma("unroll") for (int k = 0; k < 2; ++k) dst[m][k] = *(const PG8_LAS bf16x8*)(lds + PG8_SA(b, h) + aoff + m * 2048 + k * 1024); } while (0)
#define PG8_LDB(dst, b, h) do { _Pragma("unroll") for (int n = 0; n < 2; ++n) _Pragma("unroll") for (int k = 0; k < 2; ++k) dst[n][k] = *(const PG8_LAS bf16x8*)(lds + PG8_SB(b, h) + boff + n * 2048 + k * 1024); } while (0)
#define PG8_MMA(ai, bj, At, Bt) do { __builtin_amdgcn_s_setprio(1); _Pragma("unroll") for (int m = 0; m < 4; ++m) _Pragma("unroll") for (int n = 0; n < 2; ++n) { \
        if constexpr (FP8) { const i32x8 fb = __builtin_shufflevector((i32x4)Bt[n][0], (i32x4)Bt[n][1], 0, 1, 2, 3, 4, 5, 6, 7), fa = __builtin_shufflevector((i32x4)At[m][0], (i32x4)At[m][1], 0, 1, 2, 3, 4, 5, 6, 7); \
            acc[ai][bj][m][n] = __builtin_amdgcn_mfma_scale_f32_16x16x128_f8f6f4(fb, fa, acc[ai][bj][m][n], 0, 0, 0, 0x7f7f7f7f, 0, 0x7f7f7f7f); } \
        else { _Pragma("unroll") for (int k = 0; k < 2; ++k) acc[ai][bj][m][n] = __builtin_amdgcn_mfma_f32_16x16x32_bf16(Bt[n][k], At[m][k], acc[ai][bj][m][n], 0, 0, 0); } } \
        __builtin_amdgcn_s_setprio(0); } while (0)
#define PG8_WAIT_V(n) asm volatile("s_waitcnt vmcnt(" #n ")" ::: "memory")
#define PG8_WAIT_L(n) asm volatile("s_waitcnt lgkmcnt(" #n ")" ::: "memory")
#define PG8_BAR __builtin_amdgcn_s_barrier()
#define PG8_SCHED __builtin_amdgcn_sched_barrier(0)
    Unit cur, nxt; int ui = 0;
    if (!S.next(0, cur)) return;
    f32x4 acc[2][2][4][2];
#pragma unroll
    for (int a = 0; a < 2; ++a)
#pragma unroll
        for (int b = 0; b < 2; ++b)
#pragma unroll
            for (int m = 0; m < 4; ++m)
#pragma unroll
                for (int n = 0; n < 2; ++n) acc[a][b][m][n] = (f32x4){0.f, 0.f, 0.f, 0.f};
    bf16x8 At[4][2], B0[2][2], B1[2][2];
    unsigned vA[2][2], vN[2][2];
    S.a_voff(0, cur, tid, vA);
    const char* cA = S.a_base(cur); const char* cB = S.b_base(cur);
    PG8_STAGE(PG8_SB(0, 0), cB, voffB); PG8_STAGE(PG8_SB(0, 1), cB + hstep, voffB); PG8_STAGE(PG8_SA(0, 0), cA, vA[0]); PG8_STAGE(PG8_SA(0, 1), cA, vA[1]);
    if (wr == 1) PG8_BAR;
    PG8_WAIT_V(2); PG8_BAR;
    PG8_STAGE(PG8_SB(1, 0), cB + kstep, voffB); PG8_STAGE(PG8_SA(1, 0), cA + kstep, vA[0]); PG8_STAGE(PG8_SB(1, 1), cB + hstep + kstep, voffB);
    PG8_WAIT_V(6); PG8_BAR;
    for (;;) {
        const bool has_next = S.next(ui + 1, nxt);
        if (has_next) S.a_voff(ui + 1, nxt, tid, vN);
        const char* nA = has_next ? S.a_base(nxt) : cA; const char* nB = has_next ? S.b_base(nxt) : cB;
        for (int t = 0; t < nt; t += 2) {
            const bool last = (t == nt - 2);
            const char* a1 = cA + (size_t)(t + 1) * kstep;
            const char* a2 = last ? nA : cA + (size_t)(t + 2) * kstep; const char* b2 = last ? nB : cB + (size_t)(t + 2) * kstep;
            const char* a3 = a2 + kstep; const char* b3 = b2 + kstep;
            PG8_LDB(B0, 0, 0); PG8_LDB(B1, 0, 1); PG8_SCHED; PG8_LDA(At, 0, 0); PG8_STAGE(PG8_SA(1, 1), a1, vA[1]);
            if (last && has_next) {
#pragma unroll
                for (int h = 0; h < 2; ++h)
#pragma unroll
                    for (int i = 0; i < 2; ++i) vA[h][i] = vN[h][i];
            }
            PG8_WAIT_V(8); PG8_WAIT_L(0); PG8_BAR; PG8_MMA(0, 0, At, B0); PG8_MMA(0, 1, At, B1); PG8_BAR; PG8_SCHED;
            PG8_LDA(At, 0, 1); PG8_STAGE(PG8_SB(0, 0), b2, voffB); PG8_STAGE(PG8_SB(0, 1), b2 + hstep, voffB); PG8_STAGE(PG8_SA(0, 0), a2, vA[0]);
            PG8_WAIT_V(8); PG8_WAIT_L(0); PG8_BAR; PG8_MMA(1, 0, At, B0); PG8_MMA(1, 1, At, B1); PG8_BAR; PG8_SCHED;
            PG8_LDB(B0, 1, 0); PG8_LDB(B1, 1, 1); PG8_SCHED; PG8_LDA(At, 1, 0); PG8_STAGE(PG8_SA(0, 1), a2, vA[1]);
            PG8_WAIT_V(8); PG8_WAIT_L(0); PG8_BAR; PG8_MMA(0, 0, At, B0); PG8_MMA(0, 1, At, B1); PG8_BAR; PG8_SCHED;
            PG8_LDA(At, 1, 1); PG8_STAGE(PG8_SB(1, 0), b3, voffB); PG8_STAGE(PG8_SB(1, 1), b3 + hstep, voffB); PG8_STAGE(PG8_SA(1, 0), a3, vA[0]);
            PG8_WAIT_V(8); PG8_WAIT_L(0); PG8_BAR; PG8_MMA(1, 0, At, B0); PG8_MMA(1, 1, At, B1); PG8_BAR; PG8_SCHED;
        }
        if (wr == 0) PG8_BAR;
        E(acc, cur, wr, wc, fr, fq);
        if (!has_next) break;
#pragma unroll
        for (int a = 0; a < 2; ++a)
#pragma unroll
            for (int b = 0; b < 2; ++b)
#pragma unroll
                for (int m = 0; m < 4; ++m)
#pragma unroll
                    for (int n = 0; n < 2; ++n) acc[a][b][m][n] = (f32x4){0.f, 0.f, 0.f, 0.f};
        cur = nxt; cA = nA; cB = nB; ++ui;
        if (wr == 1) PG8_BAR;
    }
    PG8_WAIT_V(0);
    PG8_BAR;
#undef PG8_SA
#undef PG8_SB
#undef PG8_STAGE
#undef PG8_LDA
#undef PG8_LDB
#undef PG8_MMA
#undef PG8_WAIT_V
#undef PG8_WAIT_L
#undef PG8_BAR
#undef PG8_SCHED
}
}

#define LAS __attribute__((address_space(3)))
typedef pg8::f32x4 f32x4; typedef pg8::u32x4 u32x4; typedef pg8::Unit Unit;
constexpr size_t TSTEP2K = (size_t)256 * 2048 * 2, TSTEP512 = (size_t)256 * 512 * 2;

struct SchedIn {
    const char *A, *Bt; int G, c;
    __device__ __forceinline__ bool next(int i, Unit& u) const { const int Lx = i * G + c; if (Lx >= 844) return false;
        if (Lx < 832) pg8::rect_unit(Lx, 64, 13, u); else { const int r = Lx - 832; u.pm = 64 + (r & 3); const int q = r >> 2; u.pn = q == 2 ? 12 : 2 + q; } return true; }
    __device__ __forceinline__ const char* a_base(const Unit& u) const { return A + (size_t)u.pm * TSTEP2K; }
    __device__ __forceinline__ const char* b_base(const Unit& u) const { return Bt + (size_t)u.pn * TSTEP2K; }
    __device__ __forceinline__ void a_voff(int, const Unit&, int tid, unsigned (&v)[2][2]) const { pg8::dense_voff(2048, tid, v); }
};
struct SchedQKV {
    const char *A, *Bt; int G, c;
    __device__ __forceinline__ bool next(int i, Unit& u) const { const int Lx = i * G + c; if (Lx >= 928) return false;
        if (Lx < 384) pg8::rect_unit(Lx, 64, 6, u); else { pg8::rect_unit(Lx - 384, 68, 8, u); u.pm += 64; u.pn += 6; } return true; }
    __device__ __forceinline__ const char* a_base(const Unit& u) const { return A + (size_t)u.pm * TSTEP512; }
    __device__ __forceinline__ const char* b_base(const Unit& u) const { return Bt + (size_t)u.pn * TSTEP512; }
    __device__ __forceinline__ void a_voff(int, const Unit&, int tid, unsigned (&v)[2][2]) const { pg8::dense_voff(512, tid, v); }
};
struct SchedDense {
    const char *A, *Bt; int G, c, nM, nN, bshift, KU;
    __device__ __forceinline__ bool next(int i, Unit& u) const { const int Lx = i * G + c; if (Lx >= nM * nN) return false; pg8::rect_unit(Lx, nM, nN, u); return true; }
    __device__ __forceinline__ const char* a_base(const Unit& u) const { return A + (size_t)u.pm * 512 * KU; }
    __device__ __forceinline__ const char* b_base(const Unit& u) const { return Bt + (size_t)((u.pm >> bshift) * nN + u.pn) * 512 * KU; }
    __device__ __forceinline__ void a_voff(int, const Unit&, int tid, unsigned (&v)[2][2]) const { pg8::dense_voff(KU, tid, v); }
};
struct SchedGather {
    const char *A, *Bt; int G, c; const LAS unsigned* tab; int KU;
    __device__ __forceinline__ bool next(int i, Unit& u) const { const int Lx = i * G + c; if (Lx >= 2048) return false; pg8::rect_unit(Lx, 128, 16, u); return true; }
    __device__ __forceinline__ const char* a_base(const Unit&) const { return A; }
    __device__ __forceinline__ const char* b_base(const Unit& u) const { return Bt + (size_t)((u.pm >> 3) * 16 + u.pn) * 512 * KU; }
    __device__ __forceinline__ void a_voff(int i, const Unit&, int tid, unsigned (&v)[2][2]) const {
#pragma unroll
        for (int p = 0; p < 2; ++p) { int R, C; pg8::stage_rc(tid * 16 + p * 8192, R, C); v[0][p] = tab[i * 256 + R] + (unsigned)C * 2u; v[1][p] = tab[i * 256 + 128 + R] + (unsigned)C * 2u; }
    }
};

__device__ __forceinline__ float gelu_fast(float x) {
    const float z2 = -2.302208198f * (x + 0.044715f * x * x * x);
    return x * __builtin_amdgcn_rcpf(1.f + __builtin_amdgcn_exp2f(z2));
}
__device__ __forceinline__ float silu_fast(float x) { return x * __builtin_amdgcn_rcpf(1.f + __builtin_amdgcn_exp2f(-1.4426950408889634f * x)); }
__device__ __forceinline__ float dot4(const f32x4& a) { return (a[0] * a[0] + a[1] * a[1]) + (a[2] * a[2] + a[3] * a[3]); }
__device__ __forceinline__ void rope8(f32x4& a, f32x4& b, const float* tabrow  , int fq) {
    const f32x4 t0 = *(const f32x4*)(tabrow + 8 * fq), t1 = *(const f32x4*)(tabrow + 8 * fq + 4);
    f32x4 ra, rb;
    ra[0] = a[0] * t0[0] - a[1] * t0[1]; ra[1] = a[1] * t0[0] + a[0] * t0[1]; ra[2] = a[2] * t0[2] - a[3] * t0[3]; ra[3] = a[3] * t0[2] + a[2] * t0[3];
    rb[0] = b[0] * t1[0] - b[1] * t1[1]; rb[1] = b[1] * t1[0] + b[0] * t1[1]; rb[2] = b[2] * t1[2] - b[3] * t1[3]; rb[3] = b[3] * t1[2] + b[2] * t1[3];
    a = ra; b = rb;
}
struct EpiIn {
    static constexpr bool PERM = true; unsigned char* ws;
    __device__ __forceinline__ void operator()(const f32x4 (&acc)[2][2][4][2], const Unit& u, int wr, int wc, int fr, int fq) const {
        const int pn = u.pn, row0 = u.pm * 256 + wr * 64 + fr, c8 = wc * 32 + 8 * fq;
        if (pn < 4) {
            bf16* base = (bf16*)(ws + WS_CQKV) + (pn >= 2 ? (size_t)M * 512 : 0) + (pn & 1) * 256 + c8;
            float* ssq = (float*)(ws + (pn >= 2 ? WS_SSQKV : WS_SSQQ)) + (pn & 1) * 4 + wc;
#pragma unroll
            for (int ai = 0; ai < 2; ++ai)
#pragma unroll
                for (int m = 0; m < 4; ++m) { const int row = row0 + ai * 128 + m * 16; float s = 0.f;
#pragma unroll
                    for (int bj = 0; bj < 2; ++bj) { s += dot4(acc[ai][bj][m][0]) + dot4(acc[ai][bj][m][1]); *(u32x4*)(base + (size_t)row * 512 + bj * 128) = pg8::pack8(acc[ai][bj][m][0], acc[ai][bj][m][1]); }
                    s += __shfl_xor(s, 16); s += __shfl_xor(s, 32);
                    if (fq == 0) ssq[(size_t)row * 8] = s; }
        } else if (pn < 12) {
            bf16* base = (bf16*)(ws + (pn < 8 ? WS_U : WS_VS)) + ((pn - 4) & 3) * 256 + c8;
#pragma unroll
            for (int ai = 0; ai < 2; ++ai)
#pragma unroll
                for (int m = 0; m < 4; ++m) { const int row = row0 + ai * 128 + m * 16;
#pragma unroll
                    for (int bj = 0; bj < 2; ++bj) { f32x4 a = acc[ai][bj][m][0], b = acc[ai][bj][m][1];
#pragma unroll
                        for (int j = 0; j < 4; ++j) { a[j] = gelu_fast(a[j]); b[j] = gelu_fast(b[j]); }
                        *(u32x4*)(base + (size_t)row * 1024 + bj * 128) = pg8::pack8(a, b); } }
        } else if (wc < 2) {
            const float* tab = (const float*)(ws + WS_ROPE);
#pragma unroll
            for (int ai = 0; ai < 2; ++ai)
#pragma unroll
                for (int m = 0; m < 4; ++m) { const int row = row0 + ai * 128 + m * 16; f32x4 a = acc[ai][0][m][0], b = acc[ai][0][m][1]; int bb, kpos;
                    if (row < M) { bb = row >> 12; kpos = row & 4095; const int ax = wc ? (kpos & 63) : (kpos >> 6); rope8(a, b, tab + ax * 32, fq); }
                    else { bb = (row - M) >> 8; kpos = L + ((row - M) & 255); }
                    const u32x4 w = pg8::pack8(a, b); bf16* d = (bf16*)(ws + WS_K) + ((size_t)(bb * H) * LK + kpos) * DQK + 128 + c8;
#pragma unroll
                    for (int hh = 0; hh < H; ++hh) *(u32x4*)(d + (size_t)hh * LK * DQK) = w; }
        }
    }
};
struct EpiQKV {
    static constexpr bool PERM = true; unsigned char* ws;
    __device__ __forceinline__ void operator()(const f32x4 (&acc)[2][2][4][2], const Unit& u, int wr, int wc, int fr, int fq) const {
        const int c8 = wc * 32 + 8 * fq;
        if (u.pn < 6) {
            const int pn = u.pn, row0 = u.pm * 256 + wr * 64 + fr; const float* tab = (const float*)(ws + WS_ROPE);
#pragma unroll
            for (int ai = 0; ai < 2; ++ai)
#pragma unroll
                for (int m = 0; m < 4; ++m) { const int row = row0 + ai * 128 + m * 16; const int bb = row >> 12, t = row & 4095;
                    const f32x4 s0 = *(const f32x4*)((const float*)(ws + WS_SSQQ) + (size_t)row * 8), s1 = *(const f32x4*)((const float*)(ws + WS_SSQQ) + (size_t)row * 8 + 4);
                    const float rs = rsqrtf((((s0[0] + s0[1]) + (s0[2] + s0[3])) + ((s1[0] + s1[1]) + (s1[2] + s1[3]))) * (1.f / 512.f) + EPS);
#pragma unroll
                    for (int bj = 0; bj < 2; ++bj) { f32x4 a = acc[ai][bj][m][0] * rs, b = acc[ai][bj][m][1] * rs; bf16* d;
                        if (pn < 4) d = (bf16*)(ws + WS_Q) + ((size_t)(bb * H + pn * 2 + bj) * L + t) * DQK + c8;
                        else { const int hd = (pn - 4) * 4 + bj * 2 + (wc >> 1), ax = (wc & 1) ? (t & 63) : (t >> 6); rope8(a, b, tab + ax * 32, fq);
                            d = (bf16*)(ws + WS_Q) + ((size_t)(bb * H + hd) * L + t) * DQK + 128 + (wc & 1) * 32 + 8 * fq; }
                        *(u32x4*)d = pg8::pack8(a, b); } }
        } else {
            const int hd = u.pn - 6, row0 = (u.pm - 64) * 256 + wr * 64 + fr;
#pragma unroll
            for (int ai = 0; ai < 2; ++ai)
#pragma unroll
                for (int m = 0; m < 4; ++m) { const int row = row0 + ai * 128 + m * 16; int bb, kpos;
                    if (row < M) { bb = row >> 12; kpos = row & 4095; } else { bb = (row - M) >> 8; kpos = L + ((row - M) & 255); }
                    const f32x4 s0 = *(const f32x4*)((const float*)(ws + WS_SSQKV) + (size_t)row * 8), s1 = *(const f32x4*)((const float*)(ws + WS_SSQKV) + (size_t)row * 8 + 4);
                    const float rs = rsqrtf((((s0[0] + s0[1]) + (s0[2] + s0[3])) + ((s1[0] + s1[1]) + (s1[2] + s1[3]))) * (1.f / 512.f) + EPS);
                    const size_t kr = (size_t)(bb * H + hd) * LK + kpos;
                    *(u32x4*)((bf16*)(ws + WS_K) + kr * DQK + c8) = pg8::pack8(acc[ai][0][m][0] * rs, acc[ai][0][m][1] * rs);
                    *(u32x4*)((bf16*)(ws + WS_V) + kr * VH + c8) = pg8::pack8(acc[ai][1][m][0] * rs, acc[ai][1][m][1] * rs); }
        }
    }
};
struct EpiY {
    static constexpr bool PERM = true; unsigned char* ws;
    __device__ __forceinline__ void operator()(const f32x4 (&acc)[2][2][4][2], const Unit& u, int wr, int wc, int fr, int fq) const {
        const int row0 = u.pm * 256 + wr * 64 + fr; bf16* base = (bf16*)(ws + WS_Y) + u.pn * 256 + wc * 32 + 8 * fq; float* ssq = (float*)(ws + WS_SSQY) + u.pn * 4 + wc;
#pragma unroll
        for (int ai = 0; ai < 2; ++ai)
#pragma unroll
            for (int m = 0; m < 4; ++m) { const int row = row0 + ai * 128 + m * 16; float s = 0.f;
#pragma unroll
                for (int bj = 0; bj < 2; ++bj) { s += dot4(acc[ai][bj][m][0]) + dot4(acc[ai][bj][m][1]); *(u32x4*)(base + (size_t)row * D + bj * 128) = pg8::pack8(acc[ai][bj][m][0], acc[ai][bj][m][1]); }
                s += __shfl_xor(s, 16); s += __shfl_xor(s, 32);
                if (fq == 0) ssq[(size_t)row * 32] = s; }
    }
};
__device__ __forceinline__ unsigned pack4_fp8(float a, float b, float c, float d) { int w = 0; w = __builtin_amdgcn_cvt_pk_fp8_f32(a, b, w, false); w = __builtin_amdgcn_cvt_pk_fp8_f32(c, d, w, true); return (unsigned)w; }
constexpr float W8_SCALE = 64.f, W8_INV = 1.f / 64.f;
struct EpiAct8 {
    static constexpr bool PERM = true; unsigned char* ws;
    __device__ __forceinline__ void operator()(const f32x4 (&acc)[2][2][4][2], const Unit& u, int wr, int wc, int fr, int fq) const {
        const int row0 = u.pm * 256 + wr * 64 + fr; unsigned char* base = ws + WS_ACT + u.pn * 128 + wc * 32 + 8 * fq;
#pragma unroll
        for (int ai = 0; ai < 2; ++ai)
#pragma unroll
            for (int m = 0; m < 4; ++m) { const int row = row0 + ai * 128 + m * 16; f32x4 a, b;
#pragma unroll
                for (int j = 0; j < 4; ++j) { a[j] = silu_fast(acc[ai][0][m][0][j] * W8_INV) * (acc[ai][1][m][0][j] * W8_INV); b[j] = silu_fast(acc[ai][0][m][1][j] * W8_INV) * (acc[ai][1][m][1][j] * W8_INV); }
                *(unsigned long long*)(base + (size_t)row * FF) = (unsigned long long)pack4_fp8(a[0], a[1], a[2], a[3]) | ((unsigned long long)pack4_fp8(b[0], b[1], b[2], b[3]) << 32); }
    }
};
struct EpiYE8 {
    static constexpr bool PERM = true; unsigned char* ws;
    __device__ __forceinline__ void operator()(const f32x4 (&acc)[2][2][4][2], const Unit& u, int wr, int wc, int fr, int fq) const {
        const int row0 = u.pm * 256 + wr * 64 + fr; bf16* base = (bf16*)(ws + WS_YE) + u.pn * 256 + wc * 32 + 8 * fq;
#pragma unroll
        for (int ai = 0; ai < 2; ++ai)
#pragma unroll
            for (int m = 0; m < 4; ++m) { const int row = row0 + ai * 128 + m * 16;
#pragma unroll
                for (int bj = 0; bj < 2; ++bj) *(u32x4*)(base + (size_t)row * D + bj * 128) = pg8::pack8(acc[ai][bj][m][0] * W8_INV, acc[ai][bj][m][1] * W8_INV); }
    }
};
struct EpiAct {
    static constexpr bool PERM = true; unsigned char* ws;
    __device__ __forceinline__ void operator()(const f32x4 (&acc)[2][2][4][2], const Unit& u, int wr, int wc, int fr, int fq) const {
        const int row0 = u.pm * 256 + wr * 64 + fr; bf16* base = (bf16*)(ws + WS_ACT) + u.pn * 128 + wc * 32 + 8 * fq;
#pragma unroll
        for (int ai = 0; ai < 2; ++ai)
#pragma unroll
            for (int m = 0; m < 4; ++m) { const int row = row0 + ai * 128 + m * 16; f32x4 a, b;
#pragma unroll
                for (int j = 0; j < 4; ++j) { a[j] = silu_fast(acc[ai][0][m][0][j]) * acc[ai][1][m][0][j]; b[j] = silu_fast(acc[ai][0][m][1][j]) * acc[ai][1][m][1][j]; }
                *(u32x4*)(base + (size_t)row * FF) = pg8::pack8(a, b); }
    }
};
struct EpiYE {
    static constexpr bool PERM = true; unsigned char* ws;
    __device__ __forceinline__ void operator()(const f32x4 (&acc)[2][2][4][2], const Unit& u, int wr, int wc, int fr, int fq) const {
        const int row0 = u.pm * 256 + wr * 64 + fr; bf16* base = (bf16*)(ws + WS_YE) + u.pn * 256 + wc * 32 + 8 * fq;
#pragma unroll
        for (int ai = 0; ai < 2; ++ai)
#pragma unroll
            for (int m = 0; m < 4; ++m) { const int row = row0 + ai * 128 + m * 16;
#pragma unroll
                for (int bj = 0; bj < 2; ++bj) *(u32x4*)(base + (size_t)row * D + bj * 128) = pg8::pack8(acc[ai][bj][m][0], acc[ai][bj][m][1]); }
    }
};

namespace att {
using bf16x8 = __attribute__((ext_vector_type(8))) short;
using s16x4  = __attribute__((ext_vector_type(4))) short;
using f32x16 = __attribute__((ext_vector_type(16))) float;
using u32x4  = __attribute__((ext_vector_type(4))) unsigned;
constexpr int QBLK = 32, KVBLK = 64, NW = 8;
constexpr float SCALE = cfg::ATT_SCALE, THR = 8.f;
constexpr int LDQ = 192, LDKK = 192, LDV = 128, LDO = 2048;
constexpr int SHM_V = KVBLK * 128 * 2, SHM_K = KVBLK * 192 * 2, SHM_QPE = 2 * SHM_V + 2 * SHM_K + NW * 64 * 4, SHM_ATTN = SHM_QPE + NW * 4096;
#define KSWZ(row, colB) ((row) * 384 + ((colB) ^ (((row) & 7) << 4)))
#define SBAR() __builtin_amdgcn_sched_barrier(0)
__device__ __forceinline__ int crow(int r, int hi) { return (r & 3) + 8 * (r >> 2) + 4 * hi; }
__device__ __forceinline__ unsigned cvtpk(float lo, float hi) { unsigned r; asm volatile("v_cvt_pk_bf16_f32 %0, %1, %2" : "=v"(r) : "v"(lo), "v"(hi)); return r; }

__device__ __forceinline__ void partialSM(f32x16& p0, f32x16& p1, float& m_reg, float& mn, float& alpha) {
  constexpr float C = SCALE * 1.4426950408889634f;
  float pmax = p0[0];
#pragma unroll
  for (int r = 1; r < 16; ++r) pmax = fmaxf(pmax, p0[r]);
#pragma unroll
  for (int r = 0; r < 16; ++r) pmax = fmaxf(pmax, p1[r]);
  { auto rr = __builtin_amdgcn_permlane32_swap(__float_as_uint(pmax), __float_as_uint(pmax), false, false);
    pmax = fmaxf(__uint_as_float(rr[0]), __uint_as_float(rr[1])); }
  if (__builtin_expect(__all(pmax - m_reg <= THR / SCALE), 1)) { mn = m_reg; alpha = 1.f; }
  else { mn = fmaxf(m_reg, pmax); alpha = __builtin_amdgcn_exp2f((m_reg - mn) * C); m_reg = mn; }
  float mnC = -mn * C;
#pragma unroll
  for (int r = 0; r < 16; ++r) p0[r] = fmaf(p0[r], C, mnC);
#pragma unroll
  for (int r = 0; r < 16; ++r) p1[r] = fmaf(p1[r], C, mnC);
#pragma unroll
  for (int r = 0; r < 16; ++r) p0[r] = __builtin_amdgcn_exp2f(p0[r]);
}
__device__ __forceinline__ void finishSM(f32x16& p0, f32x16& p1, float alpha, float& l_reg, bf16x8& pa0, bf16x8& pa1, bf16x8& pa2, bf16x8& pa3) {
#pragma unroll
  for (int r = 0; r < 16; ++r) p1[r] = __builtin_amdgcn_exp2f(p1[r]);
  float ps = 0;
#pragma unroll
  for (int r = 0; r < 16; ++r) ps += p0[r];
#pragma unroll
  for (int r = 0; r < 16; ++r) ps += p1[r];
  { auto rr = __builtin_amdgcn_permlane32_swap(__float_as_uint(ps), __float_as_uint(ps), false, false);
    ps = __uint_as_float(rr[0]) + __uint_as_float(rr[1]); }
  l_reg = l_reg * alpha + ps;
#define PK4(P, BASE, OUT) do { unsigned a0 = cvtpk(P[BASE + 0], P[BASE + 1]), a1 = cvtpk(P[BASE + 2], P[BASE + 3]);   \
    unsigned b0 = cvtpk(P[BASE + 4], P[BASE + 5]), b1 = cvtpk(P[BASE + 6], P[BASE + 7]);                              \
    auto r0 = __builtin_amdgcn_permlane32_swap(a0, b0, false, false); auto r1 = __builtin_amdgcn_permlane32_swap(a1, b1, false, false); \
    u32x4 w = {r0[0], r1[0], r0[1], r1[1]}; OUT = *reinterpret_cast<bf16x8*>(&w); } while (0)
  PK4(p0, 0, pa0); PK4(p0, 8, pa1); PK4(p1, 0, pa2); PK4(p1, 8, pa3);
#undef PK4
}
__device__ __forceinline__ void qkt(f32x16& p0, f32x16& p1, const char* Ks, const bf16x8* qr, const char* qpe, int r32, int hi) {
  p0 = f32x16{}; p1 = f32x16{};
#pragma unroll
  for (int d0 = 0; d0 < 12; ++d0) { const int cb = (d0 * 16 + hi * 8) * 2;
    bf16x8 b0 = *reinterpret_cast<const bf16x8*>(Ks + KSWZ(r32, cb));
    bf16x8 b1 = *reinterpret_cast<const bf16x8*>(Ks + KSWZ(32 + r32, cb));
    const bf16x8 q = d0 < 8 ? qr[d0 < 8 ? d0 : 0] : *reinterpret_cast<const bf16x8*>(qpe + (d0 - 8) * 1024);
    p0 = __builtin_amdgcn_mfma_f32_32x32x16_bf16(b0, q, p0, 0, 0, 0);
    p1 = __builtin_amdgcn_mfma_f32_32x32x16_bf16(b1, q, p1, 0, 0, 0); }
}
__device__ __forceinline__ int v_st(int k, int c) { const int kk = (k & ~0xC) | ((k & 4) << 1) | ((k & 8) >> 1); return ((kk >> 3) * 4 + (c >> 5)) * 512 + ((kk & 7) * 32 + (c & 31)) * 2; }
__device__ __forceinline__ int v_rd_base(int lane) { return ((lane & 3) << 3) | (((lane >> 2) & 3) << 6) | (((lane >> 4) & 1) << 5) | (((lane >> 5) & 1) << 8); }
constexpr int v_rd_off(int d0, int ks, int half) { return d0 * 512 + ks * 4096 + half * 2048; }
template <int OFF> __device__ __forceinline__ s16x4 tr_read(int vb) {
  s16x4 r; asm volatile("ds_read_b64_tr_b16 %0, %1 offset:%2" : "=&v"(r) : "v"(vb), "i"(OFF) : "memory"); return r;
}
template <int D0> __device__ __forceinline__ void pv_one(f32x16& od, int vb, bf16x8 pa0, bf16x8 pa1, bf16x8 pa2, bf16x8 pa3) {
  const s16x4 l0 = tr_read<v_rd_off(D0, 0, 0)>(vb), h0 = tr_read<v_rd_off(D0, 0, 1)>(vb), l1 = tr_read<v_rd_off(D0, 1, 0)>(vb), h1 = tr_read<v_rd_off(D0, 1, 1)>(vb);
  const s16x4 l2 = tr_read<v_rd_off(D0, 2, 0)>(vb), h2 = tr_read<v_rd_off(D0, 2, 1)>(vb), l3 = tr_read<v_rd_off(D0, 3, 0)>(vb), h3 = tr_read<v_rd_off(D0, 3, 1)>(vb);
  asm volatile("s_waitcnt lgkmcnt(0)" ::: "memory"); SBAR();
#define PK(L, H) (bf16x8){L[0], L[1], L[2], L[3], H[0], H[1], H[2], H[3]}
  od = __builtin_amdgcn_mfma_f32_32x32x16_bf16(pa0, PK(l0, h0), od, 0, 0, 0);
  od = __builtin_amdgcn_mfma_f32_32x32x16_bf16(pa1, PK(l1, h1), od, 0, 0, 0);
  od = __builtin_amdgcn_mfma_f32_32x32x16_bf16(pa2, PK(l2, h2), od, 0, 0, 0);
  od = __builtin_amdgcn_mfma_f32_32x32x16_bf16(pa3, PK(l3, h3), od, 0, 0, 0);
#undef PK
}
__device__ __forceinline__ void pv_d0(f32x16* o, int vb, bf16x8 pa0, bf16x8 pa1, bf16x8 pa2, bf16x8 pa3) {
  pv_one<0>(o[0], vb, pa0, pa1, pa2, pa3); pv_one<1>(o[1], vb, pa0, pa1, pa2, pa3); pv_one<2>(o[2], vb, pa0, pa1, pa2, pa3); pv_one<3>(o[3], vb, pa0, pa1, pa2, pa3);
}
__device__ __forceinline__ void attn_unit(const bf16* __restrict__ Qb, const bf16* __restrict__ Kh, const bf16* __restrict__ Vh, bf16* __restrict__ Ob, int seq, char* lds) {
  const int tid = threadIdx.x, wid = tid >> 6, lane = tid & 63, r32 = lane & 31, hi = lane >> 5;
  char* V_lds = lds; char* K_lds = lds + 2 * SHM_V;
  float* ws = (float*)(lds + 2 * SHM_V + 2 * SHM_K) + wid * 64; float* li_l = ws; float* al_l = ws + 32;
  float m_reg = -1e30f, l_reg = 0; f32x16 o[4] = {}; bf16x8 qr[8];
  const bf16* Qw = Qb + (long)(wid * QBLK + r32) * LDQ + hi * 8;
  char* qpe = lds + SHM_QPE + wid * 4096 + lane * 16;
#pragma unroll
  for (int d0 = 0; d0 < 8; ++d0) qr[d0] = *reinterpret_cast<const bf16x8*>(Qw + d0 * 16);
#pragma unroll
  for (int d0 = 8; d0 < 12; ++d0) *reinterpret_cast<bf16x8*>(qpe + (d0 - 8) * 1024) = *reinterpret_cast<const bf16x8*>(Qw + d0 * 16);
  const int sr = tid >> 4, sc = (tid & 15) * 8, vst0 = v_st(sr, sc), vst1 = v_st(32 + sr, sc);
  int kro[3], kst[3];
#pragma unroll
  for (int j = 0; j < 3; ++j) { const int p = tid + 512 * j, row = p / 24, pc = p - row * 24; kro[j] = row * LDKK + pc * 8; kst[j] = KSWZ(row, pc * 16); }
  const int vb0 = (int)(uintptr_t)V_lds + v_rd_base(lane);
  bf16x8 vs0, vs1, ks0, ks1, ks2;
#define SLOAD(k0) do { vs0 = *reinterpret_cast<const bf16x8*>(&Vh[(long)((k0) + sr) * LDV + sc]); vs1 = *reinterpret_cast<const bf16x8*>(&Vh[(long)((k0) + 32 + sr) * LDV + sc]); \
    ks0 = *reinterpret_cast<const bf16x8*>(&Kh[(long)(k0) * LDKK + kro[0]]); ks1 = *reinterpret_cast<const bf16x8*>(&Kh[(long)(k0) * LDKK + kro[1]]); ks2 = *reinterpret_cast<const bf16x8*>(&Kh[(long)(k0) * LDKK + kro[2]]); } while (0)
#define SWRITE(b) do { *(bf16x8*)(V_lds + (b) * SHM_V + vst0) = vs0; *(bf16x8*)(V_lds + (b) * SHM_V + vst1) = vs1; \
    *(bf16x8*)(K_lds + (b) * SHM_K + kst[0]) = ks0; *(bf16x8*)(K_lds + (b) * SHM_K + kst[1]) = ks1; *(bf16x8*)(K_lds + (b) * SHM_K + kst[2]) = ks2; } while (0)
#define SWAIT() asm volatile("s_waitcnt vmcnt(0)" ::: "memory")
#define RESC(a) do { if (__any((a) < 1.f)) { if (hi == 0) al_l[r32] = (a); asm volatile("s_waitcnt lgkmcnt(0)" ::: "memory"); \
    _Pragma("unroll") for (int d = 0; d < 4; ++d) _Pragma("unroll") for (int r = 0; r < 16; ++r) o[d][r] *= al_l[crow(r, hi)]; } } while (0)
  f32x16 pA0, pA1; float mnA, alA; bf16x8 pa0, pa1, pa2, pa3; const int NT = seq / KVBLK;
  SLOAD(0); SWAIT(); SWRITE(0); __syncthreads();
  for (int j = 0; j < NT; ++j) {
    const int bsel = j & 1;
    SBAR(); qkt(pA0, pA1, K_lds + bsel * SHM_K, qr, qpe, r32, hi);
    partialSM(pA0, pA1, m_reg, mnA, alA);
    RESC(alA);
    finishSM(pA0, pA1, alA, l_reg, pa0, pa1, pa2, pa3); SBAR();
    if (j + 1 < NT) SLOAD((j + 1) * KVBLK);
    SBAR();
    pv_d0(o, vb0 + bsel * (int)SHM_V, pa0, pa1, pa2, pa3);
    if (j + 1 < NT) { SWAIT(); if (bsel) SWRITE(0); else SWRITE(1); }
    __syncthreads();
  }
  if (hi == 0) li_l[r32] = l_reg; asm volatile("s_waitcnt lgkmcnt(0)" ::: "memory");
  float rli[16];
#pragma unroll
  for (int r = 0; r < 16; ++r) rli[r] = __builtin_amdgcn_rcpf(li_l[crow(r, hi)]);
  bf16* Ow = Ob + (long)(wid * QBLK) * LDO;
#pragma unroll
  for (int r = 0; r < 16; ++r) { const int orow = crow(r, hi);
#pragma unroll
    for (int d0 = 0; d0 < 4; ++d0) Ow[(long)orow * LDO + d0 * 32 + r32] = f2bf(o[d0][r] * rli[r]); }
#undef SLOAD
#undef SWRITE
#undef SWAIT
#undef RESC
}
#undef KSWZ
#undef SBAR
}

#define XB_TMO      128
#define XB_XCNT(j)  (256  + 64 * (j))
#define XB_XSUB(j)  (1280 + 64 * (j))
#define XB_XGEN(j)  (2304 + 64 * (j))
#define XB_TOP      3328
#define XB_TOPGEN   3392
#define XCD_BAR_WORDS 3456
#define XB_SPIN_CAP (1u << 18)
__device__ __forceinline__ unsigned xb_ld(unsigned* p)              { return __hip_atomic_load(p, __ATOMIC_RELAXED, __HIP_MEMORY_SCOPE_AGENT); }
__device__ __forceinline__ unsigned xb_add(unsigned* p, unsigned v) { return __hip_atomic_fetch_add(p, v, __ATOMIC_RELAXED, __HIP_MEMORY_SCOPE_AGENT); }
__device__ __forceinline__ unsigned xb_xcc_id() { return (unsigned)__builtin_amdgcn_s_getreg((3 << 11) | 20) & 0xFu; }
#define XB_SPIN(cond, bar) do { unsigned _sp = 0; while (cond) { __builtin_amdgcn_s_sleep(1); \
    if ((++_sp & 255u) == 0u) { if (xb_ld(&(bar)[XB_TMO])) break; if (_sp > XB_SPIN_CAP) { atomicAdd(&(bar)[XB_TMO], 1u); break; } } } } while (0)
struct XcdBarrier { unsigned* bar; unsigned x; volatile LAS unsigned* st; };
__device__ __forceinline__ XcdBarrier xcd_barrier_post(unsigned* bar, volatile LAS unsigned* st) {
    XcdBarrier b; b.bar = bar; b.x = xb_xcc_id(); b.st = st;
    if (threadIdx.x == 0) (void)xb_add(&bar[XB_XCNT(b.x)], 1u);
    return b;
}
__device__ __forceinline__ void xcd_barrier_complete(unsigned* bar, unsigned x, unsigned& nloc, unsigned& nx) {
    const unsigned G = gridDim.x * gridDim.y * gridDim.z;
    unsigned sum, cnt, mine, sp = 0u;
    for (;;) {
        sum = 0u; cnt = 0u; mine = 0u;
#pragma unroll
        for (unsigned j = 0; j < 16; ++j) { const unsigned c = xb_ld(&bar[XB_XCNT(j)]); sum += c; cnt += (c > 0u) ? 1u : 0u; mine = (j == x) ? c : mine; }
        if (sum == G) break;
        __builtin_amdgcn_s_sleep(1);
        if ((++sp & 255u) == 0u) { if (xb_ld(&bar[XB_TMO])) break; if (sp > XB_SPIN_CAP) { atomicAdd(&bar[XB_TMO], 1u); break; } }
    }
    nloc = mine > 0u ? mine : 1u; nx = cnt > 0u ? cnt : 1u;
}
__device__ __forceinline__ void xcd_barrier(const XcdBarrier& b) {
    asm volatile("s_waitcnt vmcnt(0)" ::: "memory");
    __syncthreads();
    if (threadIdx.x == 0) {
        unsigned* bar = b.bar;
        __builtin_amdgcn_s_waitcnt(0);
        unsigned nloc = b.st[0], nx = b.st[1];
        if (nloc == 0u) { xcd_barrier_complete(bar, b.x, nloc, nx); b.st[0] = nloc; b.st[1] = nx; }
        const unsigned old = xb_add(&bar[XB_XSUB(b.x)], 1u);
        const unsigned gen = old / nloc;
        if (old + 1u == (gen + 1u) * nloc) {
            __builtin_amdgcn_fence(__ATOMIC_RELEASE, "agent");
            asm volatile("s_waitcnt vmcnt(0)" ::: "memory");
            const unsigned og = xb_add(&bar[XB_TOP], 1u);
            const unsigned tg = og / nx;
            if (og + 1u == (tg + 1u) * nx) xb_add(&bar[XB_TOPGEN], 1u);
            else XB_SPIN(xb_ld(&bar[XB_TOPGEN]) == tg, bar);
            __builtin_amdgcn_fence(__ATOMIC_ACQUIRE, "agent");
            xb_add(&bar[XB_XGEN(b.x)], 1u);
            asm volatile("s_waitcnt vmcnt(0)" ::: "memory");
        } else {
            XB_SPIN(xb_ld(&bar[XB_XGEN(b.x)]) == gen, bar);
            __builtin_amdgcn_fence(__ATOMIC_ACQUIRE, "agent");
            asm volatile("s_waitcnt vmcnt(0)" ::: "memory");
        }
    }
    __syncthreads();
}

constexpr int NWAVES = 8, NTHREADS = 512;
constexpr int RING_BYTES = 131072, TAB_OFF = RING_BYTES, TAB_BYTES = 8192, MISC_OFF = TAB_OFF + TAB_BYTES, LDS_BYTES = 147456;
constexpr int CW_BAR = 4096;
#define LDS_WAIT() asm volatile("s_waitcnt lgkmcnt(0)" ::: "memory")
typedef unsigned v4u __attribute__((ext_vector_type(4)));
__device__ __forceinline__ unsigned pk2(float lo, float hi) { return (unsigned)f2bf(lo) | ((unsigned)f2bf(hi) << 16); }

__device__ __forceinline__ void p0_mod_item(const Ptrs& p, int it, int lane) {
    const int kc = it / 48, cc = it - kc * 48, k0 = kc * 64, c0 = cc * 256 + lane * 4;
    float sv[5];
#pragma unroll
    for (int r = 0; r < 5; ++r) { const float* cv = r < 4 ? p.c + r * D : p.c_ctx; sv[r] = silu_f(cv[k0 + lane]); }
    f32x4 acc[5];
#pragma unroll
    for (int r = 0; r < 5; ++r) acc[r] = (f32x4){0.f, 0.f, 0.f, 0.f};
    const float* w = p.w_ada + (size_t)k0 * 12288 + c0;
#pragma unroll 8
    for (int k = 0; k < 64; ++k) { const f32x4 wv = *(const f32x4*)(w + (size_t)k * 12288);
#pragma unroll
        for (int r = 0; r < 5; ++r) acc[r] += __int_as_float(__builtin_amdgcn_readlane(__float_as_int(sv[r]), k)) * wv; }
    float* part = (float*)(p.ws + WS_PART) + (size_t)kc * 5 * 12288 + c0;
#pragma unroll
    for (int r = 0; r < 5; ++r) *(f32x4*)(part + (size_t)r * 12288) = acc[r];
}
__device__ __forceinline__ void cvt_load(const float* src, int ldw, int lane, f32x4 (&v)[8]) {
    const int kr = lane >> 3, nq = lane & 7;
#pragma unroll
    for (int i = 0; i < 8; ++i) v[i] = *(const f32x4*)(src + (size_t)(8 * i + kr) * ldw + 4 * nq);
}
__device__ __forceinline__ void cvt_finish(const f32x4 (&v)[8], bf16* dst, int ldk, bool rope, const float* kscale, LAS float* scr, int lane) {
    const int kr = lane >> 3, nq = lane & 7;
#pragma unroll
    for (int i = 0; i < 8; ++i) { const int k = 8 * i + kr; const float sc = kscale ? kscale[k] : 1.f;
#pragma unroll
        for (int t = 0; t < 4; ++t) { const int cs = 4 * nq + t, nn = rope ? ((cs & 15) * 2 + (cs >> 4)) : cs; scr[k * 33 + nn] = v[i][t] * sc; } }
    LDS_WAIT(); asm volatile("" ::: "memory");
    const int c = lane & 7;
#pragma unroll
    for (int j = 0; j < 4; ++j) { const int n = (lane >> 3) + 8 * j; const LAS float* s = scr + (8 * c) * 33 + n;
        v4u o; o.x = pg8::cvt_pk_bf16(s[0 * 33], s[1 * 33]); o.y = pg8::cvt_pk_bf16(s[2 * 33], s[3 * 33]); o.z = pg8::cvt_pk_bf16(s[4 * 33], s[5 * 33]); o.w = pg8::cvt_pk_bf16(s[6 * 33], s[7 * 33]);
        *(v4u*)(dst + (size_t)n * ldk + 8 * c) = o; }
    LDS_WAIT(); asm volatile("" ::: "memory");
}
__device__ __forceinline__ void cvt_finish_fp8(const f32x4 (&v)[8], unsigned char* dst, int ldk, LAS float* scr, int lane) {
    const int kr = lane >> 3, nq = lane & 7;
#pragma unroll
    for (int i = 0; i < 8; ++i) { const int k = 8 * i + kr;
#pragma unroll
        for (int t = 0; t < 4; ++t) scr[k * 33 + 4 * nq + t] = v[i][t] * W8_SCALE; }
    LDS_WAIT(); asm volatile("" ::: "memory");
    const int c = lane & 3;
#pragma unroll
    for (int j = 0; j < 2; ++j) { const int n = (lane >> 2) + 16 * j; const LAS float* s = scr + (16 * c) * 33 + n;
        v4u o; o.x = pack4_fp8(s[0 * 33], s[1 * 33], s[2 * 33], s[3 * 33]); o.y = pack4_fp8(s[4 * 33], s[5 * 33], s[6 * 33], s[7 * 33]);
        o.z = pack4_fp8(s[8 * 33], s[9 * 33], s[10 * 33], s[11 * 33]); o.w = pack4_fp8(s[12 * 33], s[13 * 33], s[14 * 33], s[15 * 33]);
        *(v4u*)(dst + (size_t)n * ldk + 16 * c) = o; }
    LDS_WAIT(); asm volatile("" ::: "memory");
}
__device__ __forceinline__ void cvt_item(const float* src, int ldw, bf16* dst, int ldk, bool rope, const float* kscale, LAS float* scr, int lane) {
    f32x4 v[8]; cvt_load(src, ldw, lane, v); cvt_finish(v, dst, ldk, rope, kscale, scr, lane);
}
constexpr int I_MOD = 1536, I_WIN = 32 * 98, I_WQ = 8 * 48, I_WKV = 8 * 64, I_WOUT = 32 * 64, I_GU = 16 * 32 * 128, I_DN = 16 * 32 * 64, I_SGU = 256, I_ZERO = 768, I_ROPE = 1;
constexpr int P0_ITEMS = I_MOD + I_WIN + I_WQ + I_WKV + I_WOUT + I_SGU + I_ZERO + I_ROPE, PX_ITEMS = I_GU + I_DN;
__device__ __forceinline__ void p0_item(const Ptrs& p, int it, LAS float* scr, int lane) {
    if (it < I_MOD) { p0_mod_item(p, it, lane); return; } it -= I_MOD;
    if (it < I_WIN) { const int kb = it / 98, nb = it - kb * 98, n0 = nb * 32; int col0; bool rope = false;
        if (n0 < 1024) col0 = n0; else if (n0 < 3072) col0 = n0 + 64; else { col0 = OFF_KPE + (nb - 96) * 32; rope = true; }
        cvt_item(p.w_in + (size_t)kb * 64 * INC + col0, INC, (bf16*)(p.ws + WS_WIN_T) + (size_t)n0 * D + kb * 64, D, rope, nullptr, scr, lane); return; } it -= I_WIN;
    if (it < I_WQ) { const int kb = it / 48, nb = it - kb * 48, n0 = nb * 32; int col0; bool rope = false;
        if (n0 < 1024) col0 = (n0 >> 7) * DQK + (n0 & 127); else { const int jj = n0 - 1024; col0 = (jj >> 6) * DQK + 128 + ((jj & 63) >> 5) * 32; rope = true; }
        cvt_item(p.w_uq + (size_t)kb * 64 * 1536 + col0, 1536, (bf16*)(p.ws + WS_WQKV_T) + (size_t)n0 * 512 + kb * 64, 512, rope, p.q_norm_w + kb * 64, scr, lane); return; } it -= I_WQ;
    if (it < I_WKV) { const int kb = it / 64, nb = it - kb * 64, n0 = nb * 32;
        cvt_item(p.w_ukv + (size_t)kb * 64 * 2048 + n0, 2048, (bf16*)(p.ws + WS_WQKV_T) + (size_t)(1536 + n0) * 512 + kb * 64, 512, false, p.kv_norm_w + kb * 64, scr, lane); return; } it -= I_WKV;
    if (it < I_WOUT) { const int kb = it / 64, nb = it - kb * 64, n0 = nb * 32;
        cvt_item(p.w_out + (size_t)kb * 64 * D + n0, D, (bf16*)(p.ws + WS_WOUT_T) + (size_t)n0 * D + kb * 64, D, false, nullptr, scr, lane); return; } it -= I_WOUT;
    if (it < I_SGU) { const float* s = p.sgu_w + (size_t)it * 512 + lane * 8; const f32x4 a = *(const f32x4*)s, b = *(const f32x4*)(s + 4);
        v4u o; o.x = pk2(a[0], a[1]); o.y = pk2(a[2], a[3]); o.z = pk2(b[0], b[1]); o.w = pk2(b[2], b[3]); *(v4u*)((bf16*)(p.ws + WS_SGUW) + (size_t)it * 512 + lane * 8) = o; return; } it -= I_SGU;
    if (it < I_ZERO) { *(v4u*)((bf16*)(p.ws + WS_WIN_T) + (size_t)3136 * D + (size_t)it * 512 + lane * 8) = (v4u){0u, 0u, 0u, 0u}; return; }
    float* tab = (float*)(p.ws + WS_ROPE);
    for (int j = 0; j < 16; ++j) { const int idx = j * 64 + lane, ax = idx >> 4, ii = idx & 15; float s, c; sincosf((float)ax * rope_inv(ii), &s, &c); tab[idx * 2] = c; tab[idx * 2 + 1] = s; }
}
constexpr int WEL = FP8_MOE ? 1 : 2;
__device__ __forceinline__ void px_ptrs(const Ptrs& p, int it, const float*& src, unsigned char*& dst) {
    if (it < I_GU) { const int e = it >> 12, r = it & 4095, kb = r >> 7, nb = r & 127, n0 = nb * 32, pn = n0 >> 8, within = n0 & 255;
        src = (within < 128 ? p.w_e_gate : p.w_e_up) + ((size_t)e * D + kb * 64) * FF + pn * 128 + (within & 127);
        dst = p.ws + WS_WGU_T + (((size_t)e * 4096 + n0) * D + kb * 64) * WEL; }
    else { it -= I_GU; const int e = it >> 11, r = it & 2047, kb = r >> 6, nb = r & 63, n0 = nb * 32;
        src = p.w_e_down + ((size_t)e * FF + kb * 64) * D + n0; dst = p.ws + WS_WD_T + (((size_t)e * D + n0) * FF + kb * 64) * WEL; }
}
__device__ __forceinline__ void px_finish(const f32x4 (&v)[8], unsigned char* dst, LAS float* scr, int lane) {
    if constexpr (FP8_MOE) cvt_finish_fp8(v, dst, 2048, scr, lane); else cvt_finish(v, (bf16*)dst, 2048, false, nullptr, scr, lane);
}
__device__ __forceinline__ void px_convert(const Ptrs& p, int gw, int NGW, LAS float* scr, int lane) {
    f32x4 va[8], vb[8]; const float *sa, *sb; unsigned char *da, *db;
    int it = gw;
    if (it < PX_ITEMS) { px_ptrs(p, it, sa, da); cvt_load(sa, 2048, lane, va); }
    while (it < PX_ITEMS) {
        const int i1 = it + NGW, i2 = it + 2 * NGW;
        if (i1 < PX_ITEMS) { px_ptrs(p, i1, sb, db); cvt_load(sb, 2048, lane, vb); }
        px_finish(va, da, scr, lane);
        if (i1 >= PX_ITEMS) break;
        if (i2 < PX_ITEMS) { px_ptrs(p, i2, sa, da); cvt_load(sa, 2048, lane, va); }
        px_finish(vb, db, scr, lane);
        it = i2;
    }
}
__device__ __forceinline__ void p1_row(const Ptrs& p, int row, int lane) {
    const float* src = row < M ? p.x + (size_t)row * D : p.ctx + (size_t)(row - M) * D;
    const float* mod = (const float*)(p.ws + WS_MOD) + (row < M ? row >> 12 : 4) * 12288;
    f32x4 v[8]; float s = 0.f;
#pragma unroll
    for (int j = 0; j < 8; ++j) { v[j] = *(const f32x4*)(src + j * 256 + lane * 4); s += dot4(v[j]); }
    const float rs = rsqrtf(wave_sum(s) * (1.f / D) + EPS);
    bf16* o = (bf16*)(p.ws + WS_H) + (size_t)row * D;
#pragma unroll
    for (int j = 0; j < 8; ++j) { const int c = j * 256 + lane * 4; const f32x4 g = *(const f32x4*)(p.pre_norm1 + c), sc = *(const f32x4*)(mod + 2048 + c), sh = *(const f32x4*)(mod + c);
        const f32x4 h = v[j] * rs * g * (1.f + sc) + sh; *(unsigned long long*)(o + c) = (unsigned long long)pk2(h[0], h[1]) | ((unsigned long long)pk2(h[2], h[3]) << 32); }
}
typedef float f32x16 __attribute__((ext_vector_type(16)));
typedef short bf16x8v __attribute__((ext_vector_type(8)));
__device__ __forceinline__ void sgu_unit(const Ptrs& p, int chunk, int g, LAS unsigned char* lds, int tid) {
    constexpr int VROW = 272;
    const int lane = tid & 63, wid = tid >> 6;
    {
        const int q = tid >> 2, cg = tid & 3;
        const bf16* src = (const bf16*)(p.ws + WS_VS) + (size_t)(chunk * 128 + q) * 1024 + g * 128 + cg * 32;
        float x[32];
#pragma unroll
        for (int j = 0; j < 4; ++j) { const v4u w = *(const v4u*)(src + j * 8);
#pragma unroll
            for (int t = 0; t < 4; ++t) { x[j * 8 + 2 * t] = __uint_as_float(w[t] << 16); x[j * 8 + 2 * t + 1] = __uint_as_float(w[t] & 0xffff0000u); } }
        float s = 0.f;
#pragma unroll
        for (int j = 0; j < 32; ++j) s += x[j];
        s += __shfl_xor(s, 1); s += __shfl_xor(s, 2);
        const float mu = s * (1.f / 128.f); float vq = 0.f;
#pragma unroll
        for (int j = 0; j < 32; ++j) { x[j] -= mu; vq += x[j] * x[j]; }
        vq += __shfl_xor(vq, 1); vq += __shfl_xor(vq, 2);
        const float rs = rsqrtf(vq * (1.f / 128.f) + EPS);
        const float* gw = p.sgu_norm_w + g * 128 + cg * 32;
#pragma unroll
        for (int j = 0; j < 32; ++j) *(LAS bf16*)(lds + (cg * 32 + j) * VROW + q * 2) = f2bf(x[j] * rs * gw[j]);
    }
    LDS_WAIT(); __syncthreads();
    const int pb = wid >> 1, ch = wid & 1, r32 = lane & 31, hi = lane >> 5;
    f32x16 acc0 = {}, acc1 = {};
    const bf16* wrow = (const bf16*)(p.ws + WS_SGUW) + ((size_t)g * 128 + pb * 32 + r32) * 128 + hi * 8;
#pragma unroll
    for (int ks = 0; ks < 8; ++ks) {
        const bf16x8v a = *(const bf16x8v*)(wrow + ks * 16);
        const bf16x8v b0 = *(const LAS bf16x8v*)(lds + (ch * 64 + r32) * VROW + (ks * 16 + hi * 8) * 2);
        const bf16x8v b1 = *(const LAS bf16x8v*)(lds + (ch * 64 + 32 + r32) * VROW + (ks * 16 + hi * 8) * 2);
        acc0 = __builtin_amdgcn_mfma_f32_32x32x16_bf16(a, b0, acc0, 0, 0, 0);
        acc1 = __builtin_amdgcn_mfma_f32_32x32x16_bf16(a, b1, acc1, 0, 0, 0);
    }
#pragma unroll
    for (int r = 0; r < 16; ++r) { const int pr = pb * 32 + (r & 3) + 8 * (r >> 2) + 4 * hi; const size_t tok = (size_t)chunk * 128 + pr; const float bias = p.sgu_b[g * 128 + pr];
        const bf16* ur = (const bf16*)(p.ws + WS_U) + tok * 1024 + g * 128 + ch * 64 + r32; bf16* orow = (bf16*)(p.ws + WS_CAT) + tok * D + 1024 + g * 128 + ch * 64 + r32;
        orow[0] = f2bf(bf2f(ur[0]) * (acc0[r] + bias)); orow[32] = f2bf(bf2f(ur[32]) * (acc1[r] + bias)); }
    __syncthreads();
}
__device__ __forceinline__ void topk_unit(const Ptrs& p, int e, int b, LAS unsigned* sh, int tid) {
    const int lane = tid & 63, wid = tid >> 6;
    const float* aff = (const float*)(p.ws + WS_AFF) + (size_t)b * L * 16 + e;
    unsigned key[8];
#pragma unroll
    for (int j = 0; j < 8; ++j) key[j] = __float_as_uint(aff[(size_t)(tid * 8 + j) * 16]);
    unsigned prefix = 0u, mask = 0u, need = CAP;
    for (int shift = 24; shift >= 0; shift -= 8) {
        if (tid < 256) sh[tid] = 0u;
        __syncthreads();
#pragma unroll
        for (int j = 0; j < 8; ++j) if ((key[j] & mask) == prefix) atomicAdd((unsigned*)&sh[(key[j] >> shift) & 255u], 1u);
        __syncthreads();
        if (wid == 0) {
            const unsigned c0 = sh[4 * lane], c1 = sh[4 * lane + 1], c2 = sh[4 * lane + 2], c3 = sh[4 * lane + 3];
            const unsigned s = c0 + c1 + c2 + c3; unsigned S = s;
#pragma unroll
            for (int d = 1; d < 64; d <<= 1) { const unsigned v = __shfl_down(S, d); if (lane + d < 64) S += v; }
            const unsigned above = S - s;
            if (S >= need && above < need) { unsigned cum = above, bin, nd;
                if (cum + c3 >= need) { bin = 3; nd = need - cum; } else { cum += c3;
                if (cum + c2 >= need) { bin = 2; nd = need - cum; } else { cum += c2;
                if (cum + c1 >= need) { bin = 1; nd = need - cum; } else { cum += c1; bin = 0; nd = need - cum; } } }
                sh[256] = 4u * lane + bin; sh[257] = nd; }
        }
        __syncthreads();
        prefix |= sh[256] << shift; mask |= 255u << shift; need = sh[257];
        __syncthreads();
    }
    unsigned cg = 0u, ce = 0u;
#pragma unroll
    for (int j = 0; j < 8; ++j) { cg += key[j] > prefix ? 1u : 0u; ce += key[j] == prefix ? 1u : 0u; }
    unsigned pk = (cg << 16) | ce, inc = pk;
#pragma unroll
    for (int d = 1; d < 64; d <<= 1) { const unsigned v = __shfl_up(inc, d); if (lane >= d) inc += v; }
    if (lane == 63) sh[264 + wid] = inc;
    __syncthreads();
    unsigned off = 0u;
#pragma unroll
    for (int w = 0; w < 8; ++w) off += (w < wid) ? sh[264 + w] : 0u;
    unsigned ex = off + inc - pk; unsigned gtb = ex >> 16, eqb = ex & 0xffffu;
    int* inv = (int*)(p.ws + WS_INV) + (size_t)(b * L + tid * 8) * 16 + e; int* idx = (int*)(p.ws + WS_IDX) + (size_t)(e * 4 + b) * CAP;
#pragma unroll
    for (int j = 0; j < 8; ++j) { const bool gt = key[j] > prefix, eq = key[j] == prefix; const bool sel = gt || (eq && eqb < need);
        const unsigned slot = gtb + (eqb < need ? eqb : need);
        inv[(size_t)j * 16] = sel ? (int)slot : -1; if (sel) idx[slot] = tid * 8 + j;
        gtb += gt ? 1u : 0u; eqb += eq ? 1u : 0u; }
    __syncthreads();
}

__device__ __forceinline__ f32x4 ld_bf16x4(const bf16* s) { const unsigned long long w = *(const unsigned long long*)s; const unsigned lo = (unsigned)w, hi2 = (unsigned)(w >> 32);
    return (f32x4){__uint_as_float(lo << 16), __uint_as_float(lo & 0xffff0000u), __uint_as_float(hi2 << 16), __uint_as_float(hi2 & 0xffff0000u)}; }
__device__ __forceinline__ void st_bf16x4(bf16* d, const f32x4& h) { *(unsigned long long*)d = (unsigned long long)pk2(h[0], h[1]) | ((unsigned long long)pk2(h[2], h[3]) << 32); }
__device__ __forceinline__ void p6_row(const Ptrs& p, int row, int lane, const LAS float* wt) {
    const int b = row >> 12; const float* mod = (const float*)(p.ws + WS_MOD) + b * 12288;
    const float ssq = wave_sum(lane < 32 ? ((const float*)(p.ws + WS_SSQY))[(size_t)row * 32 + lane] : 0.f);
    const float rsy = rsqrtf(ssq * (1.f / D) + EPS);
    const bf16* y = (const bf16*)(p.ws + WS_Y) + (size_t)row * D; const float* xr = p.x + (size_t)row * D; float* o = p.out + (size_t)row * D;
    f32x4 v[8]; float s = 0.f;
#pragma unroll
    for (int j = 0; j < 8; ++j) { const int c = j * 256 + lane * 4;
        v[j] = *(const f32x4*)(xr + c) + *(const f32x4*)(mod + 4096 + c) * (ld_bf16x4(y + c) * rsy * *(const f32x4*)(p.post_norm1 + c));
        *(f32x4*)(o + c) = v[j]; s += dot4(v[j]); }
    const float rs = rsqrtf(wave_sum(s) * (1.f / D) + EPS);
    bf16* h2 = (bf16*)(p.ws + WS_H2) + (size_t)row * D;
    float lg[16];
#pragma unroll
    for (int e = 0; e < 16; ++e) lg[e] = 0.f;
#pragma unroll
    for (int j = 0; j < 8; ++j) { const int c = j * 256 + lane * 4;
        const f32x4 h = v[j] * rs * *(const f32x4*)(p.pre_norm2 + c) * (1.f + *(const f32x4*)(mod + 8192 + c)) + *(const f32x4*)(mod + 6144 + c);
        if constexpr (FP8_MOE) *(unsigned*)((unsigned char*)(p.ws + WS_H2) + (size_t)row * D + c) = pack4_fp8(h[0], h[1], h[2], h[3]); else st_bf16x4(h2 + c, h);
#pragma unroll
        for (int e = 0; e < 16; ++e) { const f32x4 w = *(const LAS f32x4*)(wt + e * 2048 + c); lg[e] += (h[0] * w[0] + h[1] * w[1]) + (h[2] * w[2] + h[3] * w[3]); }
        asm volatile("" ::: "memory"); }
#define XSTEP(N, MASK) _Pragma("unroll") for (int i = 0; i < N; ++i) { const bool up = (lane & MASK) != 0; const float send = up ? lg[i] : lg[i + N]; const float keep = up ? lg[i + N] : lg[i]; lg[i] = keep + __shfl_xor(send, MASK); }
    XSTEP(8, 32) XSTEP(4, 16) XSTEP(2, 8) XSTEP(1, 4)
#undef XSTEP
    float lgt = lg[0]; lgt += __shfl_xor(lgt, 2); lgt += __shfl_xor(lgt, 1);
    lgt += p.b_router[lane >> 2];
    float mx = lgt;
#pragma unroll
    for (int o2 = 4; o2 < 64; o2 <<= 1) mx = fmaxf(mx, __shfl_xor(mx, o2));
    const float ex = __expf(lgt - mx); float se = ex;
#pragma unroll
    for (int o2 = 4; o2 < 64; o2 <<= 1) se += __shfl_xor(se, o2);
    if ((lane & 3) == 0) ((float*)(p.ws + WS_AFF))[(size_t)row * 16 + (lane >> 2)] = ex / se;
}
__device__ __forceinline__ void p11_row(const Ptrs& p, int row, int lane) {
    const int b = row >> 12; const float* mod = (const float*)(p.ws + WS_MOD) + b * 12288;
    const int* inv = (const int*)(p.ws + WS_INV) + (size_t)row * 16; const float* aff = (const float*)(p.ws + WS_AFF) + (size_t)row * 16;
    f32x4 v[8];
#pragma unroll
    for (int j = 0; j < 8; ++j) v[j] = (f32x4){0.f, 0.f, 0.f, 0.f};
    for (int e = 0; e < 16; ++e) { const int sl = inv[e]; if (sl >= 0) { const float g = aff[e]; const bf16* ye = (const bf16*)(p.ws + WS_YE) + ((size_t)(e * 4 + b) * CAP + sl) * D + lane * 4;
#pragma unroll
            for (int j = 0; j < 8; ++j) v[j] += g * ld_bf16x4(ye + j * 256); } }
    float s = 0.f;
#pragma unroll
    for (int j = 0; j < 8; ++j) s += dot4(v[j]);
    const float rs = rsqrtf(wave_sum(s) * (1.f / D) + EPS);
    float* o = p.out + (size_t)row * D;
#pragma unroll
    for (int j = 0; j < 8; ++j) { const int c = j * 256 + lane * 4; *(f32x4*)(o + c) = *(const f32x4*)(o + c) + *(const f32x4*)(mod + 10240 + c) * (v[j] * rs * *(const f32x4*)(p.post_norm2 + c)); }
}

struct Args { Ptrs p; int ph_lo, ph_hi, bar_idx, pad; };
__global__ void __launch_bounds__(NTHREADS, 2) fwd(Args args) {
    extern __shared__ __attribute__((aligned(16))) unsigned char lds_raw[];
    LAS unsigned char* lds = (LAS unsigned char*)lds_raw;
#if defined(__HIP_DEVICE_COMPILE__)
    typedef __attribute__((address_space(4))) const Args CArgs;
#define LOADP() Ptrs p; { const CArgs* kp_ = (const CArgs*)__builtin_amdgcn_kernarg_segment_ptr(); asm volatile("" : "+s"(kp_)); p = kp_->p; }
#else
#define LOADP() Ptrs p = args.p;
#endif
    const int tid = threadIdx.x, lane = tid & 63, wave = __builtin_amdgcn_readfirstlane(tid >> 6);
    const int G = gridDim.x, bx = blockIdx.x, vcu = (G % 8 == 0) ? (bx % 8) * (G / 8) + bx / 8 : bx;
    const int gw = vcu * NWAVES + wave, NGW = G * NWAVES;
    volatile LAS unsigned* MISC = (volatile LAS unsigned*)(lds + MISC_OFF);
    if (tid < 64) MISC[tid] = 0u;
    __syncthreads();
    const int lo = args.ph_lo, hi = args.ph_hi;
    XcdBarrier bar; { LOADP(); bar.bar = (unsigned*)(p.ws + WS_CTL) + CW_BAR + args.bar_idx * 4096; bar.x = 0; bar.st = nullptr;
    if (hi - lo > 1) bar = xcd_barrier_post((unsigned*)(p.ws + WS_CTL) + CW_BAR + args.bar_idx * 4096, MISC + 8); }
#ifdef ONLY_PHASE
#define IN(k) ((k) == ONLY_PHASE && lo <= (k) && (k) < hi)
#else
#define IN(k) (lo <= (k) && (k) < hi)
#endif
#define SEAM(k) do { if (IN(k) && IN((k) + 1)) xcd_barrier(bar); } while (0)

    if (IN(0)) { LOADP();
        LAS float* scr = (LAS float*)(lds + wave * 8448);
        for (int it = gw; it < P0_ITEMS; it += NGW) p0_item(p, it, scr, lane);
    }
    SEAM(0);
    if (IN(1)) { LOADP();
        const int gid = bx * NTHREADS + tid;
        if (gid < 5 * 12288) { const int r = gid / 12288, j = gid - r * 12288; float s = p.b_ada[j]; const float* part = (const float*)(p.ws + WS_PART) + (size_t)r * 12288 + j;
            for (int kc = 0; kc < 32; ++kc) s += part[(size_t)kc * 5 * 12288];
            ((float*)(p.ws + WS_MOD))[gid] = s; }
    }
    SEAM(1);
    if (IN(2)) { LOADP(); for (int row = gw; row < MALL; row += NGW) p1_row(p, row, lane); }
    SEAM(2);
    if (IN(3)) { LOADP();
        SchedIn S{(const char*)(p.ws + WS_H), (const char*)(p.ws + WS_WIN_T), G, bx}; EpiIn E{p.ws};
        pg8::gemm_phase<EpiIn, SchedIn>(lds, 2048, S, E);
    }
    SEAM(3);
    if (IN(4)) { LOADP();
        SchedQKV S{(const char*)(p.ws + WS_CQKV), (const char*)(p.ws + WS_WQKV_T), G, bx}; EpiQKV E{p.ws};
        pg8::gemm_phase<EpiQKV, SchedQKV>(lds, 512, S, E);
        __syncthreads();
        for (int u = vcu; u < 1024; u += G) sgu_unit(p, u >> 3, u & 7, lds, tid);
    }
    SEAM(4);
    if (IN(5)) {
        const int grp = (vcu >> 4) % 3;
#define PX_CONV(g) do { if (grp == (g)) { LOADP(); __syncthreads(); px_convert(p, gw, NGW, (LAS float*)(lds + wave * 8448), lane); __syncthreads(); } } while (0)
#define ATT_UNIT(u_) do { const int u = (u_); if (u < 512) { LOADP(); const int bh = u >> 4, qb = u & 15; __syncthreads(); \
            att::attn_unit((const bf16*)(p.ws + WS_Q) + ((size_t)bh * L + qb * 256) * DQK, (const bf16*)(p.ws + WS_K) + (size_t)bh * LK * DQK, (const bf16*)(p.ws + WS_V) + (size_t)bh * LK * VH, \
                           (bf16*)(p.ws + WS_CAT) + ((size_t)(bh >> 3) * L + qb * 256) * D + (bh & 7) * 128, LK, (char*)lds_raw); } } while (0)
        PX_CONV(0); ATT_UNIT(vcu); PX_CONV(1); ATT_UNIT(vcu + G); PX_CONV(2);
        for (int u = vcu + 2 * G; u < 512; u += G) ATT_UNIT(u);
#undef PX_CONV
#undef ATT_UNIT
        __syncthreads();
    }
    SEAM(5);
    if (IN(6)) { LOADP();
        SchedDense S{(const char*)(p.ws + WS_CAT), (const char*)(p.ws + WS_WOUT_T), G, bx, 64, 8, 31, 2048}; EpiY E{p.ws};
        pg8::gemm_phase<EpiY, SchedDense>(lds, 2048, S, E);
    }
    SEAM(6);
    if (IN(7)) { LOADP();
        LAS float* wt = (LAS float*)lds;
        for (int c = tid; c < D; c += NTHREADS) { const float* wr = p.w_router + (size_t)c * 16;
#pragma unroll
            for (int q = 0; q < 4; ++q) { const f32x4 w = *(const f32x4*)(wr + q * 4);
#pragma unroll
                for (int t = 0; t < 4; ++t) wt[(q * 4 + t) * 2048 + c] = w[t]; } }
        LDS_WAIT(); __syncthreads();
        for (int row = gw; row < M; row += NGW) p6_row(p, row, lane, wt);
        __syncthreads();
    }
    SEAM(7);
    if (IN(8)) { LOADP(); for (int u = bx; u < 64; u += G) topk_unit(p, u >> 2, u & 3, (LAS unsigned*)lds, tid); }
    SEAM(8);
    if (IN(9)) { LOADP();
        constexpr int KU = FP8_MOE ? 1024 : 2048;
        SchedGather S{(const char*)(p.ws + WS_H2), (const char*)(p.ws + WS_WGU_T), G, bx, (const LAS unsigned*)(lds + TAB_OFF), KU};
        for (int q = tid; q < 2048; q += NTHREADS) { const int i = q >> 8, r = q & 255; Unit u;
            if (S.next(i, u)) { const int e = u.pm >> 3, m = (u.pm & 7) * 256 + r, b = m >> 9; const int tok = ((const int*)(p.ws + WS_IDX))[(size_t)(e * 4 + b) * CAP + (m & 511)];
                ((LAS unsigned*)(lds + TAB_OFF))[q] = (unsigned)(b * L + tok) * (unsigned)(KU * 2); } }
        LDS_WAIT(); __syncthreads();
        if constexpr (FP8_MOE) { EpiAct8 E{p.ws}; pg8::gemm_phase<EpiAct8, SchedGather, true>(lds, KU, S, E); }
        else { EpiAct E{p.ws}; pg8::gemm_phase<EpiAct, SchedGather, false>(lds, KU, S, E); }
    }
    SEAM(9);
    if (IN(10)) { LOADP();
        constexpr int KU = FP8_MOE ? 1024 : 2048;
        SchedDense S{(const char*)(p.ws + WS_ACT), (const char*)(p.ws + WS_WD_T), G, bx, 128, 8, 3, KU};
        if constexpr (FP8_MOE) { EpiYE8 E{p.ws}; pg8::gemm_phase<EpiYE8, SchedDense, true>(lds, KU, S, E); }
        else { EpiYE E{p.ws}; pg8::gemm_phase<EpiYE, SchedDense, false>(lds, KU, S, E); }
    }
    SEAM(10);
    if (IN(11)) { LOADP(); for (int row = gw; row < M; row += NGW) p11_row(p, row, lane); }
#undef IN
#undef SEAM
}

#ifndef PHASE_MODE
#define PHASE_MODE "FFFFFFFFFFFF"
#endif
#ifndef MERGE
#define MERGE 1
#endif
template <class P> static void launch_ngemm(const P& f, int Mr, int Nr, int Z, hipStream_t s) { hipLaunchKernelGGL((ngemm<P>), dim3(Nr / 64, Mr / 64, Z), dim3(256), 0, s, f); }
static void naive_phase(int ph, const Ptrs& p, hipStream_t stream) {
    switch (ph) {
    case 0: hipLaunchKernelGGL(n_mod, dim3(48, 5), dim3(256), 0, stream, p); break;
    case 1: break;
    case 2: hipLaunchKernelGGL(n_hrows, dim3(MALL / 4), dim3(256), 0, stream, p); break;
    case 3: launch_ngemm(GIn{p, D}, MALL, 3136, 1, stream);
        hipLaunchKernelGGL(n_ssq, dim3(M / 4), dim3(256), 0, stream, (const bf16*)(p.ws + WS_CQKV), M, 512, (float*)(p.ws + WS_SSQQ), 8);
        hipLaunchKernelGGL(n_ssq, dim3(MALL / 4), dim3(256), 0, stream, (const bf16*)(p.ws + WS_CQKV) + (size_t)M * 512, MALL, 512, (float*)(p.ws + WS_SSQKV), 8); break;
    case 4: launch_ngemm(GQ{p, 512}, M, 1536, 1, stream); launch_ngemm(GKV{p, 512}, MALL, 2048, 1, stream);
        hipLaunchKernelGGL(n_vn, dim3(M * 8 / 4), dim3(256), 0, stream, p); launch_ngemm(GSgu{p, 128}, 128, 128, 1024, stream); break;
    case 5: for (int bh = 0; bh < B * H; ++bh) { launch_ngemm(GScore{p, DQK, bh}, L, LK, 1, stream);
            hipLaunchKernelGGL(n_softmax, dim3(L), dim3(256), 0, stream, (float*)(p.ws + WS_S), LK); launch_ngemm(GPV{p, LK, bh}, L, VH, 1, stream); } break;
    case 6: launch_ngemm(GOut{p, D}, M, D, 1, stream);
        hipLaunchKernelGGL(n_ssq, dim3(M / 4), dim3(256), 0, stream, (const bf16*)(p.ws + WS_Y), M, D, (float*)(p.ws + WS_SSQY), 32); break;
    case 7: hipLaunchKernelGGL(n_rowmid, dim3(M / 4), dim3(256), 0, stream, p); break;
    case 8: hipLaunchKernelGGL(n_topk, dim3(64), dim3(1024), 0, stream, p); break;
    case 9: launch_ngemm(GE1{p, D}, 2048, 4096, 16, stream); break;
    case 10: launch_ngemm(GE2{p, FF}, 2048, 2048, 16, stream); break;
    case 11: hipLaunchKernelGGL(n_rowfinal, dim3(M / 4), dim3(256), 0, stream, p); break;
    }
}
extern "C" void kernel_launch(void* const* d_in, const int* in_sizes, int n_in, void* d_out, int out_size, void* d_ws, size_t ws_size, hipStream_t stream) {
    static int grid = 0;
    if (grid == 0) {
        if (n_in != 24 || ws_size < WS_END || out_size != M * D) { fprintf(stderr, "kernel_launch: unexpected shapes n_in %d ws %zu out %d\n", n_in, ws_size, out_size); grid = -1; return; }
        int dev = 0, cus = 0, per_cu = 0;
        if (hipGetDevice(&dev) != hipSuccess || hipDeviceGetAttribute(&cus, hipDeviceAttributeMultiprocessorCount, dev) != hipSuccess) { grid = -1; return; }
        if (hipFuncSetAttribute((const void*)fwd, hipFuncAttributeMaxDynamicSharedMemorySize, LDS_BYTES) != hipSuccess) { fprintf(stderr, "kernel_launch: hipFuncSetAttribute failed\n"); grid = -1; return; }
        if (hipOccupancyMaxActiveBlocksPerMultiprocessor(&per_cu, (const void*)fwd, NTHREADS, LDS_BYTES) != hipSuccess || per_cu < 1) fprintf(stderr, "kernel_launch: occupancy query says %d\n", per_cu);
        (void)hipGetLastError();
        grid = cus;
    }
    if (grid < 0) return;
    Ptrs p{};
    const float** f = (const float**)&p;
    for (int i = 0; i < 24; ++i) f[i] = (const float*)d_in[i];
    p.out = (float*)d_out; p.ws = (unsigned char*)d_ws;
    (void)hipMemsetAsync(p.ws + WS_CTL, 0, 1 * MiB, stream);
    const char* mode = PHASE_MODE; int nbar = 0;
    for (int ph = 0; ph < 12;) {
        if (mode[ph] == 'F') { int e = ph + 1; if (MERGE) while (e < 12 && mode[e] == 'F') ++e;
            Args a{}; a.p = p; a.ph_lo = ph; a.ph_hi = e; a.bar_idx = nbar++; a.pad = 0;
            hipLaunchKernelGGL(fwd, dim3(grid), dim3(NTHREADS), LDS_BYTES, stream, a);
            const hipError_t le = hipPeekAtLastError(); if (le != hipSuccess) fprintf(stderr, "kernel_launch: launch failed: %s\n", hipGetErrorName(le));
#ifdef DUP_PHASE
            if (ph == DUP_PHASE) { a.bar_idx = nbar++; hipLaunchKernelGGL(fwd, dim3(grid), dim3(NTHREADS), LDS_BYTES, stream, a); }
#endif
            ph = e; }
        else { naive_phase(ph, p, stream); ++ph; }
    }
}
```

```cpp
#define PHASE_MODE "FFFFFFFFFFFF"
#define MERGE 1
#include <hip/hip_runtime.h>
#include <cstdio>
#include <cstdint>

typedef unsigned short bf16;
#ifndef FP8_MOE
#define FP8_MOE 1
#endif
namespace cfg {
constexpr int B = 4, L = 4096, D = 2048, CTX = 256, H = 8, LK = L + CTX;
constexpr int M = B * L;
constexpr int MC = B * CTX;
constexpr int MALL = M + MC;
constexpr int QL = 512, KVL = 512, NOPE = 128, ROPE = 64, VH = 128, DQK = 192;
constexpr int SGW = 1024, INC = 3136, OFF_KPE = 1024, OFF_U = 1088, OFF_V = 2112;
constexpr int NE = 16, CAP = 512, FF = 2048;
constexpr float EPS = 1e-6f;
constexpr float ATT_SCALE = 0.07216878364870322f;
constexpr size_t MiB = 1u << 20;
constexpr size_t WS_CTL = 0;
constexpr size_t WS_MOD = 1 * MiB;
constexpr size_t WS_SSQQ = 2 * MiB;
constexpr size_t WS_SSQKV = 3 * MiB;
constexpr size_t WS_SSQY = 4 * MiB;
constexpr size_t WS_AFF = 6 * MiB;
constexpr size_t WS_INV = 7 * MiB;
constexpr size_t WS_IDX = 8 * MiB;
constexpr size_t WS_WIN_T = 16 * MiB;
constexpr size_t WS_WQKV_T = 30 * MiB;
constexpr size_t WS_WOUT_T = 34 * MiB;
constexpr size_t WS_SGUW = 42 * MiB;
constexpr size_t WS_WGU_T = 64 * MiB;
constexpr size_t WS_WD_T = 320 * MiB;
constexpr size_t WS_H = 448 * MiB;
constexpr size_t WS_CQKV = 516 * MiB;
constexpr size_t WS_U = 549 * MiB;
constexpr size_t WS_VS = 581 * MiB;
constexpr size_t WS_Q = 613 * MiB;
constexpr size_t WS_K = 661 * MiB;
constexpr size_t WS_V = 712 * MiB;
constexpr size_t WS_CAT = 746 * MiB;
constexpr size_t WS_Y = 810 * MiB;
constexpr size_t WS_H2 = WS_CAT;
constexpr size_t WS_ACT = WS_H;
constexpr size_t WS_YE = WS_Q;
constexpr size_t WS_S = 874 * MiB;
constexpr size_t WS_VN = 942 * MiB;
constexpr size_t WS_ROPE = 9 * MiB;
constexpr size_t WS_PART = WS_S;
constexpr size_t WS_END = 974 * MiB;
}
using namespace cfg;

__device__ __forceinline__ float bf2f(bf16 v) { return __uint_as_float(((unsigned)v) << 16); }
__device__ __forceinline__ bf16 f2bf(float f) { unsigned u = __float_as_uint(f); return (bf16)((u + 0x7fffu + ((u >> 16) & 1u)) >> 16); }
__device__ __forceinline__ float silu_f(float x) { return x / (1.f + __expf(-x)); }
__device__ __forceinline__ float gelu_tanh(float x) { const float z = 0.7978845608028654f * (x + 0.044715f * x * x * x); return 0.5f * x * (1.f + tanhf(z)); }
__device__ __forceinline__ float wave_sum(float v) {
#pragma unroll
    for (int o = 1; o < 64; o <<= 1) v += __shfl_xor(v, o);
    return v;
}
__device__ __forceinline__ float rope_inv(int ii) { return __expf(-(float)ii * (9.210340371976184f / 16.f)); }

struct Ptrs {
    const float *x, *c, *ctx, *c_ctx, *w_ada, *b_ada, *pre_norm1, *w_in, *q_norm_w, *w_uq, *kv_norm_w, *w_ukv, *sgu_norm_w, *sgu_w, *sgu_b, *w_out,
        *post_norm1, *pre_norm2, *w_router, *b_router, *w_e_gate, *w_e_up, *w_e_down, *post_norm2;
    float* out; unsigned char* ws;
};

__global__ void n_mod(Ptrs p) {
    const int j = blockIdx.x * 256 + threadIdx.x, r = blockIdx.y;
    const float* cv = r < 4 ? p.c + r * D : p.c_ctx;
    float s = 0.f;
    for (int k = 0; k < D; ++k) s += silu_f(cv[k]) * p.w_ada[(size_t)k * 12288 + j];
    ((float*)(p.ws + WS_MOD))[r * 12288 + j] = s + p.b_ada[j];
}
__global__ __launch_bounds__(256) void n_hrows(Ptrs p) {
    const int row = blockIdx.x * 4 + (threadIdx.x >> 6), lane = threadIdx.x & 63;
    if (row >= MALL) return;
    const float* src = row < M ? p.x + (size_t)row * D : p.ctx + (size_t)(row - M) * D;
    const int mr = row < M ? row >> 12 : 4;
    const float* mod = (const float*)(p.ws + WS_MOD) + mr * 12288;
    float v[32]; float s = 0.f;
    for (int j = 0; j < 32; ++j) { v[j] = src[j * 64 + lane]; s += v[j] * v[j]; }
    const float rs = rsqrtf(wave_sum(s) * (1.f / D) + EPS);
    bf16* o = (bf16*)(p.ws + WS_H) + (size_t)row * D;
    for (int j = 0; j < 32; ++j) { const int c = j * 64 + lane; o[c] = f2bf(v[j] * rs * p.pre_norm1[c] * (1.f + mod[2048 + c]) + mod[c]); }
}
template <class P> __global__ __launch_bounds__(256) void ngemm(P p) {
    __shared__ float As[16][65], Bs[16][65];
    const int tx = threadIdx.x & 15, ty = threadIdx.x >> 4, z = blockIdx.z;
    const int m0 = blockIdx.y * 64, n0 = blockIdx.x * 64;
    float acc[4][4] = {};
    for (int k0 = 0; k0 < p.K; k0 += 16) {
        for (int j = 0; j < 4; ++j) { const int idx = threadIdx.x + 256 * j; const int kk = idx & 15, mm = idx >> 4; As[kk][mm] = p.a(z, m0 + mm, k0 + kk); }
        for (int j = 0; j < 4; ++j) { const int idx = threadIdx.x + 256 * j; const int nn = idx & 63, kk = idx >> 6; Bs[kk][nn] = p.b(z, k0 + kk, n0 + nn); }
        __syncthreads();
#pragma unroll
        for (int kk = 0; kk < 16; ++kk) {
            float a[4], b[4];
#pragma unroll
            for (int i = 0; i < 4; ++i) { a[i] = As[kk][ty * 4 + i]; b[i] = Bs[kk][tx * 4 + i]; }
#pragma unroll
            for (int i = 0; i < 4; ++i)
#pragma unroll
                for (int j = 0; j < 4; ++j) acc[i][j] += a[i] * b[j];
        }
        __syncthreads();
    }
    for (int i = 0; i < 4; ++i) p.epi(z, m0 + ty * 4 + i, n0 + tx * 4, acc[i]);
}
__device__ __forceinline__ void rope_pair(float& x1, float& x2, int i, int pos) {
    const int ii = i & 15; const float ax = (float)((i >> 4) ? (pos & 63) : (pos >> 6));
    float s, c; sincosf(ax * rope_inv(ii), &s, &c);
    const float r1 = x1 * c - x2 * s, r2 = x2 * c + x1 * s; x1 = r1; x2 = r2;
}
struct GIn {
    Ptrs p; int K;
    __device__ float a(int, int m, int k) const { return bf2f(((const bf16*)(p.ws + WS_H))[(size_t)m * D + k]); }
    __device__ float b(int, int k, int n) const {
        int o; if (n < 1024) o = n; else if (n < 3072) o = n + 64; else { const int j = n - 3072, i = j >> 1, s = j & 1; o = OFF_KPE + (i >> 4) * 32 + s * 16 + (i & 15); }
        return p.w_in[(size_t)k * INC + o];
    }
    __device__ void epi(int, int m, int n0, const float* v) const {
        bf16* CQ = (bf16*)(p.ws + WS_CQKV); bf16* CKV = CQ + (size_t)M * 512;
        if (n0 < 512) { if (m < M) for (int j = 0; j < 4; ++j) CQ[(size_t)m * 512 + n0 + j] = f2bf(v[j]); }
        else if (n0 < 1024) { for (int j = 0; j < 4; ++j) CKV[(size_t)m * 512 + n0 - 512 + j] = f2bf(v[j]); }
        else if (n0 < 2048) { if (m < M) for (int j = 0; j < 4; ++j) ((bf16*)(p.ws + WS_U))[(size_t)m * 1024 + n0 - 1024 + j] = f2bf(gelu_tanh(v[j])); }
        else if (n0 < 3072) { if (m < M) for (int j = 0; j < 4; ++j) ((bf16*)(p.ws + WS_VS))[(size_t)m * 1024 + n0 - 2048 + j] = f2bf(gelu_tanh(v[j])); }
        else {
            const int jj = n0 - 3072; bf16* Kb = (bf16*)(p.ws + WS_K);
            for (int q = 0; q < 2; ++q) {
                const int i = (jj >> 1) + q; float x1 = v[2 * q], x2 = v[2 * q + 1]; int b, kpos;
                if (m < M) { b = m >> 12; kpos = m & 4095; rope_pair(x1, x2, i, kpos); } else { b = (m - M) >> 8; kpos = L + ((m - M) & 255); }
                for (int hh = 0; hh < H; ++hh) { bf16* d = Kb + ((size_t)(b * H + hh) * LK + kpos) * DQK + 128 + 2 * i; d[0] = f2bf(x1); d[1] = f2bf(x2); }
            }
        }
    }
};
__global__ void n_ssq(const bf16* T, int rows, int cols, float* out, int nslots) {
    const int row = blockIdx.x * 4 + (threadIdx.x >> 6), lane = threadIdx.x & 63;
    if (row >= rows) return;
    float s = 0.f; for (int c = lane; c < cols; c += 64) { const float v = bf2f(T[(size_t)row * cols + c]); s += v * v; }
    s = wave_sum(s);
    if (lane < nslots) out[(size_t)row * nslots + lane] = lane == 0 ? s : 0.f;
}
__device__ __forceinline__ float sum_slots(const float* s, int n) { float t = 0.f; for (int i = 0; i < n; ++i) t += s[i]; return t; }
struct GQ {
    Ptrs p; int K;
    __device__ float a(int, int m, int k) const { return bf2f(((const bf16*)(p.ws + WS_CQKV))[(size_t)m * 512 + k]); }
    __device__ float b(int, int k, int n) const {
        int o; if (n < 1024) o = (n >> 7) * DQK + (n & 127); else { const int jj = n - 1024, hd = jj >> 6, j6 = jj & 63, i = j6 >> 1, s = j6 & 1; o = hd * DQK + 128 + (i >> 4) * 32 + s * 16 + (i & 15); }
        return p.w_uq[(size_t)k * 1536 + o] * p.q_norm_w[k];
    }
    __device__ void epi(int, int m, int n0, const float* v) const {
        const float rs = rsqrtf(sum_slots((const float*)(p.ws + WS_SSQQ) + (size_t)m * 8, 8) * (1.f / 512.f) + EPS);
        const int b = m >> 12, t = m & 4095; bf16* Qb = (bf16*)(p.ws + WS_Q);
        if (n0 < 1024) { const int hd = n0 >> 7, d = n0 & 127; for (int j = 0; j < 4; ++j) Qb[((size_t)(b * H + hd) * L + t) * DQK + d + j] = f2bf(v[j] * rs); }
        else { const int jj = n0 - 1024, hd = jj >> 6, j6 = jj & 63;
            for (int q = 0; q < 2; ++q) { const int i = (j6 >> 1) + q; float x1 = v[2 * q] * rs, x2 = v[2 * q + 1] * rs; rope_pair(x1, x2, i, t);
                bf16* d = Qb + ((size_t)(b * H + hd) * L + t) * DQK + 128 + 2 * i; d[0] = f2bf(x1); d[1] = f2bf(x2); } }
    }
};
struct GKV {
    Ptrs p; int K;
    __device__ float a(int, int m, int k) const { return bf2f(((const bf16*)(p.ws + WS_CQKV))[(size_t)(M + m) * 512 + k]); }
    __device__ float b(int, int k, int n) const { return p.w_ukv[(size_t)k * 2048 + n] * p.kv_norm_w[k]; }
    __device__ void epi(int, int m, int n0, const float* v) const {
        const float rs = rsqrtf(sum_slots((const float*)(p.ws + WS_SSQKV) + (size_t)m * 8, 8) * (1.f / 512.f) + EPS);
        int b, kpos; if (m < M) { b = m >> 12; kpos = m & 4095; } else { b = (m - M) >> 8; kpos = L + ((m - M) & 255); }
        const int hd = n0 >> 8, c = n0 & 255;
        if (c < 128) { bf16* d = (bf16*)(p.ws + WS_K) + ((size_t)(b * H + hd) * LK + kpos) * DQK + c; for (int j = 0; j < 4; ++j) d[j] = f2bf(v[j] * rs); }
        else { bf16* d = (bf16*)(p.ws + WS_V) + ((size_t)(b * H + hd) * LK + kpos) * VH + c - 128; for (int j = 0; j < 4; ++j) d[j] = f2bf(v[j] * rs); }
    }
};
__global__ void n_vn(Ptrs p) {
    const int w = blockIdx.x * 4 + (threadIdx.x >> 6), lane = threadIdx.x & 63;
    const int tok = w >> 3, g = w & 7;
    const bf16* s = (const bf16*)(p.ws + WS_VS) + (size_t)tok * 1024 + g * 128;
    const float a = bf2f(s[lane]), b = bf2f(s[lane + 64]);
    const float mu = wave_sum(a + b) * (1.f / 128.f);
    const float da = a - mu, db = b - mu;
    const float rs = rsqrtf(wave_sum(da * da + db * db) * (1.f / 128.f) + EPS);
    bf16* o = (bf16*)(p.ws + WS_VN) + (size_t)tok * 1024 + g * 128;
    o[lane] = f2bf(da * rs * p.sgu_norm_w[g * 128 + lane]); o[lane + 64] = f2bf(db * rs * p.sgu_norm_w[g * 128 + lane + 64]);
}
struct GSgu {
    Ptrs p; int K;
    __device__ float a(int z, int m, int k) const { return p.sgu_w[((size_t)(z & 7) * 128 + m) * 128 + k]; }
    __device__ float b(int z, int k, int n) const { return bf2f(((const bf16*)(p.ws + WS_VN))[(size_t)((z >> 3) * 128 + k) * 1024 + (z & 7) * 128 + n]); }
    __device__ void epi(int z, int m, int n0, const float* v) const {
        const int g = z & 7; const size_t row = (size_t)(z >> 3) * 128 + m; const float bias = p.sgu_b[g * 128 + m];
        for (int j = 0; j < 4; ++j) { const float u = bf2f(((const bf16*)(p.ws + WS_U))[row * 1024 + g * 128 + n0 + j]);
            ((bf16*)(p.ws + WS_CAT))[row * D + 1024 + g * 128 + n0 + j] = f2bf(u * (v[j] + bias)); }
    }
};
struct GScore {
    Ptrs p; int K; int bh;
    __device__ float a(int, int m, int k) const { return bf2f(((const bf16*)(p.ws + WS_Q))[((size_t)bh * L + m) * DQK + k]); }
    __device__ float b(int, int k, int n) const { return bf2f(((const bf16*)(p.ws + WS_K))[((size_t)bh * LK + n) * DQK + k]); }
    __device__ void epi(int, int m, int n0, const float* v) const { float* S = (float*)(p.ws + WS_S) + (size_t)m * LK + n0; for (int j = 0; j < 4; ++j) S[j] = v[j] * ATT_SCALE; }
};
__global__ void n_softmax(float* S, int cols) {
    float* r = S + (size_t)blockIdx.x * cols; __shared__ float red[4];
    float mx = -1e30f; for (int c = threadIdx.x; c < cols; c += 256) mx = fmaxf(mx, r[c]);
    for (int o = 1; o < 64; o <<= 1) mx = fmaxf(mx, __shfl_xor(mx, o));
    if ((threadIdx.x & 63) == 0) red[threadIdx.x >> 6] = mx; __syncthreads();
    mx = fmaxf(fmaxf(red[0], red[1]), fmaxf(red[2], red[3])); __syncthreads();
    float s = 0.f; for (int c = threadIdx.x; c < cols; c += 256) { const float e = __expf(r[c] - mx); r[c] = e; s += e; }
    s = wave_sum(s); if ((threadIdx.x & 63) == 0) red[threadIdx.x >> 6] = s; __syncthreads();
    s = (red[0] + red[1]) + (red[2] + red[3]); const float inv = 1.f / s;
    for (int c = threadIdx.x; c < cols; c += 256) r[c] *= inv;
}
struct GPV {
    Ptrs p; int K; int bh;
    __device__ float a(int, int m, int k) const { return ((const float*)(p.ws + WS_S))[(size_t)m * LK + k]; }
    __device__ float b(int, int k, int n) const { return bf2f(((const bf16*)(p.ws + WS_V))[((size_t)bh * LK + k) * VH + n]); }
    __device__ void epi(int, int m, int n0, const float* v) const { bf16* d = (bf16*)(p.ws + WS_CAT) + ((size_t)(bh >> 3) * L + m) * D + (bh & 7) * 128 + n0; for (int j = 0; j < 4; ++j) d[j] = f2bf(v[j]); }
};
struct GOut {
    Ptrs p; int K;
    __device__ float a(int, int m, int k) const { return bf2f(((const bf16*)(p.ws + WS_CAT))[(size_t)m * D + k]); }
    __device__ float b(int, int k, int n) const { return p.w_out[(size_t)k * D + n]; }
    __device__ void epi(int, int m, int n0, const float* v) const { bf16* d = (bf16*)(p.ws + WS_Y) + (size_t)m * D + n0; for (int j = 0; j < 4; ++j) d[j] = f2bf(v[j]); }
};
__device__ __forceinline__ void row_pass_mid(const Ptrs& p, int row, int lane) {
    const int b = row >> 12; const float* mod = (const float*)(p.ws + WS_MOD) + b * 12288;
    const float ssq = wave_sum(lane < 32 ? ((const float*)(p.ws + WS_SSQY))[(size_t)row * 32 + lane] : 0.f);
    const float rsy = rsqrtf(ssq * (1.f / D) + EPS);
    const bf16* y = (const bf16*)(p.ws + WS_Y) + (size_t)row * D; const float* xr = p.x + (size_t)row * D; float* o = p.out + (size_t)row * D;
    float v[32]; float s = 0.f;
    for (int j = 0; j < 32; ++j) { const int c = j * 64 + lane; v[j] = xr[c] + mod[4096 + c] * (bf2f(y[c]) * rsy * p.post_norm1[c]); o[c] = v[j]; s += v[j] * v[j]; }
    const float rs = rsqrtf(wave_sum(s) * (1.f / D) + EPS);
    bf16* h2 = (bf16*)(p.ws + WS_H2) + (size_t)row * D; float lg[16];
    for (int e = 0; e < 16; ++e) lg[e] = 0.f;
    for (int j = 0; j < 32; ++j) { const int c = j * 64 + lane; const float h = v[j] * rs * p.pre_norm2[c] * (1.f + mod[8192 + c]) + mod[6144 + c]; h2[c] = f2bf(h);
        const float* wr = p.w_router + (size_t)c * 16; for (int e = 0; e < 16; ++e) lg[e] += h * wr[e]; }
    float mx = -1e30f;
    for (int e = 0; e < 16; ++e) { lg[e] = wave_sum(lg[e]) + p.b_router[e]; mx = fmaxf(mx, lg[e]); }
    float se = 0.f; for (int e = 0; e < 16; ++e) { lg[e] = __expf(lg[e] - mx); se += lg[e]; }
    const float inv = 1.f / se;
    if (lane < 16) { float val = 0.f; for (int e = 0; e < 16; ++e) val = (lane == e) ? lg[e] * inv : val; ((float*)(p.ws + WS_AFF))[(size_t)row * 16 + lane] = val; }
}
__global__ __launch_bounds__(256) void n_rowmid(Ptrs p) { const int row = blockIdx.x * 4 + (threadIdx.x >> 6); row_pass_mid(p, row, threadIdx.x & 63); }
__global__ void n_topk(Ptrs p) {
    __shared__ float vals[L];
    const int e = blockIdx.x >> 2, b = blockIdx.x & 3;
    const float* aff = (const float*)(p.ws + WS_AFF) + (size_t)b * L * 16 + e;
    for (int t = threadIdx.x; t < L; t += blockDim.x) vals[t] = aff[(size_t)t * 16];
    __syncthreads();
    for (int t = threadIdx.x; t < L; t += blockDim.x) {
        const float v = vals[t]; int rank = 0;
        for (int u = 0; u < L; ++u) { const float w = vals[u]; rank += (w > v || (w == v && u < t)) ? 1 : 0; }
        ((int*)(p.ws + WS_INV))[(size_t)(b * L + t) * 16 + e] = rank < CAP ? rank : -1;
        if (rank < CAP) ((int*)(p.ws + WS_IDX))[(size_t)(e * 4 + b) * CAP + rank] = t;
    }
}
struct GE1 {
    Ptrs p; int K;
    __device__ float a(int z, int m, int k) const { const int b = m >> 9; const int tok = ((const int*)(p.ws + WS_IDX))[(size_t)(z * 4 + b) * CAP + (m & 511)];
        return bf2f(((const bf16*)(p.ws + WS_H2))[((size_t)b * L + tok) * D + k]); }
    __device__ float b(int z, int k, int n) const { const float* w = (n & 1) ? p.w_e_up : p.w_e_gate; return w[((size_t)z * D + k) * FF + (n >> 1)]; }
    __device__ void epi(int z, int m, int n0, const float* v) const { bf16* d = (bf16*)(p.ws + WS_ACT) + ((size_t)z * 2048 + m) * FF + (n0 >> 1);
        d[0] = f2bf(silu_f(v[0]) * v[1]); d[1] = f2bf(silu_f(v[2]) * v[3]); }
};
struct GE2 {
    Ptrs p; int K;
    __device__ float a(int z, int m, int k) const { return bf2f(((const bf16*)(p.ws + WS_ACT))[((size_t)z * 2048 + m) * FF + k]); }
    __device__ float b(int z, int k, int n) const { return p.w_e_down[((size_t)z * FF + k) * D + n]; }
    __device__ void epi(int z, int m, int n0, const float* v) const { bf16* d = (bf16*)(p.ws + WS_YE) + ((size_t)z * 2048 + m) * D + n0; for (int j = 0; j < 4; ++j) d[j] = f2bf(v[j]); }
};
__device__ __forceinline__ void row_pass_final(const Ptrs& p, int row, int lane) {
    const int b = row >> 12; const float* mod = (const float*)(p.ws + WS_MOD) + b * 12288;
    const int* inv = (const int*)(p.ws + WS_INV) + (size_t)row * 16; const float* aff = (const float*)(p.ws + WS_AFF) + (size_t)row * 16;
    float v[32]; for (int j = 0; j < 32; ++j) v[j] = 0.f;
    for (int e = 0; e < 16; ++e) { const int sl = inv[e]; if (sl >= 0) { const float g = aff[e]; const bf16* ye = (const bf16*)(p.ws + WS_YE) + ((size_t)(e * 4 + b) * CAP + sl) * D;
            for (int j = 0; j < 32; ++j) v[j] += g * bf2f(ye[j * 64 + lane]); } }
    float s = 0.f; for (int j = 0; j < 32; ++j) s += v[j] * v[j];
    const float rs = rsqrtf(wave_sum(s) * (1.f / D) + EPS);
    float* o = p.out + (size_t)row * D;
    for (int j = 0; j < 32; ++j) { const int c = j * 64 + lane; o[c] = o[c] + mod[10240 + c] * (v[j] * rs * p.post_norm2[c]); }
}
__global__ __launch_bounds__(256) void n_rowfinal(Ptrs p) { const int row = blockIdx.x * 4 + (threadIdx.x >> 6); row_pass_final(p, row, threadIdx.x & 63); }


namespace pg8 {
#define PG8_LAS __attribute__((address_space(3)))
typedef short bf16x8 __attribute__((ext_vector_type(8)));
typedef float f32x4 __attribute__((ext_vector_type(4)));
typedef float f32x2 __attribute__((ext_vector_type(2)));
typedef unsigned u32x4 __attribute__((ext_vector_type(4)));
constexpr int BM = 256, BK = 64, HALF = 128, HTB = HALF * BK * 2, STAGE_BYTES = 8 * HTB, NXCD = 8, WGM = 8;

__host__ __device__ __forceinline__ int lds_byte(int r, int c) { const int st = (r >> 4) * 2 + (c >> 5), rr = r & 15, cc = c & 31, ob = rr * 64 + cc * 2; return st * 1024 + (ob ^ (((ob >> 9) & 1) << 5)); }
__host__ __device__ __forceinline__ void stage_rc(int b, int& R, int& C) { const int st = b / 1024, sb = b % 1024, swz = sb ^ (((sb >> 9) & 1) << 5); R = (st >> 1) * 16 + swz / 64; C = (st & 1) * 32 + (swz % 64) / 2; }
__host__ __device__ __forceinline__ int perm32(int rho) { const int n = rho >> 4, i = rho & 15; return 8 * (i >> 2) + 4 * n + (i & 3); }

struct Unit { int pm, pn, ui; };
__device__ __forceinline__ void rect_unit(int L, int nM, int nN, Unit& u) {
    const int nwg = nM * nN; int wgid = L;
    { const int q = nwg / NXCD, r = nwg % NXCD, xcd = wgid % NXCD, off = wgid / NXCD; wgid = (xcd < r ? xcd * (q + 1) : r * (q + 1) + (xcd - r) * q) + off; }
    const int nig = WGM * nN, gid = wgid / nig, fm = gid * WGM, gsz = (nM - fm) < WGM ? (nM - fm) : WGM;
    u.pm = fm + ((wgid % nig) % gsz); u.pn = (wgid % nig) / gsz;
}
__device__ __forceinline__ void dense_voff(int K, int tid, unsigned (&v)[2][2]) {
#pragma unroll
    for (int i = 0; i < 2; ++i) { int R, C; stage_rc(tid * 16 + i * 8192, R, C); v[0][i] = (unsigned)(R * K + C) * 2u; v[1][i] = (unsigned)((R + HALF) * K + C) * 2u; }
}

__device__ __forceinline__ unsigned cvt_pk_bf16(float lo, float hi) { unsigned r; asm volatile("v_cvt_pk_bf16_f32 %0, %1, %2" : "=v"(r) : "v"(lo), "v"(hi)); return r; }
__device__ __forceinline__ u32x4 pack8(const f32x4& a, const f32x4& b) { u32x4 w; w.x = cvt_pk_bf16(a[0], a[1]); w.y = cvt_pk_bf16(a[2], a[3]); w.z = cvt_pk_bf16(b[0], b[1]); w.w = cvt_pk_bf16(b[2], b[3]); return w; }

typedef int i32x4 __attribute__((ext_vector_type(4)));
typedef int i32x8 __attribute__((ext_vector_type(8)));
template <class Epi, class Sched, bool FP8 = false>
__device__ __forceinline__ void gemm_phase(PG8_LAS unsigned char* lds, const int K, const Sched& S, const Epi& E) {
    const int tid = threadIdx.x, wid = __builtin_amdgcn_readfirstlane(tid >> 6), lane = tid & 63, wr = wid >> 2, wc = wid & 3, fr = lane & 15, fq = lane >> 4;
    const int nt = K / BK;
    unsigned voffB[2];
#pragma unroll
    for (int i = 0; i < 2; ++i) { int R, C; stage_rc(tid * 16 + i * 8192, R, C); const int Rb = Epi::PERM ? ((R & ~31) + perm32(R & 31)) : R; voffB[i] = (unsigned)(Rb * K + C) * 2u; }
    const size_t kstep = (size_t)(BK * 2);
    const size_t hstep = (size_t)HALF * K * 2;
    const unsigned ldsw = (unsigned)wid * 1024u;
    const int aoff = lds_byte(wr * 64 + fr, fq * 8), boff = lds_byte(wc * 32 + fr, fq * 8);
#define PG8_SA(b, h) (((b) * 2 + (h)) * HTB)
#define PG8_SB(b, h) ((4 + (b) * 2 + (h)) * HTB)
#define PG8_STAGE(bufoff, gbase, voff) do { _Pragma("unroll") for (int _i = 0; _i < 2; ++_i) \
        __builtin_amdgcn_global_load_lds((const unsigned*)((const char*)(gbase) + (voff)[_i]), (PG8_LAS unsigned*)(lds + (bufoff) + ldsw + _i * 8192), 16, 0, 0); } while (0)
#define PG8_LDA(dst, b, h) do { _Pragma("unroll") for (int m = 0; m < 4; ++m) _Pragma("unroll") for (int k = 0; k < 2; ++k) dst[m][k] = *(const PG8_LAS bf16x8*)(lds + PG8_SA(b, h) + aoff + m * 2048 + k * 1024); } while (0)
#define PG8_LDB(dst, b, h) do { _Pragma("unroll") for (int n = 0; n < 2; ++n) _Pragma("unroll") for (int k = 0; k < 2; ++k) dst[n][k] = *(const PG8_LAS bf16x8*)(lds + PG8_SB(b, h) + boff + n * 2048 + k * 1024); } while (0)
#define PG8_MMA(ai, bj, At, Bt) do { __builtin_amdgcn_s_setprio(1); _Pragma("unroll") for (int m = 0; m < 4; ++m) _Pragma("unroll") for (int n = 0; n < 2; ++n) { \
        if constexpr (FP8) { const i32x8 fb = __builtin_shufflevector((i32x4)Bt[n][0], (i32x4)Bt[n][1], 0, 1, 2, 3, 4, 5, 6, 7), fa = __builtin_shufflevector((i32x4)At[m][0], (i32x4)At[m][1], 0, 1, 2, 3, 4, 5, 6, 7); \
            acc[ai][bj][m][n] = __builtin_amdgcn_mfma_scale_f32_16x16x128_f8f6f4(fb, fa, acc[ai][bj][m][n], 0, 0, 0, 0x7f7f7f7f, 0, 0x7f7f7f7f); } \
        else { _Pragma("unroll") for (int k = 0; k < 2; ++k) acc[ai][bj][m][n] = __builtin_amdgcn_mfma_f32_16x16x32_bf16(Bt[n][k], At[m][k], acc[ai][bj][m][n], 0, 0, 0); } } \
        __builtin_amdgcn_s_setprio(0); } while (0)
#define PG8_WAIT_V(n) asm volatile("s_waitcnt vmcnt(" #n ")" ::: "memory")
#define PG8_WAIT_L(n) asm volatile("s_waitcnt lgkmcnt(" #n ")" ::: "memory")
#define PG8_BAR __builtin_amdgcn_s_barrier()
#define PG8_SCHED __builtin_amdgcn_sched_barrier(0)
    Unit cur, nxt; int ui = 0;
    if (!S.next(0, cur)) return;
    f32x4 acc[2][2][4][2];
#pragma unroll
    for (int a = 0; a < 2; ++a)
#pragma unroll
        for (int b = 0; b < 2; ++b)
#pragma unroll
            for (int m = 0; m < 4; ++m)
#pragma unroll
                for (int n = 0; n < 2; ++n) acc[a][b][m][n] = (f32x4){0.f, 0.f, 0.f, 0.f};
    bf16x8 At[4][2], B0[2][2], B1[2][2];
    unsigned vA[2][2], vN[2][2];
    S.a_voff(0, cur, tid, vA);
    const char* cA = S.a_base(cur); const char* cB = S.b_base(cur);
    PG8_STAGE(PG8_SB(0, 0), cB, voffB); PG8_STAGE(PG8_SB(0, 1), cB + hstep, voffB); PG8_STAGE(PG8_SA(0, 0), cA, vA[0]); PG8_STAGE(PG8_SA(0, 1), cA, vA[1]);
    if (wr == 1) PG8_BAR;
    PG8_WAIT_V(2); PG8_BAR;
    PG8_STAGE(PG8_SB(1, 0), cB + kstep, voffB); PG8_STAGE(PG8_SA(1, 0), cA + kstep, vA[0]); PG8_STAGE(PG8_SB(1, 1), cB + hstep + kstep, voffB);
    PG8_WAIT_V(6); PG8_BAR;
    for (;;) {
        const bool has_next = S.next(ui + 1, nxt);
        if (has_next) S.a_voff(ui + 1, nxt, tid, vN);
        const char* nA = has_next ? S.a_base(nxt) : cA; const char* nB = has_next ? S.b_base(nxt) : cB;
        for (int t = 0; t < nt; t += 2) {
            const bool last = (t == nt - 2);
            const char* a1 = cA + (size_t)(t + 1) * kstep;
            const char* a2 = last ? nA : cA + (size_t)(t + 2) * kstep; const char* b2 = last ? nB : cB + (size_t)(t + 2) * kstep;
            const char* a3 = a2 + kstep; const char* b3 = b2 + kstep;
            PG8_LDB(B0, 0, 0); PG8_LDB(B1, 0, 1); PG8_SCHED; PG8_LDA(At, 0, 0); PG8_STAGE(PG8_SA(1, 1), a1, vA[1]);
            if (last && has_next) {
#pragma unroll
                for (int h = 0; h < 2; ++h)
#pragma unroll
                    for (int i = 0; i < 2; ++i) vA[h][i] = vN[h][i];
            }
            PG8_WAIT_V(8); PG8_WAIT_L(0); PG8_BAR; PG8_MMA(0, 0, At, B0); PG8_MMA(0, 1, At, B1); PG8_BAR; PG8_SCHED;
            PG8_LDA(At, 0, 1); PG8_STAGE(PG8_SB(0, 0), b2, voffB); PG8_STAGE(PG8_SB(0, 1), b2 + hstep, voffB); PG8_STAGE(PG8_SA(0, 0), a2, vA[0]);
            PG8_WAIT_V(8); PG8_WAIT_L(0); PG8_BAR; PG8_MMA(1, 0, At, B0); PG8_MMA(1, 1, At, B1); PG8_BAR; PG8_SCHED;
            PG8_LDB(B0, 1, 0); PG8_LDB(B1, 1, 1); PG8_SCHED; PG8_LDA(At, 1, 0); PG8_STAGE(PG8_SA(0, 1), a2, vA[1]);
            PG8_WAIT_V(8); PG8_WAIT_L(0); PG8_BAR; PG8_MMA(0, 0, At, B0); PG8_MMA(0, 1, At, B1); PG8_BAR; PG8_SCHED;
            PG8_LDA(At, 1, 1); PG8_STAGE(PG8_SB(1, 0), b3, voffB); PG8_STAGE(PG8_SB(1, 1), b3 + hstep, voffB); PG8_STAGE(PG8_SA(1, 0), a3, vA[0]);
            PG8_WAIT_V(8); PG8_WAIT_L(0); PG8_BAR; PG8_MMA(1, 0, At, B0); PG8_MMA(1, 1, At, B1); PG8_BAR; PG8_SCHED;
        }
        if (wr == 0) PG8_BAR;
        E(acc, cur, wr, wc, fr, fq);
        if (!has_next) break;
#pragma unroll
        for (int a = 0; a < 2; ++a)
#pragma unroll
            for (int b = 0; b < 2; ++b)
#pragma unroll
                for (int m = 0; m < 4; ++m)
#pragma unroll
                    for (int n = 0; n < 2; ++n) acc[a][b][m][n] = (f32x4){0.f, 0.f, 0.f, 0.f};
        cur = nxt; cA = nA; cB = nB; ++ui;
        if (wr == 1) PG8_BAR;
    }
    PG8_WAIT_V(0);
    PG8_BAR;
#undef PG8_SA
#undef PG8_SB
#undef PG8_STAGE
#undef PG8_LDA
#undef PG8_LDB
#undef PG8_MMA
#undef PG8_WAIT_V
#undef PG8_WAIT_L
#undef PG8_BAR
#undef PG8_SCHED
}
}

#define LAS __attribute__((address_space(3)))
typedef pg8::f32x4 f32x4; typedef pg8::u32x4 u32x4; typedef pg8::Unit Unit;
constexpr size_t TSTEP2K = (size_t)256 * 2048 * 2, TSTEP512 = (size_t)256 * 512 * 2;

struct SchedIn {
    static constexpr bool GATHER = false; const char *A, *Bt; int G, c;
    __device__ __forceinline__ bool next(int i, Unit& u) const { const int Lx = i * G + c; if (Lx >= 844) return false;
        if (Lx < 832) pg8::rect_unit(Lx, 64, 13, u); else { const int r = Lx - 832; u.pm = 64 + (r & 3); const int q = r >> 2; u.pn = q == 2 ? 12 : 2 + q; } return true; }
    __device__ __forceinline__ const char* a_base(const Unit& u) const { return A + (size_t)u.pm * TSTEP2K; }
    __device__ __forceinline__ const char* b_base(const Unit& u) const { return Bt + (size_t)u.pn * TSTEP2K; }
    __device__ __forceinline__ void a_voff(int, const Unit&, int tid, unsigned (&v)[2][2]) const { pg8::dense_voff(2048, tid, v); }
};
struct SchedQKV {
    static constexpr bool GATHER = false; const char *A, *Bt; int G, c;
    __device__ __forceinline__ bool next(int i, Unit& u) const { const int Lx = i * G + c; if (Lx >= 928) return false;
        if (Lx < 384) pg8::rect_unit(Lx, 64, 6, u); else { pg8::rect_unit(Lx - 384, 68, 8, u); u.pm += 64; u.pn += 6; } u.ui = i; return true; }
    __device__ __forceinline__ const char* a_base(const Unit& u) const { return A + (size_t)u.pm * TSTEP512; }
    __device__ __forceinline__ const char* b_base(const Unit& u) const { return Bt + (size_t)u.pn * TSTEP512; }
    __device__ __forceinline__ void a_voff(int, const Unit&, int tid, unsigned (&v)[2][2]) const { pg8::dense_voff(512, tid, v); }
};
template <int nM, int nN, int BSHIFT, int KU> struct SchedDense {
    static constexpr bool GATHER = false; const char *A, *Bt; int G, c;
    __device__ __forceinline__ bool next(int i, Unit& u) const { const int Lx = i * G + c; if (Lx >= nM * nN) return false; pg8::rect_unit(Lx, nM, nN, u); return true; }
    __device__ __forceinline__ const char* a_base(const Unit& u) const { return A + (size_t)u.pm * (512 * KU); }
    __device__ __forceinline__ const char* b_base(const Unit& u) const { return Bt + (size_t)((u.pm >> BSHIFT) * nN + u.pn) * (512 * KU); }
    __device__ __forceinline__ void a_voff(int, const Unit&, int tid, unsigned (&v)[2][2]) const { pg8::dense_voff(KU, tid, v); }
};
template <int KU> struct SchedGather {
    static constexpr bool GATHER = true; const char *A, *Bt; int G, c; const LAS unsigned* tab;
    __device__ __forceinline__ bool next(int i, Unit& u) const { const int Lx = i * G + c; if (Lx >= 2048) return false; pg8::rect_unit(Lx, 128, 16, u); return true; }
    __device__ __forceinline__ const char* a_base(const Unit&) const { return A; }
    __device__ __forceinline__ const char* b_base(const Unit& u) const { return Bt + (size_t)((u.pm >> 3) * 16 + u.pn) * (512 * KU); }
    __device__ __forceinline__ void a_voff(int i, const Unit&, int tid, unsigned (&v)[2][2]) const {
#pragma unroll
        for (int p = 0; p < 2; ++p) { int R, C; pg8::stage_rc(tid * 16 + p * 8192, R, C); v[0][p] = tab[i * 256 + R] + (unsigned)C * 2u; v[1][p] = tab[i * 256 + 128 + R] + (unsigned)C * 2u; }
    }
};

__device__ __forceinline__ float gelu_fast(float x) {
    const float z2 = -2.302208198f * (x + 0.044715f * x * x * x);
    return x * __builtin_amdgcn_rcpf(1.f + __builtin_amdgcn_exp2f(z2));
}
__device__ __forceinline__ float silu_fast(float x) { return x * __builtin_amdgcn_rcpf(1.f + __builtin_amdgcn_exp2f(-1.4426950408889634f * x)); }
__device__ __forceinline__ float dot4(const f32x4& a) { return (a[0] * a[0] + a[1] * a[1]) + (a[2] * a[2] + a[3] * a[3]); }
__device__ __forceinline__ void rope8(f32x4& a, f32x4& b, const float* tabrow  , int fq) {
    const f32x4 t0 = *(const f32x4*)(tabrow + 8 * fq), t1 = *(const f32x4*)(tabrow + 8 * fq + 4);
    f32x4 ra, rb;
    ra[0] = a[0] * t0[0] - a[1] * t0[1]; ra[1] = a[1] * t0[0] + a[0] * t0[1]; ra[2] = a[2] * t0[2] - a[3] * t0[3]; ra[3] = a[3] * t0[2] + a[2] * t0[3];
    rb[0] = b[0] * t1[0] - b[1] * t1[1]; rb[1] = b[1] * t1[0] + b[0] * t1[1]; rb[2] = b[2] * t1[2] - b[3] * t1[3]; rb[3] = b[3] * t1[2] + b[2] * t1[3];
    a = ra; b = rb;
}
struct EpiIn {
    static constexpr bool PERM = true; unsigned char* ws;
    __device__ __forceinline__ void operator()(const f32x4 (&acc)[2][2][4][2], const Unit& u, int wr, int wc, int fr, int fq) const {
        const int pn = u.pn, row0 = u.pm * 256 + wr * 64 + fr, c8 = wc * 32 + 8 * fq;
        if (pn < 4) {
            bf16* base = (bf16*)(ws + WS_CQKV) + (pn >= 2 ? (size_t)M * 512 : 0) + (pn & 1) * 256 + c8;
            float* ssq = (float*)(ws + (pn >= 2 ? WS_SSQKV : WS_SSQQ)) + (pn & 1) * 4 + wc;
#pragma unroll
            for (int ai = 0; ai < 2; ++ai)
#pragma unroll
                for (int m = 0; m < 4; ++m) { const int row = row0 + ai * 128 + m * 16; float s = 0.f;
#pragma unroll
                    for (int bj = 0; bj < 2; ++bj) { s += dot4(acc[ai][bj][m][0]) + dot4(acc[ai][bj][m][1]); *(u32x4*)(base + (size_t)row * 512 + bj * 128) = pg8::pack8(acc[ai][bj][m][0], acc[ai][bj][m][1]); }
                    s += __shfl_xor(s, 16); s += __shfl_xor(s, 32);
                    if (fq == 0) ssq[(size_t)row * 8] = s; }
        } else if (pn < 12) {
            bf16* base = (bf16*)(ws + (pn < 8 ? WS_U : WS_VS)) + ((pn - 4) & 3) * 256 + c8;
#pragma unroll
            for (int ai = 0; ai < 2; ++ai)
#pragma unroll
                for (int m = 0; m < 4; ++m) { const int row = row0 + ai * 128 + m * 16;
#pragma unroll
                    for (int bj = 0; bj < 2; ++bj) { f32x4 a = acc[ai][bj][m][0], b = acc[ai][bj][m][1];
#pragma unroll
                        for (int j = 0; j < 4; ++j) { a[j] = gelu_fast(a[j]); b[j] = gelu_fast(b[j]); }
                        *(u32x4*)(base + (size_t)row * 1024 + bj * 128) = pg8::pack8(a, b); } }
        } else if (wc < 2) {
            const float* tab = (const float*)(ws + WS_ROPE);
#pragma unroll
            for (int ai = 0; ai < 2; ++ai)
#pragma unroll
                for (int m = 0; m < 4; ++m) { const int row = row0 + ai * 128 + m * 16; f32x4 a = acc[ai][0][m][0], b = acc[ai][0][m][1]; int bb, kpos;
                    if (row < M) { bb = row >> 12; kpos = row & 4095; const int ax = wc ? (kpos & 63) : (kpos >> 6); rope8(a, b, tab + ax * 32, fq); }
                    else { bb = (row - M) >> 8; kpos = L + ((row - M) & 255); }
                    const u32x4 w = pg8::pack8(a, b); bf16* d = (bf16*)(ws + WS_K) + ((size_t)(bb * H) * LK + kpos) * DQK + 128 + c8;
#pragma unroll
                    for (int hh = 0; hh < H; ++hh) *(u32x4*)(d + (size_t)hh * LK * DQK) = w; }
        }
    }
};
struct EpiQKV {
    static constexpr bool PERM = true; unsigned char* ws; const LAS float* rstab;
    __device__ __forceinline__ void operator()(const f32x4 (&acc)[2][2][4][2], const Unit& u, int wr, int wc, int fr, int fq) const {
        const int c8 = wc * 32 + 8 * fq;
        if (u.pn < 6) {
            const int pn = u.pn, row0 = u.pm * 256 + wr * 64 + fr; const float* tab = (const float*)(ws + WS_ROPE);
#pragma unroll
            for (int ai = 0; ai < 2; ++ai)
#pragma unroll
                for (int m = 0; m < 4; ++m) { const int row = row0 + ai * 128 + m * 16; const int bb = row >> 12, t = row & 4095;
                    const float rs = rstab[u.ui * 256 + ai * 128 + wr * 64 + m * 16 + fr];
#pragma unroll
                    for (int bj = 0; bj < 2; ++bj) { f32x4 a = acc[ai][bj][m][0] * rs, b = acc[ai][bj][m][1] * rs; bf16* d;
                        if (pn < 4) d = (bf16*)(ws + WS_Q) + ((size_t)(bb * H + pn * 2 + bj) * L + t) * DQK + c8;
                        else { const int hd = (pn - 4) * 4 + bj * 2 + (wc >> 1), ax = (wc & 1) ? (t & 63) : (t >> 6); rope8(a, b, tab + ax * 32, fq);
                            d = (bf16*)(ws + WS_Q) + ((size_t)(bb * H + hd) * L + t) * DQK + 128 + (wc & 1) * 32 + 8 * fq; }
                        *(u32x4*)d = pg8::pack8(a, b); }
                    asm volatile("" ::: "memory"); }
        } else {
            const int hd = u.pn - 6, row0 = (u.pm - 64) * 256 + wr * 64 + fr;
#pragma unroll
            for (int ai = 0; ai < 2; ++ai)
#pragma unroll
                for (int m = 0; m < 4; ++m) { const int row = row0 + ai * 128 + m * 16; int bb, kpos;
                    if (row < M) { bb = row >> 12; kpos = row & 4095; } else { bb = (row - M) >> 8; kpos = L + ((row - M) & 255); }
                    const float rs = rstab[u.ui * 256 + ai * 128 + wr * 64 + m * 16 + fr];
                    const size_t kr = (size_t)(bb * H + hd) * LK + kpos;
                    *(u32x4*)((bf16*)(ws + WS_K) + kr * DQK + c8) = pg8::pack8(acc[ai][0][m][0] * rs, acc[ai][0][m][1] * rs);
                    *(u32x4*)((bf16*)(ws + WS_V) + kr * VH + c8) = pg8::pack8(acc[ai][1][m][0] * rs, acc[ai][1][m][1] * rs);
                    asm volatile("" ::: "memory"); }
        }
    }
};
struct EpiY {
    static constexpr bool PERM = true; unsigned char* ws;
    __device__ __forceinline__ void operator()(const f32x4 (&acc)[2][2][4][2], const Unit& u, int wr, int wc, int fr, int fq) const {
        const int row0 = u.pm * 256 + wr * 64 + fr; bf16* base = (bf16*)(ws + WS_Y) + u.pn * 256 + wc * 32 + 8 * fq; float* ssq = (float*)(ws + WS_SSQY) + u.pn * 4 + wc;
#pragma unroll
        for (int ai = 0; ai < 2; ++ai)
#pragma unroll
            for (int m = 0; m < 4; ++m) { const int row = row0 + ai * 128 + m * 16; float s = 0.f;
#pragma unroll
                for (int bj = 0; bj < 2; ++bj) { s += dot4(acc[ai][bj][m][0]) + dot4(acc[ai][bj][m][1]); *(u32x4*)(base + (size_t)row * D + bj * 128) = pg8::pack8(acc[ai][bj][m][0], acc[ai][bj][m][1]); }
                s += __shfl_xor(s, 16); s += __shfl_xor(s, 32);
                if (fq == 0) ssq[(size_t)row * 32] = s; }
    }
};
__device__ __forceinline__ unsigned pack4_fp8(float a, float b, float c, float d) { int w = 0; w = __builtin_amdgcn_cvt_pk_fp8_f32(a, b, w, false); w = __builtin_amdgcn_cvt_pk_fp8_f32(c, d, w, true); return (unsigned)w; }
constexpr float W8_SCALE = 64.f, W8_INV = 1.f / 64.f;
struct EpiAct8 {
    static constexpr bool PERM = true; unsigned char* ws;
    __device__ __forceinline__ void operator()(const f32x4 (&acc)[2][2][4][2], const Unit& u, int wr, int wc, int fr, int fq) const {
        const int row0 = u.pm * 256 + wr * 64 + fr; unsigned char* base = ws + WS_ACT + u.pn * 128 + wc * 32 + 8 * fq;
#pragma unroll
        for (int ai = 0; ai < 2; ++ai)
#pragma unroll
            for (int m = 0; m < 4; ++m) { const int row = row0 + ai * 128 + m * 16; f32x4 a, b;
#pragma unroll
                for (int j = 0; j < 4; ++j) { a[j] = silu_fast(acc[ai][0][m][0][j] * W8_INV) * (acc[ai][1][m][0][j] * W8_INV); b[j] = silu_fast(acc[ai][0][m][1][j] * W8_INV) * (acc[ai][1][m][1][j] * W8_INV); }
                *(unsigned long long*)(base + (size_t)row * FF) = (unsigned long long)pack4_fp8(a[0], a[1], a[2], a[3]) | ((unsigned long long)pack4_fp8(b[0], b[1], b[2], b[3]) << 32); }
    }
};
struct EpiYE8 {
    static constexpr bool PERM = true; unsigned char* ws;
    __device__ __forceinline__ void operator()(const f32x4 (&acc)[2][2][4][2], const Unit& u, int wr, int wc, int fr, int fq) const {
        const int row0 = u.pm * 256 + wr * 64 + fr; bf16* base = (bf16*)(ws + WS_YE) + u.pn * 256 + wc * 32 + 8 * fq;
#pragma unroll
        for (int ai = 0; ai < 2; ++ai)
#pragma unroll
            for (int m = 0; m < 4; ++m) { const int row = row0 + ai * 128 + m * 16;
#pragma unroll
                for (int bj = 0; bj < 2; ++bj) *(u32x4*)(base + (size_t)row * D + bj * 128) = pg8::pack8(acc[ai][bj][m][0] * W8_INV, acc[ai][bj][m][1] * W8_INV); }
    }
};
struct EpiAct {
    static constexpr bool PERM = true; unsigned char* ws;
    __device__ __forceinline__ void operator()(const f32x4 (&acc)[2][2][4][2], const Unit& u, int wr, int wc, int fr, int fq) const {
        const int row0 = u.pm * 256 + wr * 64 + fr; bf16* base = (bf16*)(ws + WS_ACT) + u.pn * 128 + wc * 32 + 8 * fq;
#pragma unroll
        for (int ai = 0; ai < 2; ++ai)
#pragma unroll
            for (int m = 0; m < 4; ++m) { const int row = row0 + ai * 128 + m * 16; f32x4 a, b;
#pragma unroll
                for (int j = 0; j < 4; ++j) { a[j] = silu_fast(acc[ai][0][m][0][j]) * acc[ai][1][m][0][j]; b[j] = silu_fast(acc[ai][0][m][1][j]) * acc[ai][1][m][1][j]; }
                *(u32x4*)(base + (size_t)row * FF) = pg8::pack8(a, b); }
    }
};
struct EpiYE {
    static constexpr bool PERM = true; unsigned char* ws;
    __device__ __forceinline__ void operator()(const f32x4 (&acc)[2][2][4][2], const Unit& u, int wr, int wc, int fr, int fq) const {
        const int row0 = u.pm * 256 + wr * 64 + fr; bf16* base = (bf16*)(ws + WS_YE) + u.pn * 256 + wc * 32 + 8 * fq;
#pragma unroll
        for (int ai = 0; ai < 2; ++ai)
#pragma unroll
            for (int m = 0; m < 4; ++m) { const int row = row0 + ai * 128 + m * 16;
#pragma unroll
                for (int bj = 0; bj < 2; ++bj) *(u32x4*)(base + (size_t)row * D + bj * 128) = pg8::pack8(acc[ai][bj][m][0], acc[ai][bj][m][1]); }
    }
};

namespace att {
using bf16x8 = __attribute__((ext_vector_type(8))) short;
using s16x4  = __attribute__((ext_vector_type(4))) short;
using f32x16 = __attribute__((ext_vector_type(16))) float;
using u32x4  = __attribute__((ext_vector_type(4))) unsigned;
constexpr int QBLK = 32, KVBLK = 64, NW = 8;
constexpr float SCALE = cfg::ATT_SCALE, THR = 8.f;
constexpr int LDQ = 192, LDKK = 192, LDV = 128, LDO = 2048;
constexpr int SHM_V = KVBLK * 128 * 2, SHM_K = KVBLK * 192 * 2, SHM_QPE = 2 * SHM_V + 2 * SHM_K + NW * 64 * 4, SHM_ATTN = SHM_QPE + NW * 4096;
#define KSWZ(row, colB) ((row) * 384 + ((colB) ^ (((row) & 7) << 4)))
#define SBAR() __builtin_amdgcn_sched_barrier(0)
__device__ __forceinline__ int crow(int r, int hi) { return (r & 3) + 8 * (r >> 2) + 4 * hi; }
__device__ __forceinline__ unsigned cvtpk(float lo, float hi) { unsigned r; asm volatile("v_cvt_pk_bf16_f32 %0, %1, %2" : "=v"(r) : "v"(lo), "v"(hi)); return r; }

__device__ __forceinline__ void partialSM(f32x16& p0, f32x16& p1, float& m_reg, float& mn, float& alpha) {
  constexpr float C = SCALE * 1.4426950408889634f;
  float pmax = p0[0];
#pragma unroll
  for (int r = 1; r < 16; ++r) pmax = fmaxf(pmax, p0[r]);
#pragma unroll
  for (int r = 0; r < 16; ++r) pmax = fmaxf(pmax, p1[r]);
  { auto rr = __builtin_amdgcn_permlane32_swap(__float_as_uint(pmax), __float_as_uint(pmax), false, false);
    pmax = fmaxf(__uint_as_float(rr[0]), __uint_as_float(rr[1])); }
  if (__builtin_expect(__all(pmax - m_reg <= THR / SCALE), 1)) { mn = m_reg; alpha = 1.f; }
  else { mn = fmaxf(m_reg, pmax); alpha = __builtin_amdgcn_exp2f((m_reg - mn) * C); m_reg = mn; }
  float mnC = -mn * C;
#pragma unroll
  for (int r = 0; r < 16; ++r) p0[r] = fmaf(p0[r], C, mnC);
#pragma unroll
  for (int r = 0; r < 16; ++r) p1[r] = fmaf(p1[r], C, mnC);
#pragma unroll
  for (int r = 0; r < 16; ++r) p0[r] = __builtin_amdgcn_exp2f(p0[r]);
}
__device__ __forceinline__ void finishSM(f32x16& p0, f32x16& p1, float alpha, float& l_reg, bf16x8& pa0, bf16x8& pa1, bf16x8& pa2, bf16x8& pa3) {
#pragma unroll
  for (int r = 0; r < 16; ++r) p1[r] = __builtin_amdgcn_exp2f(p1[r]);
  float ps = 0;
#pragma unroll
  for (int r = 0; r < 16; ++r) ps += p0[r];
#pragma unroll
  for (int r = 0; r < 16; ++r) ps += p1[r];
  { auto rr = __builtin_amdgcn_permlane32_swap(__float_as_uint(ps), __float_as_uint(ps), false, false);
    ps = __uint_as_float(rr[0]) + __uint_as_float(rr[1]); }
  l_reg = l_reg * alpha + ps;
#define PK4(P, BASE, OUT) do { unsigned a0 = cvtpk(P[BASE + 0], P[BASE + 1]), a1 = cvtpk(P[BASE + 2], P[BASE + 3]);   \
    unsigned b0 = cvtpk(P[BASE + 4], P[BASE + 5]), b1 = cvtpk(P[BASE + 6], P[BASE + 7]);                              \
    auto r0 = __builtin_amdgcn_permlane32_swap(a0, b0, false, false); auto r1 = __builtin_amdgcn_permlane32_swap(a1, b1, false, false); \
    u32x4 w = {r0[0], r1[0], r0[1], r1[1]}; OUT = *reinterpret_cast<bf16x8*>(&w); } while (0)
  PK4(p0, 0, pa0); PK4(p0, 8, pa1); PK4(p1, 0, pa2); PK4(p1, 8, pa3);
#undef PK4
}
__device__ __forceinline__ void qkt(f32x16& p0, f32x16& p1, const char* Ks, const bf16x8* qr, const char* qpe, int r32, int hi) {
  p0 = f32x16{}; p1 = f32x16{};
#pragma unroll
  for (int d0 = 0; d0 < 12; ++d0) { const int cb = (d0 * 16 + hi * 8) * 2;
    bf16x8 b0 = *reinterpret_cast<const bf16x8*>(Ks + KSWZ(r32, cb));
    bf16x8 b1 = *reinterpret_cast<const bf16x8*>(Ks + KSWZ(32 + r32, cb));
    const bf16x8 q = d0 < 8 ? qr[d0 < 8 ? d0 : 0] : *reinterpret_cast<const bf16x8*>(qpe + (d0 - 8) * 1024);
    p0 = __builtin_amdgcn_mfma_f32_32x32x16_bf16(b0, q, p0, 0, 0, 0);
    p1 = __builtin_amdgcn_mfma_f32_32x32x16_bf16(b1, q, p1, 0, 0, 0); }
}
__device__ __forceinline__ int v_st(int k, int c) { const int kk = (k & ~0xC) | ((k & 4) << 1) | ((k & 8) >> 1); return ((kk >> 3) * 4 + (c >> 5)) * 512 + ((kk & 7) * 32 + (c & 31)) * 2; }
__device__ __forceinline__ int v_rd_base(int lane) { return ((lane & 3) << 3) | (((lane >> 2) & 3) << 6) | (((lane >> 4) & 1) << 5) | (((lane >> 5) & 1) << 8); }
constexpr int v_rd_off(int d0, int ks, int half) { return d0 * 512 + ks * 4096 + half * 2048; }
template <int OFF> __device__ __forceinline__ s16x4 tr_read(int vb) {
  s16x4 r; asm volatile("ds_read_b64_tr_b16 %0, %1 offset:%2" : "=&v"(r) : "v"(vb), "i"(OFF) : "memory"); return r;
}
template <int D0> __device__ __forceinline__ void pv_one(f32x16& od, int vb, bf16x8 pa0, bf16x8 pa1, bf16x8 pa2, bf16x8 pa3) {
  const s16x4 l0 = tr_read<v_rd_off(D0, 0, 0)>(vb), h0 = tr_read<v_rd_off(D0, 0, 1)>(vb), l1 = tr_read<v_rd_off(D0, 1, 0)>(vb), h1 = tr_read<v_rd_off(D0, 1, 1)>(vb);
  const s16x4 l2 = tr_read<v_rd_off(D0, 2, 0)>(vb), h2 = tr_read<v_rd_off(D0, 2, 1)>(vb), l3 = tr_read<v_rd_off(D0, 3, 0)>(vb), h3 = tr_read<v_rd_off(D0, 3, 1)>(vb);
  asm volatile("s_waitcnt lgkmcnt(0)" ::: "memory"); SBAR();
#define PK(L, H) (bf16x8){L[0], L[1], L[2], L[3], H[0], H[1], H[2], H[3]}
  od = __builtin_amdgcn_mfma_f32_32x32x16_bf16(pa0, PK(l0, h0), od, 0, 0, 0);
  od = __builtin_amdgcn_mfma_f32_32x32x16_bf16(pa1, PK(l1, h1), od, 0, 0, 0);
  od = __builtin_amdgcn_mfma_f32_32x32x16_bf16(pa2, PK(l2, h2), od, 0, 0, 0);
  od = __builtin_amdgcn_mfma_f32_32x32x16_bf16(pa3, PK(l3, h3), od, 0, 0, 0);
#undef PK
}
__device__ __forceinline__ void pv_d0(f32x16* o, int vb, bf16x8 pa0, bf16x8 pa1, bf16x8 pa2, bf16x8 pa3) {
  pv_one<0>(o[0], vb, pa0, pa1, pa2, pa3); pv_one<1>(o[1], vb, pa0, pa1, pa2, pa3); pv_one<2>(o[2], vb, pa0, pa1, pa2, pa3); pv_one<3>(o[3], vb, pa0, pa1, pa2, pa3);
}
__device__ __forceinline__ void attn_unit(const bf16* __restrict__ Qb, const bf16* __restrict__ Kh, const bf16* __restrict__ Vh, bf16* __restrict__ Ob, int seq, char* lds) {
  const int tid = threadIdx.x, wid = tid >> 6, lane = tid & 63, r32 = lane & 31, hi = lane >> 5;
  char* V_lds = lds; char* K_lds = lds + 2 * SHM_V;
  float* ws = (float*)(lds + 2 * SHM_V + 2 * SHM_K) + wid * 64; float* li_l = ws; float* al_l = ws + 32;
  float m_reg = -1e30f, l_reg = 0; f32x16 o[4] = {}; bf16x8 qr[8];
  const bf16* Qw = Qb + (long)(wid * QBLK + r32) * LDQ + hi * 8;
  char* qpe = lds + SHM_QPE + wid * 4096 + lane * 16;
#pragma unroll
  for (int d0 = 0; d0 < 8; ++d0) qr[d0] = *reinterpret_cast<const bf16x8*>(Qw + d0 * 16);
#pragma unroll
  for (int d0 = 8; d0 < 12; ++d0) *reinterpret_cast<bf16x8*>(qpe + (d0 - 8) * 1024) = *reinterpret_cast<const bf16x8*>(Qw + d0 * 16);
  int kro[3], vro[2];
#pragma unroll
  for (int j = 0; j < 3; ++j) { const int o = (wid * 3 + j) * 1024 + lane * 16, row = o / 384, csw = o - row * 384; kro[j] = row * 384 + (csw ^ ((row & 7) << 4)); }
#pragma unroll
  for (int j = 0; j < 2; ++j) { const int o = (wid * 2 + j) * 1024 + lane * 16, st = o >> 9, within = (o & 511) >> 1, kk = (st >> 2) * 8 + (within >> 5), c = (st & 3) * 32 + (within & 31);
    const int k = (kk & ~0xC) | ((kk & 4) << 1) | ((kk & 8) >> 1); vro[j] = k * 256 + c * 2; }
  const unsigned klds = (unsigned)(uintptr_t)K_lds + wid * 3072, vlds = (unsigned)(uintptr_t)V_lds + wid * 2048;
  const int vb0 = (int)(uintptr_t)V_lds + v_rd_base(lane);
  typedef __attribute__((address_space(3))) unsigned* ldsp_t;
#define SDMA_K(k0, b) do { const char* kg = (const char*)Kh + (long)(k0) * (LDKK * 2); \
    _Pragma("unroll") for (int j_ = 0; j_ < 3; ++j_) __builtin_amdgcn_global_load_lds((const unsigned*)(kg + kro[j_]), (ldsp_t)(klds + (b) * SHM_K + j_ * 1024), 16, 0, 0); } while (0)
#define SDMA_V(k0, b) do { const char* vg = (const char*)Vh + (long)(k0) * (LDV * 2); \
    _Pragma("unroll") for (int j_ = 0; j_ < 2; ++j_) __builtin_amdgcn_global_load_lds((const unsigned*)(vg + vro[j_]), (ldsp_t)(vlds + (b) * SHM_V + j_ * 1024), 16, 0, 0); } while (0)
#define RESC(a) do { if (__any((a) < 1.f)) { if (hi == 0) al_l[r32] = (a); asm volatile("s_waitcnt lgkmcnt(0)" ::: "memory"); \
    _Pragma("unroll") for (int d = 0; d < 4; ++d) _Pragma("unroll") for (int r = 0; r < 16; ++r) o[d][r] *= al_l[crow(r, hi)]; } } while (0)
#define PHASE_END() do { asm volatile("s_waitcnt vmcnt(0) lgkmcnt(0)" ::: "memory"); __builtin_amdgcn_s_barrier(); asm volatile("" ::: "memory"); } while (0)
  f32x16 pA0, pA1; float mnA, alA; bf16x8 pa0, pa1, pa2, pa3; const int NT = seq / KVBLK;
  SDMA_K(0, 0); SDMA_V(0, 0); PHASE_END();
  if (wid >= 4) { __builtin_amdgcn_s_barrier(); asm volatile("" ::: "memory"); }
  for (int j = 0; j < NT; ++j) {
    const int bsel = j & 1;
    if (j + 1 < NT) { if (bsel) SDMA_K((j + 1) * KVBLK, 0); else SDMA_K((j + 1) * KVBLK, 1); }
    SBAR(); qkt(pA0, pA1, K_lds + bsel * SHM_K, qr, qpe, r32, hi);
    partialSM(pA0, pA1, m_reg, mnA, alA);
    PHASE_END();
    if (j + 1 < NT) { if (bsel) SDMA_V((j + 1) * KVBLK, 0); else SDMA_V((j + 1) * KVBLK, 1); }
    RESC(alA);
    finishSM(pA0, pA1, alA, l_reg, pa0, pa1, pa2, pa3); SBAR();
    pv_d0(o, vb0 + bsel * (int)SHM_V, pa0, pa1, pa2, pa3);
    PHASE_END();
  }
  if (wid < 4) { __builtin_amdgcn_s_barrier(); asm volatile("" ::: "memory"); }
  if (hi == 0) li_l[r32] = l_reg; asm volatile("s_waitcnt lgkmcnt(0)" ::: "memory");
  float rli[16];
#pragma unroll
  for (int r = 0; r < 16; ++r) rli[r] = __builtin_amdgcn_rcpf(li_l[crow(r, hi)]);
  bf16* Ow = Ob + (long)(wid * QBLK) * LDO;
#pragma unroll
  for (int r = 0; r < 16; ++r) { const int orow = crow(r, hi);
#pragma unroll
    for (int d0 = 0; d0 < 4; ++d0) Ow[(long)orow * LDO + d0 * 32 + r32] = f2bf(o[d0][r] * rli[r]); }
#undef SDMA_K
#undef SDMA_V
#undef PHASE_END
#undef RESC
}
#undef KSWZ
#undef SBAR
}

#define XB_TMO      128
#define XB_XCNT(j)  (256  + 64 * (j))
#define XB_XSUB(j)  (1280 + 64 * (j))
#define XB_XGEN(j)  (2304 + 64 * (j))
#define XB_TOP      3328
#define XB_TOPGEN   3392
#define XCD_BAR_WORDS 3456
#define XB_SPIN_CAP (1u << 18)
__device__ __forceinline__ unsigned xb_ld(unsigned* p)              { return __hip_atomic_load(p, __ATOMIC_RELAXED, __HIP_MEMORY_SCOPE_AGENT); }
__device__ __forceinline__ unsigned xb_add(unsigned* p, unsigned v) { return __hip_atomic_fetch_add(p, v, __ATOMIC_RELAXED, __HIP_MEMORY_SCOPE_AGENT); }
__device__ __forceinline__ unsigned xb_xcc_id() { return (unsigned)__builtin_amdgcn_s_getreg((3 << 11) | 20) & 0xFu; }
#define XB_SPIN(cond, bar) do { unsigned _sp = 0; while (cond) { __builtin_amdgcn_s_sleep(1); \
    if ((++_sp & 255u) == 0u) { if (xb_ld(&(bar)[XB_TMO])) break; if (_sp > XB_SPIN_CAP) { atomicAdd(&(bar)[XB_TMO], 1u); break; } } } } while (0)
struct XcdBarrier { unsigned* bar; unsigned x; volatile LAS unsigned* st; };
__device__ __forceinline__ XcdBarrier xcd_barrier_post(unsigned* bar, volatile LAS unsigned* st) {
    XcdBarrier b; b.bar = bar; b.x = xb_xcc_id(); b.st = st;
    if (threadIdx.x == 0) (void)xb_add(&bar[XB_XCNT(b.x)], 1u);
    return b;
}
__device__ __forceinline__ void xcd_barrier_complete(unsigned* bar, unsigned x, unsigned& nloc, unsigned& nx) {
    const unsigned G = gridDim.x * gridDim.y * gridDim.z;
    unsigned sum, cnt, mine, sp = 0u;
    for (;;) {
        sum = 0u; cnt = 0u; mine = 0u;
#pragma unroll
        for (unsigned j = 0; j < 16; ++j) { const unsigned c = xb_ld(&bar[XB_XCNT(j)]); sum += c; cnt += (c > 0u) ? 1u : 0u; mine = (j == x) ? c : mine; }
        if (sum == G) break;
        __builtin_amdgcn_s_sleep(1);
        if ((++sp & 255u) == 0u) { if (xb_ld(&bar[XB_TMO])) break; if (sp > XB_SPIN_CAP) { atomicAdd(&bar[XB_TMO], 1u); break; } }
    }
    nloc = mine > 0u ? mine : 1u; nx = cnt > 0u ? cnt : 1u;
}
__device__ __forceinline__ void xcd_barrier(const XcdBarrier& b) {
    asm volatile("s_waitcnt vmcnt(0)" ::: "memory");
    __syncthreads();
    if (threadIdx.x == 0) {
        unsigned* bar = b.bar;
        __builtin_amdgcn_s_waitcnt(0);
        unsigned nloc = b.st[0], nx = b.st[1];
        if (nloc == 0u) { xcd_barrier_complete(bar, b.x, nloc, nx); b.st[0] = nloc; b.st[1] = nx; }
        const unsigned old = xb_add(&bar[XB_XSUB(b.x)], 1u);
        const unsigned gen = old / nloc;
        if (old + 1u == (gen + 1u) * nloc) {
            __builtin_amdgcn_fence(__ATOMIC_RELEASE, "agent");
            asm volatile("s_waitcnt vmcnt(0)" ::: "memory");
            const unsigned og = xb_add(&bar[XB_TOP], 1u);
            const unsigned tg = og / nx;
            if (og + 1u == (tg + 1u) * nx) xb_add(&bar[XB_TOPGEN], 1u);
            else XB_SPIN(xb_ld(&bar[XB_TOPGEN]) == tg, bar);
            __builtin_amdgcn_fence(__ATOMIC_ACQUIRE, "agent");
            xb_add(&bar[XB_XGEN(b.x)], 1u);
            asm volatile("s_waitcnt vmcnt(0)" ::: "memory");
        } else {
            XB_SPIN(xb_ld(&bar[XB_XGEN(b.x)]) == gen, bar);
            __builtin_amdgcn_fence(__ATOMIC_ACQUIRE, "agent");
            asm volatile("s_waitcnt vmcnt(0)" ::: "memory");
        }
    }
    __syncthreads();
}

constexpr int NWAVES = 8, NTHREADS = 512;
constexpr int RING_BYTES = 131072, TAB_OFF = RING_BYTES, TAB_BYTES = 8192, LDS_BYTES = 163840, MISC_OFF = LDS_BYTES - 512, VEC_OFF = RING_BYTES;
constexpr int CW_BAR = 4096;
#define LDS_WAIT() asm volatile("s_waitcnt lgkmcnt(0)" ::: "memory")
typedef unsigned v4u __attribute__((ext_vector_type(4)));
__device__ __forceinline__ unsigned pk2(float lo, float hi) { return (unsigned)f2bf(lo) | ((unsigned)f2bf(hi) << 16); }

__device__ __forceinline__ void p0_mod_item(const Ptrs& p, int it, int lane) {
    const int kc = it / 48, cc = it - kc * 48, k0 = kc * 64, c0 = cc * 256 + lane * 4;
    float sv[5];
#pragma unroll
    for (int r = 0; r < 5; ++r) { const float* cv = r < 4 ? p.c + r * D : p.c_ctx; sv[r] = silu_f(cv[k0 + lane]); }
    f32x4 acc[5];
#pragma unroll
    for (int r = 0; r < 5; ++r) acc[r] = (f32x4){0.f, 0.f, 0.f, 0.f};
    const float* w = p.w_ada + (size_t)k0 * 12288 + c0;
#pragma unroll 8
    for (int k = 0; k < 64; ++k) { const f32x4 wv = *(const f32x4*)(w + (size_t)k * 12288);
#pragma unroll
        for (int r = 0; r < 5; ++r) acc[r] += __int_as_float(__builtin_amdgcn_readlane(__float_as_int(sv[r]), k)) * wv; }
    float* part = (float*)(p.ws + WS_PART) + (size_t)kc * 5 * 12288 + c0;
#pragma unroll
    for (int r = 0; r < 5; ++r) *(f32x4*)(part + (size_t)r * 12288) = acc[r];
}
__device__ __forceinline__ void cvt_load(const float* src, int ldw, int lane, f32x4 (&v)[8]) {
    const int kr = lane >> 3, nq = lane & 7;
#pragma unroll
    for (int i = 0; i < 8; ++i) v[i] = *(const f32x4*)(src + (size_t)(8 * i + kr) * ldw + 4 * nq);
}
__device__ __forceinline__ void cvt_finish(const f32x4 (&v)[8], bf16* dst, int ldk, bool rope, const float* kscale, LAS float* scr, int lane) {
    const int kr = lane >> 3, nq = lane & 7;
#pragma unroll
    for (int i = 0; i < 8; ++i) { const int k = 8 * i + kr; const float sc = kscale ? kscale[k] : 1.f;
#pragma unroll
        for (int t = 0; t < 4; ++t) { const int cs = 4 * nq + t, nn = rope ? ((cs & 15) * 2 + (cs >> 4)) : cs; scr[k * 33 + nn] = v[i][t] * sc; } }
    LDS_WAIT(); asm volatile("" ::: "memory");
    const int c = lane & 7;
#pragma unroll
    for (int j = 0; j < 4; ++j) { const int n = (lane >> 3) + 8 * j; const LAS float* s = scr + (8 * c) * 33 + n;
        v4u o; o.x = pg8::cvt_pk_bf16(s[0 * 33], s[1 * 33]); o.y = pg8::cvt_pk_bf16(s[2 * 33], s[3 * 33]); o.z = pg8::cvt_pk_bf16(s[4 * 33], s[5 * 33]); o.w = pg8::cvt_pk_bf16(s[6 * 33], s[7 * 33]);
        *(v4u*)(dst + (size_t)n * ldk + 8 * c) = o; }
    LDS_WAIT(); asm volatile("" ::: "memory");
}
__device__ __forceinline__ void cvt_finish_fp8(const f32x4 (&v)[8], unsigned char* dst, int ldk, LAS float* scr, int lane) {
    const int kr = lane >> 3, nq = lane & 7;
#pragma unroll
    for (int i = 0; i < 8; ++i) { const int k = 8 * i + kr;
#pragma unroll
        for (int t = 0; t < 4; ++t) scr[k * 33 + 4 * nq + t] = v[i][t] * W8_SCALE; }
    LDS_WAIT(); asm volatile("" ::: "memory");
    const int c = lane & 3;
#pragma unroll
    for (int j = 0; j < 2; ++j) { const int n = (lane >> 2) + 16 * j; const LAS float* s = scr + (16 * c) * 33 + n;
        v4u o; o.x = pack4_fp8(s[0 * 33], s[1 * 33], s[2 * 33], s[3 * 33]); o.y = pack4_fp8(s[4 * 33], s[5 * 33], s[6 * 33], s[7 * 33]);
        o.z = pack4_fp8(s[8 * 33], s[9 * 33], s[10 * 33], s[11 * 33]); o.w = pack4_fp8(s[12 * 33], s[13 * 33], s[14 * 33], s[15 * 33]);
        *(v4u*)(dst + (size_t)n * ldk + 16 * c) = o; }
    LDS_WAIT(); asm volatile("" ::: "memory");
}
__device__ __forceinline__ void cvt_item(const float* src, int ldw, bf16* dst, int ldk, bool rope, const float* kscale, LAS float* scr, int lane) {
    f32x4 v[8]; cvt_load(src, ldw, lane, v); cvt_finish(v, dst, ldk, rope, kscale, scr, lane);
}
constexpr int I_MOD = 1536, I_WIN = 32 * 98, I_WQ = 8 * 48, I_WKV = 8 * 64, I_WOUT = 32 * 64, I_GU = 16 * 32 * 128, I_DN = 16 * 32 * 64, I_SGU = 256, I_ZERO = 768, I_ROPE = 1;
constexpr int P0_ITEMS = I_MOD + I_WIN + I_WQ + I_WKV + I_WOUT + I_SGU + I_ZERO + I_ROPE, PX_ITEMS = I_GU + I_DN;
__device__ __forceinline__ void p0_item(const Ptrs& p, int it, LAS float* scr, int lane) {
    if (it < I_MOD) { p0_mod_item(p, it, lane); return; } it -= I_MOD;
    if (it < I_WIN) { const int kb = it / 98, nb = it - kb * 98, n0 = nb * 32; int col0; bool rope = false;
        if (n0 < 1024) col0 = n0; else if (n0 < 3072) col0 = n0 + 64; else { col0 = OFF_KPE + (nb - 96) * 32; rope = true; }
        cvt_item(p.w_in + (size_t)kb * 64 * INC + col0, INC, (bf16*)(p.ws + WS_WIN_T) + (size_t)n0 * D + kb * 64, D, rope, nullptr, scr, lane); return; } it -= I_WIN;
    if (it < I_WQ) { const int kb = it / 48, nb = it - kb * 48, n0 = nb * 32; int col0; bool rope = false;
        if (n0 < 1024) col0 = (n0 >> 7) * DQK + (n0 & 127); else { const int jj = n0 - 1024; col0 = (jj >> 6) * DQK + 128 + ((jj & 63) >> 5) * 32; rope = true; }
        cvt_item(p.w_uq + (size_t)kb * 64 * 1536 + col0, 1536, (bf16*)(p.ws + WS_WQKV_T) + (size_t)n0 * 512 + kb * 64, 512, rope, p.q_norm_w + kb * 64, scr, lane); return; } it -= I_WQ;
    if (it < I_WKV) { const int kb = it / 64, nb = it - kb * 64, n0 = nb * 32;
        cvt_item(p.w_ukv + (size_t)kb * 64 * 2048 + n0, 2048, (bf16*)(p.ws + WS_WQKV_T) + (size_t)(1536 + n0) * 512 + kb * 64, 512, false, p.kv_norm_w + kb * 64, scr, lane); return; } it -= I_WKV;
    if (it < I_WOUT) { const int kb = it / 64, nb = it - kb * 64, n0 = nb * 32;
        cvt_item(p.w_out + (size_t)kb * 64 * D + n0, D, (bf16*)(p.ws + WS_WOUT_T) + (size_t)n0 * D + kb * 64, D, false, nullptr, scr, lane); return; } it -= I_WOUT;
    if (it < I_SGU) { const float* s = p.sgu_w + (size_t)it * 512 + lane * 8; const f32x4 a = *(const f32x4*)s, b = *(const f32x4*)(s + 4);
        v4u o; o.x = pk2(a[0], a[1]); o.y = pk2(a[2], a[3]); o.z = pk2(b[0], b[1]); o.w = pk2(b[2], b[3]); *(v4u*)((bf16*)(p.ws + WS_SGUW) + (size_t)it * 512 + lane * 8) = o; return; } it -= I_SGU;
    if (it < I_ZERO) { *(v4u*)((bf16*)(p.ws + WS_WIN_T) + (size_t)3136 * D + (size_t)it * 512 + lane * 8) = (v4u){0u, 0u, 0u, 0u}; return; }
    float* tab = (float*)(p.ws + WS_ROPE);
    for (int j = 0; j < 16; ++j) { const int idx = j * 64 + lane, ax = idx >> 4, ii = idx & 15; float s, c; sincosf((float)ax * rope_inv(ii), &s, &c); tab[idx * 2] = c; tab[idx * 2 + 1] = s; }
}
constexpr int WEL = FP8_MOE ? 1 : 2;
#if 0
#else
__device__ __forceinline__ void px_ptrs(const Ptrs& p, int it, const float*& src, unsigned char*& dst) {
    if (it < I_GU) { const int e = it >> 12, r = it & 4095, kb = r >> 7, nb = r & 127, n0 = nb * 32, pn = n0 >> 8, within = n0 & 255;
        src = (within < 128 ? p.w_e_gate : p.w_e_up) + ((size_t)e * D + kb * 64) * FF + pn * 128 + (within & 127);
        dst = p.ws + WS_WGU_T + (((size_t)e * 4096 + n0) * D + kb * 64) * WEL; }
    else { it -= I_GU; const int e = it >> 11, r = it & 2047, kb = r >> 6, nb = r & 63, n0 = nb * 32;
        src = p.w_e_down + ((size_t)e * FF + kb * 64) * D + n0; dst = p.ws + WS_WD_T + (((size_t)e * D + n0) * FF + kb * 64) * WEL; }
}
__device__ __forceinline__ void px_finish(const f32x4 (&v)[8], unsigned char* dst, LAS float* scr, int lane) {
    if constexpr (FP8_MOE) cvt_finish_fp8(v, dst, 2048, scr, lane); else cvt_finish(v, (bf16*)dst, 2048, false, nullptr, scr, lane);
}
__device__ __forceinline__ void px_convert(const Ptrs& p, int gw, int NGW, LAS float* scr, int lane) {
    f32x4 va[8], vb[8], vc[8]; const float* s_; unsigned char *da, *db, *dc;
    int it = gw;
    if (it < PX_ITEMS) { px_ptrs(p, it, s_, da); cvt_load(s_, 2048, lane, va); }
    if (it + NGW < PX_ITEMS) { px_ptrs(p, it + NGW, s_, db); cvt_load(s_, 2048, lane, vb); }
    while (it < PX_ITEMS) {
        if (it + 2 * NGW < PX_ITEMS) { px_ptrs(p, it + 2 * NGW, s_, dc); cvt_load(s_, 2048, lane, vc); }
        px_finish(va, da, scr, lane);
        if (it + NGW >= PX_ITEMS) break;
        if (it + 3 * NGW < PX_ITEMS) { px_ptrs(p, it + 3 * NGW, s_, da); cvt_load(s_, 2048, lane, va); }
        px_finish(vb, db, scr, lane);
        if (it + 2 * NGW >= PX_ITEMS) break;
        if (it + 4 * NGW < PX_ITEMS) { px_ptrs(p, it + 4 * NGW, s_, db); cvt_load(s_, 2048, lane, vb); }
        px_finish(vc, dc, scr, lane);
        it += 3 * NGW;
    }
}
#endif
__device__ __forceinline__ void p1_row(const Ptrs& p, int row, int lane, const LAS float* vg  , const LAS float* vs  ) {
    const float* src = row < M ? p.x + (size_t)row * D : p.ctx + (size_t)(row - M) * D;
    f32x4 v[8]; float s = 0.f;
#pragma unroll
    for (int j = 0; j < 8; ++j) { v[j] = *(const f32x4*)(src + j * 256 + lane * 4); s += dot4(v[j]); }
    const float rs = rsqrtf(wave_sum(s) * (1.f / D) + EPS);
    bf16* o = (bf16*)(p.ws + WS_H) + (size_t)row * D;
#pragma unroll
    for (int j = 0; j < 8; ++j) { const int c = j * 256 + lane * 4; const f32x4 h = v[j] * rs * *(const LAS f32x4*)(vg + c) + *(const LAS f32x4*)(vs + c);
        *(unsigned long long*)(o + c) = (unsigned long long)pk2(h[0], h[1]) | ((unsigned long long)pk2(h[2], h[3]) << 32); }
}
typedef float f32x16 __attribute__((ext_vector_type(16)));
typedef short bf16x8v __attribute__((ext_vector_type(8)));
__device__ __forceinline__ void sgu_unit(const Ptrs& p, int chunk, int g, LAS unsigned char* lds, int tid) {
    constexpr int VROW = 272;
    const int lane = tid & 63, wid = tid >> 6;
    {
        const int q = tid >> 2, cg = tid & 3;
        const bf16* src = (const bf16*)(p.ws + WS_VS) + (size_t)(chunk * 128 + q) * 1024 + g * 128 + cg * 32;
        float x[32];
#pragma unroll
        for (int j = 0; j < 4; ++j) { const v4u w = *(const v4u*)(src + j * 8);
#pragma unroll
            for (int t = 0; t < 4; ++t) { x[j * 8 + 2 * t] = __uint_as_float(w[t] << 16); x[j * 8 + 2 * t + 1] = __uint_as_float(w[t] & 0xffff0000u); } }
        float s = 0.f;
#pragma unroll
        for (int j = 0; j < 32; ++j) s += x[j];
        s += __shfl_xor(s, 1); s += __shfl_xor(s, 2);
        const float mu = s * (1.f / 128.f); float vq = 0.f;
#pragma unroll
        for (int j = 0; j < 32; ++j) { x[j] -= mu; vq += x[j] * x[j]; }
        vq += __shfl_xor(vq, 1); vq += __shfl_xor(vq, 2);
        const float rs = rsqrtf(vq * (1.f / 128.f) + EPS);
        const float* gw = p.sgu_norm_w + g * 128 + cg * 32;
#pragma unroll
        for (int j = 0; j < 32; ++j) *(LAS bf16*)(lds + (cg * 32 + j) * VROW + q * 2) = f2bf(x[j] * rs * gw[j]);
    }
    LDS_WAIT(); __syncthreads();
    const int pb = wid >> 1, ch = wid & 1, r32 = lane & 31, hi = lane >> 5;
    f32x16 acc0 = {}, acc1 = {};
    const bf16* wrow = (const bf16*)(p.ws + WS_SGUW) + ((size_t)g * 128 + pb * 32 + r32) * 128 + hi * 8;
#pragma unroll
    for (int ks = 0; ks < 8; ++ks) {
        const bf16x8v a = *(const bf16x8v*)(wrow + ks * 16);
        const bf16x8v b0 = *(const LAS bf16x8v*)(lds + (ch * 64 + r32) * VROW + (ks * 16 + hi * 8) * 2);
        const bf16x8v b1 = *(const LAS bf16x8v*)(lds + (ch * 64 + 32 + r32) * VROW + (ks * 16 + hi * 8) * 2);
        acc0 = __builtin_amdgcn_mfma_f32_32x32x16_bf16(a, b0, acc0, 0, 0, 0);
        acc1 = __builtin_amdgcn_mfma_f32_32x32x16_bf16(a, b1, acc1, 0, 0, 0);
    }
#pragma unroll
    for (int r = 0; r < 16; ++r) { const int pr = pb * 32 + (r & 3) + 8 * (r >> 2) + 4 * hi; const size_t tok = (size_t)chunk * 128 + pr; const float bias = p.sgu_b[g * 128 + pr];
        const bf16* ur = (const bf16*)(p.ws + WS_U) + tok * 1024 + g * 128 + ch * 64 + r32; bf16* orow = (bf16*)(p.ws + WS_CAT) + tok * D + 1024 + g * 128 + ch * 64 + r32;
        orow[0] = f2bf(bf2f(ur[0]) * (acc0[r] + bias)); orow[32] = f2bf(bf2f(ur[32]) * (acc1[r] + bias)); }
    __syncthreads();
}
__device__ __forceinline__ void topk_unit(const Ptrs& p, int e, int b, LAS unsigned* sh, int tid) {
    const int lane = tid & 63, wid = tid >> 6;
    const float* aff = (const float*)(p.ws + WS_AFF) + (size_t)b * L * 16 + e;
    unsigned key[8];
#pragma unroll
    for (int j = 0; j < 8; ++j) key[j] = __float_as_uint(aff[(size_t)(tid * 8 + j) * 16]);
    unsigned prefix = 0u, mask = 0u, need = CAP;
    for (int shift = 24; shift >= 0; shift -= 8) {
        if (tid < 256) sh[tid] = 0u;
        __syncthreads();
#pragma unroll
        for (int j = 0; j < 8; ++j) if ((key[j] & mask) == prefix) atomicAdd((unsigned*)&sh[(key[j] >> shift) & 255u], 1u);
        __syncthreads();
        if (wid == 0) {
            const unsigned c0 = sh[4 * lane], c1 = sh[4 * lane + 1], c2 = sh[4 * lane + 2], c3 = sh[4 * lane + 3];
            const unsigned s = c0 + c1 + c2 + c3; unsigned S = s;
#pragma unroll
            for (int d = 1; d < 64; d <<= 1) { const unsigned v = __shfl_down(S, d); if (lane + d < 64) S += v; }
            const unsigned above = S - s;
            if (S >= need && above < need) { unsigned cum = above, bin, nd;
                if (cum + c3 >= need) { bin = 3; nd = need - cum; } else { cum += c3;
                if (cum + c2 >= need) { bin = 2; nd = need - cum; } else { cum += c2;
                if (cum + c1 >= need) { bin = 1; nd = need - cum; } else { cum += c1; bin = 0; nd = need - cum; } } }
                sh[256] = 4u * lane + bin; sh[257] = nd; }
        }
        __syncthreads();
        prefix |= sh[256] << shift; mask |= 255u << shift; need = sh[257];
        __syncthreads();
    }
    unsigned cg = 0u, ce = 0u;
#pragma unroll
    for (int j = 0; j < 8; ++j) { cg += key[j] > prefix ? 1u : 0u; ce += key[j] == prefix ? 1u : 0u; }
    unsigned pk = (cg << 16) | ce, inc = pk;
#pragma unroll
    for (int d = 1; d < 64; d <<= 1) { const unsigned v = __shfl_up(inc, d); if (lane >= d) inc += v; }
    if (lane == 63) sh[264 + wid] = inc;
    __syncthreads();
    unsigned off = 0u;
#pragma unroll
    for (int w = 0; w < 8; ++w) off += (w < wid) ? sh[264 + w] : 0u;
    unsigned ex = off + inc - pk; unsigned gtb = ex >> 16, eqb = ex & 0xffffu;
    int* inv = (int*)(p.ws + WS_INV) + (size_t)(b * L + tid * 8) * 16 + e; int* idx = (int*)(p.ws + WS_IDX) + (size_t)(e * 4 + b) * CAP;
#pragma unroll
    for (int j = 0; j < 8; ++j) { const bool gt = key[j] > prefix, eq = key[j] == prefix; const bool sel = gt || (eq && eqb < need);
        const unsigned slot = gtb + (eqb < need ? eqb : need);
        inv[(size_t)j * 16] = sel ? (int)slot : -1; if (sel) idx[slot] = tid * 8 + j;
        gtb += gt ? 1u : 0u; eqb += eq ? 1u : 0u; }
    __syncthreads();
}

__device__ __forceinline__ f32x4 ld_bf16x4(const bf16* s) { const unsigned long long w = *(const unsigned long long*)s; const unsigned lo = (unsigned)w, hi2 = (unsigned)(w >> 32);
    return (f32x4){__uint_as_float(lo << 16), __uint_as_float(lo & 0xffff0000u), __uint_as_float(hi2 << 16), __uint_as_float(hi2 & 0xffff0000u)}; }
__device__ __forceinline__ void st_bf16x4(bf16* d, const f32x4& h) { *(unsigned long long*)d = (unsigned long long)pk2(h[0], h[1]) | ((unsigned long long)pk2(h[2], h[3]) << 32); }
struct P6In { f32x4 x[8]; unsigned long long y[8]; float ssq; };
__device__ __forceinline__ void p6_fetch(const Ptrs& p, int row, int lane, P6In& in) {
    const float* xr = p.x + (size_t)row * D + lane * 4; const bf16* y = (const bf16*)(p.ws + WS_Y) + (size_t)row * D + lane * 4;
#pragma unroll
    for (int j = 0; j < 8; ++j) { in.x[j] = *(const f32x4*)(xr + j * 256); in.y[j] = *(const unsigned long long*)(y + j * 256); }
    in.ssq = lane < 32 ? ((const float*)(p.ws + WS_SSQY))[(size_t)row * 32 + lane] : 0.f;
}
__device__ __forceinline__ f32x4 bf16x4_to_f32(unsigned long long w) { const unsigned lo = (unsigned)w, hi2 = (unsigned)(w >> 32);
    return (f32x4){__uint_as_float(lo << 16), __uint_as_float(lo & 0xffff0000u), __uint_as_float(hi2 << 16), __uint_as_float(hi2 & 0xffff0000u)}; }
__device__ __forceinline__ void p6_row(const Ptrs& p, int row, int lane, const LAS float* wt, const LAS float* vt, const P6In& in, int flags) {
    const float rsy = rsqrtf(wave_sum(in.ssq) * (1.f / D) + EPS);
    float* o = ((flags & 1) ? (float*)(p.ws + WS_S) : p.out) + (size_t)row * D;
    f32x4 v[8]; float s = 0.f;
#pragma unroll
    for (int j = 0; j < 8; ++j) { const int c = j * 256 + lane * 4;
        v[j] = in.x[j] + (bf16x4_to_f32(in.y[j]) * rsy) * *(const LAS f32x4*)(vt + c);
        *(f32x4*)(o + c) = v[j]; s += dot4(v[j]); }
    const float rs = rsqrtf(wave_sum(s) * (1.f / D) + EPS);
    bf16* h2 = (bf16*)(p.ws + ((flags & 1) ? WS_VN : WS_H2)) + (size_t)row * D;
    float lg[16];
#pragma unroll
    for (int e = 0; e < 16; ++e) lg[e] = 0.f;
#pragma unroll
    for (int j = 0; j < 8; ++j) { const int c = j * 256 + lane * 4;
        const f32x4 h = v[j] * rs * *(const LAS f32x4*)(vt + 2048 + c) + *(const LAS f32x4*)(vt + 4096 + c);
        if constexpr (FP8_MOE) *(unsigned*)((unsigned char*)(p.ws + ((flags & 1) ? WS_VN : WS_H2)) + (size_t)row * D + c) = pack4_fp8(h[0], h[1], h[2], h[3]); else st_bf16x4(h2 + c, h);
        if (!(flags & 2))
#pragma unroll
        for (int e = 0; e < 16; ++e) { const f32x4 w = *(const LAS f32x4*)(wt + e * 2048 + c); lg[e] += (h[0] * w[0] + h[1] * w[1]) + (h[2] * w[2] + h[3] * w[3]); }
        asm volatile("" ::: "memory"); }
#define XSTEP(N, MASK) _Pragma("unroll") for (int i = 0; i < N; ++i) { const bool up = (lane & MASK) != 0; const float send = up ? lg[i] : lg[i + N]; const float keep = up ? lg[i + N] : lg[i]; lg[i] = keep + __shfl_xor(send, MASK); }
    XSTEP(8, 32) XSTEP(4, 16) XSTEP(2, 8) XSTEP(1, 4)
#undef XSTEP
    float lgt = lg[0]; lgt += __shfl_xor(lgt, 2); lgt += __shfl_xor(lgt, 1);
    lgt += p.b_router[lane >> 2];
    float mx = lgt;
#pragma unroll
    for (int o2 = 4; o2 < 64; o2 <<= 1) mx = fmaxf(mx, __shfl_xor(mx, o2));
    const float ex = __expf(lgt - mx); float se = ex;
#pragma unroll
    for (int o2 = 4; o2 < 64; o2 <<= 1) se += __shfl_xor(se, o2);
    if ((lane & 3) == 0 && !(flags & 1)) ((float*)(p.ws + WS_AFF))[(size_t)row * 16 + (lane >> 2)] = ex / se;
}
typedef unsigned u32x4v __attribute__((ext_vector_type(4)));
struct P11In { f32x4 x[8]; int inv; float aff; };
__device__ __forceinline__ void p11_fetch(const Ptrs& p, int row, int lane, P11In& in) {
    const float* xr = p.out + (size_t)row * D + lane * 8;
#pragma unroll
    for (int j = 0; j < 4; ++j) { in.x[2 * j] = *(const f32x4*)(xr + j * 512); in.x[2 * j + 1] = *(const f32x4*)(xr + j * 512 + 4); }
    in.inv = ((const int*)(p.ws + WS_INV))[(size_t)row * 16 + (lane & 15)]; in.aff = ((const float*)(p.ws + WS_AFF))[(size_t)row * 16 + (lane & 15)];
}
__device__ __forceinline__ void acc_bf16x8(f32x4& a, f32x4& b, const u32x4v& w, float g) {
    a[0] += g * __uint_as_float(w[0] << 16); a[1] += g * __uint_as_float(w[0] & 0xffff0000u); a[2] += g * __uint_as_float(w[1] << 16); a[3] += g * __uint_as_float(w[1] & 0xffff0000u);
    b[0] += g * __uint_as_float(w[2] << 16); b[1] += g * __uint_as_float(w[2] & 0xffff0000u); b[2] += g * __uint_as_float(w[3] << 16); b[3] += g * __uint_as_float(w[3] & 0xffff0000u);
}
__device__ __forceinline__ void p11_row(const Ptrs& p, int row, int lane, float* dsto, const LAS float* vt, const P11In& in, int flags) {
    const int b = row >> 12;
    unsigned mask = (flags & 2) ? 0u : (unsigned)(__ballot(in.inv >= 0) & 0xffffull);
    f32x4 v[8];
#pragma unroll
    for (int j = 0; j < 8; ++j) v[j] = (f32x4){0.f, 0.f, 0.f, 0.f};
    while (mask) {
        u32x4v r[4][4]; float g[4]; bool on[4];
#pragma unroll
        for (int k = 0; k < 4; ++k) { on[k] = mask != 0u; g[k] = 0.f;
            if (on[k]) { const int e = __builtin_ctz(mask); mask &= mask - 1u; const int sl = __builtin_amdgcn_readlane(in.inv, e); g[k] = __int_as_float(__builtin_amdgcn_readlane(__float_as_int(in.aff), e));
                const bf16* ye = (const bf16*)(p.ws + WS_YE) + ((size_t)(e * 4 + b) * CAP + sl) * D + lane * 8;
#pragma unroll
                for (int j = 0; j < 4; ++j) r[k][j] = *(const u32x4v*)(ye + j * 512); } }
#pragma unroll
        for (int k = 0; k < 4; ++k) if (on[k]) {
#pragma unroll
            for (int j = 0; j < 4; ++j) acc_bf16x8(v[2 * j], v[2 * j + 1], r[k][j], g[k]); }
    }
    float s = 0.f;
#pragma unroll
    for (int j = 0; j < 8; ++j) s += dot4(v[j]);
    const float rs = rsqrtf(wave_sum(s) * (1.f / D) + EPS);
    float* od = dsto + (size_t)row * D + lane * 8;
#pragma unroll
    for (int j = 0; j < 4; ++j) { const int c = j * 512 + lane * 8;
        *(f32x4*)(od + j * 512) = in.x[2 * j] + (v[2 * j] * rs) * *(const LAS f32x4*)(vt + c);
        *(f32x4*)(od + j * 512 + 4) = in.x[2 * j + 1] + (v[2 * j + 1] * rs) * *(const LAS f32x4*)(vt + c + 4); }
}

struct Args { Ptrs p; int ph_lo, ph_hi, bar_idx, pad; };
#ifdef DUP_PHASE
#define PROBE_FLAGS args.pad
#else
#define PROBE_FLAGS 0
#endif
__global__ void __launch_bounds__(NTHREADS, 2) fwd(Args args) {
    extern __shared__ __attribute__((aligned(16))) unsigned char lds_raw[];
    LAS unsigned char* lds = (LAS unsigned char*)lds_raw;
#if defined(__HIP_DEVICE_COMPILE__)
    typedef __attribute__((address_space(4))) const Args CArgs;
#define LOADP() Ptrs p; { const CArgs* kp_ = (const CArgs*)__builtin_amdgcn_kernarg_segment_ptr(); asm volatile("" : "+s"(kp_)); p = kp_->p; }
#else
#define LOADP() Ptrs p = args.p;
#endif
#define TIDS() int tid = threadIdx.x; asm volatile("" : "+v"(tid)); const int lane = tid & 63, wave = __builtin_amdgcn_readfirstlane(tid >> 6); \
    const int G = gridDim.x, bx = blockIdx.x, vcu = (G % 8 == 0) ? (bx % 8) * (G / 8) + bx / 8 : bx; const int gw = vcu * NWAVES + wave, NGW = G * NWAVES; (void)lane; (void)gw; (void)NGW; (void)vcu; (void)bx;
    volatile LAS unsigned* MISC = (volatile LAS unsigned*)(lds + MISC_OFF);
    if (threadIdx.x < 64) MISC[threadIdx.x] = 0u;
    __syncthreads();
#if defined(__HIP_DEVICE_COMPILE__)
#define ARGF(f) ([&]() { const CArgs* kq_ = (const CArgs*)__builtin_amdgcn_kernarg_segment_ptr(); asm volatile("" : "+s"(kq_)); return kq_->f; }())
#else
#define ARGF(f) (args.f)
#endif
    if (ARGF(ph_hi) - ARGF(ph_lo) > 1) { LOADP(); (void)xcd_barrier_post((unsigned*)(p.ws + WS_CTL) + CW_BAR + ARGF(bar_idx) * 4096, MISC + 8); }
#define GRID_BARRIER() do { LOADP(); XcdBarrier b_; b_.bar = (unsigned*)(p.ws + WS_CTL) + CW_BAR + ARGF(bar_idx) * 4096; b_.x = xb_xcc_id(); b_.st = (volatile LAS unsigned*)(lds + MISC_OFF) + 8; xcd_barrier(b_); } while (0)
#define lo ARGF(ph_lo)
#define hi ARGF(ph_hi)
#if defined(ONLY_SET)
#define IN(k) (((ONLY_SET >> (k)) & 1) && lo <= (k) && (k) < hi)
#elif defined(ONLY_PHASE)
#define IN(k) ((k) == ONLY_PHASE && lo <= (k) && (k) < hi)
#else
#define IN(k) (lo <= (k) && (k) < hi)
#endif
#define SEAM(k) do { if (IN(k) && IN((k) + 1)) GRID_BARRIER(); } while (0)

    if (IN(0)) { LOADP(); TIDS();
        LAS float* scr = (LAS float*)(lds + wave * 8448);
        for (int it = gw; it < P0_ITEMS; it += NGW) p0_item(p, it, scr, lane);
    }
    SEAM(0);
    if (IN(1)) { LOADP(); TIDS();
        const int gid = bx * NTHREADS + tid;
        if (gid < 5 * 12288) { const int r = gid / 12288, j = gid - r * 12288; float s = p.b_ada[j]; const float* part = (const float*)(p.ws + WS_PART) + (size_t)r * 12288 + j;
            for (int kc = 0; kc < 32; ++kc) s += part[(size_t)kc * 5 * 12288];
            ((float*)(p.ws + WS_MOD))[gid] = s; }
    }
    SEAM(1);
    if (IN(2)) { LOADP(); TIDS();
        const int bsel = vcu & 3, wsub = (vcu >> 2) * NWAVES + wave, nsub = ((G + 3 - bsel) >> 2) * NWAVES;
        LAS float* vt = (LAS float*)lds;
        for (int c = tid; c < D; c += NTHREADS) { const float* mb = (const float*)(p.ws + WS_MOD) + bsel * 12288; const float* mc = (const float*)(p.ws + WS_MOD) + 4 * 12288; const float g = p.pre_norm1[c];
            vt[c] = g * (1.f + mb[2048 + c]); vt[2048 + c] = mb[c]; vt[4096 + c] = g * (1.f + mc[2048 + c]); vt[6144 + c] = mc[c]; }
        LDS_WAIT(); __syncthreads();
        for (int r = wsub; r < L; r += nsub) p1_row(p, bsel * L + r, lane, vt, vt + 2048);
        for (int row = M + gw; row < MALL; row += NGW) p1_row(p, row, lane, vt + 4096, vt + 6144);
        __syncthreads();
    }
    SEAM(2);
    if (IN(3)) { LOADP(); TIDS();
        SchedIn S{(const char*)(p.ws + WS_H), (const char*)(p.ws + WS_WIN_T), G, bx}; EpiIn E{p.ws};
        pg8::gemm_phase<EpiIn, SchedIn>(lds, 2048, S, E);
    }
    SEAM(3);
    if (IN(4)) { LOADP(); TIDS();
        SchedQKV S{(const char*)(p.ws + WS_CQKV), (const char*)(p.ws + WS_WQKV_T), G, bx};
        LAS float* rstab = (LAS float*)(lds + TAB_OFF);
        for (int q = tid; q < 2048; q += NTHREADS) { const int i = q >> 8, r = q & 255; Unit u;
            if (S.next(i, u)) { const float* sp = u.pm < 64 ? (const float*)(p.ws + WS_SSQQ) + (size_t)(u.pm * 256 + r) * 8 : (const float*)(p.ws + WS_SSQKV) + (size_t)((u.pm - 64) * 256 + r) * 8;
                const f32x4 s0 = *(const f32x4*)sp, s1 = *(const f32x4*)(sp + 4);
                rstab[q] = rsqrtf((((s0[0] + s0[1]) + (s0[2] + s0[3])) + ((s1[0] + s1[1]) + (s1[2] + s1[3]))) * (1.f / 512.f) + EPS); } }
        LDS_WAIT(); __syncthreads();
        EpiQKV E{p.ws, rstab};
        pg8::gemm_phase<EpiQKV, SchedQKV>(lds, 512, S, E);
        __syncthreads();
        for (int u = vcu; u < 1024; u += G) sgu_unit(p, u >> 3, u & 7, lds, tid);
    }
    SEAM(4);
    if (IN(5)) { TIDS();
        const int grp = (vcu >> 4) % 3;
#define PX_CONV(g) do { if (grp == (g)) { LOADP(); __syncthreads(); px_convert(p, gw, NGW, (LAS float*)(lds + wave * 8448), lane); __syncthreads(); } } while (0)
#define ATT_UNIT(u_) do { const int u = (u_); if (u < 512) { LOADP(); const int bh = u >> 4, qb = u & 15; __syncthreads(); \
            att::attn_unit((const bf16*)(p.ws + WS_Q) + ((size_t)bh * L + qb * 256) * DQK, (const bf16*)(p.ws + WS_K) + (size_t)bh * LK * DQK, (const bf16*)(p.ws + WS_V) + (size_t)bh * LK * VH, \
                           (bf16*)(p.ws + WS_CAT) + ((size_t)(bh >> 3) * L + qb * 256) * D + (bh & 7) * 128, LK, (char*)lds_raw); } } while (0)
        PX_CONV(0); ATT_UNIT(vcu); PX_CONV(1); ATT_UNIT(vcu + G); PX_CONV(2);
        for (int u = vcu + 2 * G; u < 512; u += G) ATT_UNIT(u);
#undef PX_CONV
#undef ATT_UNIT
        __syncthreads();
    }
    SEAM(5);
    if (IN(6)) { LOADP(); TIDS();
        typedef SchedDense<64, 8, 31, 2048> SD; SD S{(const char*)(p.ws + WS_CAT), (const char*)(p.ws + WS_WOUT_T), G, bx}; EpiY E{p.ws};
        pg8::gemm_phase<EpiY, SD>(lds, 2048, S, E);
    }
    SEAM(6);
    if (IN(7)) { LOADP(); TIDS();
        LAS float* wt = (LAS float*)lds;
        for (int c = tid; c < D; c += NTHREADS) { const float* wr = p.w_router + (size_t)c * 16;
#pragma unroll
            for (int q = 0; q < 4; ++q) { const f32x4 w = *(const f32x4*)(wr + q * 4);
#pragma unroll
                for (int t = 0; t < 4; ++t) wt[(q * 4 + t) * 2048 + c] = w[t]; } }
        LDS_WAIT(); __syncthreads();
        const int bsel = vcu & 3, wsub = (vcu >> 2) * NWAVES + wave, nsub = ((G + 3 - bsel) >> 2) * NWAVES;
        LAS float* vt = (LAS float*)(lds + VEC_OFF);
        for (int c = tid; c < D; c += NTHREADS) { const float* mb = (const float*)(p.ws + WS_MOD) + bsel * 12288;
            vt[c] = mb[4096 + c] * p.post_norm1[c]; vt[2048 + c] = p.pre_norm2[c] * (1.f + mb[8192 + c]); vt[4096 + c] = mb[6144 + c]; }
        LDS_WAIT(); __syncthreads();
        { P6In nxt; if (wsub < L) p6_fetch(p, bsel * L + wsub, lane, nxt);
          for (int r = wsub; r < L; r += nsub) { const P6In cur = nxt; if (r + nsub < L) p6_fetch(p, bsel * L + r + nsub, lane, nxt);
              p6_row(p, bsel * L + r, lane, wt, vt, cur, PROBE_FLAGS); } }
        __syncthreads();
    }
    SEAM(7);
    if (IN(8)) { LOADP(); TIDS(); for (int u = bx; u < 64; u += G) topk_unit(p, u >> 2, u & 3, (LAS unsigned*)lds, tid); }
    SEAM(8);
    if (IN(9)) { LOADP(); TIDS();
        constexpr int KU = FP8_MOE ? 1024 : 2048;
        typedef SchedGather<KU> SG; SG S{(const char*)(p.ws + WS_H2), (const char*)(p.ws + WS_WGU_T), G, bx, (const LAS unsigned*)(lds + TAB_OFF)};
        for (int q = tid; q < 2048; q += NTHREADS) { const int i = q >> 8, r = q & 255; Unit u;
            if (S.next(i, u)) { const int e = u.pm >> 3, m = (u.pm & 7) * 256 + r, b = m >> 9; const int tok = ((const int*)(p.ws + WS_IDX))[(size_t)(e * 4 + b) * CAP + (m & 511)];
                ((LAS unsigned*)(lds + TAB_OFF))[q] = (unsigned)(b * L + tok) * (unsigned)(KU * 2); } }
        LDS_WAIT(); __syncthreads();
        if constexpr (FP8_MOE) { EpiAct8 E{p.ws}; pg8::gemm_phase<EpiAct8, SG, true>(lds, KU, S, E); }
        else { EpiAct E{p.ws}; pg8::gemm_phase<EpiAct, SG, false>(lds, KU, S, E); }
    }
    SEAM(9);
    if (IN(10)) { LOADP(); TIDS();
        constexpr int KU = FP8_MOE ? 1024 : 2048;
        typedef SchedDense<128, 8, 3, KU> SD; SD S{(const char*)(p.ws + WS_ACT), (const char*)(p.ws + WS_WD_T), G, bx};
        if constexpr (FP8_MOE) { EpiYE8 E{p.ws}; pg8::gemm_phase<EpiYE8, SD, true>(lds, KU, S, E); }
        else { EpiYE E{p.ws}; pg8::gemm_phase<EpiYE, SD, false>(lds, KU, S, E); }
    }
    SEAM(10);
    if (IN(11)) { LOADP(); TIDS(); float* dsto = args.pad ? (float*)(p.ws + WS_S) : p.out;
        const int bsel = vcu & 3, wsub = (vcu >> 2) * NWAVES + wave, nsub = ((G + 3 - bsel) >> 2) * NWAVES;
        LAS float* vt = (LAS float*)(lds + VEC_OFF);
        for (int c = tid; c < D; c += NTHREADS) vt[c] = ((const float*)(p.ws + WS_MOD))[bsel * 12288 + 10240 + c] * p.post_norm2[c];
        LDS_WAIT(); __syncthreads();
        P11In nxt; if (wsub < L) p11_fetch(p, bsel * L + wsub, lane, nxt);
        for (int r = wsub; r < L; r += nsub) { const P11In cur = nxt; if (r + nsub < L) p11_fetch(p, bsel * L + r + nsub, lane, nxt); p11_row(p, bsel * L + r, lane, dsto, vt, cur, PROBE_FLAGS); } }
#undef IN
#undef SEAM
#undef lo
#undef hi
}

#ifndef PHASE_MODE
#define PHASE_MODE "FFFFFFFFFFFF"
#endif
#ifndef DUP_FLAGS
#define DUP_FLAGS 0
#endif
#ifndef MERGE
#define MERGE 1
#endif
template <class P> static void launch_ngemm(const P& f, int Mr, int Nr, int Z, hipStream_t s) { hipLaunchKernelGGL((ngemm<P>), dim3(Nr / 64, Mr / 64, Z), dim3(256), 0, s, f); }
static void naive_phase(int ph, const Ptrs& p, hipStream_t stream) {
    switch (ph) {
    case 0: hipLaunchKernelGGL(n_mod, dim3(48, 5), dim3(256), 0, stream, p); break;
    case 1: break;
    case 2: hipLaunchKernelGGL(n_hrows, dim3(MALL / 4), dim3(256), 0, stream, p); break;
    case 3: launch_ngemm(GIn{p, D}, MALL, 3136, 1, stream);
        hipLaunchKernelGGL(n_ssq, dim3(M / 4), dim3(256), 0, stream, (const bf16*)(p.ws + WS_CQKV), M, 512, (float*)(p.ws + WS_SSQQ), 8);
        hipLaunchKernelGGL(n_ssq, dim3(MALL / 4), dim3(256), 0, stream, (const bf16*)(p.ws + WS_CQKV) + (size_t)M * 512, MALL, 512, (float*)(p.ws + WS_SSQKV), 8); break;
    case 4: launch_ngemm(GQ{p, 512}, M, 1536, 1, stream); launch_ngemm(GKV{p, 512}, MALL, 2048, 1, stream);
        hipLaunchKernelGGL(n_vn, dim3(M * 8 / 4), dim3(256), 0, stream, p); launch_ngemm(GSgu{p, 128}, 128, 128, 1024, stream); break;
    case 5: for (int bh = 0; bh < B * H; ++bh) { launch_ngemm(GScore{p, DQK, bh}, L, LK, 1, stream);
            hipLaunchKernelGGL(n_softmax, dim3(L), dim3(256), 0, stream, (float*)(p.ws + WS_S), LK); launch_ngemm(GPV{p, LK, bh}, L, VH, 1, stream); } break;
    case 6: launch_ngemm(GOut{p, D}, M, D, 1, stream);
        hipLaunchKernelGGL(n_ssq, dim3(M / 4), dim3(256), 0, stream, (const bf16*)(p.ws + WS_Y), M, D, (float*)(p.ws + WS_SSQY), 32); break;
    case 7: hipLaunchKernelGGL(n_rowmid, dim3(M / 4), dim3(256), 0, stream, p); break;
    case 8: hipLaunchKernelGGL(n_topk, dim3(64), dim3(1024), 0, stream, p); break;
    case 9: launch_ngemm(GE1{p, D}, 2048, 4096, 16, stream); break;
    case 10: launch_ngemm(GE2{p, FF}, 2048, 2048, 16, stream); break;
    case 11: hipLaunchKernelGGL(n_rowfinal, dim3(M / 4), dim3(256), 0, stream, p); break;
    }
}
extern "C" void kernel_launch(void* const* d_in, const int* in_sizes, int n_in, void* d_out, int out_size, void* d_ws, size_t ws_size, hipStream_t stream) {
    static int grid = 0;
    if (grid == 0) {
        if (n_in != 24 || ws_size < WS_END || out_size != M * D) { fprintf(stderr, "kernel_launch: unexpected shapes n_in %d ws %zu out %d\n", n_in, ws_size, out_size); grid = -1; return; }
        int dev = 0, cus = 0, per_cu = 0;
        if (hipGetDevice(&dev) != hipSuccess || hipDeviceGetAttribute(&cus, hipDeviceAttributeMultiprocessorCount, dev) != hipSuccess) { grid = -1; return; }
        if (hipFuncSetAttribute((const void*)fwd, hipFuncAttributeMaxDynamicSharedMemorySize, LDS_BYTES) != hipSuccess) { fprintf(stderr, "kernel_launch: hipFuncSetAttribute failed\n"); grid = -1; return; }
        if (hipOccupancyMaxActiveBlocksPerMultiprocessor(&per_cu, (const void*)fwd, NTHREADS, LDS_BYTES) != hipSuccess || per_cu < 1) fprintf(stderr, "kernel_launch: occupancy query says %d\n", per_cu);
        (void)hipGetLastError();
        grid = cus;
    }
    if (grid < 0) return;
    Ptrs p{};
    const float** f = (const float**)&p;
    for (int i = 0; i < 24; ++i) f[i] = (const float*)d_in[i];
    p.out = (float*)d_out; p.ws = (unsigned char*)d_ws;
    (void)hipMemsetAsync(p.ws + WS_CTL, 0, 1 * MiB, stream);
    const char* mode = PHASE_MODE; int nbar = 0;
    for (int ph = 0; ph < 12;) {
#ifdef DUP_PHASE
        if (ph == 11 && DUP_PHASE == 11) { Args a2{}; a2.p = p; a2.ph_lo = 11; a2.ph_hi = 12; a2.bar_idx = nbar++; a2.pad = 1 | DUP_FLAGS; hipLaunchKernelGGL(fwd, dim3(grid), dim3(NTHREADS), LDS_BYTES, stream, a2); }
#endif
        if (mode[ph] == 'F') { int e = ph + 1; if (MERGE) while (e < 12 && mode[e] == 'F') ++e;
            Args a{}; a.p = p; a.ph_lo = ph; a.ph_hi = e; a.bar_idx = nbar++; a.pad = 0;
            hipLaunchKernelGGL(fwd, dim3(grid), dim3(NTHREADS), LDS_BYTES, stream, a);
            const hipError_t le = hipPeekAtLastError(); if (le != hipSuccess) fprintf(stderr, "kernel_launch: launch failed: %s\n", hipGetErrorName(le));
#ifdef DUP_PHASE
            if (ph == DUP_PHASE && ph != 11) { Args a2 = a; a2.bar_idx = nbar++; a2.pad = DUP_FLAGS; hipLaunchKernelGGL(fwd, dim3(grid), dim3(NTHREADS), LDS_BYTES, stream, a2);
                if (ph == 11) hipLaunchKernelGGL(fwd, dim3(grid), dim3(NTHREADS), LDS_BYTES, stream, a2); }
#endif
            ph = e; }
        else { naive_phase(ph, p, stream); ++ph; }
    }
}
```

```cpp
#define PHASE_MODE "FFFFFFFFFFFF"
#define MERGE 1
#include <hip/hip_runtime.h>
#include <cstdio>
#include <cstdint>

typedef unsigned short bf16;
#ifndef FP8_MOE
#define FP8_MOE 1
#endif
namespace cfg {
constexpr int B = 4, L = 4096, D = 2048, CTX = 256, H = 8, LK = L + CTX;
constexpr int M = B * L;
constexpr int MC = B * CTX;
constexpr int MALL = M + MC;
constexpr int QL = 512, KVL = 512, NOPE = 128, ROPE = 64, VH = 128, DQK = 192;
constexpr int SGW = 1024, INC = 3136, OFF_KPE = 1024, OFF_U = 1088, OFF_V = 2112;
constexpr int NE = 16, CAP = 512, FF = 2048;
constexpr float EPS = 1e-6f;
constexpr float ATT_SCALE = 0.07216878364870322f;
constexpr size_t MiB = 1u << 20;
constexpr size_t WS_CTL = 0;
constexpr size_t WS_MOD = 1 * MiB;
constexpr size_t WS_SSQQ = 2 * MiB;
constexpr size_t WS_SSQKV = 3 * MiB;
constexpr size_t WS_SSQY = 4 * MiB;
constexpr size_t WS_AFF = 6 * MiB;
constexpr size_t WS_INV = 7 * MiB;
constexpr size_t WS_IDX = 8 * MiB;
constexpr size_t WS_WIN_T = 16 * MiB;
constexpr size_t WS_WQKV_T = 30 * MiB;
constexpr size_t WS_WOUT_T = 34 * MiB;
constexpr size_t WS_SGUW = 42 * MiB;
constexpr size_t WS_WGU_T = 64 * MiB;
constexpr size_t WS_WD_T = 320 * MiB;
constexpr size_t WS_H = 448 * MiB;
constexpr size_t WS_CQKV = 516 * MiB;
constexpr size_t WS_U = 549 * MiB;
constexpr size_t WS_VS = 581 * MiB;
constexpr size_t WS_Q = 613 * MiB;
constexpr size_t WS_K = 661 * MiB;
constexpr size_t WS_V = 712 * MiB;
constexpr size_t WS_CAT = 746 * MiB;
constexpr size_t WS_Y = 810 * MiB;
constexpr size_t WS_H2 = WS_CAT;
constexpr size_t WS_ACT = WS_H;
constexpr size_t WS_YE = WS_Q;
constexpr size_t WS_S = 874 * MiB;
constexpr size_t WS_VN = 942 * MiB;
constexpr size_t WS_ROPE = 9 * MiB;
constexpr size_t WS_PART = WS_S;
constexpr size_t WS_END = 974 * MiB;
}
using namespace cfg;

__device__ __forceinline__ float bf2f(bf16 v) { return __uint_as_float(((unsigned)v) << 16); }
__device__ __forceinline__ bf16 f2bf(float f) { unsigned u = __float_as_uint(f); return (bf16)((u + 0x7fffu + ((u >> 16) & 1u)) >> 16); }
__device__ __forceinline__ float silu_f(float x) { return x / (1.f + __expf(-x)); }
__device__ __forceinline__ float gelu_tanh(float x) { const float z = 0.7978845608028654f * (x + 0.044715f * x * x * x); return 0.5f * x * (1.f + tanhf(z)); }
__device__ __forceinline__ float wave_sum(float v) {
#pragma unroll
    for (int o = 1; o < 64; o <<= 1) v += __shfl_xor(v, o);
    return v;
}
__device__ __forceinline__ float rope_inv(int ii) { return __expf(-(float)ii * (9.210340371976184f / 16.f)); }

struct Ptrs {
    const float *x, *c, *ctx, *c_ctx, *w_ada, *b_ada, *pre_norm1, *w_in, *q_norm_w, *w_uq, *kv_norm_w, *w_ukv, *sgu_norm_w, *sgu_w, *sgu_b, *w_out,
        *post_norm1, *pre_norm2, *w_router, *b_router, *w_e_gate, *w_e_up, *w_e_down, *post_norm2;
    float* out; unsigned char* ws;
};

__global__ void n_mod(Ptrs p) {
    const int j = blockIdx.x * 256 + threadIdx.x, r = blockIdx.y;
    const float* cv = r < 4 ? p.c + r * D : p.c_ctx;
    float s = 0.f;
    for (int k = 0; k < D; ++k) s += silu_f(cv[k]) * p.w_ada[(size_t)k * 12288 + j];
    ((float*)(p.ws + WS_MOD))[r * 12288 + j] = s + p.b_ada[j];
}
__global__ __launch_bounds__(256) void n_hrows(Ptrs p) {
    const int row = blockIdx.x * 4 + (threadIdx.x >> 6), lane = threadIdx.x & 63;
    if (row >= MALL) return;
    const float* src = row < M ? p.x + (size_t)row * D : p.ctx + (size_t)(row - M) * D;
    const int mr = row < M ? row >> 12 : 4;
    const float* mod = (const float*)(p.ws + WS_MOD) + mr * 12288;
    float v[32]; float s = 0.f;
    for (int j = 0; j < 32; ++j) { v[j] = src[j * 64 + lane]; s += v[j] * v[j]; }
    const float rs = rsqrtf(wave_sum(s) * (1.f / D) + EPS);
    bf16* o = (bf16*)(p.ws + WS_H) + (size_t)row * D;
    for (int j = 0; j < 32; ++j) { const int c = j * 64 + lane; o[c] = f2bf(v[j] * rs * p.pre_norm1[c] * (1.f + mod[2048 + c]) + mod[c]); }
}
template <class P> __global__ __launch_bounds__(256) void ngemm(P p) {
    __shared__ float As[16][65], Bs[16][65];
    const int tx = threadIdx.x & 15, ty = threadIdx.x >> 4, z = blockIdx.z;
    const int m0 = blockIdx.y * 64, n0 = blockIdx.x * 64;
    float acc[4][4] = {};
    for (int k0 = 0; k0 < p.K; k0 += 16) {
        for (int j = 0; j < 4; ++j) { const int idx = threadIdx.x + 256 * j; const int kk = idx & 15, mm = idx >> 4; As[kk][mm] = p.a(z, m0 + mm, k0 + kk); }
        for (int j = 0; j < 4; ++j) { const int idx = threadIdx.x + 256 * j; const int nn = idx & 63, kk = idx >> 6; Bs[kk][nn] = p.b(z, k0 + kk, n0 + nn); }
        __syncthreads();
#pragma unroll
        for (int kk = 0; kk < 16; ++kk) {
            float a[4], b[4];
#pragma unroll
            for (int i = 0; i < 4; ++i) { a[i] = As[kk][ty * 4 + i]; b[i] = Bs[kk][tx * 4 + i]; }
#pragma unroll
            for (int i = 0; i < 4; ++i)
#pragma unroll
                for (int j = 0; j < 4; ++j) acc[i][j] += a[i] * b[j];
        }
        __syncthreads();
    }
    for (int i = 0; i < 4; ++i) p.epi(z, m0 + ty * 4 + i, n0 + tx * 4, acc[i]);
}
__device__ __forceinline__ void rope_pair(float& x1, float& x2, int i, int pos) {
    const int ii = i & 15; const float ax = (float)((i >> 4) ? (pos & 63) : (pos >> 6));
    float s, c; sincosf(ax * rope_inv(ii), &s, &c);
    const float r1 = x1 * c - x2 * s, r2 = x2 * c + x1 * s; x1 = r1; x2 = r2;
}
struct GIn {
    Ptrs p; int K;
    __device__ float a(int, int m, int k) const { return bf2f(((const bf16*)(p.ws + WS_H))[(size_t)m * D + k]); }
    __device__ float b(int, int k, int n) const {
        int o; if (n < 1024) o = n; else if (n < 3072) o = n + 64; else { const int j = n - 3072, i = j >> 1, s = j & 1; o = OFF_KPE + (i >> 4) * 32 + s * 16 + (i & 15); }
        return p.w_in[(size_t)k * INC + o];
    }
    __device__ void epi(int, int m, int n0, const float* v) const {
        bf16* CQ = (bf16*)(p.ws + WS_CQKV); bf16* CKV = CQ + (size_t)M * 512;
        if (n0 < 512) { if (m < M) for (int j = 0; j < 4; ++j) CQ[(size_t)m * 512 + n0 + j] = f2bf(v[j]); }
        else if (n0 < 1024) { for (int j = 0; j < 4; ++j) CKV[(size_t)m * 512 + n0 - 512 + j] = f2bf(v[j]); }
        else if (n0 < 2048) { if (m < M) for (int j = 0; j < 4; ++j) ((bf16*)(p.ws + WS_U))[(size_t)m * 1024 + n0 - 1024 + j] = f2bf(gelu_tanh(v[j])); }
        else if (n0 < 3072) { if (m < M) for (int j = 0; j < 4; ++j) ((bf16*)(p.ws + WS_VS))[(size_t)m * 1024 + n0 - 2048 + j] = f2bf(gelu_tanh(v[j])); }
        else {
            const int jj = n0 - 3072; bf16* Kb = (bf16*)(p.ws + WS_K);
            for (int q = 0; q < 2; ++q) {
                const int i = (jj >> 1) + q; float x1 = v[2 * q], x2 = v[2 * q + 1]; int b, kpos;
                if (m < M) { b = m >> 12; kpos = m & 4095; rope_pair(x1, x2, i, kpos); } else { b = (m - M) >> 8; kpos = L + ((m - M) & 255); }
                for (int hh = 0; hh < H; ++hh) { bf16* d = Kb + ((size_t)(b * H + hh) * LK + kpos) * DQK + 128 + 2 * i; d[0] = f2bf(x1); d[1] = f2bf(x2); }
            }
        }
    }
};
__global__ void n_ssq(const bf16* T, int rows, int cols, float* out, int nslots) {
    const int row = blockIdx.x * 4 + (threadIdx.x >> 6), lane = threadIdx.x & 63;
    if (row >= rows) return;
    float s = 0.f; for (int c = lane; c < cols; c += 64) { const float v = bf2f(T[(size_t)row * cols + c]); s += v * v; }
    s = wave_sum(s);
    if (lane < nslots) out[(size_t)row * nslots + lane] = lane == 0 ? s : 0.f;
}
__device__ __forceinline__ float sum_slots(const float* s, int n) { float t = 0.f; for (int i = 0; i < n; ++i) t += s[i]; return t; }
struct GQ {
    Ptrs p; int K;
    __device__ float a(int, int m, int k) const { return bf2f(((const bf16*)(p.ws + WS_CQKV))[(size_t)m * 512 + k]); }
    __device__ float b(int, int k, int n) const {
        int o; if (n < 1024) o = (n >> 7) * DQK + (n & 127); else { const int jj = n - 1024, hd = jj >> 6, j6 = jj & 63, i = j6 >> 1, s = j6 & 1; o = hd * DQK + 128 + (i >> 4) * 32 + s * 16 + (i & 15); }
        return p.w_uq[(size_t)k * 1536 + o] * p.q_norm_w[k];
    }
    __device__ void epi(int, int m, int n0, const float* v) const {
        const float rs = rsqrtf(sum_slots((const float*)(p.ws + WS_SSQQ) + (size_t)m * 8, 8) * (1.f / 512.f) + EPS);
        const int b = m >> 12, t = m & 4095; bf16* Qb = (bf16*)(p.ws + WS_Q);
        if (n0 < 1024) { const int hd = n0 >> 7, d = n0 & 127; for (int j = 0; j < 4; ++j) Qb[((size_t)(b * H + hd) * L + t) * DQK + d + j] = f2bf(v[j] * rs); }
        else { const int jj = n0 - 1024, hd = jj >> 6, j6 = jj & 63;
            for (int q = 0; q < 2; ++q) { const int i = (j6 >> 1) + q; float x1 = v[2 * q] * rs, x2 = v[2 * q + 1] * rs; rope_pair(x1, x2, i, t);
                bf16* d = Qb + ((size_t)(b * H + hd) * L + t) * DQK + 128 + 2 * i; d[0] = f2bf(x1); d[1] = f2bf(x2); } }
    }
};
struct GKV {
    Ptrs p; int K;
    __device__ float a(int, int m, int k) const { return bf2f(((const bf16*)(p.ws + WS_CQKV))[(size_t)(M + m) * 512 + k]); }
    __device__ float b(int, int k, int n) const { return p.w_ukv[(size_t)k * 2048 + n] * p.kv_norm_w[k]; }
    __device__ void epi(int, int m, int n0, const float* v) const {
        const float rs = rsqrtf(sum_slots((const float*)(p.ws + WS_SSQKV) + (size_t)m * 8, 8) * (1.f / 512.f) + EPS);
        int b, kpos; if (m < M) { b = m >> 12; kpos = m & 4095; } else { b = (m - M) >> 8; kpos = L + ((m - M) & 255); }
        const int hd = n0 >> 8, c = n0 & 255;
        if (c < 128) { bf16* d = (bf16*)(p.ws + WS_K) + ((size_t)(b * H + hd) * LK + kpos) * DQK + c; for (int j = 0; j < 4; ++j) d[j] = f2bf(v[j] * rs); }
        else { bf16* d = (bf16*)(p.ws + WS_V) + ((size_t)(b * H + hd) * LK + kpos) * VH + c - 128; for (int j = 0; j < 4; ++j) d[j] = f2bf(v[j] * rs); }
    }
};
__global__ void n_vn(Ptrs p) {
    const int w = blockIdx.x * 4 + (threadIdx.x >> 6), lane = threadIdx.x & 63;
    const int tok = w >> 3, g = w & 7;
    const bf16* s = (const bf16*)(p.ws + WS_VS) + (size_t)tok * 1024 + g * 128;
    const float a = bf2f(s[lane]), b = bf2f(s[lane + 64]);
    const float mu = wave_sum(a + b) * (1.f / 128.f);
    const float da = a - mu, db = b - mu;
    const float rs = rsqrtf(wave_sum(da * da + db * db) * (1.f / 128.f) + EPS);
    bf16* o = (bf16*)(p.ws + WS_VN) + (size_t)tok * 1024 + g * 128;
    o[lane] = f2bf(da * rs * p.sgu_norm_w[g * 128 + lane]); o[lane + 64] = f2bf(db * rs * p.sgu_norm_w[g * 128 + lane + 64]);
}
struct GSgu {
    Ptrs p; int K;
    __device__ float a(int z, int m, int k) const { return p.sgu_w[((size_t)(z & 7) * 128 + m) * 128 + k]; }
    __device__ float b(int z, int k, int n) const { return bf2f(((const bf16*)(p.ws + WS_VN))[(size_t)((z >> 3) * 128 + k) * 1024 + (z & 7) * 128 + n]); }
    __device__ void epi(int z, int m, int n0, const float* v) const {
        const int g = z & 7; const size_t row = (size_t)(z >> 3) * 128 + m; const float bias = p.sgu_b[g * 128 + m];
        for (int j = 0; j < 4; ++j) { const float u = bf2f(((const bf16*)(p.ws + WS_U))[row * 1024 + g * 128 + n0 + j]);
            ((bf16*)(p.ws + WS_CAT))[row * D + 1024 + g * 128 + n0 + j] = f2bf(u * (v[j] + bias)); }
    }
};
struct GScore {
    Ptrs p; int K; int bh;
    __device__ float a(int, int m, int k) const { return bf2f(((const bf16*)(p.ws + WS_Q))[((size_t)bh * L + m) * DQK + k]); }
    __device__ float b(int, int k, int n) const { return bf2f(((const bf16*)(p.ws + WS_K))[((size_t)bh * LK + n) * DQK + k]); }
    __device__ void epi(int, int m, int n0, const float* v) const { float* S = (float*)(p.ws + WS_S) + (size_t)m * LK + n0; for (int j = 0; j < 4; ++j) S[j] = v[j] * ATT_SCALE; }
};
__global__ void n_softmax(float* S, int cols) {
    float* r = S + (size_t)blockIdx.x * cols; __shared__ float red[4];
    float mx = -1e30f; for (int c = threadIdx.x; c < cols; c += 256) mx = fmaxf(mx, r[c]);
    for (int o = 1; o < 64; o <<= 1) mx = fmaxf(mx, __shfl_xor(mx, o));
    if ((threadIdx.x & 63) == 0) red[threadIdx.x >> 6] = mx; __syncthreads();
    mx = fmaxf(fmaxf(red[0], red[1]), fmaxf(red[2], red[3])); __syncthreads();
    float s = 0.f; for (int c = threadIdx.x; c < cols; c += 256) { const float e = __expf(r[c] - mx); r[c] = e; s += e; }
    s = wave_sum(s); if ((threadIdx.x & 63) == 0) red[threadIdx.x >> 6] = s; __syncthreads();
    s = (red[0] + red[1]) + (red[2] + red[3]); const float inv = 1.f / s;
    for (int c = threadIdx.x; c < cols; c += 256) r[c] *= inv;
}
struct GPV {
    Ptrs p; int K; int bh;
    __device__ float a(int, int m, int k) const { return ((const float*)(p.ws + WS_S))[(size_t)m * LK + k]; }
    __device__ float b(int, int k, int n) const { return bf2f(((const bf16*)(p.ws + WS_V))[((size_t)bh * LK + k) * VH + n]); }
    __device__ void epi(int, int m, int n0, const float* v) const { bf16* d = (bf16*)(p.ws + WS_CAT) + ((size_t)(bh >> 3) * L + m) * D + (bh & 7) * 128 + n0; for (int j = 0; j < 4; ++j) d[j] = f2bf(v[j]); }
};
struct GOut {
    Ptrs p; int K;
    __device__ float a(int, int m, int k) const { return bf2f(((const bf16*)(p.ws + WS_CAT))[(size_t)m * D + k]); }
    __device__ float b(int, int k, int n) const { return p.w_out[(size_t)k * D + n]; }
    __device__ void epi(int, int m, int n0, const float* v) const { bf16* d = (bf16*)(p.ws + WS_Y) + (size_t)m * D + n0; for (int j = 0; j < 4; ++j) d[j] = f2bf(v[j]); }
};
__device__ __forceinline__ void row_pass_mid(const Ptrs& p, int row, int lane) {
    const int b = row >> 12; const float* mod = (const float*)(p.ws + WS_MOD) + b * 12288;
    const float ssq = wave_sum(lane < 32 ? ((const float*)(p.ws + WS_SSQY))[(size_t)row * 32 + lane] : 0.f);
    const float rsy = rsqrtf(ssq * (1.f / D) + EPS);
    const bf16* y = (const bf16*)(p.ws + WS_Y) + (size_t)row * D; const float* xr = p.x + (size_t)row * D; float* o = p.out + (size_t)row * D;
    float v[32]; float s = 0.f;
    for (int j = 0; j < 32; ++j) { const int c = j * 64 + lane; v[j] = xr[c] + mod[4096 + c] * (bf2f(y[c]) * rsy * p.post_norm1[c]); o[c] = v[j]; s += v[j] * v[j]; }
    const float rs = rsqrtf(wave_sum(s) * (1.f / D) + EPS);
    bf16* h2 = (bf16*)(p.ws + WS_H2) + (size_t)row * D; float lg[16];
    for (int e = 0; e < 16; ++e) lg[e] = 0.f;
    for (int j = 0; j < 32; ++j) { const int c = j * 64 + lane; const float h = v[j] * rs * p.pre_norm2[c] * (1.f + mod[8192 + c]) + mod[6144 + c]; h2[c] = f2bf(h);
        const float* wr = p.w_router + (size_t)c * 16; for (int e = 0; e < 16; ++e) lg[e] += h * wr[e]; }
    float mx = -1e30f;
    for (int e = 0; e < 16; ++e) { lg[e] = wave_sum(lg[e]) + p.b_router[e]; mx = fmaxf(mx, lg[e]); }
    float se = 0.f; for (int e = 0; e < 16; ++e) { lg[e] = __expf(lg[e] - mx); se += lg[e]; }
    const float inv = 1.f / se;
    if (lane < 16) { float val = 0.f; for (int e = 0; e < 16; ++e) val = (lane == e) ? lg[e] * inv : val; ((float*)(p.ws + WS_AFF))[(size_t)row * 16 + lane] = val; }
}
__global__ __launch_bounds__(256) void n_rowmid(Ptrs p) { const int row = blockIdx.x * 4 + (threadIdx.x >> 6); row_pass_mid(p, row, threadIdx.x & 63); }
__global__ void n_topk(Ptrs p) {
    __shared__ float vals[L];
    const int e = blockIdx.x >> 2, b = blockIdx.x & 3;
    const float* aff = (const float*)(p.ws + WS_AFF) + (size_t)b * L * 16 + e;
    for (int t = threadIdx.x; t < L; t += blockDim.x) vals[t] = aff[(size_t)t * 16];
    __syncthreads();
    for (int t = threadIdx.x; t < L; t += blockDim.x) {
        const float v = vals[t]; int rank = 0;
        for (int u = 0; u < L; ++u) { const float w = vals[u]; rank += (w > v || (w == v && u < t)) ? 1 : 0; }
        ((int*)(p.ws + WS_INV))[(size_t)(b * L + t) * 16 + e] = rank < CAP ? rank : -1;
        if (rank < CAP) ((int*)(p.ws + WS_IDX))[(size_t)(e * 4 + b) * CAP + rank] = t;
    }
}
struct GE1 {
    Ptrs p; int K;
    __device__ float a(int z, int m, int k) const { const int b = m >> 9; const int tok = ((const int*)(p.ws + WS_IDX))[(size_t)(z * 4 + b) * CAP + (m & 511)];
        return bf2f(((const bf16*)(p.ws + WS_H2))[((size_t)b * L + tok) * D + k]); }
    __device__ float b(int z, int k, int n) const { const float* w = (n & 1) ? p.w_e_up : p.w_e_gate; return w[((size_t)z * D + k) * FF + (n >> 1)]; }
    __device__ void epi(int z, int m, int n0, const float* v) const { bf16* d = (bf16*)(p.ws + WS_ACT) + ((size_t)z * 2048 + m) * FF + (n0 >> 1);
        d[0] = f2bf(silu_f(v[0]) * v[1]); d[1] = f2bf(silu_f(v[2]) * v[3]); }
};
struct GE2 {
    Ptrs p; int K;
    __device__ float a(int z, int m, int k) const { return bf2f(((const bf16*)(p.ws + WS_ACT))[((size_t)z * 2048 + m) * FF + k]); }
    __device__ float b(int z, int k, int n) const { return p.w_e_down[((size_t)z * FF + k) * D + n]; }
    __device__ void epi(int z, int m, int n0, const float* v) const { bf16* d = (bf16*)(p.ws + WS_YE) + ((size_t)z * 2048 + m) * D + n0; for (int j = 0; j < 4; ++j) d[j] = f2bf(v[j]); }
};
__device__ __forceinline__ void row_pass_final(const Ptrs& p, int row, int lane) {
    const int b = row >> 12; const float* mod = (const float*)(p.ws + WS_MOD) + b * 12288;
    const int* inv = (const int*)(p.ws + WS_INV) + (size_t)row * 16; const float* aff = (const float*)(p.ws + WS_AFF) + (size_t)row * 16;
    float v[32]; for (int j = 0; j < 32; ++j) v[j] = 0.f;
    for (int e = 0; e < 16; ++e) { const int sl = inv[e]; if (sl >= 0) { const float g = aff[e]; const bf16* ye = (const bf16*)(p.ws + WS_YE) + ((size_t)(e * 4 + b) * CAP + sl) * D;
            for (int j = 0; j < 32; ++j) v[j] += g * bf2f(ye[j * 64 + lane]); } }
    float s = 0.f; for (int j = 0; j < 32; ++j) s += v[j] * v[j];
    const float rs = rsqrtf(wave_sum(s) * (1.f / D) + EPS);
    float* o = p.out + (size_t)row * D;
    for (int j = 0; j < 32; ++j) { const int c = j * 64 + lane; o[c] = o[c] + mod[10240 + c] * (v[j] * rs * p.post_norm2[c]); }
}
__global__ __launch_bounds__(256) void n_rowfinal(Ptrs p) { const int row = blockIdx.x * 4 + (threadIdx.x >> 6); row_pass_final(p, row, threadIdx.x & 63); }


namespace pg8 {
#define PG8_LAS __attribute__((address_space(3)))
typedef short bf16x8 __attribute__((ext_vector_type(8)));
typedef float f32x4 __attribute__((ext_vector_type(4)));
typedef float f32x2 __attribute__((ext_vector_type(2)));
typedef unsigned u32x4 __attribute__((ext_vector_type(4)));
constexpr int BM = 256, BK = 64, HALF = 128, HTB = HALF * BK * 2, STAGE_BYTES = 8 * HTB, NXCD = 8, WGM = 8;

__host__ __device__ __forceinline__ int lds_byte(int r, int c) { const int st = (r >> 4) * 2 + (c >> 5), rr = r & 15, cc = c & 31, ob = rr * 64 + cc * 2; return st * 1024 + (ob ^ (((ob >> 9) & 1) << 5)); }
__host__ __device__ __forceinline__ void stage_rc(int b, int& R, int& C) { const int st = b / 1024, sb = b % 1024, swz = sb ^ (((sb >> 9) & 1) << 5); R = (st >> 1) * 16 + swz / 64; C = (st & 1) * 32 + (swz % 64) / 2; }
__host__ __device__ __forceinline__ int perm32(int rho) { const int n = rho >> 4, i = rho & 15; return 8 * (i >> 2) + 4 * n + (i & 3); }

struct Unit { int pm, pn, ui; };
__device__ __forceinline__ void rect_unit(int L, int nM, int nN, Unit& u) {
    const int nwg = nM * nN; int wgid = L;
    { const int q = nwg / NXCD, r = nwg % NXCD, xcd = wgid % NXCD, off = wgid / NXCD; wgid = (xcd < r ? xcd * (q + 1) : r * (q + 1) + (xcd - r) * q) + off; }
    const int nig = WGM * nN, gid = wgid / nig, fm = gid * WGM, gsz = (nM - fm) < WGM ? (nM - fm) : WGM;
    u.pm = fm + ((wgid % nig) % gsz); u.pn = (wgid % nig) / gsz;
}
__device__ __forceinline__ void dense_voff(int K, int tid, unsigned (&v)[2][2]) {
#pragma unroll
    for (int i = 0; i < 2; ++i) { int R, C; stage_rc(tid * 16 + i * 8192, R, C); v[0][i] = (unsigned)(R * K + C) * 2u; v[1][i] = (unsigned)((R + HALF) * K + C) * 2u; }
}

__device__ __forceinline__ unsigned cvt_pk_bf16(float lo, float hi) { unsigned r; asm volatile("v_cvt_pk_bf16_f32 %0, %1, %2" : "=v"(r) : "v"(lo), "v"(hi)); return r; }
__device__ __forceinline__ u32x4 pack8(const f32x4& a, const f32x4& b) { u32x4 w; w.x = cvt_pk_bf16(a[0], a[1]); w.y = cvt_pk_bf16(a[2], a[3]); w.z = cvt_pk_bf16(b[0], b[1]); w.w = cvt_pk_bf16(b[2], b[3]); return w; }

typedef int i32x4 __attribute__((ext_vector_type(4)));
typedef int i32x8 __attribute__((ext_vector_type(8)));
template <class Epi, class Sched, bool FP8 = false>
__device__ __forceinline__ void gemm_phase(PG8_LAS unsigned char* lds, const int K, const Sched& S, const Epi& E) {
    const int tid = threadIdx.x, wid = __builtin_amdgcn_readfirstlane(tid >> 6), lane = tid & 63, wr = wid >> 2, wc = wid & 3, fr = lane & 15, fq = lane >> 4;
    const int nt = K / BK;
    unsigned voffB[2];
#pragma unroll
    for (int i = 0; i < 2; ++i) { int R, C; stage_rc(tid * 16 + i * 8192, R, C); const int Rb = Epi::PERM ? ((R & ~31) + perm32(R & 31)) : R; voffB[i] = (unsigned)(Rb * K + C) * 2u; }
    const size_t kstep = (size_t)(BK * 2);
    const size_t hstep = (size_t)HALF * K * 2;
    const unsigned ldsw = (unsigned)wid * 1024u;
    const int aoff = lds_byte(wr * 64 + fr, fq * 8), boff = lds_byte(wc * 32 + fr, fq * 8);
#define PG8_SA(b, h) (((b) * 2 + (h)) * HTB)
#define PG8_SB(b, h) ((4 + (b) * 2 + (h)) * HTB)
#define PG8_STAGE(bufoff, gbase, voff) do { _Pragma("unroll") for (int _i = 0; _i < 2; ++_i) \
        __builtin_amdgcn_global_load_lds((const unsigned*)((const char*)(gbase) + (voff)[_i]), (PG8_LAS unsigned*)(lds + (bufoff) + ldsw + _i * 8192), 16, 0, 0); } while (0)
#define PG8_LDA(dst, b, h) do { _Pragma("unroll") for (int m = 0; m < 4; ++m) _Pragma("unroll") for (int k = 0; k < 2; ++k) dst[m][k] = *(const PG8_LAS bf16x8*)(lds + PG8_SA(b, h) + aoff + m * 2048 + k * 1024); } while (0)
#define PG8_LDB(dst, b, h) do { _Pragma("unroll") for (int n = 0; n < 2; ++n) _Pragma("unroll") for (int k = 0; k < 2; ++k) dst[n][k] = *(const PG8_LAS bf16x8*)(lds + PG8_SB(b, h) + boff + n * 2048 + k * 1024); } while (0)
#define PG8_MMA(ai, bj, At, Bt) do { __builtin_amdgcn_s_setprio(1); _Pragma("unroll") for (int m = 0; m < 4; ++m) _Pragma("unroll") for (int n = 0; n < 2; ++n) { \
        if constexpr (FP8) { const i32x8 fb = __builtin_shufflevector((i32x4)Bt[n][0], (i32x4)Bt[n][1], 0, 1, 2, 3, 4, 5, 6, 7), fa = __builtin_shufflevector((i32x4)At[m][0], (i32x4)At[m][1], 0, 1, 2, 3, 4, 5, 6, 7); \
            acc[ai][bj][m][n] = __builtin_amdgcn_mfma_scale_f32_16x16x128_f8f6f4(fb, fa, acc[ai][bj][m][n], 0, 0, 0, 0x7f7f7f7f, 0, 0x7f7f7f7f); } \
        else { _Pragma("unroll") for (int k = 0; k < 2; ++k) acc[ai][bj][m][n] = __builtin_amdgcn_mfma_f32_16x16x32_bf16(Bt[n][k], At[m][k], acc[ai][bj][m][n], 0, 0, 0); } } \
        __builtin_amdgcn_s_setprio(0); } while (0)
#define PG8_WAIT_V(n) asm volatile("s_waitcnt vmcnt(" #n ")" ::: "memory")
#define PG8_WAIT_L(n) asm volatile("s_waitcnt lgkmcnt(" #n ")" ::: "memory")
#define PG8_BAR __builtin_amdgcn_s_barrier()
#define PG8_SCHED __builtin_amdgcn_sched_barrier(0)
    Unit cur, nxt; int ui = 0;
    if (!S.next(0, cur)) return;
    f32x4 acc[2][2][4][2];
#pragma unroll
    for (int a = 0; a < 2; ++a)
#pragma unroll
        for (int b = 0; b < 2; ++b)
#pragma unroll
            for (int m = 0; m < 4; ++m)
#pragma unroll
                for (int n = 0; n < 2; ++n) acc[a][b][m][n] = (f32x4){0.f, 0.f, 0.f, 0.f};
    bf16x8 At[4][2], B0[2][2], B1[2][2];
    unsigned vA[2][2], vN[2][2];
    S.a_voff(0, cur, tid, vA);
    const char* cA = S.a_base(cur); const char* cB = S.b_base(cur);
    PG8_STAGE(PG8_SB(0, 0), cB, voffB); PG8_STAGE(PG8_SB(0, 1), cB + hstep, voffB); PG8_STAGE(PG8_SA(0, 0), cA, vA[0]); PG8_STAGE(PG8_SA(0, 1), cA, vA[1]);
    if (wr == 1) PG8_BAR;
    PG8_WAIT_V(2); PG8_BAR;
    PG8_STAGE(PG8_SB(1, 0), cB + kstep, voffB); PG8_STAGE(PG8_SA(1, 0), cA + kstep, vA[0]); PG8_STAGE(PG8_SB(1, 1), cB + hstep + kstep, voffB);
    PG8_WAIT_V(6); PG8_BAR;
    for (;;) {
        const bool has_next = S.next(ui + 1, nxt);
        if (has_next) S.a_voff(ui + 1, nxt, tid, vN);
        const char* nA = has_next ? S.a_base(nxt) : cA; const char* nB = has_next ? S.b_base(nxt) : cB;
        for (int t = 0; t < nt; t += 2) {
            const bool last = (t == nt - 2);
            const char* a1 = cA + (size_t)(t + 1) * kstep;
            const char* a2 = last ? nA : cA + (size_t)(t + 2) * kstep; const char* b2 = last ? nB : cB + (size_t)(t + 2) * kstep;
            const char* a3 = a2 + kstep; const char* b3 = b2 + kstep;
            PG8_LDB(B0, 0, 0); PG8_LDB(B1, 0, 1); PG8_SCHED; PG8_LDA(At, 0, 0); PG8_STAGE(PG8_SA(1, 1), a1, vA[1]);
            if (last && has_next) {
#pragma unroll
                for (int h = 0; h < 2; ++h)
#pragma unroll
                    for (int i = 0; i < 2; ++i) vA[h][i] = vN[h][i];
            }
            PG8_WAIT_V(8); PG8_WAIT_L(0); PG8_BAR; PG8_MMA(0, 0, At, B0); PG8_MMA(0, 1, At, B1); PG8_BAR; PG8_SCHED;
            PG8_LDA(At, 0, 1); PG8_STAGE(PG8_SB(0, 0), b2, voffB); PG8_STAGE(PG8_SB(0, 1), b2 + hstep, voffB); PG8_STAGE(PG8_SA(0, 0), a2, vA[0]);
            PG8_WAIT_V(8); PG8_WAIT_L(0); PG8_BAR; PG8_MMA(1, 0, At, B0); PG8_MMA(1, 1, At, B1); PG8_BAR; PG8_SCHED;
            PG8_LDB(B0, 1, 0); PG8_LDB(B1, 1, 1); PG8_SCHED; PG8_LDA(At, 1, 0); PG8_STAGE(PG8_SA(0, 1), a2, vA[1]);
            PG8_WAIT_V(8); PG8_WAIT_L(0); PG8_BAR; PG8_MMA(0, 0, At, B0); PG8_MMA(0, 1, At, B1); PG8_BAR; PG8_SCHED;
            PG8_LDA(At, 1, 1); PG8_STAGE(PG8_SB(1, 0), b3, voffB); PG8_STAGE(PG8_SB(1, 1), b3 + hstep, voffB); PG8_STAGE(PG8_SA(1, 0), a3, vA[0]);
            PG8_WAIT_V(8); PG8_WAIT_L(0); PG8_BAR; PG8_MMA(1, 0, At, B0); PG8_MMA(1, 1, At, B1); PG8_BAR; PG8_SCHED;
        }
        if (wr == 0) PG8_BAR;
        E(acc, cur, wr, wc, fr, fq);
        if (!has_next) break;
#pragma unroll
        for (int a = 0; a < 2; ++a)
#pragma unroll
            for (int b = 0; b < 2; ++b)
#pragma unroll
                for (int m = 0; m < 4; ++m)
#pragma unroll
                    for (int n = 0; n < 2; ++n) acc[a][b][m][n] = (f32x4){0.f, 0.f, 0.f, 0.f};
        cur = nxt; cA = nA; cB = nB; ++ui;
        if (wr == 1) PG8_BAR;
    }
    PG8_WAIT_V(0);
    PG8_BAR;
#undef PG8_SA
#undef PG8_SB
#undef PG8_STAGE
#undef PG8_LDA
#undef PG8_LDB
#undef PG8_MMA
#undef PG8_WAIT_V
#undef PG8_WAIT_L
#undef PG8_BAR
#undef PG8_SCHED
}
}

#define LAS __attribute__((address_space(3)))
typedef pg8::f32x4 f32x4; typedef pg8::u32x4 u32x4; typedef pg8::Unit Unit;
constexpr size_t TSTEP2K = (size_t)256 * 2048 * 2, TSTEP512 = (size_t)256 * 512 * 2;

struct SchedIn {
    static constexpr bool GATHER = false; const char *A, *Bt; int G, c;
    __device__ __forceinline__ bool next(int i, Unit& u) const { const int Lx = i * G + c; if (Lx >= 844) return false;
        if (Lx < 832) pg8::rect_unit(Lx, 64, 13, u); else { const int r = Lx - 832; u.pm = 64 + (r & 3); const int q = r >> 2; u.pn = q == 2 ? 12 : 2 + q; } return true; }
    __device__ __forceinline__ const char* a_base(const Unit& u) const { return A + (size_t)u.pm * TSTEP2K; }
    __device__ __forceinline__ const char* b_base(const Unit& u) const { return Bt + (size_t)u.pn * TSTEP2K; }
    __device__ __forceinline__ void a_voff(int, const Unit&, int tid, unsigned (&v)[2][2]) const { pg8::dense_voff(2048, tid, v); }
};
struct SchedQKV {
    static constexpr bool GATHER = false; const char *A, *Bt; int G, c;
    __device__ __forceinline__ bool next(int i, Unit& u) const { const int Lx = i * G + c; if (Lx >= 928) return false;
        if (Lx < 384) pg8::rect_unit(Lx, 64, 6, u); else { pg8::rect_unit(Lx - 384, 68, 8, u); u.pm += 64; u.pn += 6; } u.ui = i; return true; }
    __device__ __forceinline__ const char* a_base(const Unit& u) const { return A + (size_t)u.pm * TSTEP512; }
    __device__ __forceinline__ const char* b_base(const Unit& u) const { return Bt + (size_t)u.pn * TSTEP512; }
    __device__ __forceinline__ void a_voff(int, const Unit&, int tid, unsigned (&v)[2][2]) const { pg8::dense_voff(512, tid, v); }
};
template <int nM, int nN, int BSHIFT, int KU> struct SchedDense {
    static constexpr bool GATHER = false; const char *A, *Bt; int G, c;
    __device__ __forceinline__ bool next(int i, Unit& u) const { const int Lx = i * G + c; if (Lx >= nM * nN) return false; pg8::rect_unit(Lx, nM, nN, u); return true; }
    __device__ __forceinline__ const char* a_base(const Unit& u) const { return A + (size_t)u.pm * (512 * KU); }
    __device__ __forceinline__ const char* b_base(const Unit& u) const { return Bt + (size_t)((u.pm >> BSHIFT) * nN + u.pn) * (512 * KU); }
    __device__ __forceinline__ void a_voff(int, const Unit&, int tid, unsigned (&v)[2][2]) const { pg8::dense_voff(KU, tid, v); }
};
template <int KU> struct SchedGather {
    static constexpr bool GATHER = true; const char *A, *Bt; int G, c; const LAS unsigned* tab;
    __device__ __forceinline__ bool next(int i, Unit& u) const { const int Lx = i * G + c; if (Lx >= 2048) return false; pg8::rect_unit(Lx, 128, 16, u); return true; }
    __device__ __forceinline__ const char* a_base(const Unit&) const { return A; }
    __device__ __forceinline__ const char* b_base(const Unit& u) const { return Bt + (size_t)((u.pm >> 3) * 16 + u.pn) * (512 * KU); }
    __device__ __forceinline__ void a_voff(int i, const Unit&, int tid, unsigned (&v)[2][2]) const {
#pragma unroll
        for (int p = 0; p < 2; ++p) { int R, C; pg8::stage_rc(tid * 16 + p * 8192, R, C); v[0][p] = tab[i * 256 + R] + (unsigned)C * 2u; v[1][p] = tab[i * 256 + 128 + R] + (unsigned)C * 2u; }
    }
};

__device__ __forceinline__ float gelu_fast(float x) {
    const float z2 = -2.302208198f * (x + 0.044715f * x * x * x);
    return x * __builtin_amdgcn_rcpf(1.f + __builtin_amdgcn_exp2f(z2));
}
__device__ __forceinline__ float silu_fast(float x) { return x * __builtin_amdgcn_rcpf(1.f + __builtin_amdgcn_exp2f(-1.4426950408889634f * x)); }
__device__ __forceinline__ float dot4(const f32x4& a) { return (a[0] * a[0] + a[1] * a[1]) + (a[2] * a[2] + a[3] * a[3]); }
__device__ __forceinline__ void rope8(f32x4& a, f32x4& b, const float* tabrow  , int fq) {
    const f32x4 t0 = *(const f32x4*)(tabrow + 8 * fq), t1 = *(const f32x4*)(tabrow + 8 * fq + 4);
    f32x4 ra, rb;
    ra[0] = a[0] * t0[0] - a[1] * t0[1]; ra[1] = a[1] * t0[0] + a[0] * t0[1]; ra[2] = a[2] * t0[2] - a[3] * t0[3]; ra[3] = a[3] * t0[2] + a[2] * t0[3];
    rb[0] = b[0] * t1[0] - b[1] * t1[1]; rb[1] = b[1] * t1[0] + b[0] * t1[1]; rb[2] = b[2] * t1[2] - b[3] * t1[3]; rb[3] = b[3] * t1[2] + b[2] * t1[3];
    a = ra; b = rb;
}
struct EpiIn {
    static constexpr bool PERM = true; unsigned char* ws;
    __device__ __forceinline__ void operator()(const f32x4 (&acc)[2][2][4][2], const Unit& u, int wr, int wc, int fr, int fq) const {
        const int pn = u.pn, row0 = u.pm * 256 + wr * 64 + fr, c8 = wc * 32 + 8 * fq;
        if (pn < 4) {
            bf16* base = (bf16*)(ws + WS_CQKV) + (pn >= 2 ? (size_t)M * 512 : 0) + (pn & 1) * 256 + c8;
            float* ssq = (float*)(ws + (pn >= 2 ? WS_SSQKV : WS_SSQQ)) + (pn & 1) * 4 + wc;
#pragma unroll
            for (int ai = 0; ai < 2; ++ai)
#pragma unroll
                for (int m = 0; m < 4; ++m) { const int row = row0 + ai * 128 + m * 16; float s = 0.f;
#pragma unroll
                    for (int bj = 0; bj < 2; ++bj) { s += dot4(acc[ai][bj][m][0]) + dot4(acc[ai][bj][m][1]); *(u32x4*)(base + (size_t)row * 512 + bj * 128) = pg8::pack8(acc[ai][bj][m][0], acc[ai][bj][m][1]); }
                    s += __shfl_xor(s, 16); s += __shfl_xor(s, 32);
                    if (fq == 0) ssq[(size_t)row * 8] = s; }
        } else if (pn < 12) {
            bf16* base = (bf16*)(ws + (pn < 8 ? WS_U : WS_VS)) + ((pn - 4) & 3) * 256 + c8;
#pragma unroll
            for (int ai = 0; ai < 2; ++ai)
#pragma unroll
                for (int m = 0; m < 4; ++m) { const int row = row0 + ai * 128 + m * 16;
#pragma unroll
                    for (int bj = 0; bj < 2; ++bj) { f32x4 a = acc[ai][bj][m][0], b = acc[ai][bj][m][1];
#pragma unroll
                        for (int j = 0; j < 4; ++j) { a[j] = gelu_fast(a[j]); b[j] = gelu_fast(b[j]); }
                        *(u32x4*)(base + (size_t)row * 1024 + bj * 128) = pg8::pack8(a, b); } }
        } else if (wc < 2) {
            const float* tab = (const float*)(ws + WS_ROPE);
#pragma unroll
            for (int ai = 0; ai < 2; ++ai)
#pragma unroll
                for (int m = 0; m < 4; ++m) { const int row = row0 + ai * 128 + m * 16; f32x4 a = acc[ai][0][m][0], b = acc[ai][0][m][1]; int bb, kpos;
                    if (row < M) { bb = row >> 12; kpos = row & 4095; const int ax = wc ? (kpos & 63) : (kpos >> 6); rope8(a, b, tab + ax * 32, fq); }
                    else { bb = (row - M) >> 8; kpos = L + ((row - M) & 255); }
                    const u32x4 w = pg8::pack8(a, b); bf16* d = (bf16*)(ws + WS_K) + ((size_t)(bb * H) * LK + kpos) * DQK + 128 + c8;
#pragma unroll
                    for (int hh = 0; hh < H; ++hh) *(u32x4*)(d + (size_t)hh * LK * DQK) = w; }
        }
    }
};
struct EpiQKV {
    static constexpr bool PERM = true; unsigned char* ws; const LAS float* rstab;
    __device__ __forceinline__ void operator()(const f32x4 (&acc)[2][2][4][2], const Unit& u, int wr, int wc, int fr, int fq) const {
        const int c8 = wc * 32 + 8 * fq;
        if (u.pn < 6) {
            const int pn = u.pn, row0 = u.pm * 256 + wr * 64 + fr; const float* tab = (const float*)(ws + WS_ROPE);
#pragma unroll
            for (int ai = 0; ai < 2; ++ai)
#pragma unroll
                for (int m = 0; m < 4; ++m) { const int row = row0 + ai * 128 + m * 16; const int bb = row >> 12, t = row & 4095;
                    const float rs = rstab[u.ui * 256 + ai * 128 + wr * 64 + m * 16 + fr];
#pragma unroll
                    for (int bj = 0; bj < 2; ++bj) { f32x4 a = acc[ai][bj][m][0] * rs, b = acc[ai][bj][m][1] * rs; bf16* d;
                        if (pn < 4) d = (bf16*)(ws + WS_Q) + ((size_t)(bb * H + pn * 2 + bj) * L + t) * DQK + c8;
                        else { const int hd = (pn - 4) * 4 + bj * 2 + (wc >> 1), ax = (wc & 1) ? (t & 63) : (t >> 6); rope8(a, b, tab + ax * 32, fq);
                            d = (bf16*)(ws + WS_Q) + ((size_t)(bb * H + hd) * L + t) * DQK + 128 + (wc & 1) * 32 + 8 * fq; }
                        *(u32x4*)d = pg8::pack8(a, b); }
                    asm volatile("" ::: "memory"); }
        } else {
            const int hd = u.pn - 6, row0 = (u.pm - 64) * 256 + wr * 64 + fr;
#pragma unroll
            for (int ai = 0; ai < 2; ++ai)
#pragma unroll
                for (int m = 0; m < 4; ++m) { const int row = row0 + ai * 128 + m * 16; int bb, kpos;
                    if (row < M) { bb = row >> 12; kpos = row & 4095; } else { bb = (row - M) >> 8; kpos = L + ((row - M) & 255); }
                    const float rs = rstab[u.ui * 256 + ai * 128 + wr * 64 + m * 16 + fr];
                    const size_t kr = (size_t)(bb * H + hd) * LK + kpos;
                    *(u32x4*)((bf16*)(ws + WS_K) + kr * DQK + c8) = pg8::pack8(acc[ai][0][m][0] * rs, acc[ai][0][m][1] * rs);
                    *(u32x4*)((bf16*)(ws + WS_V) + kr * VH + c8) = pg8::pack8(acc[ai][1][m][0] * rs, acc[ai][1][m][1] * rs);
                    asm volatile("" ::: "memory"); }
        }
    }
};
struct EpiY {
    static constexpr bool PERM = true; unsigned char* ws;
    __device__ __forceinline__ void operator()(const f32x4 (&acc)[2][2][4][2], const Unit& u, int wr, int wc, int fr, int fq) const {
        const int row0 = u.pm * 256 + wr * 64 + fr; bf16* base = (bf16*)(ws + WS_Y) + u.pn * 256 + wc * 32 + 8 * fq; float* ssq = (float*)(ws + WS_SSQY) + u.pn * 4 + wc;
#pragma unroll
        for (int ai = 0; ai < 2; ++ai)
#pragma unroll
            for (int m = 0; m < 4; ++m) { const int row = row0 + ai * 128 + m * 16; float s = 0.f;
#pragma unroll
                for (int bj = 0; bj < 2; ++bj) { s += dot4(acc[ai][bj][m][0]) + dot4(acc[ai][bj][m][1]); *(u32x4*)(base + (size_t)row * D + bj * 128) = pg8::pack8(acc[ai][bj][m][0], acc[ai][bj][m][1]); }
                s += __shfl_xor(s, 16); s += __shfl_xor(s, 32);
                if (fq == 0) ssq[(size_t)row * 32] = s; }
    }
};
__device__ __forceinline__ unsigned pack4_fp8(float a, float b, float c, float d) { int w = 0; w = __builtin_amdgcn_cvt_pk_fp8_f32(a, b, w, false); w = __builtin_amdgcn_cvt_pk_fp8_f32(c, d, w, true); return (unsigned)w; }
constexpr float W8_SCALE = 64.f, W8_INV = 1.f / 64.f;
struct EpiAct8 {
    static constexpr bool PERM = true; unsigned char* ws;
    __device__ __forceinline__ void operator()(const f32x4 (&acc)[2][2][4][2], const Unit& u, int wr, int wc, int fr, int fq) const {
        const int row0 = u.pm * 256 + wr * 64 + fr; unsigned char* base = ws + WS_ACT + u.pn * 128 + wc * 32 + 8 * fq;
#pragma unroll
        for (int ai = 0; ai < 2; ++ai)
#pragma unroll
            for (int m = 0; m < 4; ++m) { const int row = row0 + ai * 128 + m * 16; f32x4 a, b;
#pragma unroll
                for (int j = 0; j < 4; ++j) { a[j] = silu_fast(acc[ai][0][m][0][j] * W8_INV) * (acc[ai][1][m][0][j] * W8_INV); b[j] = silu_fast(acc[ai][0][m][1][j] * W8_INV) * (acc[ai][1][m][1][j] * W8_INV); }
                *(unsigned long long*)(base + (size_t)row * FF) = (unsigned long long)pack4_fp8(a[0], a[1], a[2], a[3]) | ((unsigned long long)pack4_fp8(b[0], b[1], b[2], b[3]) << 32); }
    }
};
struct EpiYE8 {
    static constexpr bool PERM = true; unsigned char* ws;
    __device__ __forceinline__ void operator()(const f32x4 (&acc)[2][2][4][2], const Unit& u, int wr, int wc, int fr, int fq) const {
        const int row0 = u.pm * 256 + wr * 64 + fr; bf16* base = (bf16*)(ws + WS_YE) + u.pn * 256 + wc * 32 + 8 * fq;
#pragma unroll
        for (int ai = 0; ai < 2; ++ai)
#pragma unroll
            for (int m = 0; m < 4; ++m) { const int row = row0 + ai * 128 + m * 16;
#pragma unroll
                for (int bj = 0; bj < 2; ++bj) *(u32x4*)(base + (size_t)row * D + bj * 128) = pg8::pack8(acc[ai][bj][m][0] * W8_INV, acc[ai][bj][m][1] * W8_INV); }
    }
};
struct EpiAct {
    static constexpr bool PERM = true; unsigned char* ws;
    __device__ __forceinline__ void operator()(const f32x4 (&acc)[2][2][4][2], const Unit& u, int wr, int wc, int fr, int fq) const {
        const int row0 = u.pm * 256 + wr * 64 + fr; bf16* base = (bf16*)(ws + WS_ACT) + u.pn * 128 + wc * 32 + 8 * fq;
#pragma unroll
        for (int ai = 0; ai < 2; ++ai)
#pragma unroll
            for (int m = 0; m < 4; ++m) { const int row = row0 + ai * 128 + m * 16; f32x4 a, b;
#pragma unroll
                for (int j = 0; j < 4; ++j) { a[j] = silu_fast(acc[ai][0][m][0][j]) * acc[ai][1][m][0][j]; b[j] = silu_fast(acc[ai][0][m][1][j]) * acc[ai][1][m][1][j]; }
                *(u32x4*)(base + (size_t)row * FF) = pg8::pack8(a, b); }
    }
};
struct EpiYE {
    static constexpr bool PERM = true; unsigned char* ws;
    __device__ __forceinline__ void operator()(const f32x4 (&acc)[2][2][4][2], const Unit& u, int wr, int wc, int fr, int fq) const {
        const int row0 = u.pm * 256 + wr * 64 + fr; bf16* base = (bf16*)(ws + WS_YE) + u.pn * 256 + wc * 32 + 8 * fq;
#pragma unroll
        for (int ai = 0; ai < 2; ++ai)
#pragma unroll
            for (int m = 0; m < 4; ++m) { const int row = row0 + ai * 128 + m * 16;
#pragma unroll
                for (int bj = 0; bj < 2; ++bj) *(u32x4*)(base + (size_t)row * D + bj * 128) = pg8::pack8(acc[ai][bj][m][0], acc[ai][bj][m][1]); }
    }
};

namespace att {
using bf16x8 = __attribute__((ext_vector_type(8))) short;
using s16x4  = __attribute__((ext_vector_type(4))) short;
using f32x16 = __attribute__((ext_vector_type(16))) float;
using u32x4  = __attribute__((ext_vector_type(4))) unsigned;
constexpr int QBLK = 32, KVBLK = 64, NW = 8;
constexpr float SCALE = cfg::ATT_SCALE, THR = 8.f;
constexpr int LDQ = 192, LDKK = 192, LDV = 128, LDO = 2048;
constexpr int KROW = 400, SHM_V = KVBLK * 128 * 2, SHM_K = KVBLK * KROW, SHM_QPE = 2 * SHM_V + 2 * SHM_K + NW * 64 * 4, SHM_ATTN = SHM_QPE + NW * 4096;
#define KSWZ(row, colB) ((row) * KROW + (colB))
#define SBAR() __builtin_amdgcn_sched_barrier(0)
__device__ __forceinline__ int crow(int r, int hi) { return (r & 3) + 8 * (r >> 2) + 4 * hi; }
__device__ __forceinline__ unsigned cvtpk(float lo, float hi) { unsigned r; asm volatile("v_cvt_pk_bf16_f32 %0, %1, %2" : "=v"(r) : "v"(lo), "v"(hi)); return r; }

__device__ __forceinline__ void partialSM(f32x16& p0, f32x16& p1, float& m_reg, float& mn, float& alpha) {
  constexpr float C = SCALE * 1.4426950408889634f;
  float pmax = p0[0];
#pragma unroll
  for (int r = 1; r < 16; ++r) pmax = fmaxf(pmax, p0[r]);
#pragma unroll
  for (int r = 0; r < 16; ++r) pmax = fmaxf(pmax, p1[r]);
  { auto rr = __builtin_amdgcn_permlane32_swap(__float_as_uint(pmax), __float_as_uint(pmax), false, false);
    pmax = fmaxf(__uint_as_float(rr[0]), __uint_as_float(rr[1])); }
  if (__builtin_expect(__all(pmax - m_reg <= THR / SCALE), 1)) { mn = m_reg; alpha = 1.f; }
  else { mn = fmaxf(m_reg, pmax); alpha = __builtin_amdgcn_exp2f((m_reg - mn) * C); m_reg = mn; }
  float mnC = -mn * C;
#pragma unroll
  for (int r = 0; r < 16; ++r) p0[r] = fmaf(p0[r], C, mnC);
#pragma unroll
  for (int r = 0; r < 16; ++r) p1[r] = fmaf(p1[r], C, mnC);
#pragma unroll
  for (int r = 0; r < 16; ++r) p0[r] = __builtin_amdgcn_exp2f(p0[r]);
}
__device__ __forceinline__ void finishSM(f32x16& p0, f32x16& p1, float alpha, float& l_reg, bf16x8& pa0, bf16x8& pa1, bf16x8& pa2, bf16x8& pa3) {
#pragma unroll
  for (int r = 0; r < 16; ++r) p1[r] = __builtin_amdgcn_exp2f(p1[r]);
  float ps = 0;
#pragma unroll
  for (int r = 0; r < 16; ++r) ps += p0[r];
#pragma unroll
  for (int r = 0; r < 16; ++r) ps += p1[r];
  { auto rr = __builtin_amdgcn_permlane32_swap(__float_as_uint(ps), __float_as_uint(ps), false, false);
    ps = __uint_as_float(rr[0]) + __uint_as_float(rr[1]); }
  l_reg = l_reg * alpha + ps;
#define PK4(P, BASE, OUT) do { unsigned a0 = cvtpk(P[BASE + 0], P[BASE + 1]), a1 = cvtpk(P[BASE + 2], P[BASE + 3]);   \
    unsigned b0 = cvtpk(P[BASE + 4], P[BASE + 5]), b1 = cvtpk(P[BASE + 6], P[BASE + 7]);                              \
    auto r0 = __builtin_amdgcn_permlane32_swap(a0, b0, false, false); auto r1 = __builtin_amdgcn_permlane32_swap(a1, b1, false, false); \
    u32x4 w = {r0[0], r1[0], r0[1], r1[1]}; OUT = *reinterpret_cast<bf16x8*>(&w); } while (0)
  PK4(p0, 0, pa0); PK4(p0, 8, pa1); PK4(p1, 0, pa2); PK4(p1, 8, pa3);
#undef PK4
}
__device__ __forceinline__ void qkt(f32x16& p0, f32x16& p1, const char* Ks, const bf16x8* qr, const char* qpe, int r32, int hi) {
  p0 = f32x16{}; p1 = f32x16{};
#pragma unroll
  for (int d0 = 0; d0 < 12; ++d0) { const int cb = (d0 * 16 + hi * 8) * 2;
    bf16x8 b0 = *reinterpret_cast<const bf16x8*>(Ks + KSWZ(r32, cb));
    bf16x8 b1 = *reinterpret_cast<const bf16x8*>(Ks + KSWZ(32 + r32, cb));
    const bf16x8 q = d0 < 8 ? qr[d0 < 8 ? d0 : 0] : *reinterpret_cast<const bf16x8*>(qpe + (d0 - 8) * 1024);
    p0 = __builtin_amdgcn_mfma_f32_32x32x16_bf16(b0, q, p0, 0, 0, 0);
    p1 = __builtin_amdgcn_mfma_f32_32x32x16_bf16(b1, q, p1, 0, 0, 0); }
}
__device__ __forceinline__ int v_st(int k, int c) { const int kk = (k & ~0xC) | ((k & 4) << 1) | ((k & 8) >> 1); return ((kk >> 3) * 4 + (c >> 5)) * 512 + ((kk & 7) * 32 + (c & 31)) * 2; }
__device__ __forceinline__ int v_rd_base(int lane) { return ((lane & 3) << 3) | (((lane >> 2) & 3) << 6) | (((lane >> 4) & 1) << 5) | (((lane >> 5) & 1) << 8); }
constexpr int v_rd_off(int d0, int ks, int half) { return d0 * 512 + ks * 4096 + half * 2048; }
template <int OFF> __device__ __forceinline__ s16x4 tr_read(int vb) {
  s16x4 r; asm volatile("ds_read_b64_tr_b16 %0, %1 offset:%2" : "=&v"(r) : "v"(vb), "i"(OFF) : "memory"); return r;
}
template <int D0> __device__ __forceinline__ void pv_one(f32x16& od, int vb, bf16x8 pa0, bf16x8 pa1, bf16x8 pa2, bf16x8 pa3) {
  const s16x4 l0 = tr_read<v_rd_off(D0, 0, 0)>(vb), h0 = tr_read<v_rd_off(D0, 0, 1)>(vb), l1 = tr_read<v_rd_off(D0, 1, 0)>(vb), h1 = tr_read<v_rd_off(D0, 1, 1)>(vb);
  const s16x4 l2 = tr_read<v_rd_off(D0, 2, 0)>(vb), h2 = tr_read<v_rd_off(D0, 2, 1)>(vb), l3 = tr_read<v_rd_off(D0, 3, 0)>(vb), h3 = tr_read<v_rd_off(D0, 3, 1)>(vb);
  asm volatile("s_waitcnt lgkmcnt(0)" ::: "memory"); SBAR();
#define PK(L, H) (bf16x8){L[0], L[1], L[2], L[3], H[0], H[1], H[2], H[3]}
  od = __builtin_amdgcn_mfma_f32_32x32x16_bf16(pa0, PK(l0, h0), od, 0, 0, 0);
  od = __builtin_amdgcn_mfma_f32_32x32x16_bf16(pa1, PK(l1, h1), od, 0, 0, 0);
  od = __builtin_amdgcn_mfma_f32_32x32x16_bf16(pa2, PK(l2, h2), od, 0, 0, 0);
  od = __builtin_amdgcn_mfma_f32_32x32x16_bf16(pa3, PK(l3, h3), od, 0, 0, 0);
#undef PK
}
__device__ __forceinline__ void pv_d0(f32x16* o, int vb, bf16x8 pa0, bf16x8 pa1, bf16x8 pa2, bf16x8 pa3) {
  pv_one<0>(o[0], vb, pa0, pa1, pa2, pa3); pv_one<1>(o[1], vb, pa0, pa1, pa2, pa3); pv_one<2>(o[2], vb, pa0, pa1, pa2, pa3); pv_one<3>(o[3], vb, pa0, pa1, pa2, pa3);
}
template <int V>
__device__ __forceinline__ void attn_unit(const bf16* __restrict__ Qb, const bf16* __restrict__ Kh, const bf16* __restrict__ Vh, bf16* __restrict__ Ob, int seq, char* lds) {
  const int tid = threadIdx.x, wid = tid >> 6, lane = tid & 63, r32 = lane & 31, hi = lane >> 5;
  char* V_lds = lds; char* K_lds = lds + 2 * SHM_V;
  float* ws = (float*)(lds + 2 * SHM_V + 2 * SHM_K) + wid * 64; float* li_l = ws; float* al_l = ws + 32;
  float m_reg = -1e30f, l_reg = 0; f32x16 o[4] = {}; bf16x8 qr[8];
  const bf16* Qw = Qb + (long)(wid * QBLK + r32) * LDQ + hi * 8;
  char* qpe = lds + SHM_QPE + wid * 4096 + lane * 16;
#pragma unroll
  for (int d0 = 0; d0 < 8; ++d0) qr[d0] = *reinterpret_cast<const bf16x8*>(Qw + d0 * 16);
#pragma unroll
  for (int d0 = 8; d0 < 12; ++d0) *reinterpret_cast<bf16x8*>(qpe + (d0 - 8) * 1024) = *reinterpret_cast<const bf16x8*>(Qw + d0 * 16);
  int kro[4], vro[2];
#pragma unroll
  for (int j = 0; j < 4; ++j) { const int o = (wid + 8 * j) * 1024 + lane * 16, row = o / KROW, c = (o - row * KROW) >> 4; kro[j] = row * 384 + (c < 24 ? c : 0) * 16; }
#pragma unroll
  for (int j = 0; j < 2; ++j) { const int o = (wid * 2 + j) * 1024 + lane * 16, st = o >> 9, within = (o & 511) >> 1, kk = (st >> 2) * 8 + (within >> 5), c = (st & 3) * 32 + (within & 31);
    const int k = (kk & ~0xC) | ((kk & 4) << 1) | ((kk & 8) >> 1); vro[j] = k * 256 + c * 2; }
  const unsigned klds = (unsigned)(uintptr_t)K_lds + wid * 1024, vlds = (unsigned)(uintptr_t)V_lds + wid * 2048;
  const int vb0 = (int)(uintptr_t)V_lds + v_rd_base(lane);
  typedef __attribute__((address_space(3))) unsigned* ldsp_t;
#define SDMA_K(k0, b) do { const char* kg = (const char*)Kh + (long)(k0) * (LDKK * 2); \
    _Pragma("unroll") for (int j_ = 0; j_ < 3; ++j_) __builtin_amdgcn_global_load_lds((const unsigned*)(kg + kro[j_]), (ldsp_t)(klds + (b) * SHM_K + j_ * 8192), 16, 0, 0); \
    if (wid == 0) __builtin_amdgcn_global_load_lds((const unsigned*)(kg + kro[3]), (ldsp_t)(klds + (b) * SHM_K + 3 * 8192), 16, 0, 0); } while (0)
#define SDMA_V(k0, b) do { const char* vg = (const char*)Vh + (long)(k0) * (LDV * 2); \
    _Pragma("unroll") for (int j_ = 0; j_ < 2; ++j_) __builtin_amdgcn_global_load_lds((const unsigned*)(vg + vro[j_]), (ldsp_t)(vlds + (b) * SHM_V + j_ * 1024), 16, 0, 0); } while (0)
#define RESC(a) do { if (__any((a) < 1.f)) { if (hi == 0) al_l[r32] = (a); asm volatile("s_waitcnt lgkmcnt(0)" ::: "memory"); \
    _Pragma("unroll") for (int d = 0; d < 4; ++d) _Pragma("unroll") for (int r = 0; r < 16; ++r) o[d][r] *= al_l[crow(r, hi)]; } } while (0)
#define PHASE_END() do { asm volatile("s_waitcnt vmcnt(0) lgkmcnt(0)" ::: "memory"); __builtin_amdgcn_s_barrier(); asm volatile("" ::: "memory"); } while (0)
  f32x16 pA0, pA1; float mnA, alA; bf16x8 pa0, pa1, pa2, pa3; const int NT = seq / KVBLK;
  SDMA_K(0, 0); SDMA_V(0, 0); PHASE_END();
  if (wid >= 4) { __builtin_amdgcn_s_barrier(); asm volatile("" ::: "memory"); }
  for (int j = 0; j < NT; ++j) {
    const int bsel = j & 1;
    if (!(V & 8)) if (j + 1 < NT) { if (bsel) SDMA_K((j + 1) * KVBLK, 0); else SDMA_K((j + 1) * KVBLK, 1); }
    SBAR(); if (!(V & 4)) qkt(pA0, pA1, K_lds + bsel * SHM_K, qr, qpe, r32, hi); else { pA0 = o[0]; pA1 = o[1]; }
    if (!(V & 1)) partialSM(pA0, pA1, m_reg, mnA, alA); else { mnA = 0.f; alA = 1.f; }
    PHASE_END();
    if (!(V & 8)) if (j + 1 < NT) { if (bsel) SDMA_V((j + 1) * KVBLK, 0); else SDMA_V((j + 1) * KVBLK, 1); }
    RESC(alA);
    if (!(V & 1)) finishSM(pA0, pA1, alA, l_reg, pa0, pa1, pa2, pa3); else { pa0 = (bf16x8){(short)__float_as_int(pA0[0])}; pa1 = (bf16x8){(short)__float_as_int(pA0[1])}; pa2 = (bf16x8){(short)__float_as_int(pA1[0])}; pa3 = (bf16x8){(short)__float_as_int(pA1[1])}; l_reg += pA0[2]; } SBAR();
    if (!(V & 2)) pv_d0(o, vb0 + bsel * (int)SHM_V, pa0, pa1, pa2, pa3); else { o[0][0] += __int_as_float(pa0[0]); o[1][0] += __int_as_float(pa1[0]); o[2][0] += __int_as_float(pa2[0]); o[3][0] += __int_as_float(pa3[0]); }
    PHASE_END();
  }
  if (wid < 4) { __builtin_amdgcn_s_barrier(); asm volatile("" ::: "memory"); }
  if (hi == 0) li_l[r32] = l_reg; asm volatile("s_waitcnt lgkmcnt(0)" ::: "memory");
  float rli[16];
#pragma unroll
  for (int r = 0; r < 16; ++r) rli[r] = __builtin_amdgcn_rcpf(li_l[crow(r, hi)]);
  bf16* Ow = Ob + (long)(wid * QBLK) * LDO;
#pragma unroll
  for (int r = 0; r < 16; ++r) { const int orow = crow(r, hi);
#pragma unroll
    for (int d0 = 0; d0 < 4; ++d0) Ow[(long)orow * LDO + d0 * 32 + r32] = f2bf(o[d0][r] * rli[r]); }
#undef SDMA_K
#undef SDMA_V
#undef PHASE_END
#undef RESC
}
#undef KSWZ
#undef SBAR
}

#define XB_TMO      128
#define XB_XCNT(j)  (256  + 64 * (j))
#define XB_XSUB(j)  (1280 + 64 * (j))
#define XB_XGEN(j)  (2304 + 64 * (j))
#define XB_TOP      3328
#define XB_TOPGEN   3392
#define XCD_BAR_WORDS 3456
#define XB_SPIN_CAP (1u << 18)
__device__ __forceinline__ unsigned xb_ld(unsigned* p)              { return __hip_atomic_load(p, __ATOMIC_RELAXED, __HIP_MEMORY_SCOPE_AGENT); }
__device__ __forceinline__ unsigned xb_add(unsigned* p, unsigned v) { return __hip_atomic_fetch_add(p, v, __ATOMIC_RELAXED, __HIP_MEMORY_SCOPE_AGENT); }
__device__ __forceinline__ unsigned xb_xcc_id() { return (unsigned)__builtin_amdgcn_s_getreg((3 << 11) | 20) & 0xFu; }
#define XB_SPIN(cond, bar) do { unsigned _sp = 0; while (cond) { __builtin_amdgcn_s_sleep(1); \
    if ((++_sp & 255u) == 0u) { if (xb_ld(&(bar)[XB_TMO])) break; if (_sp > XB_SPIN_CAP) { atomicAdd(&(bar)[XB_TMO], 1u); break; } } } } while (0)
struct XcdBarrier { unsigned* bar; unsigned x; volatile LAS unsigned* st; };
__device__ __forceinline__ XcdBarrier xcd_barrier_post(unsigned* bar, volatile LAS unsigned* st) {
    XcdBarrier b; b.bar = bar; b.x = xb_xcc_id(); b.st = st;
    if (threadIdx.x == 0) (void)xb_add(&bar[XB_XCNT(b.x)], 1u);
    return b;
}
__device__ __forceinline__ void xcd_barrier_complete(unsigned* bar, unsigned x, unsigned& nloc, unsigned& nx) {
    const unsigned G = gridDim.x * gridDim.y * gridDim.z;
    unsigned sum, cnt, mine, sp = 0u;
    for (;;) {
        sum = 0u; cnt = 0u; mine = 0u;
#pragma unroll
        for (unsigned j = 0; j < 16; ++j) { const unsigned c = xb_ld(&bar[XB_XCNT(j)]); sum += c; cnt += (c > 0u) ? 1u : 0u; mine = (j == x) ? c : mine; }
        if (sum == G) break;
        __builtin_amdgcn_s_sleep(1);
        if ((++sp & 255u) == 0u) { if (xb_ld(&bar[XB_TMO])) break; if (sp > XB_SPIN_CAP) { atomicAdd(&bar[XB_TMO], 1u); break; } }
    }
    nloc = mine > 0u ? mine : 1u; nx = cnt > 0u ? cnt : 1u;
}
__device__ __forceinline__ void xcd_barrier(const XcdBarrier& b) {
    asm volatile("s_waitcnt vmcnt(0)" ::: "memory");
    __syncthreads();
    if (threadIdx.x == 0) {
        unsigned* bar = b.bar;
        __builtin_amdgcn_s_waitcnt(0);
        unsigned nloc = b.st[0], nx = b.st[1];
        if (nloc == 0u) { xcd_barrier_complete(bar, b.x, nloc, nx); b.st[0] = nloc; b.st[1] = nx; }
        const unsigned old = xb_add(&bar[XB_XSUB(b.x)], 1u);
        const unsigned gen = old / nloc;
        if (old + 1u == (gen + 1u) * nloc) {
            __builtin_amdgcn_fence(__ATOMIC_RELEASE, "agent");
            asm volatile("s_waitcnt vmcnt(0)" ::: "memory");
            const unsigned og = xb_add(&bar[XB_TOP], 1u);
            const unsigned tg = og / nx;
            if (og + 1u == (tg + 1u) * nx) xb_add(&bar[XB_TOPGEN], 1u);
            else XB_SPIN(xb_ld(&bar[XB_TOPGEN]) == tg, bar);
            __builtin_amdgcn_fence(__ATOMIC_ACQUIRE, "agent");
            xb_add(&bar[XB_XGEN(b.x)], 1u);
            asm volatile("s_waitcnt vmcnt(0)" ::: "memory");
        } else {
            XB_SPIN(xb_ld(&bar[XB_XGEN(b.x)]) == gen, bar);
            __builtin_amdgcn_fence(__ATOMIC_ACQUIRE, "agent");
            asm volatile("s_waitcnt vmcnt(0)" ::: "memory");
        }
    }
    __syncthreads();
}

constexpr int NWAVES = 8, NTHREADS = 512;
constexpr int RING_BYTES = 131072, TAB_OFF = RING_BYTES, TAB_BYTES = 8192, LDS_BYTES = 163840, MISC_OFF = LDS_BYTES - 512, VEC_OFF = RING_BYTES;
constexpr int CW_BAR = 4096;
#define LDS_WAIT() asm volatile("s_waitcnt lgkmcnt(0)" ::: "memory")
typedef unsigned v4u __attribute__((ext_vector_type(4)));
__device__ __forceinline__ unsigned pk2(float lo, float hi) { return (unsigned)f2bf(lo) | ((unsigned)f2bf(hi) << 16); }

__device__ __forceinline__ void p0_mod_item(const Ptrs& p, int it, int lane) {
    const int kc = it / 48, cc = it - kc * 48, k0 = kc * 64, c0 = cc * 256 + lane * 4;
    float sv[5];
#pragma unroll
    for (int r = 0; r < 5; ++r) { const float* cv = r < 4 ? p.c + r * D : p.c_ctx; sv[r] = silu_f(cv[k0 + lane]); }
    f32x4 acc[5];
#pragma unroll
    for (int r = 0; r < 5; ++r) acc[r] = (f32x4){0.f, 0.f, 0.f, 0.f};
    const float* w = p.w_ada + (size_t)k0 * 12288 + c0;
#pragma unroll 8
    for (int k = 0; k < 64; ++k) { const f32x4 wv = *(const f32x4*)(w + (size_t)k * 12288);
#pragma unroll
        for (int r = 0; r < 5; ++r) acc[r] += __int_as_float(__builtin_amdgcn_readlane(__float_as_int(sv[r]), k)) * wv; }
    float* part = (float*)(p.ws + WS_PART) + (size_t)kc * 5 * 12288 + c0;
#pragma unroll
    for (int r = 0; r < 5; ++r) *(f32x4*)(part + (size_t)r * 12288) = acc[r];
}
__device__ __forceinline__ void cvt_load(const float* src, int ldw, int lane, f32x4 (&v)[8]) {
    const int kr = lane >> 3, nq = lane & 7;
#pragma unroll
    for (int i = 0; i < 8; ++i) v[i] = *(const f32x4*)(src + (size_t)(8 * i + kr) * ldw + 4 * nq);
}
__device__ __forceinline__ void cvt_finish(const f32x4 (&v)[8], bf16* dst, int ldk, bool rope, const float* kscale, LAS float* scr, int lane) {
    const int kr = lane >> 3, nq = lane & 7;
#pragma unroll
    for (int i = 0; i < 8; ++i) { const int k = 8 * i + kr; const float sc = kscale ? kscale[k] : 1.f;
#pragma unroll
        for (int t = 0; t < 4; ++t) { const int cs = 4 * nq + t, nn = rope ? ((cs & 15) * 2 + (cs >> 4)) : cs; scr[k * 33 + nn] = v[i][t] * sc; } }
    LDS_WAIT(); asm volatile("" ::: "memory");
    const int c = lane & 7;
#pragma unroll
    for (int j = 0; j < 4; ++j) { const int n = (lane >> 3) + 8 * j; const LAS float* s = scr + (8 * c) * 33 + n;
        v4u o; o.x = pg8::cvt_pk_bf16(s[0 * 33], s[1 * 33]); o.y = pg8::cvt_pk_bf16(s[2 * 33], s[3 * 33]); o.z = pg8::cvt_pk_bf16(s[4 * 33], s[5 * 33]); o.w = pg8::cvt_pk_bf16(s[6 * 33], s[7 * 33]);
        *(v4u*)(dst + (size_t)n * ldk + 8 * c) = o; }
    LDS_WAIT(); asm volatile("" ::: "memory");
}
__device__ __forceinline__ void cvt_finish_fp8(const f32x4 (&v)[8], unsigned char* dst, int ldk, LAS float* scr, int lane) {
    const int kr = lane >> 3, nq = lane & 7;
#pragma unroll
    for (int i = 0; i < 8; ++i) { const int k = 8 * i + kr;
#pragma unroll
        for (int t = 0; t < 4; ++t) scr[k * 33 + 4 * nq + t] = v[i][t] * W8_SCALE; }
    LDS_WAIT(); asm volatile("" ::: "memory");
    const int c = lane & 3;
#pragma unroll
    for (int j = 0; j < 2; ++j) { const int n = (lane >> 2) + 16 * j; const LAS float* s = scr + (16 * c) * 33 + n;
        v4u o; o.x = pack4_fp8(s[0 * 33], s[1 * 33], s[2 * 33], s[3 * 33]); o.y = pack4_fp8(s[4 * 33], s[5 * 33], s[6 * 33], s[7 * 33]);
        o.z = pack4_fp8(s[8 * 33], s[9 * 33], s[10 * 33], s[11 * 33]); o.w = pack4_fp8(s[12 * 33], s[13 * 33], s[14 * 33], s[15 * 33]);
        *(v4u*)(dst + (size_t)n * ldk + 16 * c) = o; }
    LDS_WAIT(); asm volatile("" ::: "memory");
}
__device__ __forceinline__ void cvt_item(const float* src, int ldw, bf16* dst, int ldk, bool rope, const float* kscale, LAS float* scr, int lane) {
    f32x4 v[8]; cvt_load(src, ldw, lane, v); cvt_finish(v, dst, ldk, rope, kscale, scr, lane);
}
constexpr int I_MOD = 1536, I_WIN = 32 * 98, I_WQ = 8 * 48, I_WKV = 8 * 64, I_WOUT = 32 * 64, I_GU = 16 * 32 * 128, I_DN = 16 * 32 * 64, I_SGU = 256, I_ZERO = 768, I_ROPE = 1;
constexpr int P0_ITEMS = I_MOD + I_WIN + I_WQ + I_WKV + I_WOUT + I_SGU + I_ZERO + I_ROPE, PX_ITEMS = I_GU + I_DN;
__device__ __forceinline__ void p0_item(const Ptrs& p, int it, LAS float* scr, int lane) {
    if (it < I_MOD) { p0_mod_item(p, it, lane); return; } it -= I_MOD;
    if (it < I_WIN) { const int kb = it / 98, nb = it - kb * 98, n0 = nb * 32; int col0; bool rope = false;
        if (n0 < 1024) col0 = n0; else if (n0 < 3072) col0 = n0 + 64; else { col0 = OFF_KPE + (nb - 96) * 32; rope = true; }
        cvt_item(p.w_in + (size_t)kb * 64 * INC + col0, INC, (bf16*)(p.ws + WS_WIN_T) + (size_t)n0 * D + kb * 64, D, rope, nullptr, scr, lane); return; } it -= I_WIN;
    if (it < I_WQ) { const int kb = it / 48, nb = it - kb * 48, n0 = nb * 32; int col0; bool rope = false;
        if (n0 < 1024) col0 = (n0 >> 7) * DQK + (n0 & 127); else { const int jj = n0 - 1024; col0 = (jj >> 6) * DQK + 128 + ((jj & 63) >> 5) * 32; rope = true; }
        cvt_item(p.w_uq + (size_t)kb * 64 * 1536 + col0, 1536, (bf16*)(p.ws + WS_WQKV_T) + (size_t)n0 * 512 + kb * 64, 512, rope, p.q_norm_w + kb * 64, scr, lane); return; } it -= I_WQ;
    if (it < I_WKV) { const int kb = it / 64, nb = it - kb * 64, n0 = nb * 32;
        cvt_item(p.w_ukv + (size_t)kb * 64 * 2048 + n0, 2048, (bf16*)(p.ws + WS_WQKV_T) + (size_t)(1536 + n0) * 512 + kb * 64, 512, false, p.kv_norm_w + kb * 64, scr, lane); return; } it -= I_WKV;
    if (it < I_WOUT) { const int kb = it / 64, nb = it - kb * 64, n0 = nb * 32;
        cvt_item(p.w_out + (size_t)kb * 64 * D + n0, D, (bf16*)(p.ws + WS_WOUT_T) + (size_t)n0 * D + kb * 64, D, false, nullptr, scr, lane); return; } it -= I_WOUT;
    if (it < I_SGU) { const float* s = p.sgu_w + (size_t)it * 512 + lane * 8; const f32x4 a = *(const f32x4*)s, b = *(const f32x4*)(s + 4);
        v4u o; o.x = pk2(a[0], a[1]); o.y = pk2(a[2], a[3]); o.z = pk2(b[0], b[1]); o.w = pk2(b[2], b[3]); *(v4u*)((bf16*)(p.ws + WS_SGUW) + (size_t)it * 512 + lane * 8) = o; return; } it -= I_SGU;
    if (it < I_ZERO) { *(v4u*)((bf16*)(p.ws + WS_WIN_T) + (size_t)3136 * D + (size_t)it * 512 + lane * 8) = (v4u){0u, 0u, 0u, 0u}; return; }
    float* tab = (float*)(p.ws + WS_ROPE);
    for (int j = 0; j < 16; ++j) { const int idx = j * 64 + lane, ax = idx >> 4, ii = idx & 15; float s, c; sincosf((float)ax * rope_inv(ii), &s, &c); tab[idx * 2] = c; tab[idx * 2 + 1] = s; }
}
constexpr int PX_N3 = 0, PX_N4 = 0, PX_N8 = 48, PX_R3 = 0, PX_R4 = PX_R3 + 180 * PX_N3, PX_R8 = PX_R4 + 96 * PX_N4, PX_R5 = PX_R8 + 192 * PX_N8;
constexpr int WEL = FP8_MOE ? 1 : 2;
#if 0
#else
__device__ __forceinline__ void px_ptrs(const Ptrs& p, int it, const float*& src, unsigned char*& dst) {
    if (it < I_GU) { const int e = it >> 12, r = it & 4095, kb = r >> 7, nb = r & 127, n0 = nb * 32, pn = n0 >> 8, within = n0 & 255;
        src = (within < 128 ? p.w_e_gate : p.w_e_up) + ((size_t)e * D + kb * 64) * FF + pn * 128 + (within & 127);
        dst = p.ws + WS_WGU_T + (((size_t)e * 4096 + n0) * D + kb * 64) * WEL; }
    else { it -= I_GU; const int e = it >> 11, r = it & 2047, kb = r >> 6, nb = r & 63, n0 = nb * 32;
        src = p.w_e_down + ((size_t)e * FF + kb * 64) * D + n0; dst = p.ws + WS_WD_T + (((size_t)e * D + n0) * FF + kb * 64) * WEL; }
}
__device__ __forceinline__ void px_dma(const float* src, unsigned ldsbase, int lane) {
    typedef __attribute__((address_space(3))) unsigned* ldsp_t;
#pragma unroll
    for (int i = 0; i < 8; ++i) { const int k = 8 * i + (lane >> 3), nq = ((lane & 7) - 2 * (k >> 4)) & 7;
        __builtin_amdgcn_global_load_lds((const unsigned*)(src + (size_t)k * 2048 + 4 * nq), (ldsp_t)(ldsbase + i * 1024), 16, 0, 0); }
}
__device__ __forceinline__ void px_out(unsigned char* dst, const LAS float* t, int lane) {
    if constexpr (FP8_MOE) {
        const int c = lane & 3;
#pragma unroll
        for (int j = 0; j < 2; ++j) { const int n = (lane >> 2) + 16 * j; float v[16];
#pragma unroll
            for (int q = 0; q < 16; ++q) { const int k = 16 * c + q; v[q] = t[(k * 8 + (((n >> 2) + 2 * c) & 7)) * 4 + (n & 3)] * W8_SCALE; }
            v4u o; o.x = pack4_fp8(v[0], v[1], v[2], v[3]); o.y = pack4_fp8(v[4], v[5], v[6], v[7]); o.z = pack4_fp8(v[8], v[9], v[10], v[11]); o.w = pack4_fp8(v[12], v[13], v[14], v[15]);
            *(v4u*)(dst + (size_t)n * 2048 + 16 * c) = o; }
    } else {
        const int c = lane & 7;
#pragma unroll
        for (int j = 0; j < 4; ++j) { const int n = (lane >> 3) + 8 * j; float v[8];
#pragma unroll
            for (int q = 0; q < 8; ++q) { const int k = 8 * c + q; v[q] = t[(k * 8 + (((n >> 2) + 2 * (k >> 4)) & 7)) * 4 + (n & 3)]; }
            v4u o; o.x = pg8::cvt_pk_bf16(v[0], v[1]); o.y = pg8::cvt_pk_bf16(v[2], v[3]); o.z = pg8::cvt_pk_bf16(v[4], v[5]); o.w = pg8::cvt_pk_bf16(v[6], v[7]);
            *(v4u*)((bf16*)dst + (size_t)n * 2048 + 8 * c) = o; }
    }
}
__device__ __forceinline__ void px_convert(const Ptrs& p, int it0, int NGW, int PX_END, LAS float* scr, int lane) {
    const unsigned l0 = (unsigned)(uintptr_t)scr; const float* s_; unsigned char *da, *db;
    int it = it0;
    if (it < PX_END) { px_ptrs(p, it, s_, da); px_dma(s_, l0, lane); }
    while (it < PX_END) {
        const int i1 = it + NGW, i2 = it + 2 * NGW;
        if (i1 < PX_END) { px_ptrs(p, i1, s_, db); px_dma(s_, l0 + 8192, lane); asm volatile("s_waitcnt vmcnt(8)" ::: "memory"); } else asm volatile("s_waitcnt vmcnt(0)" ::: "memory");
        px_out(da, scr, lane);
        if (i1 >= PX_END) break;
        asm volatile("s_waitcnt lgkmcnt(0)" ::: "memory");
        if (i2 < PX_END) { px_ptrs(p, i2, s_, da); px_dma(s_, l0, lane); asm volatile("s_waitcnt vmcnt(8)" ::: "memory"); } else asm volatile("s_waitcnt vmcnt(0)" ::: "memory");
        px_out(db, scr + 2048, lane);
        asm volatile("s_waitcnt lgkmcnt(0)" ::: "memory");
        it = i2;
    }
}
#endif
__device__ __forceinline__ void p1_row(const Ptrs& p, int row, int lane, const LAS float* vg  , const LAS float* vs  ) {
    const float* src = row < M ? p.x + (size_t)row * D : p.ctx + (size_t)(row - M) * D;
    f32x4 v[8]; float s = 0.f;
#pragma unroll
    for (int j = 0; j < 8; ++j) { v[j] = *(const f32x4*)(src + j * 256 + lane * 4); s += dot4(v[j]); }
    const float rs = rsqrtf(wave_sum(s) * (1.f / D) + EPS);
    bf16* o = (bf16*)(p.ws + WS_H) + (size_t)row * D;
#pragma unroll
    for (int j = 0; j < 8; ++j) { const int c = j * 256 + lane * 4; const f32x4 h = v[j] * rs * *(const LAS f32x4*)(vg + c) + *(const LAS f32x4*)(vs + c);
        *(unsigned long long*)(o + c) = (unsigned long long)pk2(h[0], h[1]) | ((unsigned long long)pk2(h[2], h[3]) << 32); }
}
typedef float f32x16 __attribute__((ext_vector_type(16)));
typedef short bf16x8v __attribute__((ext_vector_type(8)));
__device__ __forceinline__ void sgu_unit(const Ptrs& p, int chunk, int g, LAS unsigned char* lds, int tid) {
    constexpr int VROW = 272;
    const int lane = tid & 63, wid = tid >> 6;
    {
        const int q = tid >> 2, cg = tid & 3;
        const bf16* src = (const bf16*)(p.ws + WS_VS) + (size_t)(chunk * 128 + q) * 1024 + g * 128 + cg * 32;
        float x[32];
#pragma unroll
        for (int j = 0; j < 4; ++j) { const v4u w = *(const v4u*)(src + j * 8);
#pragma unroll
            for (int t = 0; t < 4; ++t) { x[j * 8 + 2 * t] = __uint_as_float(w[t] << 16); x[j * 8 + 2 * t + 1] = __uint_as_float(w[t] & 0xffff0000u); } }
        float s = 0.f;
#pragma unroll
        for (int j = 0; j < 32; ++j) s += x[j];
        s += __shfl_xor(s, 1); s += __shfl_xor(s, 2);
        const float mu = s * (1.f / 128.f); float vq = 0.f;
#pragma unroll
        for (int j = 0; j < 32; ++j) { x[j] -= mu; vq += x[j] * x[j]; }
        vq += __shfl_xor(vq, 1); vq += __shfl_xor(vq, 2);
        const float rs = rsqrtf(vq * (1.f / 128.f) + EPS);
        const float* gw = p.sgu_norm_w + g * 128 + cg * 32;
#pragma unroll
        for (int j = 0; j < 32; ++j) *(LAS bf16*)(lds + (cg * 32 + j) * VROW + q * 2) = f2bf(x[j] * rs * gw[j]);
    }
    LDS_WAIT(); __syncthreads();
    const int pb = wid >> 1, ch = wid & 1, r32 = lane & 31, hi = lane >> 5;
    f32x16 acc0 = {}, acc1 = {};
    const bf16* wrow = (const bf16*)(p.ws + WS_SGUW) + ((size_t)g * 128 + pb * 32 + r32) * 128 + hi * 8;
#pragma unroll
    for (int ks = 0; ks < 8; ++ks) {
        const bf16x8v a = *(const bf16x8v*)(wrow + ks * 16);
        const bf16x8v b0 = *(const LAS bf16x8v*)(lds + (ch * 64 + r32) * VROW + (ks * 16 + hi * 8) * 2);
        const bf16x8v b1 = *(const LAS bf16x8v*)(lds + (ch * 64 + 32 + r32) * VROW + (ks * 16 + hi * 8) * 2);
        acc0 = __builtin_amdgcn_mfma_f32_32x32x16_bf16(a, b0, acc0, 0, 0, 0);
        acc1 = __builtin_amdgcn_mfma_f32_32x32x16_bf16(a, b1, acc1, 0, 0, 0);
    }
#pragma unroll
    for (int r = 0; r < 16; ++r) { const int pr = pb * 32 + (r & 3) + 8 * (r >> 2) + 4 * hi; const size_t tok = (size_t)chunk * 128 + pr; const float bias = p.sgu_b[g * 128 + pr];
        const bf16* ur = (const bf16*)(p.ws + WS_U) + tok * 1024 + g * 128 + ch * 64 + r32; bf16* orow = (bf16*)(p.ws + WS_CAT) + tok * D + 1024 + g * 128 + ch * 64 + r32;
        orow[0] = f2bf(bf2f(ur[0]) * (acc0[r] + bias)); orow[32] = f2bf(bf2f(ur[32]) * (acc1[r] + bias)); }
    __syncthreads();
}
__device__ __forceinline__ void topk_unit(const Ptrs& p, int e, int b, LAS unsigned* sh, int tid) {
    const int lane = tid & 63, wid = tid >> 6;
    const float* aff = (const float*)(p.ws + WS_AFF) + (size_t)b * L * 16 + e;
    unsigned key[8];
#pragma unroll
    for (int j = 0; j < 8; ++j) key[j] = __float_as_uint(aff[(size_t)(tid * 8 + j) * 16]);
    unsigned prefix = 0u, mask = 0u, need = CAP;
    for (int shift = 24; shift >= 0; shift -= 8) {
        if (tid < 256) sh[tid] = 0u;
        __syncthreads();
#pragma unroll
        for (int j = 0; j < 8; ++j) if ((key[j] & mask) == prefix) atomicAdd((unsigned*)&sh[(key[j] >> shift) & 255u], 1u);
        __syncthreads();
        if (wid == 0) {
            const unsigned c0 = sh[4 * lane], c1 = sh[4 * lane + 1], c2 = sh[4 * lane + 2], c3 = sh[4 * lane + 3];
            const unsigned s = c0 + c1 + c2 + c3; unsigned S = s;
#pragma unroll
            for (int d = 1; d < 64; d <<= 1) { const unsigned v = __shfl_down(S, d); if (lane + d < 64) S += v; }
            const unsigned above = S - s;
            if (S >= need && above < need) { unsigned cum = above, bin, nd;
                if (cum + c3 >= need) { bin = 3; nd = need - cum; } else { cum += c3;
                if (cum + c2 >= need) { bin = 2; nd = need - cum; } else { cum += c2;
                if (cum + c1 >= need) { bin = 1; nd = need - cum; } else { cum += c1; bin = 0; nd = need - cum; } } }
                sh[256] = 4u * lane + bin; sh[257] = nd; }
        }
        __syncthreads();
        prefix |= sh[256] << shift; mask |= 255u << shift; need = sh[257];
        __syncthreads();
    }
    unsigned cg = 0u, ce = 0u;
#pragma unroll
    for (int j = 0; j < 8; ++j) { cg += key[j] > prefix ? 1u : 0u; ce += key[j] == prefix ? 1u : 0u; }
    unsigned pk = (cg << 16) | ce, inc = pk;
#pragma unroll
    for (int d = 1; d < 64; d <<= 1) { const unsigned v = __shfl_up(inc, d); if (lane >= d) inc += v; }
    if (lane == 63) sh[264 + wid] = inc;
    __syncthreads();
    unsigned off = 0u;
#pragma unroll
    for (int w = 0; w < 8; ++w) off += (w < wid) ? sh[264 + w] : 0u;
    unsigned ex = off + inc - pk; unsigned gtb = ex >> 16, eqb = ex & 0xffffu;
    int* inv = (int*)(p.ws + WS_INV) + (size_t)(b * L + tid * 8) * 16 + e; int* idx = (int*)(p.ws + WS_IDX) + (size_t)(e * 4 + b) * CAP;
#pragma unroll
    for (int j = 0; j < 8; ++j) { const bool gt = key[j] > prefix, eq = key[j] == prefix; const bool sel = gt || (eq && eqb < need);
        const unsigned slot = gtb + (eqb < need ? eqb : need);
        inv[(size_t)j * 16] = sel ? (int)slot : -1; if (sel) idx[slot] = tid * 8 + j;
        gtb += gt ? 1u : 0u; eqb += eq ? 1u : 0u; }
    __syncthreads();
}

__device__ __forceinline__ f32x4 ld_bf16x4(const bf16* s) { const unsigned long long w = *(const unsigned long long*)s; const unsigned lo = (unsigned)w, hi2 = (unsigned)(w >> 32);
    return (f32x4){__uint_as_float(lo << 16), __uint_as_float(lo & 0xffff0000u), __uint_as_float(hi2 << 16), __uint_as_float(hi2 & 0xffff0000u)}; }
__device__ __forceinline__ void st_bf16x4(bf16* d, const f32x4& h) { *(unsigned long long*)d = (unsigned long long)pk2(h[0], h[1]) | ((unsigned long long)pk2(h[2], h[3]) << 32); }
struct P6In { f32x4 x[8]; unsigned long long y[8]; float ssq; };
__device__ __forceinline__ void p6_fetch(const Ptrs& p, int row, int lane, P6In& in) {
    const float* xr = p.x + (size_t)row * D + lane * 4; const bf16* y = (const bf16*)(p.ws + WS_Y) + (size_t)row * D + lane * 4;
#pragma unroll
    for (int j = 0; j < 8; ++j) { in.x[j] = *(const f32x4*)(xr + j * 256); in.y[j] = *(const unsigned long long*)(y + j * 256); }
    in.ssq = lane < 32 ? ((const float*)(p.ws + WS_SSQY))[(size_t)row * 32 + lane] : 0.f;
}
__device__ __forceinline__ f32x4 bf16x4_to_f32(unsigned long long w) { const unsigned lo = (unsigned)w, hi2 = (unsigned)(w >> 32);
    return (f32x4){__uint_as_float(lo << 16), __uint_as_float(lo & 0xffff0000u), __uint_as_float(hi2 << 16), __uint_as_float(hi2 & 0xffff0000u)}; }
__device__ __forceinline__ void p6_row(const Ptrs& p, int row, int lane, const LAS float* wt, const LAS float* vt, const P6In& in, int flags) {
    const float rsy = rsqrtf(wave_sum(in.ssq) * (1.f / D) + EPS);
    float* o = ((flags & 1) ? (float*)(p.ws + WS_S) : p.out) + (size_t)row * D;
    f32x4 v[8]; float s = 0.f;
#pragma unroll
    for (int j = 0; j < 8; ++j) { const int c = j * 256 + lane * 4;
        v[j] = in.x[j] + (bf16x4_to_f32(in.y[j]) * rsy) * *(const LAS f32x4*)(vt + c);
        *(f32x4*)(o + c) = v[j]; s += dot4(v[j]); }
    const float rs = rsqrtf(wave_sum(s) * (1.f / D) + EPS);
    bf16* h2 = (bf16*)(p.ws + ((flags & 1) ? WS_VN : WS_H2)) + (size_t)row * D;
    float lg[16];
#pragma unroll
    for (int e = 0; e < 16; ++e) lg[e] = 0.f;
    f32x4 hv[8];
#pragma unroll
    for (int j = 0; j < 8; ++j) { const int c = j * 256 + lane * 4;
        hv[j] = v[j] * rs * *(const LAS f32x4*)(vt + 2048 + c) + *(const LAS f32x4*)(vt + 4096 + c);
        if constexpr (FP8_MOE) *(unsigned*)((unsigned char*)(p.ws + ((flags & 1) ? WS_VN : WS_H2)) + (size_t)row * D + c) = pack4_fp8(hv[j][0], hv[j][1], hv[j][2], hv[j][3]); else st_bf16x4(h2 + c, hv[j]); }
    if (!(flags & 2)) {
        f32x4 wa[8], wb[8];
#define RLOAD(dst, st) do { const LAS float* wp_ = wt + ((st) & 1) * 8 * 2048 + ((st) >> 1) * 256 + lane * 4; _Pragma("unroll") for (int e_ = 0; e_ < 8; ++e_) dst[e_] = *(const LAS f32x4*)(wp_ + e_ * 2048); } while (0)
#define RFMA(src, st) do { const f32x4 h_ = hv[(st) >> 1]; _Pragma("unroll") for (int e_ = 0; e_ < 8; ++e_) lg[((st) & 1) * 8 + e_] += (h_[0] * src[e_][0] + h_[1] * src[e_][1]) + (h_[2] * src[e_][2] + h_[3] * src[e_][3]); } while (0)
        RLOAD(wa, 0);
#pragma unroll
        for (int st = 0; st < 16; st += 2) {
            RLOAD(wb, st + 1); __builtin_amdgcn_sched_barrier(0); RFMA(wa, st); __builtin_amdgcn_sched_barrier(0);
            if (st + 2 < 16) RLOAD(wa, st + 2); __builtin_amdgcn_sched_barrier(0); RFMA(wb, st + 1); __builtin_amdgcn_sched_barrier(0);
        }
#undef RLOAD
#undef RFMA
    }
#define XSTEP(N, MASK) _Pragma("unroll") for (int i = 0; i < N; ++i) { const bool up = (lane & MASK) != 0; const float send = up ? lg[i] : lg[i + N]; const float keep = up ? lg[i + N] : lg[i]; lg[i] = keep + __shfl_xor(send, MASK); }
    XSTEP(8, 32) XSTEP(4, 16) XSTEP(2, 8) XSTEP(1, 4)
#undef XSTEP
    float lgt = lg[0]; lgt += __shfl_xor(lgt, 2); lgt += __shfl_xor(lgt, 1);
    lgt += p.b_router[lane >> 2];
    float mx = lgt;
#pragma unroll
    for (int o2 = 4; o2 < 64; o2 <<= 1) mx = fmaxf(mx, __shfl_xor(mx, o2));
    const float ex = __expf(lgt - mx); float se = ex;
#pragma unroll
    for (int o2 = 4; o2 < 64; o2 <<= 1) se += __shfl_xor(se, o2);
    if ((lane & 3) == 0 && !(flags & 1)) ((float*)(p.ws + WS_AFF))[(size_t)row * 16 + (lane >> 2)] = ex / se;
}
typedef unsigned u32x4v __attribute__((ext_vector_type(4)));
struct P11In { f32x4 x[8]; int inv; float aff; };
__device__ __forceinline__ void p11_fetch(const Ptrs& p, int row, int lane, P11In& in) {
    const float* xr = p.out + (size_t)row * D + lane * 8;
#pragma unroll
    for (int j = 0; j < 4; ++j) { in.x[2 * j] = *(const f32x4*)(xr + j * 512); in.x[2 * j + 1] = *(const f32x4*)(xr + j * 512 + 4); }
    in.inv = ((const int*)(p.ws + WS_INV))[(size_t)row * 16 + (lane & 15)]; in.aff = ((const float*)(p.ws + WS_AFF))[(size_t)row * 16 + (lane & 15)];
}
__device__ __forceinline__ void acc_bf16x8(f32x4& a, f32x4& b, const u32x4v& w, float g) {
    a[0] += g * __uint_as_float(w[0] << 16); a[1] += g * __uint_as_float(w[0] & 0xffff0000u); a[2] += g * __uint_as_float(w[1] << 16); a[3] += g * __uint_as_float(w[1] & 0xffff0000u);
    b[0] += g * __uint_as_float(w[2] << 16); b[1] += g * __uint_as_float(w[2] & 0xffff0000u); b[2] += g * __uint_as_float(w[3] << 16); b[3] += g * __uint_as_float(w[3] & 0xffff0000u);
}
__device__ __forceinline__ void p11_row(const Ptrs& p, int row, int lane, float* dsto, const LAS float* vt, const P11In& in, int flags) {
    const int b = row >> 12;
    unsigned mask = (flags & 2) ? 0u : (unsigned)(__ballot(in.inv >= 0) & 0xffffull);
    f32x4 v[8];
#pragma unroll
    for (int j = 0; j < 8; ++j) v[j] = (f32x4){0.f, 0.f, 0.f, 0.f};
    while (mask) {
        u32x4v r[4][4]; float g[4]; bool on[4];
#pragma unroll
        for (int k = 0; k < 4; ++k) { on[k] = mask != 0u; g[k] = 0.f;
            if (on[k]) { const int e = __builtin_ctz(mask); mask &= mask - 1u; const int sl = __builtin_amdgcn_readlane(in.inv, e); g[k] = __int_as_float(__builtin_amdgcn_readlane(__float_as_int(in.aff), e));
                const bf16* ye = (const bf16*)(p.ws + WS_YE) + ((size_t)(e * 4 + b) * CAP + sl) * D + lane * 8;
#pragma unroll
                for (int j = 0; j < 4; ++j) r[k][j] = *(const u32x4v*)(ye + j * 512); } }
#pragma unroll
        for (int k = 0; k < 4; ++k) if (on[k]) {
#pragma unroll
            for (int j = 0; j < 4; ++j) acc_bf16x8(v[2 * j], v[2 * j + 1], r[k][j], g[k]); }
    }
    float s = 0.f;
#pragma unroll
    for (int j = 0; j < 8; ++j) s += dot4(v[j]);
    const float rs = rsqrtf(wave_sum(s) * (1.f / D) + EPS);
    float* od = dsto + (size_t)row * D + lane * 8;
#pragma unroll
    for (int j = 0; j < 4; ++j) { const int c = j * 512 + lane * 8;
        *(f32x4*)(od + j * 512) = in.x[2 * j] + (v[2 * j] * rs) * *(const LAS f32x4*)(vt + c);
        *(f32x4*)(od + j * 512 + 4) = in.x[2 * j + 1] + (v[2 * j + 1] * rs) * *(const LAS f32x4*)(vt + c + 4); }
}

struct Args { Ptrs p; int ph_lo, ph_hi, bar_idx, pad; };
#ifdef DUP_PHASE
#define PROBE_FLAGS args.pad
#else
#define PROBE_FLAGS 0
#endif
__global__ void __launch_bounds__(NTHREADS, 2) fwd(Args args) {
    extern __shared__ __attribute__((aligned(16))) unsigned char lds_raw[];
    LAS unsigned char* lds = (LAS unsigned char*)lds_raw;
#if defined(__HIP_DEVICE_COMPILE__)
    typedef __attribute__((address_space(4))) const Args CArgs;
#define LOADP() Ptrs p; { const CArgs* kp_ = (const CArgs*)__builtin_amdgcn_kernarg_segment_ptr(); asm volatile("" : "+s"(kp_)); p = kp_->p; }
#else
#define LOADP() Ptrs p = args.p;
#endif
#define TIDS() int tid = threadIdx.x; asm volatile("" : "+v"(tid)); const int lane = tid & 63, wave = __builtin_amdgcn_readfirstlane(tid >> 6); \
    const int G = gridDim.x, bx = blockIdx.x, vcu = (G % 8 == 0) ? (bx % 8) * (G / 8) + bx / 8 : bx; const int gw = vcu * NWAVES + wave, NGW = G * NWAVES; (void)lane; (void)gw; (void)NGW; (void)vcu; (void)bx;
    volatile LAS unsigned* MISC = (volatile LAS unsigned*)(lds + MISC_OFF);
    if (threadIdx.x < 64) MISC[threadIdx.x] = 0u;
    __syncthreads();
#if defined(__HIP_DEVICE_COMPILE__)
#define ARGF(f) ([&]() { const CArgs* kq_ = (const CArgs*)__builtin_amdgcn_kernarg_segment_ptr(); asm volatile("" : "+s"(kq_)); return kq_->f; }())
#else
#define ARGF(f) (args.f)
#endif
    if (ARGF(ph_hi) - ARGF(ph_lo) > 1) { LOADP(); (void)xcd_barrier_post((unsigned*)(p.ws + WS_CTL) + CW_BAR + ARGF(bar_idx) * 4096, MISC + 8); }
#define GRID_BARRIER() do { LOADP(); XcdBarrier b_; b_.bar = (unsigned*)(p.ws + WS_CTL) + CW_BAR + ARGF(bar_idx) * 4096; b_.x = xb_xcc_id(); b_.st = (volatile LAS unsigned*)(lds + MISC_OFF) + 8; xcd_barrier(b_); } while (0)
#define lo ARGF(ph_lo)
#define hi ARGF(ph_hi)
#if defined(ONLY_SET)
#define IN(k) (((ONLY_SET >> (k)) & 1) && lo <= (k) && (k) < hi)
#elif defined(ONLY_PHASE)
#define IN(k) ((k) == ONLY_PHASE && lo <= (k) && (k) < hi)
#else
#define IN(k) (lo <= (k) && (k) < hi)
#endif
#define SEAM(k) do { if (IN(k) && IN((k) + 1)) GRID_BARRIER(); } while (0)

    if (IN(0)) { LOADP(); TIDS();
        LAS float* scr = (LAS float*)(lds + wave * 8448);
        for (int it = gw; it < P0_ITEMS; it += NGW) p0_item(p, it, scr, lane);
    }
    SEAM(0);
    if (IN(1)) { LOADP(); TIDS();
        const int gid = bx * NTHREADS + tid;
        if (gid < 5 * 12288) { const int r = gid / 12288, j = gid - r * 12288; float s = p.b_ada[j]; const float* part = (const float*)(p.ws + WS_PART) + (size_t)r * 12288 + j;
            for (int kc = 0; kc < 32; ++kc) s += part[(size_t)kc * 5 * 12288];
            ((float*)(p.ws + WS_MOD))[gid] = s; }
    }
    SEAM(1);
    if (IN(2)) { LOADP(); TIDS();
        const int bsel = vcu & 3, wsub = (vcu >> 2) * NWAVES + wave, nsub = ((G + 3 - bsel) >> 2) * NWAVES;
        LAS float* vt = (LAS float*)lds;
        for (int c = tid; c < D; c += NTHREADS) { const float* mb = (const float*)(p.ws + WS_MOD) + bsel * 12288; const float* mc = (const float*)(p.ws + WS_MOD) + 4 * 12288; const float g = p.pre_norm1[c];
            vt[c] = g * (1.f + mb[2048 + c]); vt[2048 + c] = mb[c]; vt[4096 + c] = g * (1.f + mc[2048 + c]); vt[6144 + c] = mc[c]; }
        LDS_WAIT(); __syncthreads();
        for (int r = wsub; r < L; r += nsub) p1_row(p, bsel * L + r, lane, vt, vt + 2048);
        for (int row = M + gw; row < MALL; row += NGW) p1_row(p, row, lane, vt + 4096, vt + 6144);
        __syncthreads();
    }
    SEAM(2);
    if (IN(3)) { LOADP(); TIDS();
        SchedIn S{(const char*)(p.ws + WS_H), (const char*)(p.ws + WS_WIN_T), G, bx}; EpiIn E{p.ws};
        pg8::gemm_phase<EpiIn, SchedIn>(lds, 2048, S, E);
        if (G == 256 && bx >= 76) { const int base = PX_R3 + (bx - 76) * PX_N3; px_convert(p, base + wave, NWAVES, base + PX_N3, (LAS float*)(lds + wave * 16384), lane); __syncthreads(); }
    }
    SEAM(3);
    if (IN(4)) { LOADP(); TIDS();
        SchedQKV S{(const char*)(p.ws + WS_CQKV), (const char*)(p.ws + WS_WQKV_T), G, bx};
        LAS float* rstab = (LAS float*)(lds + TAB_OFF);
        for (int q = tid; q < 2048; q += NTHREADS) { const int i = q >> 8, r = q & 255; Unit u;
            if (S.next(i, u)) { const float* sp = u.pm < 64 ? (const float*)(p.ws + WS_SSQQ) + (size_t)(u.pm * 256 + r) * 8 : (const float*)(p.ws + WS_SSQKV) + (size_t)((u.pm - 64) * 256 + r) * 8;
                const f32x4 s0 = *(const f32x4*)sp, s1 = *(const f32x4*)(sp + 4);
                rstab[q] = rsqrtf((((s0[0] + s0[1]) + (s0[2] + s0[3])) + ((s1[0] + s1[1]) + (s1[2] + s1[3]))) * (1.f / 512.f) + EPS); } }
        LDS_WAIT(); __syncthreads();
        EpiQKV E{p.ws, rstab};
        pg8::gemm_phase<EpiQKV, SchedQKV>(lds, 512, S, E);
        if (G == 256 && bx >= 160) { const int base = PX_R4 + (bx - 160) * PX_N4; px_convert(p, base + wave, NWAVES, base + PX_N4, (LAS float*)(lds + wave * 16384), lane); }
        __syncthreads();
        for (int u = vcu; u < 1024; u += G) sgu_unit(p, u >> 3, u & 7, lds, tid);
    }
    SEAM(4);
    if (IN(5)) { TIDS();
        const int grp = vcu % 3;
#ifdef PX_TWICE
#define PX_REP 2
#else
#define PX_REP 1
#endif
#define PX_CONV(g) do { if (grp == (g)) { LOADP(); __syncthreads(); for (int rep_ = 0; rep_ < PX_REP; ++rep_) px_convert(p, (G == 256 ? PX_R5 : 0) + gw, NGW, PX_ITEMS, (LAS float*)(lds + wave * 16384), lane); __syncthreads(); } } while (0)
#define ATT_UNIT(u_) do { const int u = (u_); if (u < 512) { LOADP(); const int bh = u >> 4, qb = u & 15; __syncthreads(); \
            att::attn_unit<0>((const bf16*)(p.ws + WS_Q) + ((size_t)bh * L + qb * 256) * DQK, (const bf16*)(p.ws + WS_K) + (size_t)bh * LK * DQK, (const bf16*)(p.ws + WS_V) + (size_t)bh * LK * VH, \
                           (bf16*)(p.ws + WS_CAT) + ((size_t)(bh >> 3) * L + qb * 256) * D + (bh & 7) * 128, LK, (char*)lds_raw); } } while (0)
        PX_CONV(0); ATT_UNIT(vcu); PX_CONV(1); ATT_UNIT(vcu + G); PX_CONV(2);
        for (int u = vcu + 2 * G; u < 512; u += G) ATT_UNIT(u);
#undef PX_CONV
#undef ATT_UNIT
        __syncthreads();
    }
    SEAM(5);
    if (IN(6)) { LOADP(); TIDS();
        typedef SchedDense<64, 8, 31, 2048> SD; SD S{(const char*)(p.ws + WS_CAT), (const char*)(p.ws + WS_WOUT_T), G, bx}; EpiY E{p.ws};
        pg8::gemm_phase<EpiY, SD>(lds, 2048, S, E);
    }
    SEAM(6);
    if (IN(7)) { LOADP(); TIDS();
        LAS float* wt = (LAS float*)lds;
        for (int c = tid; c < D; c += NTHREADS) { const float* wr = p.w_router + (size_t)c * 16;
#pragma unroll
            for (int q = 0; q < 4; ++q) { const f32x4 w = *(const f32x4*)(wr + q * 4);
#pragma unroll
                for (int t = 0; t < 4; ++t) wt[(q * 4 + t) * 2048 + c] = w[t]; } }
        LDS_WAIT(); __syncthreads();
        const int bsel = vcu & 3, wsub = (vcu >> 2) * NWAVES + wave, nsub = ((G + 3 - bsel) >> 2) * NWAVES;
        LAS float* vt = (LAS float*)(lds + VEC_OFF);
        for (int c = tid; c < D; c += NTHREADS) { const float* mb = (const float*)(p.ws + WS_MOD) + bsel * 12288;
            vt[c] = mb[4096 + c] * p.post_norm1[c]; vt[2048 + c] = p.pre_norm2[c] * (1.f + mb[8192 + c]); vt[4096 + c] = mb[6144 + c]; }
        LDS_WAIT(); __syncthreads();
        { P6In nxt; if (wsub < L) p6_fetch(p, bsel * L + wsub, lane, nxt);
          for (int r = wsub; r < L; r += nsub) { const P6In cur = nxt; if (r + nsub < L) p6_fetch(p, bsel * L + r + nsub, lane, nxt);
              p6_row(p, bsel * L + r, lane, wt, vt, cur, PROBE_FLAGS); } }
        __syncthreads();
    }
    SEAM(7);
    if (IN(8)) { LOADP(); TIDS(); for (int u = bx; u < 64; u += G) topk_unit(p, u >> 2, u & 3, (LAS unsigned*)lds, tid);
        if (G == 256 && bx >= 64) { const int base = PX_R8 + (bx - 64) * PX_N8; px_convert(p, base + wave, NWAVES, base + PX_N8, (LAS float*)(lds + wave * 16384), lane); } }
    SEAM(8);
    if (IN(9)) { LOADP(); TIDS();
        constexpr int KU = FP8_MOE ? 1024 : 2048;
        typedef SchedGather<KU> SG; SG S{(const char*)(p.ws + WS_H2), (const char*)(p.ws + WS_WGU_T), G, bx, (const LAS unsigned*)(lds + TAB_OFF)};
        for (int q = tid; q < 2048; q += NTHREADS) { const int i = q >> 8, r = q & 255; Unit u;
            if (S.next(i, u)) { const int e = u.pm >> 3, m = (u.pm & 7) * 256 + r, b = m >> 9; const int tok = ((const int*)(p.ws + WS_IDX))[(size_t)(e * 4 + b) * CAP + (m & 511)];
                ((LAS unsigned*)(lds + TAB_OFF))[q] = (unsigned)(b * L + tok) * (unsigned)(KU * 2); } }
        LDS_WAIT(); __syncthreads();
        if constexpr (FP8_MOE) { EpiAct8 E{p.ws}; pg8::gemm_phase<EpiAct8, SG, true>(lds, KU, S, E); }
        else { EpiAct E{p.ws}; pg8::gemm_phase<EpiAct, SG, false>(lds, KU, S, E); }
    }
    SEAM(9);
    if (IN(10)) { LOADP(); TIDS();
        constexpr int KU = FP8_MOE ? 1024 : 2048;
        typedef SchedDense<128, 8, 3, KU> SD; SD S{(const char*)(p.ws + WS_ACT), (const char*)(p.ws + WS_WD_T), G, bx};
        if constexpr (FP8_MOE) { EpiYE8 E{p.ws}; pg8::gemm_phase<EpiYE8, SD, true>(lds, KU, S, E); }
        else { EpiYE E{p.ws}; pg8::gemm_phase<EpiYE, SD, false>(lds, KU, S, E); }
    }
    SEAM(10);
    if (IN(11)) { LOADP(); TIDS(); float* dsto = args.pad ? (float*)(p.ws + WS_S) : p.out;
        const int bsel = vcu & 3, wsub = (vcu >> 2) * NWAVES + wave, nsub = ((G + 3 - bsel) >> 2) * NWAVES;
        LAS float* vt = (LAS float*)(lds + VEC_OFF);
        for (int c = tid; c < D; c += NTHREADS) vt[c] = ((const float*)(p.ws + WS_MOD))[bsel * 12288 + 10240 + c] * p.post_norm2[c];
        LDS_WAIT(); __syncthreads();
        P11In nxt; if (wsub < L) p11_fetch(p, bsel * L + wsub, lane, nxt);
        for (int r = wsub; r < L; r += nsub) { const P11In cur = nxt; if (r + nsub < L) p11_fetch(p, bsel * L + r + nsub, lane, nxt); p11_row(p, bsel * L + r, lane, dsto, vt, cur, PROBE_FLAGS); } }
#ifdef PROBE_ATTN
    if (IN(12)) { TIDS();
        for (int u = vcu; u < 512; u += G) { LOADP(); const int bh = u >> 4, qb = u & 15; __syncthreads();
            att::attn_unit<PROBE_ATTN>((const bf16*)(p.ws + WS_Q) + ((size_t)bh * L + qb * 256) * DQK, (const bf16*)(p.ws + WS_K) + (size_t)bh * LK * DQK, (const bf16*)(p.ws + WS_V) + (size_t)bh * LK * VH,
                           (bf16*)(p.ws + WS_S) + ((size_t)(bh >> 3) * L + qb * 256) * D + (bh & 7) * 128, LK, (char*)lds_raw); }
        __syncthreads(); }
#endif
#undef IN
#undef SEAM
#undef lo
#undef hi
}

#ifndef PHASE_MODE
#define PHASE_MODE "FFFFFFFFFFFF"
#endif
#ifndef DUP_FLAGS
#define DUP_FLAGS 0
#endif
#ifndef MERGE
#define MERGE 1
#endif
template <class P> static void launch_ngemm(const P& f, int Mr, int Nr, int Z, hipStream_t s) { hipLaunchKernelGGL((ngemm<P>), dim3(Nr / 64, Mr / 64, Z), dim3(256), 0, s, f); }
static void naive_phase(int ph, const Ptrs& p, hipStream_t stream) {
    switch (ph) {
    case 0: hipLaunchKernelGGL(n_mod, dim3(48, 5), dim3(256), 0, stream, p); break;
    case 1: break;
    case 2: hipLaunchKernelGGL(n_hrows, dim3(MALL / 4), dim3(256), 0, stream, p); break;
    case 3: launch_ngemm(GIn{p, D}, MALL, 3136, 1, stream);
        hipLaunchKernelGGL(n_ssq, dim3(M / 4), dim3(256), 0, stream, (const bf16*)(p.ws + WS_CQKV), M, 512, (float*)(p.ws + WS_SSQQ), 8);
        hipLaunchKernelGGL(n_ssq, dim3(MALL / 4), dim3(256), 0, stream, (const bf16*)(p.ws + WS_CQKV) + (size_t)M * 512, MALL, 512, (float*)(p.ws + WS_SSQKV), 8); break;
    case 4: launch_ngemm(GQ{p, 512}, M, 1536, 1, stream); launch_ngemm(GKV{p, 512}, MALL, 2048, 1, stream);
        hipLaunchKernelGGL(n_vn, dim3(M * 8 / 4), dim3(256), 0, stream, p); launch_ngemm(GSgu{p, 128}, 128, 128, 1024, stream); break;
    case 5: for (int bh = 0; bh < B * H; ++bh) { launch_ngemm(GScore{p, DQK, bh}, L, LK, 1, stream);
            hipLaunchKernelGGL(n_softmax, dim3(L), dim3(256), 0, stream, (float*)(p.ws + WS_S), LK); launch_ngemm(GPV{p, LK, bh}, L, VH, 1, stream); } break;
    case 6: launch_ngemm(GOut{p, D}, M, D, 1, stream);
        hipLaunchKernelGGL(n_ssq, dim3(M / 4), dim3(256), 0, stream, (const bf16*)(p.ws + WS_Y), M, D, (float*)(p.ws + WS_SSQY), 32); break;
    case 7: hipLaunchKernelGGL(n_rowmid, dim3(M / 4), dim3(256), 0, stream, p); break;
    case 8: hipLaunchKernelGGL(n_topk, dim3(64), dim3(1024), 0, stream, p); break;
    case 9: launch_ngemm(GE1{p, D}, 2048, 4096, 16, stream); break;
    case 10: launch_ngemm(GE2{p, FF}, 2048, 2048, 16, stream); break;
    case 11: hipLaunchKernelGGL(n_rowfinal, dim3(M / 4), dim3(256), 0, stream, p); break;
    }
}
extern "C" void kernel_launch(void* const* d_in, const int* in_sizes, int n_in, void* d_out, int out_size, void* d_ws, size_t ws_size, hipStream_t stream) {
    static int grid = 0;
    if (grid == 0) {
        if (n_in != 24 || ws_size < WS_END || out_size != M * D) { fprintf(stderr, "kernel_launch: unexpected shapes n_in %d ws %zu out %d\n", n_in, ws_size, out_size); grid = -1; return; }
        int dev = 0, cus = 0, per_cu = 0;
        if (hipGetDevice(&dev) != hipSuccess || hipDeviceGetAttribute(&cus, hipDeviceAttributeMultiprocessorCount, dev) != hipSuccess) { grid = -1; return; }
        if (hipFuncSetAttribute((const void*)fwd, hipFuncAttributeMaxDynamicSharedMemorySize, LDS_BYTES) != hipSuccess) { fprintf(stderr, "kernel_launch: hipFuncSetAttribute failed\n"); grid = -1; return; }
        if (hipOccupancyMaxActiveBlocksPerMultiprocessor(&per_cu, (const void*)fwd, NTHREADS, LDS_BYTES) != hipSuccess || per_cu < 1) fprintf(stderr, "kernel_launch: occupancy query says %d\n", per_cu);
        (void)hipGetLastError();
        grid = cus;
    }
    if (grid < 0) return;
    Ptrs p{};
    const float** f = (const float**)&p;
    for (int i = 0; i < 24; ++i) f[i] = (const float*)d_in[i];
    p.out = (float*)d_out; p.ws = (unsigned char*)d_ws;
    (void)hipMemsetAsync(p.ws + WS_CTL, 0, 1 * MiB, stream);
    const char* mode = PHASE_MODE; int nbar = 0;
    for (int ph = 0; ph < 12;) {
#ifdef DUP_PHASE
        if (ph == 11 && DUP_PHASE == 11) { Args a2{}; a2.p = p; a2.ph_lo = 11; a2.ph_hi = 12; a2.bar_idx = nbar++; a2.pad = 1 | DUP_FLAGS; hipLaunchKernelGGL(fwd, dim3(grid), dim3(NTHREADS), LDS_BYTES, stream, a2); }
#endif
        if (mode[ph] == 'F') { int e = ph + 1; if (MERGE) while (e < 12 && mode[e] == 'F') ++e;
            Args a{}; a.p = p; a.ph_lo = ph; a.ph_hi = e; a.bar_idx = nbar++; a.pad = 0;
            hipLaunchKernelGGL(fwd, dim3(grid), dim3(NTHREADS), LDS_BYTES, stream, a);
            const hipError_t le = hipPeekAtLastError(); if (le != hipSuccess) fprintf(stderr, "kernel_launch: launch failed: %s\n", hipGetErrorName(le));
#ifdef PROBE_ATTN
            if (ph == 5) { Args a3 = a; a3.ph_lo = 12; a3.ph_hi = 13; a3.bar_idx = nbar++; hipLaunchKernelGGL(fwd, dim3(grid), dim3(NTHREADS), LDS_BYTES, stream, a3); }
#endif
#ifdef DUP_PHASE
            if (ph == DUP_PHASE && ph != 11) { Args a2 = a; a2.bar_idx = nbar++; a2.pad = DUP_FLAGS; hipLaunchKernelGGL(fwd, dim3(grid), dim3(NTHREADS), LDS_BYTES, stream, a2);
                if (ph == 11) hipLaunchKernelGGL(fwd, dim3(grid), dim3(NTHREADS), LDS_BYTES, stream, a2); }
#endif
            ph = e; }
        else { naive_phase(ph, p, stream); ++ph; }
    }
}
```

```cpp
#define PHASE_MODE "FFFFFFFFFFFF"
#define MERGE 1
#include <hip/hip_runtime.h>
#include <cstdio>
#include <cstdint>

typedef unsigned short bf16;
#ifndef FP8_MOE
#define FP8_MOE 1
#endif
namespace cfg {
constexpr int B = 4, L = 4096, D = 2048, CTX = 256, H = 8, LK = L + CTX;
constexpr int M = B * L;
constexpr int MC = B * CTX;
constexpr int MALL = M + MC;
constexpr int QL = 512, KVL = 512, NOPE = 128, ROPE = 64, VH = 128, DQK = 192;
constexpr int SGW = 1024, INC = 3136, OFF_KPE = 1024, OFF_U = 1088, OFF_V = 2112;
constexpr int NE = 16, CAP = 512, FF = 2048;
constexpr float EPS = 1e-6f;
constexpr float ATT_SCALE = 0.07216878364870322f;
constexpr size_t MiB = 1u << 20;
constexpr size_t WS_CTL = 0;
constexpr size_t WS_MOD = 1 * MiB;
constexpr size_t WS_SSQQ = 2 * MiB;
constexpr size_t WS_SSQKV = 3 * MiB;
constexpr size_t WS_SSQY = 4 * MiB;
constexpr size_t WS_AFF = 6 * MiB;
constexpr size_t WS_INV = 7 * MiB;
constexpr size_t WS_IDX = 8 * MiB;
constexpr size_t WS_WIN_T = 16 * MiB;
constexpr size_t WS_WQKV_T = 30 * MiB;
constexpr size_t WS_WOUT_T = 34 * MiB;
constexpr size_t WS_SGUW = 42 * MiB;
constexpr size_t WS_WGU_T = 64 * MiB;
constexpr size_t WS_WD_T = 320 * MiB;
constexpr size_t WS_H = 448 * MiB;
constexpr size_t WS_CQKV = 516 * MiB;
constexpr size_t WS_U = 549 * MiB;
constexpr size_t WS_VS = 581 * MiB;
constexpr size_t WS_Q = 613 * MiB;
constexpr size_t WS_K = 661 * MiB;
constexpr size_t WS_V = 712 * MiB;
constexpr size_t WS_CAT = 746 * MiB;
constexpr size_t WS_Y = 810 * MiB;
constexpr size_t WS_H2 = WS_CAT;
constexpr size_t WS_ACT = WS_H;
constexpr size_t WS_YE = WS_Q;
constexpr size_t WS_S = 874 * MiB;
constexpr size_t WS_VN = 942 * MiB;
constexpr size_t WS_ROPE = 9 * MiB;
constexpr size_t WS_PART = WS_S;
constexpr size_t WS_XN = WS_S;
constexpr size_t WS_END = 974 * MiB;
}
using namespace cfg;

__device__ __forceinline__ float bf2f(bf16 v) { return __uint_as_float(((unsigned)v) << 16); }
__device__ __forceinline__ bf16 f2bf(float f) { unsigned u = __float_as_uint(f); return (bf16)((u + 0x7fffu + ((u >> 16) & 1u)) >> 16); }
__device__ __forceinline__ float silu_f(float x) { return x / (1.f + __expf(-x)); }
__device__ __forceinline__ float gelu_tanh(float x) { const float z = 0.7978845608028654f * (x + 0.044715f * x * x * x); return 0.5f * x * (1.f + tanhf(z)); }
__device__ __forceinline__ float wave_sum(float v) {
#pragma unroll
    for (int o = 1; o < 64; o <<= 1) v += __shfl_xor(v, o);
    return v;
}
__device__ __forceinline__ float rope_inv(int ii) { return __expf(-(float)ii * (9.210340371976184f / 16.f)); }

struct Ptrs {
    const float *x, *c, *ctx, *c_ctx, *w_ada, *b_ada, *pre_norm1, *w_in, *q_norm_w, *w_uq, *kv_norm_w, *w_ukv, *sgu_norm_w, *sgu_w, *sgu_b, *w_out,
        *post_norm1, *pre_norm2, *w_router, *b_router, *w_e_gate, *w_e_up, *w_e_down, *post_norm2;
    float* out; unsigned char* ws;
};

__global__ void n_mod(Ptrs p) {
    const int j = blockIdx.x * 256 + threadIdx.x, r = blockIdx.y;
    const float* cv = r < 4 ? p.c + r * D : p.c_ctx;
    float s = 0.f;
    for (int k = 0; k < D; ++k) s += silu_f(cv[k]) * p.w_ada[(size_t)k * 12288 + j];
    ((float*)(p.ws + WS_MOD))[r * 12288 + j] = s + p.b_ada[j];
}
__global__ __launch_bounds__(256) void n_hrows(Ptrs p) {
    const int row = blockIdx.x * 4 + (threadIdx.x >> 6), lane = threadIdx.x & 63;
    if (row >= MALL) return;
    const float* src = row < M ? p.x + (size_t)row * D : p.ctx + (size_t)(row - M) * D;
    const int mr = row < M ? row >> 12 : 4;
    const float* mod = (const float*)(p.ws + WS_MOD) + mr * 12288;
    float v[32]; float s = 0.f;
    for (int j = 0; j < 32; ++j) { v[j] = src[j * 64 + lane]; s += v[j] * v[j]; }
    const float rs = rsqrtf(wave_sum(s) * (1.f / D) + EPS);
    bf16* o = (bf16*)(p.ws + WS_H) + (size_t)row * D;
    for (int j = 0; j < 32; ++j) { const int c = j * 64 + lane; o[c] = f2bf(v[j] * rs * p.pre_norm1[c] * (1.f + mod[2048 + c]) + mod[c]); }
}
template <class P> __global__ __launch_bounds__(256) void ngemm(P p) {
    __shared__ float As[16][65], Bs[16][65];
    const int tx = threadIdx.x & 15, ty = threadIdx.x >> 4, z = blockIdx.z;
    const int m0 = blockIdx.y * 64, n0 = blockIdx.x * 64;
    float acc[4][4] = {};
    for (int k0 = 0; k0 < p.K; k0 += 16) {
        for (int j = 0; j < 4; ++j) { const int idx = threadIdx.x + 256 * j; const int kk = idx & 15, mm = idx >> 4; As[kk][mm] = p.a(z, m0 + mm, k0 + kk); }
        for (int j = 0; j < 4; ++j) { const int idx = threadIdx.x + 256 * j; const int nn = idx & 63, kk = idx >> 6; Bs[kk][nn] = p.b(z, k0 + kk, n0 + nn); }
        __syncthreads();
#pragma unroll
        for (int kk = 0; kk < 16; ++kk) {
            float a[4], b[4];
#pragma unroll
            for (int i = 0; i < 4; ++i) { a[i] = As[kk][ty * 4 + i]; b[i] = Bs[kk][tx * 4 + i]; }
#pragma unroll
            for (int i = 0; i < 4; ++i)
#pragma unroll
                for (int j = 0; j < 4; ++j) acc[i][j] += a[i] * b[j];
        }
        __syncthreads();
    }
    for (int i = 0; i < 4; ++i) p.epi(z, m0 + ty * 4 + i, n0 + tx * 4, acc[i]);
}
__device__ __forceinline__ void rope_pair(float& x1, float& x2, int i, int pos) {
    const int ii = i & 15; const float ax = (float)((i >> 4) ? (pos & 63) : (pos >> 6));
    float s, c; sincosf(ax * rope_inv(ii), &s, &c);
    const float r1 = x1 * c - x2 * s, r2 = x2 * c + x1 * s; x1 = r1; x2 = r2;
}
struct GIn {
    Ptrs p; int K;
    __device__ float a(int, int m, int k) const { return bf2f(((const bf16*)(p.ws + WS_H))[(size_t)m * D + k]); }
    __device__ float b(int, int k, int n) const {
        int o; if (n < 1024) o = n; else if (n < 3072) o = n + 64; else { const int j = n - 3072, i = j >> 1, s = j & 1; o = OFF_KPE + (i >> 4) * 32 + s * 16 + (i & 15); }
        return p.w_in[(size_t)k * INC + o];
    }
    __device__ void epi(int, int m, int n0, const float* v) const {
        bf16* CQ = (bf16*)(p.ws + WS_CQKV); bf16* CKV = CQ + (size_t)M * 512;
        if (n0 < 512) { if (m < M) for (int j = 0; j < 4; ++j) CQ[(size_t)m * 512 + n0 + j] = f2bf(v[j]); }
        else if (n0 < 1024) { for (int j = 0; j < 4; ++j) CKV[(size_t)m * 512 + n0 - 512 + j] = f2bf(v[j]); }
        else if (n0 < 2048) { if (m < M) for (int j = 0; j < 4; ++j) ((bf16*)(p.ws + WS_U))[(size_t)m * 1024 + n0 - 1024 + j] = f2bf(gelu_tanh(v[j])); }
        else if (n0 < 3072) { if (m < M) for (int j = 0; j < 4; ++j) ((bf16*)(p.ws + WS_VS))[(size_t)m * 1024 + n0 - 2048 + j] = f2bf(gelu_tanh(v[j])); }
        else {
            const int jj = n0 - 3072; bf16* Kb = (bf16*)(p.ws + WS_K);
            for (int q = 0; q < 2; ++q) {
                const int i = (jj >> 1) + q; float x1 = v[2 * q], x2 = v[2 * q + 1]; int b, kpos;
                if (m < M) { b = m >> 12; kpos = m & 4095; rope_pair(x1, x2, i, kpos); } else { b = (m - M) >> 8; kpos = L + ((m - M) & 255); }
                for (int hh = 0; hh < H; ++hh) { bf16* d = Kb + ((size_t)(b * H + hh) * LK + kpos) * DQK + 128 + 2 * i; d[0] = f2bf(x1); d[1] = f2bf(x2); }
            }
        }
    }
};
__global__ void n_ssq(const bf16* T, int rows, int cols, float* out, int nslots) {
    const int row = blockIdx.x * 4 + (threadIdx.x >> 6), lane = threadIdx.x & 63;
    if (row >= rows) return;
    float s = 0.f; for (int c = lane; c < cols; c += 64) { const float v = bf2f(T[(size_t)row * cols + c]); s += v * v; }
    s = wave_sum(s);
    if (lane < nslots) out[(size_t)row * nslots + lane] = lane == 0 ? s : 0.f;
}
__device__ __forceinline__ float sum_slots(const float* s, int n) { float t = 0.f; for (int i = 0; i < n; ++i) t += s[i]; return t; }
struct GQ {
    Ptrs p; int K;
    __device__ float a(int, int m, int k) const { return bf2f(((const bf16*)(p.ws + WS_CQKV))[(size_t)m * 512 + k]); }
    __device__ float b(int, int k, int n) const {
        int o; if (n < 1024) o = (n >> 7) * DQK + (n & 127); else { const int jj = n - 1024, hd = jj >> 6, j6 = jj & 63, i = j6 >> 1, s = j6 & 1; o = hd * DQK + 128 + (i >> 4) * 32 + s * 16 + (i & 15); }
        return p.w_uq[(size_t)k * 1536 + o] * p.q_norm_w[k];
    }
    __device__ void epi(int, int m, int n0, const float* v) const {
        const float rs = rsqrtf(sum_slots((const float*)(p.ws + WS_SSQQ) + (size_t)m * 8, 8) * (1.f / 512.f) + EPS);
        const int b = m >> 12, t = m & 4095; bf16* Qb = (bf16*)(p.ws + WS_Q);
        if (n0 < 1024) { const int hd = n0 >> 7, d = n0 & 127; for (int j = 0; j < 4; ++j) Qb[((size_t)(b * H + hd) * L + t) * DQK + d + j] = f2bf(v[j] * rs); }
        else { const int jj = n0 - 1024, hd = jj >> 6, j6 = jj & 63;
            for (int q = 0; q < 2; ++q) { const int i = (j6 >> 1) + q; float x1 = v[2 * q] * rs, x2 = v[2 * q + 1] * rs; rope_pair(x1, x2, i, t);
                bf16* d = Qb + ((size_t)(b * H + hd) * L + t) * DQK + 128 + 2 * i; d[0] = f2bf(x1); d[1] = f2bf(x2); } }
    }
};
struct GKV {
    Ptrs p; int K;
    __device__ float a(int, int m, int k) const { return bf2f(((const bf16*)(p.ws + WS_CQKV))[(size_t)(M + m) * 512 + k]); }
    __device__ float b(int, int k, int n) const { return p.w_ukv[(size_t)k * 2048 + n] * p.kv_norm_w[k]; }
    __device__ void epi(int, int m, int n0, const float* v) const {
        const float rs = rsqrtf(sum_slots((const float*)(p.ws + WS_SSQKV) + (size_t)m * 8, 8) * (1.f / 512.f) + EPS);
        int b, kpos; if (m < M) { b = m >> 12; kpos = m & 4095; } else { b = (m - M) >> 8; kpos = L + ((m - M) & 255); }
        const int hd = n0 >> 8, c = n0 & 255;
        if (c < 128) { bf16* d = (bf16*)(p.ws + WS_K) + ((size_t)(b * H + hd) * LK + kpos) * DQK + c; for (int j = 0; j < 4; ++j) d[j] = f2bf(v[j] * rs); }
        else { bf16* d = (bf16*)(p.ws + WS_V) + ((size_t)(b * H + hd) * LK + kpos) * VH + c - 128; for (int j = 0; j < 4; ++j) d[j] = f2bf(v[j] * rs); }
    }
};
__global__ void n_vn(Ptrs p) {
    const int w = blockIdx.x * 4 + (threadIdx.x >> 6), lane = threadIdx.x & 63;
    const int tok = w >> 3, g = w & 7;
    const bf16* s = (const bf16*)(p.ws + WS_VS) + (size_t)tok * 1024 + g * 128;
    const float a = bf2f(s[lane]), b = bf2f(s[lane + 64]);
    const float mu = wave_sum(a + b) * (1.f / 128.f);
    const float da = a - mu, db = b - mu;
    const float rs = rsqrtf(wave_sum(da * da + db * db) * (1.f / 128.f) + EPS);
    bf16* o = (bf16*)(p.ws + WS_VN) + (size_t)tok * 1024 + g * 128;
    o[lane] = f2bf(da * rs * p.sgu_norm_w[g * 128 + lane]); o[lane + 64] = f2bf(db * rs * p.sgu_norm_w[g * 128 + lane + 64]);
}
struct GSgu {
    Ptrs p; int K;
    __device__ float a(int z, int m, int k) const { return p.sgu_w[((size_t)(z & 7) * 128 + m) * 128 + k]; }
    __device__ float b(int z, int k, int n) const { return bf2f(((const bf16*)(p.ws + WS_VN))[(size_t)((z >> 3) * 128 + k) * 1024 + (z & 7) * 128 + n]); }
    __device__ void epi(int z, int m, int n0, const float* v) const {
        const int g = z & 7; const size_t row = (size_t)(z >> 3) * 128 + m; const float bias = p.sgu_b[g * 128 + m];
        for (int j = 0; j < 4; ++j) { const float u = bf2f(((const bf16*)(p.ws + WS_U))[row * 1024 + g * 128 + n0 + j]);
            ((bf16*)(p.ws + WS_CAT))[row * D + 1024 + g * 128 + n0 + j] = f2bf(u * (v[j] + bias)); }
    }
};
struct GScore {
    Ptrs p; int K; int bh;
    __device__ float a(int, int m, int k) const { return bf2f(((const bf16*)(p.ws + WS_Q))[((size_t)bh * L + m) * DQK + k]); }
    __device__ float b(int, int k, int n) const { return bf2f(((const bf16*)(p.ws + WS_K))[((size_t)bh * LK + n) * DQK + k]); }
    __device__ void epi(int, int m, int n0, const float* v) const { float* S = (float*)(p.ws + WS_S) + (size_t)m * LK + n0; for (int j = 0; j < 4; ++j) S[j] = v[j] * ATT_SCALE; }
};
__global__ void n_softmax(float* S, int cols) {
    float* r = S + (size_t)blockIdx.x * cols; __shared__ float red[4];
    float mx = -1e30f; for (int c = threadIdx.x; c < cols; c += 256) mx = fmaxf(mx, r[c]);
    for (int o = 1; o < 64; o <<= 1) mx = fmaxf(mx, __shfl_xor(mx, o));
    if ((threadIdx.x & 63) == 0) red[threadIdx.x >> 6] = mx; __syncthreads();
    mx = fmaxf(fmaxf(red[0], red[1]), fmaxf(red[2], red[3])); __syncthreads();
    float s = 0.f; for (int c = threadIdx.x; c < cols; c += 256) { const float e = __expf(r[c] - mx); r[c] = e; s += e; }
    s = wave_sum(s); if ((threadIdx.x & 63) == 0) red[threadIdx.x >> 6] = s; __syncthreads();
    s = (red[0] + red[1]) + (red[2] + red[3]); const float inv = 1.f / s;
    for (int c = threadIdx.x; c < cols; c += 256) r[c] *= inv;
}
struct GPV {
    Ptrs p; int K; int bh;
    __device__ float a(int, int m, int k) const { return ((const float*)(p.ws + WS_S))[(size_t)m * LK + k]; }
    __device__ float b(int, int k, int n) const { return bf2f(((const bf16*)(p.ws + WS_V))[((size_t)bh * LK + k) * VH + n]); }
    __device__ void epi(int, int m, int n0, const float* v) const { bf16* d = (bf16*)(p.ws + WS_CAT) + ((size_t)(bh >> 3) * L + m) * D + (bh & 7) * 128 + n0; for (int j = 0; j < 4; ++j) d[j] = f2bf(v[j]); }
};
struct GOut {
    Ptrs p; int K;
    __device__ float a(int, int m, int k) const { return bf2f(((const bf16*)(p.ws + WS_CAT))[(size_t)m * D + k]); }
    __device__ float b(int, int k, int n) const { return p.w_out[(size_t)k * D + n]; }
    __device__ void epi(int, int m, int n0, const float* v) const { bf16* d = (bf16*)(p.ws + WS_Y) + (size_t)m * D + n0; for (int j = 0; j < 4; ++j) d[j] = f2bf(v[j]); }
};
__device__ __forceinline__ void row_pass_mid(const Ptrs& p, int row, int lane) {
    const int b = row >> 12; const float* mod = (const float*)(p.ws + WS_MOD) + b * 12288;
    const float ssq = wave_sum(lane < 32 ? ((const float*)(p.ws + WS_SSQY))[(size_t)row * 32 + lane] : 0.f);
    const float rsy = rsqrtf(ssq * (1.f / D) + EPS);
    const bf16* y = (const bf16*)(p.ws + WS_Y) + (size_t)row * D; const float* xr = p.x + (size_t)row * D; float* o = p.out + (size_t)row * D;
    float v[32]; float s = 0.f;
    for (int j = 0; j < 32; ++j) { const int c = j * 64 + lane; v[j] = xr[c] + mod[4096 + c] * (bf2f(y[c]) * rsy * p.post_norm1[c]); o[c] = v[j]; s += v[j] * v[j]; }
    const float rs = rsqrtf(wave_sum(s) * (1.f / D) + EPS);
    bf16* h2 = (bf16*)(p.ws + WS_H2) + (size_t)row * D; float lg[16];
    for (int e = 0; e < 16; ++e) lg[e] = 0.f;
    for (int j = 0; j < 32; ++j) { const int c = j * 64 + lane; const float h = v[j] * rs * p.pre_norm2[c] * (1.f + mod[8192 + c]) + mod[6144 + c]; h2[c] = f2bf(h);
        const float* wr = p.w_router + (size_t)c * 16; for (int e = 0; e < 16; ++e) lg[e] += h * wr[e]; }
    float mx = -1e30f;
    for (int e = 0; e < 16; ++e) { lg[e] = wave_sum(lg[e]) + p.b_router[e]; mx = fmaxf(mx, lg[e]); }
    float se = 0.f; for (int e = 0; e < 16; ++e) { lg[e] = __expf(lg[e] - mx); se += lg[e]; }
    const float inv = 1.f / se;
    if (lane < 16) { float val = 0.f; for (int e = 0; e < 16; ++e) val = (lane == e) ? lg[e] * inv : val; ((float*)(p.ws + WS_AFF))[(size_t)row * 16 + lane] = val; }
}
__global__ __launch_bounds__(256) void n_rowmid(Ptrs p) { const int row = blockIdx.x * 4 + (threadIdx.x >> 6); row_pass_mid(p, row, threadIdx.x & 63); }
__global__ void n_topk(Ptrs p) {
    __shared__ float vals[L];
    const int e = blockIdx.x >> 2, b = blockIdx.x & 3;
    const float* aff = (const float*)(p.ws + WS_AFF) + (size_t)b * L * 16 + e;
    for (int t = threadIdx.x; t < L; t += blockDim.x) vals[t] = aff[(size_t)t * 16];
    __syncthreads();
    for (int t = threadIdx.x; t < L; t += blockDim.x) {
        const float v = vals[t]; int rank = 0;
        for (int u = 0; u < L; ++u) { const float w = vals[u]; rank += (w > v || (w == v && u < t)) ? 1 : 0; }
        ((int*)(p.ws + WS_INV))[(size_t)(b * L + t) * 16 + e] = rank < CAP ? rank : -1;
        if (rank < CAP) ((int*)(p.ws + WS_IDX))[(size_t)(e * 4 + b) * CAP + rank] = t;
    }
}
struct GE1 {
    Ptrs p; int K;
    __device__ float a(int z, int m, int k) const { const int b = m >> 9; const int tok = ((const int*)(p.ws + WS_IDX))[(size_t)(z * 4 + b) * CAP + (m & 511)];
        return bf2f(((const bf16*)(p.ws + WS_H2))[((size_t)b * L + tok) * D + k]); }
    __device__ float b(int z, int k, int n) const { const float* w = (n & 1) ? p.w_e_up : p.w_e_gate; return w[((size_t)z * D + k) * FF + (n >> 1)]; }
    __device__ void epi(int z, int m, int n0, const float* v) const { bf16* d = (bf16*)(p.ws + WS_ACT) + ((size_t)z * 2048 + m) * FF + (n0 >> 1);
        d[0] = f2bf(silu_f(v[0]) * v[1]); d[1] = f2bf(silu_f(v[2]) * v[3]); }
};
struct GE2 {
    Ptrs p; int K;
    __device__ float a(int z, int m, int k) const { return bf2f(((const bf16*)(p.ws + WS_ACT))[((size_t)z * 2048 + m) * FF + k]); }
    __device__ float b(int z, int k, int n) const { return p.w_e_down[((size_t)z * FF + k) * D + n]; }
    __device__ void epi(int z, int m, int n0, const float* v) const { bf16* d = (bf16*)(p.ws + WS_YE) + ((size_t)z * 2048 + m) * D + n0; for (int j = 0; j < 4; ++j) d[j] = f2bf(v[j]); }
};
__device__ __forceinline__ void row_pass_final(const Ptrs& p, int row, int lane) {
    const int b = row >> 12; const float* mod = (const float*)(p.ws + WS_MOD) + b * 12288;
    const int* inv = (const int*)(p.ws + WS_INV) + (size_t)row * 16; const float* aff = (const float*)(p.ws + WS_AFF) + (size_t)row * 16;
    float v[32]; for (int j = 0; j < 32; ++j) v[j] = 0.f;
    for (int e = 0; e < 16; ++e) { const int sl = inv[e]; if (sl >= 0) { const float g = aff[e]; const bf16* ye = (const bf16*)(p.ws + WS_YE) + ((size_t)(e * 4 + b) * CAP + sl) * D;
            for (int j = 0; j < 32; ++j) v[j] += g * bf2f(ye[j * 64 + lane]); } }
    float s = 0.f; for (int j = 0; j < 32; ++j) s += v[j] * v[j];
    const float rs = rsqrtf(wave_sum(s) * (1.f / D) + EPS);
    float* o = p.out + (size_t)row * D;
    for (int j = 0; j < 32; ++j) { const int c = j * 64 + lane; o[c] = o[c] + mod[10240 + c] * (v[j] * rs * p.post_norm2[c]); }
}
__global__ __launch_bounds__(256) void n_rowfinal(Ptrs p) { const int row = blockIdx.x * 4 + (threadIdx.x >> 6); row_pass_final(p, row, threadIdx.x & 63); }


namespace pg8 {
#define PG8_LAS __attribute__((address_space(3)))
typedef short bf16x8 __attribute__((ext_vector_type(8)));
typedef float f32x4 __attribute__((ext_vector_type(4)));
typedef float f32x2 __attribute__((ext_vector_type(2)));
typedef unsigned u32x4 __attribute__((ext_vector_type(4)));
constexpr int BM = 256, BK = 64, HALF = 128, HTB = HALF * BK * 2, STAGE_BYTES = 8 * HTB, NXCD = 8, WGM = 8;

__host__ __device__ __forceinline__ int lds_byte(int r, int c) { const int st = (r >> 4) * 2 + (c >> 5), rr = r & 15, cc = c & 31, ob = rr * 64 + cc * 2; return st * 1024 + (ob ^ (((ob >> 9) & 1) << 5)); }
__host__ __device__ __forceinline__ void stage_rc(int b, int& R, int& C) { const int st = b / 1024, sb = b % 1024, swz = sb ^ (((sb >> 9) & 1) << 5); R = (st >> 1) * 16 + swz / 64; C = (st & 1) * 32 + (swz % 64) / 2; }
__host__ __device__ __forceinline__ int perm32(int rho) { const int n = rho >> 4, i = rho & 15; return 8 * (i >> 2) + 4 * n + (i & 3); }

struct Unit { int pm, pn, ui; };
__device__ __forceinline__ void rect_unit(int L, int nM, int nN, Unit& u) {
    const int nwg = nM * nN; int wgid = L;
    { const int q = nwg / NXCD, r = nwg % NXCD, xcd = wgid % NXCD, off = wgid / NXCD; wgid = (xcd < r ? xcd * (q + 1) : r * (q + 1) + (xcd - r) * q) + off; }
    const int nig = WGM * nN, gid = wgid / nig, fm = gid * WGM, gsz = (nM - fm) < WGM ? (nM - fm) : WGM;
    u.pm = fm + ((wgid % nig) % gsz); u.pn = (wgid % nig) / gsz;
}
__device__ __forceinline__ void dense_voff(int K, int tid, unsigned (&v)[2][2]) {
#pragma unroll
    for (int i = 0; i < 2; ++i) { int R, C; stage_rc(tid * 16 + i * 8192, R, C); v[0][i] = (unsigned)(R * K + C) * 2u; v[1][i] = (unsigned)((R + HALF) * K + C) * 2u; }
}

__device__ __forceinline__ unsigned cvt_pk_bf16(float lo, float hi) { unsigned r; asm volatile("v_cvt_pk_bf16_f32 %0, %1, %2" : "=v"(r) : "v"(lo), "v"(hi)); return r; }
__device__ __forceinline__ u32x4 pack8(const f32x4& a, const f32x4& b) { u32x4 w; w.x = cvt_pk_bf16(a[0], a[1]); w.y = cvt_pk_bf16(a[2], a[3]); w.z = cvt_pk_bf16(b[0], b[1]); w.w = cvt_pk_bf16(b[2], b[3]); return w; }

typedef int i32x4 __attribute__((ext_vector_type(4)));
typedef int i32x8 __attribute__((ext_vector_type(8)));
template <class Epi, class Sched, bool FP8 = false>
__device__ __forceinline__ void gemm_phase(PG8_LAS unsigned char* lds, const int K, const Sched& S, const Epi& E) {
    const int tid = threadIdx.x, wid = __builtin_amdgcn_readfirstlane(tid >> 6), lane = tid & 63, wr = wid >> 2, wc = wid & 3, fr = lane & 15, fq = lane >> 4;
    const int nt = K / BK;
    unsigned voffB[2];
#pragma unroll
    for (int i = 0; i < 2; ++i) { int R, C; stage_rc(tid * 16 + i * 8192, R, C); const int Rb = Epi::PERM ? ((R & ~31) + perm32(R & 31)) : R; voffB[i] = (unsigned)(Rb * K + C) * 2u; }
    const size_t kstep = (size_t)(BK * 2);
    const size_t hstep = (size_t)HALF * K * 2;
    const unsigned ldsw = (unsigned)wid * 1024u;
    const int aoff = lds_byte(wr * 64 + fr, fq * 8), boff = lds_byte(wc * 32 + fr, fq * 8);
#define PG8_SA(b, h) (((b) * 2 + (h)) * HTB)
#define PG8_SB(b, h) ((4 + (b) * 2 + (h)) * HTB)
#define PG8_STAGE(bufoff, gbase, voff) do { _Pragma("unroll") for (int _i = 0; _i < 2; ++_i) \
        __builtin_amdgcn_global_load_lds((const unsigned*)((const char*)(gbase) + (voff)[_i]), (PG8_LAS unsigned*)(lds + (bufoff) + ldsw + _i * 8192), 16, 0, 0); } while (0)
#define PG8_LDA(dst, b, h) do { _Pragma("unroll") for (int m = 0; m < 4; ++m) _Pragma("unroll") for (int k = 0; k < 2; ++k) dst[m][k] = *(const PG8_LAS bf16x8*)(lds + PG8_SA(b, h) + aoff + m * 2048 + k * 1024); } while (0)
#define PG8_LDB(dst, b, h) do { _Pragma("unroll") for (int n = 0; n < 2; ++n) _Pragma("unroll") for (int k = 0; k < 2; ++k) dst[n][k] = *(const PG8_LAS bf16x8*)(lds + PG8_SB(b, h) + boff + n * 2048 + k * 1024); } while (0)
#define PG8_MMA(ai, bj, At, Bt) do { __builtin_amdgcn_s_setprio(1); _Pragma("unroll") for (int m = 0; m < 4; ++m) _Pragma("unroll") for (int n = 0; n < 2; ++n) { \
        if constexpr (FP8) { const i32x8 fb = __builtin_shufflevector((i32x4)Bt[n][0], (i32x4)Bt[n][1], 0, 1, 2, 3, 4, 5, 6, 7), fa = __builtin_shufflevector((i32x4)At[m][0], (i32x4)At[m][1], 0, 1, 2, 3, 4, 5, 6, 7); \
            acc[ai][bj][m][n] = __builtin_amdgcn_mfma_scale_f32_16x16x128_f8f6f4(fb, fa, acc[ai][bj][m][n], 0, 0, 0, 0x7f7f7f7f, 0, 0x7f7f7f7f); } \
        else { _Pragma("unroll") for (int k = 0; k < 2; ++k) acc[ai][bj][m][n] = __builtin_amdgcn_mfma_f32_16x16x32_bf16(Bt[n][k], At[m][k], acc[ai][bj][m][n], 0, 0, 0); } } \
        __builtin_amdgcn_s_setprio(0); } while (0)
#define PG8_WAIT_V(n) asm volatile("s_waitcnt vmcnt(" #n ")" ::: "memory")
#define PG8_WAIT_L(n) asm volatile("s_waitcnt lgkmcnt(" #n ")" ::: "memory")
#define PG8_BAR __builtin_amdgcn_s_barrier()
#define PG8_SCHED __builtin_amdgcn_sched_barrier(0)
    Unit cur, nxt; int ui = 0;
    if (!S.next(0, cur)) return;
    f32x4 acc[2][2][4][2];
#pragma unroll
    for (int a = 0; a < 2; ++a)
#pragma unroll
        for (int b = 0; b < 2; ++b)
#pragma unroll
            for (int m = 0; m < 4; ++m)
#pragma unroll
                for (int n = 0; n < 2; ++n) acc[a][b][m][n] = (f32x4){0.f, 0.f, 0.f, 0.f};
    bf16x8 At[4][2], B0[2][2], B1[2][2];
    unsigned vA[2][2], vN[2][2];
    S.a_voff(0, cur, tid, vA);
    const char* cA = S.a_base(cur); const char* cB = S.b_base(cur);
    PG8_STAGE(PG8_SB(0, 0), cB, voffB); PG8_STAGE(PG8_SB(0, 1), cB + hstep, voffB); PG8_STAGE(PG8_SA(0, 0), cA, vA[0]); PG8_STAGE(PG8_SA(0, 1), cA, vA[1]);
    if (wr == 1) PG8_BAR;
    PG8_WAIT_V(2); PG8_BAR;
    PG8_STAGE(PG8_SB(1, 0), cB + kstep, voffB); PG8_STAGE(PG8_SA(1, 0), cA + kstep, vA[0]); PG8_STAGE(PG8_SB(1, 1), cB + hstep + kstep, voffB);
    PG8_WAIT_V(6); PG8_BAR;
    for (;;) {
        const bool has_next = S.next(ui + 1, nxt);
        if (has_next) S.a_voff(ui + 1, nxt, tid, vN);
        const char* nA = has_next ? S.a_base(nxt) : cA; const char* nB = has_next ? S.b_base(nxt) : cB;
        for (int t = 0; t < nt; t += 2) {
            const bool last = (t == nt - 2);
            const char* a1 = cA + (size_t)(t + 1) * kstep;
            const char* a2 = last ? nA : cA + (size_t)(t + 2) * kstep; const char* b2 = last ? nB : cB + (size_t)(t + 2) * kstep;
            const char* a3 = a2 + kstep; const char* b3 = b2 + kstep;
            PG8_LDB(B0, 0, 0); PG8_LDB(B1, 0, 1); PG8_SCHED; PG8_LDA(At, 0, 0); PG8_STAGE(PG8_SA(1, 1), a1, vA[1]);
            if (last && has_next) {
#pragma unroll
                for (int h = 0; h < 2; ++h)
#pragma unroll
                    for (int i = 0; i < 2; ++i) vA[h][i] = vN[h][i];
            }
            PG8_WAIT_V(8); PG8_WAIT_L(0); PG8_BAR; PG8_MMA(0, 0, At, B0); PG8_MMA(0, 1, At, B1); PG8_BAR; PG8_SCHED;
            PG8_LDA(At, 0, 1); PG8_STAGE(PG8_SB(0, 0), b2, voffB); PG8_STAGE(PG8_SB(0, 1), b2 + hstep, voffB); PG8_STAGE(PG8_SA(0, 0), a2, vA[0]);
            PG8_WAIT_V(8); PG8_WAIT_L(0); PG8_BAR; PG8_MMA(1, 0, At, B0); PG8_MMA(1, 1, At, B1); PG8_BAR; PG8_SCHED;
            PG8_LDB(B0, 1, 0); PG8_LDB(B1, 1, 1); PG8_SCHED; PG8_LDA(At, 1, 0); PG8_STAGE(PG8_SA(0, 1), a2, vA[1]);
            PG8_WAIT_V(8); PG8_WAIT_L(0); PG8_BAR; PG8_MMA(0, 0, At, B0); PG8_MMA(0, 1, At, B1); PG8_BAR; PG8_SCHED;
            PG8_LDA(At, 1, 1); PG8_STAGE(PG8_SB(1, 0), b3, voffB); PG8_STAGE(PG8_SB(1, 1), b3 + hstep, voffB); PG8_STAGE(PG8_SA(1, 0), a3, vA[0]);
            PG8_WAIT_V(8); PG8_WAIT_L(0); PG8_BAR; PG8_MMA(1, 0, At, B0); PG8_MMA(1, 1, At, B1); PG8_BAR; PG8_SCHED;
        }
        if (wr == 0) PG8_BAR;
        E(acc, cur, wr, wc, fr, fq);
        if (!has_next) break;
#pragma unroll
        for (int a = 0; a < 2; ++a)
#pragma unroll
            for (int b = 0; b < 2; ++b)
#pragma unroll
                for (int m = 0; m < 4; ++m)
#pragma unroll
                    for (int n = 0; n < 2; ++n) acc[a][b][m][n] = (f32x4){0.f, 0.f, 0.f, 0.f};
        cur = nxt; cA = nA; cB = nB; ++ui;
        if (wr == 1) PG8_BAR;
    }
    PG8_WAIT_V(0);
    PG8_BAR;
#undef PG8_SA
#undef PG8_SB
#undef PG8_STAGE
#undef PG8_LDA
#undef PG8_LDB
#undef PG8_MMA
#undef PG8_WAIT_V
#undef PG8_WAIT_L
#undef PG8_BAR
#undef PG8_SCHED
}
}

#define LAS __attribute__((address_space(3)))
typedef pg8::f32x4 f32x4; typedef pg8::u32x4 u32x4; typedef pg8::Unit Unit;
constexpr size_t TSTEP2K = (size_t)256 * 2048 * 2, TSTEP512 = (size_t)256 * 512 * 2;

struct SchedIn {
    static constexpr bool GATHER = false; const char *A, *Bt; int G, c;
    __device__ __forceinline__ bool next(int i, Unit& u) const { const int Lx = i * G + c; if (Lx >= 844) return false;
        if (Lx < 832) pg8::rect_unit(Lx, 64, 13, u); else { const int r = Lx - 832; u.pm = 64 + (r & 3); const int q = r >> 2; u.pn = q == 2 ? 12 : 2 + q; } return true; }
    __device__ __forceinline__ const char* a_base(const Unit& u) const { return A + (size_t)u.pm * TSTEP2K; }
    __device__ __forceinline__ const char* b_base(const Unit& u) const { return Bt + (size_t)u.pn * TSTEP2K; }
    __device__ __forceinline__ void a_voff(int, const Unit&, int tid, unsigned (&v)[2][2]) const { pg8::dense_voff(2048, tid, v); }
};
struct SchedQKV {
    static constexpr bool GATHER = false; const char *A, *Bt; int G, c;
    __device__ __forceinline__ bool next(int i, Unit& u) const { const int Lx = i * G + c; if (Lx >= 928) return false;
        if (Lx < 384) pg8::rect_unit(Lx, 64, 6, u); else { pg8::rect_unit(Lx - 384, 68, 8, u); u.pm += 64; u.pn += 6; } u.ui = i; return true; }
    __device__ __forceinline__ const char* a_base(const Unit& u) const { return A + (size_t)u.pm * TSTEP512; }
    __device__ __forceinline__ const char* b_base(const Unit& u) const { return Bt + (size_t)u.pn * TSTEP512; }
    __device__ __forceinline__ void a_voff(int, const Unit&, int tid, unsigned (&v)[2][2]) const { pg8::dense_voff(512, tid, v); }
};
template <int nM, int nN, int BSHIFT, int KU> struct SchedDense {
    static constexpr bool GATHER = false; const char *A, *Bt; int G, c;
    __device__ __forceinline__ bool next(int i, Unit& u) const { const int Lx = i * G + c; if (Lx >= nM * nN) return false; pg8::rect_unit(Lx, nM, nN, u); return true; }
    __device__ __forceinline__ const char* a_base(const Unit& u) const { return A + (size_t)u.pm * (512 * KU); }
    __device__ __forceinline__ const char* b_base(const Unit& u) const { return Bt + (size_t)((u.pm >> BSHIFT) * nN + u.pn) * (512 * KU); }
    __device__ __forceinline__ void a_voff(int, const Unit&, int tid, unsigned (&v)[2][2]) const { pg8::dense_voff(KU, tid, v); }
};
template <int KU> struct SchedGather {
    static constexpr bool GATHER = true; const char *A, *Bt; int G, c; const LAS unsigned* tab;
    __device__ __forceinline__ bool next(int i, Unit& u) const { const int Lx = i * G + c; if (Lx >= 2048) return false; pg8::rect_unit(Lx, 128, 16, u); return true; }
    __device__ __forceinline__ const char* a_base(const Unit&) const { return A; }
    __device__ __forceinline__ const char* b_base(const Unit& u) const { return Bt + (size_t)((u.pm >> 3) * 16 + u.pn) * (512 * KU); }
    __device__ __forceinline__ void a_voff(int i, const Unit&, int tid, unsigned (&v)[2][2]) const {
#pragma unroll
        for (int p = 0; p < 2; ++p) { int R, C; pg8::stage_rc(tid * 16 + p * 8192, R, C); v[0][p] = tab[i * 256 + R] + (unsigned)C * 2u; v[1][p] = tab[i * 256 + 128 + R] + (unsigned)C * 2u; }
    }
};

__device__ __forceinline__ float gelu_fast(float x) {
    const float z2 = -2.302208198f * (x + 0.044715f * x * x * x);
    return x * __builtin_amdgcn_rcpf(1.f + __builtin_amdgcn_exp2f(z2));
}
__device__ __forceinline__ float silu_fast(float x) { return x * __builtin_amdgcn_rcpf(1.f + __builtin_amdgcn_exp2f(-1.4426950408889634f * x)); }
__device__ __forceinline__ float dot4(const f32x4& a) { return (a[0] * a[0] + a[1] * a[1]) + (a[2] * a[2] + a[3] * a[3]); }
__device__ __forceinline__ void rope8(f32x4& a, f32x4& b, const float* tabrow  , int fq) {
    const f32x4 t0 = *(const f32x4*)(tabrow + 8 * fq), t1 = *(const f32x4*)(tabrow + 8 * fq + 4);
    f32x4 ra, rb;
    ra[0] = a[0] * t0[0] - a[1] * t0[1]; ra[1] = a[1] * t0[0] + a[0] * t0[1]; ra[2] = a[2] * t0[2] - a[3] * t0[3]; ra[3] = a[3] * t0[2] + a[2] * t0[3];
    rb[0] = b[0] * t1[0] - b[1] * t1[1]; rb[1] = b[1] * t1[0] + b[0] * t1[1]; rb[2] = b[2] * t1[2] - b[3] * t1[3]; rb[3] = b[3] * t1[2] + b[2] * t1[3];
    a = ra; b = rb;
}
struct EpiIn {
    static constexpr bool PERM = true; unsigned char* ws;
    __device__ __forceinline__ void operator()(const f32x4 (&acc)[2][2][4][2], const Unit& u, int wr, int wc, int fr, int fq) const {
        const int pn = u.pn, row0 = u.pm * 256 + wr * 64 + fr, c8 = wc * 32 + 8 * fq;
        if (pn < 4) {
            bf16* base = (bf16*)(ws + WS_CQKV) + (pn >= 2 ? (size_t)M * 512 : 0) + (pn & 1) * 256 + c8;
            float* ssq = (float*)(ws + (pn >= 2 ? WS_SSQKV : WS_SSQQ)) + (pn & 1) * 4 + wc;
#pragma unroll
            for (int ai = 0; ai < 2; ++ai)
#pragma unroll
                for (int m = 0; m < 4; ++m) { const int row = row0 + ai * 128 + m * 16; float s = 0.f;
#pragma unroll
                    for (int bj = 0; bj < 2; ++bj) { s += dot4(acc[ai][bj][m][0]) + dot4(acc[ai][bj][m][1]); *(u32x4*)(base + (size_t)row * 512 + bj * 128) = pg8::pack8(acc[ai][bj][m][0], acc[ai][bj][m][1]); }
                    s += __shfl_xor(s, 16); s += __shfl_xor(s, 32);
                    if (fq == 0) ssq[(size_t)row * 8] = s; }
        } else if (pn < 12) {
            bf16* base = (bf16*)(ws + (pn < 8 ? WS_U : WS_VS)) + ((pn - 4) & 3) * 256 + c8;
#pragma unroll
            for (int ai = 0; ai < 2; ++ai)
#pragma unroll
                for (int m = 0; m < 4; ++m) { const int row = row0 + ai * 128 + m * 16;
#pragma unroll
                    for (int bj = 0; bj < 2; ++bj) { f32x4 a = acc[ai][bj][m][0], b = acc[ai][bj][m][1];
#pragma unroll
                        for (int j = 0; j < 4; ++j) { a[j] = gelu_fast(a[j]); b[j] = gelu_fast(b[j]); }
                        *(u32x4*)(base + (size_t)row * 1024 + bj * 128) = pg8::pack8(a, b); } }
        } else if (wc < 2) {
            const float* tab = (const float*)(ws + WS_ROPE);
#pragma unroll
            for (int ai = 0; ai < 2; ++ai)
#pragma unroll
                for (int m = 0; m < 4; ++m) { const int row = row0 + ai * 128 + m * 16; f32x4 a = acc[ai][0][m][0], b = acc[ai][0][m][1]; int bb, kpos;
                    if (row < M) { bb = row >> 12; kpos = row & 4095; const int ax = wc ? (kpos & 63) : (kpos >> 6); rope8(a, b, tab + ax * 32, fq); }
                    else { bb = (row - M) >> 8; kpos = L + ((row - M) & 255); }
                    const u32x4 w = pg8::pack8(a, b); bf16* d = (bf16*)(ws + WS_K) + ((size_t)(bb * H) * LK + kpos) * DQK + 128 + c8;
#pragma unroll
                    for (int hh = 0; hh < H; ++hh) *(u32x4*)(d + (size_t)hh * LK * DQK) = w; }
        }
    }
};
struct EpiQKV {
    static constexpr bool PERM = true; unsigned char* ws; const LAS float* rstab;
    __device__ __forceinline__ void operator()(const f32x4 (&acc)[2][2][4][2], const Unit& u, int wr, int wc, int fr, int fq) const {
        const int c8 = wc * 32 + 8 * fq;
        if (u.pn < 6) {
            const int pn = u.pn, row0 = u.pm * 256 + wr * 64 + fr; const float* tab = (const float*)(ws + WS_ROPE);
#pragma unroll
            for (int ai = 0; ai < 2; ++ai)
#pragma unroll
                for (int m = 0; m < 4; ++m) { const int row = row0 + ai * 128 + m * 16; const int bb = row >> 12, t = row & 4095;
                    const float rs = rstab[u.ui * 256 + ai * 128 + wr * 64 + m * 16 + fr];
#pragma unroll
                    for (int bj = 0; bj < 2; ++bj) { f32x4 a = acc[ai][bj][m][0] * rs, b = acc[ai][bj][m][1] * rs; bf16* d;
                        if (pn < 4) d = (bf16*)(ws + WS_Q) + ((size_t)(bb * H + pn * 2 + bj) * L + t) * DQK + c8;
                        else { const int hd = (pn - 4) * 4 + bj * 2 + (wc >> 1), ax = (wc & 1) ? (t & 63) : (t >> 6); rope8(a, b, tab + ax * 32, fq);
                            d = (bf16*)(ws + WS_Q) + ((size_t)(bb * H + hd) * L + t) * DQK + 128 + (wc & 1) * 32 + 8 * fq; }
                        *(u32x4*)d = pg8::pack8(a, b); }
                    asm volatile("" ::: "memory"); }
        } else {
            const int hd = u.pn - 6, row0 = (u.pm - 64) * 256 + wr * 64 + fr;
#pragma unroll
            for (int ai = 0; ai < 2; ++ai)
#pragma unroll
                for (int m = 0; m < 4; ++m) { const int row = row0 + ai * 128 + m * 16; int bb, kpos;
                    if (row < M) { bb = row >> 12; kpos = row & 4095; } else { bb = (row - M) >> 8; kpos = L + ((row - M) & 255); }
                    const float rs = rstab[u.ui * 256 + ai * 128 + wr * 64 + m * 16 + fr];
                    const size_t kr = (size_t)(bb * H + hd) * LK + kpos;
                    *(u32x4*)((bf16*)(ws + WS_K) + kr * DQK + c8) = pg8::pack8(acc[ai][0][m][0] * rs, acc[ai][0][m][1] * rs);
                    *(u32x4*)((bf16*)(ws + WS_V) + kr * VH + c8) = pg8::pack8(acc[ai][1][m][0] * rs, acc[ai][1][m][1] * rs);
                    asm volatile("" ::: "memory"); }
        }
    }
};
struct EpiY {
    static constexpr bool PERM = true; unsigned char* ws;
    __device__ __forceinline__ void operator()(const f32x4 (&acc)[2][2][4][2], const Unit& u, int wr, int wc, int fr, int fq) const {
        const int row0 = u.pm * 256 + wr * 64 + fr; bf16* base = (bf16*)(ws + WS_Y) + u.pn * 256 + wc * 32 + 8 * fq; float* ssq = (float*)(ws + WS_SSQY) + u.pn * 4 + wc;
#pragma unroll
        for (int ai = 0; ai < 2; ++ai)
#pragma unroll
            for (int m = 0; m < 4; ++m) { const int row = row0 + ai * 128 + m * 16; float s = 0.f;
#pragma unroll
                for (int bj = 0; bj < 2; ++bj) { s += dot4(acc[ai][bj][m][0]) + dot4(acc[ai][bj][m][1]); *(u32x4*)(base + (size_t)row * D + bj * 128) = pg8::pack8(acc[ai][bj][m][0], acc[ai][bj][m][1]); }
                s += __shfl_xor(s, 16); s += __shfl_xor(s, 32);
                if (fq == 0) ssq[(size_t)row * 32] = s; }
    }
};
__device__ __forceinline__ unsigned pack4_fp8(float a, float b, float c, float d) { int w = 0; w = __builtin_amdgcn_cvt_pk_fp8_f32(a, b, w, false); w = __builtin_amdgcn_cvt_pk_fp8_f32(c, d, w, true); return (unsigned)w; }
constexpr float W8_SCALE = 64.f, W8_INV = 1.f / 64.f;
struct EpiAct8 {
    static constexpr bool PERM = true; unsigned char* ws;
    __device__ __forceinline__ void operator()(const f32x4 (&acc)[2][2][4][2], const Unit& u, int wr, int wc, int fr, int fq) const {
        const int row0 = u.pm * 256 + wr * 64 + fr; unsigned char* base = ws + WS_ACT + u.pn * 128 + wc * 32 + 8 * fq;
#pragma unroll
        for (int ai = 0; ai < 2; ++ai)
#pragma unroll
            for (int m = 0; m < 4; ++m) { const int row = row0 + ai * 128 + m * 16; f32x4 a, b;
#pragma unroll
                for (int j = 0; j < 4; ++j) { a[j] = silu_fast(acc[ai][0][m][0][j] * W8_INV) * (acc[ai][1][m][0][j] * W8_INV); b[j] = silu_fast(acc[ai][0][m][1][j] * W8_INV) * (acc[ai][1][m][1][j] * W8_INV); }
                *(unsigned long long*)(base + (size_t)row * FF) = (unsigned long long)pack4_fp8(a[0], a[1], a[2], a[3]) | ((unsigned long long)pack4_fp8(b[0], b[1], b[2], b[3]) << 32); }
    }
};
struct EpiYE8 {
    static constexpr bool PERM = true; unsigned char* ws;
    __device__ __forceinline__ void operator()(const f32x4 (&acc)[2][2][4][2], const Unit& u, int wr, int wc, int fr, int fq) const {
        const int row0 = u.pm * 256 + wr * 64 + fr; unsigned char* base = ws + WS_YE + u.pn * 256 + wc * 32 + 8 * fq;
#pragma unroll
        for (int ai = 0; ai < 2; ++ai)
#pragma unroll
            for (int m = 0; m < 4; ++m) { const int row = row0 + ai * 128 + m * 16;
#pragma unroll
                for (int bj = 0; bj < 2; ++bj) { const f32x4 a = acc[ai][bj][m][0] * W8_INV, b = acc[ai][bj][m][1] * W8_INV;
                    *(unsigned long long*)(base + (size_t)row * D + bj * 128) = (unsigned long long)pack4_fp8(a[0], a[1], a[2], a[3]) | ((unsigned long long)pack4_fp8(b[0], b[1], b[2], b[3]) << 32); } }
    }
};
struct EpiAct {
    static constexpr bool PERM = true; unsigned char* ws;
    __device__ __forceinline__ void operator()(const f32x4 (&acc)[2][2][4][2], const Unit& u, int wr, int wc, int fr, int fq) const {
        const int row0 = u.pm * 256 + wr * 64 + fr; bf16* base = (bf16*)(ws + WS_ACT) + u.pn * 128 + wc * 32 + 8 * fq;
#pragma unroll
        for (int ai = 0; ai < 2; ++ai)
#pragma unroll
            for (int m = 0; m < 4; ++m) { const int row = row0 + ai * 128 + m * 16; f32x4 a, b;
#pragma unroll
                for (int j = 0; j < 4; ++j) { a[j] = silu_fast(acc[ai][0][m][0][j]) * acc[ai][1][m][0][j]; b[j] = silu_fast(acc[ai][0][m][1][j]) * acc[ai][1][m][1][j]; }
                *(u32x4*)(base + (size_t)row * FF) = pg8::pack8(a, b); }
    }
};
struct EpiYE {
    static constexpr bool PERM = true; unsigned char* ws;
    __device__ __forceinline__ void operator()(const f32x4 (&acc)[2][2][4][2], const Unit& u, int wr, int wc, int fr, int fq) const {
        const int row0 = u.pm * 256 + wr * 64 + fr; bf16* base = (bf16*)(ws + WS_YE) + u.pn * 256 + wc * 32 + 8 * fq;
#pragma unroll
        for (int ai = 0; ai < 2; ++ai)
#pragma unroll
            for (int m = 0; m < 4; ++m) { const int row = row0 + ai * 128 + m * 16;
#pragma unroll
                for (int bj = 0; bj < 2; ++bj) *(u32x4*)(base + (size_t)row * D + bj * 128) = pg8::pack8(acc[ai][bj][m][0], acc[ai][bj][m][1]); }
    }
};

namespace att {
using bf16x8 = __attribute__((ext_vector_type(8))) short;
using s16x4  = __attribute__((ext_vector_type(4))) short;
using f32x16 = __attribute__((ext_vector_type(16))) float;
using u32x4  = __attribute__((ext_vector_type(4))) unsigned;
constexpr int QBLK = 32, KVBLK = 64, NW = 8;
constexpr float SCALE = cfg::ATT_SCALE, THR = 8.f;
constexpr int LDQ = 192, LDKK = 192, LDV = 128, LDO = 2048;
constexpr int KROW = 400, SHM_V = KVBLK * 128 * 2, SHM_K = KVBLK * KROW, SHM_QPE = 2 * SHM_V + 2 * SHM_K + NW * 64 * 4, SHM_ATTN = SHM_QPE + NW * 4096;
#define KSWZ(row, colB) ((row) * KROW + (colB))
#define SBAR() __builtin_amdgcn_sched_barrier(0)
__device__ __forceinline__ int crow(int r, int hi) { return (r & 3) + 8 * (r >> 2) + 4 * hi; }
__device__ __forceinline__ unsigned cvtpk(float lo, float hi) { unsigned r; asm volatile("v_cvt_pk_bf16_f32 %0, %1, %2" : "=v"(r) : "v"(lo), "v"(hi)); return r; }

__device__ __forceinline__ void partialSM(f32x16& p0, f32x16& p1, float& m_reg, float& mn, float& alpha) {
  constexpr float C = SCALE * 1.4426950408889634f;
  float pmax = p0[0];
#pragma unroll
  for (int r = 1; r < 16; ++r) pmax = fmaxf(pmax, p0[r]);
#pragma unroll
  for (int r = 0; r < 16; ++r) pmax = fmaxf(pmax, p1[r]);
  { auto rr = __builtin_amdgcn_permlane32_swap(__float_as_uint(pmax), __float_as_uint(pmax), false, false);
    pmax = fmaxf(__uint_as_float(rr[0]), __uint_as_float(rr[1])); }
  if (__builtin_expect(__all(pmax - m_reg <= THR / SCALE), 1)) { mn = m_reg; alpha = 1.f; }
  else { mn = fmaxf(m_reg, pmax); alpha = __builtin_amdgcn_exp2f((m_reg - mn) * C); m_reg = mn; }
  float mnC = -mn * C;
#pragma unroll
  for (int r = 0; r < 16; ++r) p0[r] = fmaf(p0[r], C, mnC);
#pragma unroll
  for (int r = 0; r < 16; ++r) p1[r] = fmaf(p1[r], C, mnC);
#pragma unroll
  for (int r = 0; r < 16; ++r) p0[r] = __builtin_amdgcn_exp2f(p0[r]);
}
__device__ __forceinline__ void finishSM(f32x16& p0, f32x16& p1, float alpha, float& l_reg, bf16x8& pa0, bf16x8& pa1, bf16x8& pa2, bf16x8& pa3) {
#pragma unroll
  for (int r = 0; r < 16; ++r) p1[r] = __builtin_amdgcn_exp2f(p1[r]);
  float ps = 0;
#pragma unroll
  for (int r = 0; r < 16; ++r) ps += p0[r];
#pragma unroll
  for (int r = 0; r < 16; ++r) ps += p1[r];
  { auto rr = __builtin_amdgcn_permlane32_swap(__float_as_uint(ps), __float_as_uint(ps), false, false);
    ps = __uint_as_float(rr[0]) + __uint_as_float(rr[1]); }
  l_reg = l_reg * alpha + ps;
#define PK4(P, BASE, OUT) do { unsigned a0 = cvtpk(P[BASE + 0], P[BASE + 1]), a1 = cvtpk(P[BASE + 2], P[BASE + 3]);   \
    unsigned b0 = cvtpk(P[BASE + 4], P[BASE + 5]), b1 = cvtpk(P[BASE + 6], P[BASE + 7]);                              \
    auto r0 = __builtin_amdgcn_permlane32_swap(a0, b0, false, false); auto r1 = __builtin_amdgcn_permlane32_swap(a1, b1, false, false); \
    u32x4 w = {r0[0], r1[0], r0[1], r1[1]}; OUT = *reinterpret_cast<bf16x8*>(&w); } while (0)
  PK4(p0, 0, pa0); PK4(p0, 8, pa1); PK4(p1, 0, pa2); PK4(p1, 8, pa3);
#undef PK4
}
__device__ __forceinline__ void qkt(f32x16& p0, f32x16& p1, const char* Ks, const bf16x8* qr, const char* qpe, int r32, int hi) {
  p0 = f32x16{}; p1 = f32x16{};
#pragma unroll
  for (int d0 = 0; d0 < 12; ++d0) { const int cb = (d0 * 16 + hi * 8) * 2;
    bf16x8 b0 = *reinterpret_cast<const bf16x8*>(Ks + KSWZ(r32, cb));
    bf16x8 b1 = *reinterpret_cast<const bf16x8*>(Ks + KSWZ(32 + r32, cb));
    const bf16x8 q = d0 < 8 ? qr[d0 < 8 ? d0 : 0] : *reinterpret_cast<const bf16x8*>(qpe + (d0 - 8) * 1024);
    p0 = __builtin_amdgcn_mfma_f32_32x32x16_bf16(b0, q, p0, 0, 0, 0);
    p1 = __builtin_amdgcn_mfma_f32_32x32x16_bf16(b1, q, p1, 0, 0, 0); }
}
__device__ __forceinline__ int v_st(int k, int c) { const int kk = (k & ~0xC) | ((k & 4) << 1) | ((k & 8) >> 1); return ((kk >> 3) * 4 + (c >> 5)) * 512 + ((kk & 7) * 32 + (c & 31)) * 2; }
__device__ __forceinline__ int v_rd_base(int lane) { return ((lane & 3) << 3) | (((lane >> 2) & 3) << 6) | (((lane >> 4) & 1) << 5) | (((lane >> 5) & 1) << 8); }
constexpr int v_rd_off(int d0, int ks, int half) { return d0 * 512 + ks * 4096 + half * 2048; }
template <int OFF> __device__ __forceinline__ s16x4 tr_read(int vb) {
  s16x4 r; asm volatile("ds_read_b64_tr_b16 %0, %1 offset:%2" : "=&v"(r) : "v"(vb), "i"(OFF) : "memory"); return r;
}
template <int D0> __device__ __forceinline__ void pv_one(f32x16& od, int vb, bf16x8 pa0, bf16x8 pa1, bf16x8 pa2, bf16x8 pa3) {
  const s16x4 l0 = tr_read<v_rd_off(D0, 0, 0)>(vb), h0 = tr_read<v_rd_off(D0, 0, 1)>(vb), l1 = tr_read<v_rd_off(D0, 1, 0)>(vb), h1 = tr_read<v_rd_off(D0, 1, 1)>(vb);
  const s16x4 l2 = tr_read<v_rd_off(D0, 2, 0)>(vb), h2 = tr_read<v_rd_off(D0, 2, 1)>(vb), l3 = tr_read<v_rd_off(D0, 3, 0)>(vb), h3 = tr_read<v_rd_off(D0, 3, 1)>(vb);
  asm volatile("s_waitcnt lgkmcnt(0)" ::: "memory"); SBAR();
#define PK(L, H) (bf16x8){L[0], L[1], L[2], L[3], H[0], H[1], H[2], H[3]}
  od = __builtin_amdgcn_mfma_f32_32x32x16_bf16(pa0, PK(l0, h0), od, 0, 0, 0);
  od = __builtin_amdgcn_mfma_f32_32x32x16_bf16(pa1, PK(l1, h1), od, 0, 0, 0);
  od = __builtin_amdgcn_mfma_f32_32x32x16_bf16(pa2, PK(l2, h2), od, 0, 0, 0);
  od = __builtin_amdgcn_mfma_f32_32x32x16_bf16(pa3, PK(l3, h3), od, 0, 0, 0);
#undef PK
}
__device__ __forceinline__ void pv_d0(f32x16* o, int vb, bf16x8 pa0, bf16x8 pa1, bf16x8 pa2, bf16x8 pa3) {
  pv_one<0>(o[0], vb, pa0, pa1, pa2, pa3); pv_one<1>(o[1], vb, pa0, pa1, pa2, pa3); pv_one<2>(o[2], vb, pa0, pa1, pa2, pa3); pv_one<3>(o[3], vb, pa0, pa1, pa2, pa3);
}
template <int V>
__device__ __forceinline__ void attn_unit(const bf16* __restrict__ Qb, const bf16* __restrict__ Kh, const bf16* __restrict__ Vh, bf16* __restrict__ Ob, int seq, char* lds) {
  const int tid = threadIdx.x, wid = tid >> 6, lane = tid & 63, r32 = lane & 31, hi = lane >> 5;
  char* V_lds = lds; char* K_lds = lds + 2 * SHM_V;
  float* ws = (float*)(lds + 2 * SHM_V + 2 * SHM_K) + wid * 64; float* li_l = ws; float* al_l = ws + 32;
  float m_reg = -1e30f, l_reg = 0; f32x16 o[4] = {}; bf16x8 qr[8];
  const bf16* Qw = Qb + (long)(wid * QBLK + r32) * LDQ + hi * 8;
  char* qpe = lds + SHM_QPE + wid * 4096 + lane * 16;
#pragma unroll
  for (int d0 = 0; d0 < 8; ++d0) qr[d0] = *reinterpret_cast<const bf16x8*>(Qw + d0 * 16);
#pragma unroll
  for (int d0 = 8; d0 < 12; ++d0) *reinterpret_cast<bf16x8*>(qpe + (d0 - 8) * 1024) = *reinterpret_cast<const bf16x8*>(Qw + d0 * 16);
  int kro[4], vro[2];
#pragma unroll
  for (int j = 0; j < 4; ++j) { const int o = (wid + 8 * j) * 1024 + lane * 16, row = o / KROW, c = (o - row * KROW) >> 4; kro[j] = row * 384 + (c < 24 ? c : 0) * 16; }
#pragma unroll
  for (int j = 0; j < 2; ++j) { const int o = (wid * 2 + j) * 1024 + lane * 16, st = o >> 9, within = (o & 511) >> 1, kk = (st >> 2) * 8 + (within >> 5), c = (st & 3) * 32 + (within & 31);
    const int k = (kk & ~0xC) | ((kk & 4) << 1) | ((kk & 8) >> 1); vro[j] = k * 256 + c * 2; }
  const unsigned klds = (unsigned)(uintptr_t)K_lds + wid * 1024, vlds = (unsigned)(uintptr_t)V_lds + wid * 2048;
  const int vb0 = (int)(uintptr_t)V_lds + v_rd_base(lane);
  typedef __attribute__((address_space(3))) unsigned* ldsp_t;
#define SDMA_K(k0, b) do { const char* kg = (const char*)Kh + (long)(k0) * (LDKK * 2); \
    _Pragma("unroll") for (int j_ = 0; j_ < 3; ++j_) __builtin_amdgcn_global_load_lds((const unsigned*)(kg + kro[j_]), (ldsp_t)(klds + (b) * SHM_K + j_ * 8192), 16, 0, 0); \
    if (wid == 0) __builtin_amdgcn_global_load_lds((const unsigned*)(kg + kro[3]), (ldsp_t)(klds + (b) * SHM_K + 3 * 8192), 16, 0, 0); } while (0)
#define SDMA_V(k0, b) do { const char* vg = (const char*)Vh + (long)(k0) * (LDV * 2); \
    _Pragma("unroll") for (int j_ = 0; j_ < 2; ++j_) __builtin_amdgcn_global_load_lds((const unsigned*)(vg + vro[j_]), (ldsp_t)(vlds + (b) * SHM_V + j_ * 1024), 16, 0, 0); } while (0)
#define RESC(a) do { if (__any((a) < 1.f)) { if (hi == 0) al_l[r32] = (a); asm volatile("s_waitcnt lgkmcnt(0)" ::: "memory"); \
    _Pragma("unroll") for (int d = 0; d < 4; ++d) _Pragma("unroll") for (int r = 0; r < 16; ++r) o[d][r] *= al_l[crow(r, hi)]; } } while (0)
#define PHASE_END() do { asm volatile("s_waitcnt vmcnt(0) lgkmcnt(0)" ::: "memory"); __builtin_amdgcn_s_barrier(); asm volatile("" ::: "memory"); } while (0)
  f32x16 pA0, pA1; float mnA, alA; bf16x8 pa0, pa1, pa2, pa3; const int NT = seq / KVBLK;
  SDMA_K(0, 0); SDMA_V(0, 0); PHASE_END();
  if (wid >= 4) { __builtin_amdgcn_s_barrier(); asm volatile("" ::: "memory"); }
  for (int j = 0; j < NT; ++j) {
    const int bsel = j & 1;
    if (!(V & 8)) if (j + 1 < NT) { if (bsel) SDMA_K((j + 1) * KVBLK, 0); else SDMA_K((j + 1) * KVBLK, 1); }
    SBAR(); if (!(V & 4)) qkt(pA0, pA1, K_lds + bsel * SHM_K, qr, qpe, r32, hi); else { pA0 = o[0]; pA1 = o[1]; }
    if (!(V & 1)) partialSM(pA0, pA1, m_reg, mnA, alA); else { mnA = 0.f; alA = 1.f; }
    PHASE_END();
    if (!(V & 8)) if (j + 1 < NT) { if (bsel) SDMA_V((j + 1) * KVBLK, 0); else SDMA_V((j + 1) * KVBLK, 1); }
    RESC(alA);
    if (!(V & 1)) finishSM(pA0, pA1, alA, l_reg, pa0, pa1, pa2, pa3); else { pa0 = (bf16x8){(short)__float_as_int(pA0[0])}; pa1 = (bf16x8){(short)__float_as_int(pA0[1])}; pa2 = (bf16x8){(short)__float_as_int(pA1[0])}; pa3 = (bf16x8){(short)__float_as_int(pA1[1])}; l_reg += pA0[2]; } SBAR();
    if (!(V & 2)) pv_d0(o, vb0 + bsel * (int)SHM_V, pa0, pa1, pa2, pa3); else { o[0][0] += __int_as_float(pa0[0]); o[1][0] += __int_as_float(pa1[0]); o[2][0] += __int_as_float(pa2[0]); o[3][0] += __int_as_float(pa3[0]); }
    PHASE_END();
  }
  if (wid < 4) { __builtin_amdgcn_s_barrier(); asm volatile("" ::: "memory"); }
  if (hi == 0) li_l[r32] = l_reg; asm volatile("s_waitcnt lgkmcnt(0)" ::: "memory");
  float rli[16];
#pragma unroll
  for (int r = 0; r < 16; ++r) rli[r] = __builtin_amdgcn_rcpf(li_l[crow(r, hi)]);
  bf16* Ow = Ob + (long)(wid * QBLK) * LDO;
#pragma unroll
  for (int r = 0; r < 16; ++r) { const int orow = crow(r, hi);
#pragma unroll
    for (int d0 = 0; d0 < 4; ++d0) Ow[(long)orow * LDO + d0 * 32 + r32] = f2bf(o[d0][r] * rli[r]); }
#undef SDMA_K
#undef SDMA_V
#undef PHASE_END
#undef RESC
}
#undef KSWZ
#undef SBAR
}

#define XB_TMO      128
#define XB_XCNT(j)  (256  + 64 * (j))
#define XB_XSUB(j)  (1280 + 64 * (j))
#define XB_XGEN(j)  (2304 + 64 * (j))
#define XB_TOP      3328
#define XB_TOPGEN   3392
#define XCD_BAR_WORDS 3456
#define XB_SPIN_CAP (1u << 18)
__device__ __forceinline__ unsigned xb_ld(unsigned* p)              { return __hip_atomic_load(p, __ATOMIC_RELAXED, __HIP_MEMORY_SCOPE_AGENT); }
__device__ __forceinline__ unsigned xb_add(unsigned* p, unsigned v) { return __hip_atomic_fetch_add(p, v, __ATOMIC_RELAXED, __HIP_MEMORY_SCOPE_AGENT); }
__device__ __forceinline__ unsigned xb_xcc_id() { return (unsigned)__builtin_amdgcn_s_getreg((3 << 11) | 20) & 0xFu; }
#define XB_SPIN(cond, bar) do { unsigned _sp = 0; while (cond) { __builtin_amdgcn_s_sleep(1); \
    if ((++_sp & 255u) == 0u) { if (xb_ld(&(bar)[XB_TMO])) break; if (_sp > XB_SPIN_CAP) { atomicAdd(&(bar)[XB_TMO], 1u); break; } } } } while (0)
struct XcdBarrier { unsigned* bar; unsigned x; volatile LAS unsigned* st; };
__device__ __forceinline__ XcdBarrier xcd_barrier_post(unsigned* bar, volatile LAS unsigned* st) {
    XcdBarrier b; b.bar = bar; b.x = xb_xcc_id(); b.st = st;
    if (threadIdx.x == 0) (void)xb_add(&bar[XB_XCNT(b.x)], 1u);
    return b;
}
__device__ __forceinline__ void xcd_barrier_complete(unsigned* bar, unsigned x, unsigned& nloc, unsigned& nx) {
    const unsigned G = gridDim.x * gridDim.y * gridDim.z;
    unsigned sum, cnt, mine, sp = 0u;
    for (;;) {
        sum = 0u; cnt = 0u; mine = 0u;
#pragma unroll
        for (unsigned j = 0; j < 16; ++j) { const unsigned c = xb_ld(&bar[XB_XCNT(j)]); sum += c; cnt += (c > 0u) ? 1u : 0u; mine = (j == x) ? c : mine; }
        if (sum == G) break;
        __builtin_amdgcn_s_sleep(1);
        if ((++sp & 255u) == 0u) { if (xb_ld(&bar[XB_TMO])) break; if (sp > XB_SPIN_CAP) { atomicAdd(&bar[XB_TMO], 1u); break; } }
    }
    nloc = mine > 0u ? mine : 1u; nx = cnt > 0u ? cnt : 1u;
}
__device__ __forceinline__ void xcd_barrier(const XcdBarrier& b) {
    asm volatile("s_waitcnt vmcnt(0)" ::: "memory");
    __syncthreads();
    if (threadIdx.x == 0) {
        unsigned* bar = b.bar;
        __builtin_amdgcn_s_waitcnt(0);
        unsigned nloc = b.st[0], nx = b.st[1];
        if (nloc == 0u) { xcd_barrier_complete(bar, b.x, nloc, nx); b.st[0] = nloc; b.st[1] = nx; }
        const unsigned old = xb_add(&bar[XB_XSUB(b.x)], 1u);
        const unsigned gen = old / nloc;
        if (old + 1u == (gen + 1u) * nloc) {
            __builtin_amdgcn_fence(__ATOMIC_RELEASE, "agent");
            asm volatile("s_waitcnt vmcnt(0)" ::: "memory");
            const unsigned og = xb_add(&bar[XB_TOP], 1u);
            const unsigned tg = og / nx;
            if (og + 1u == (tg + 1u) * nx) xb_add(&bar[XB_TOPGEN], 1u);
            else XB_SPIN(xb_ld(&bar[XB_TOPGEN]) == tg, bar);
            __builtin_amdgcn_fence(__ATOMIC_ACQUIRE, "agent");
            xb_add(&bar[XB_XGEN(b.x)], 1u);
            asm volatile("s_waitcnt vmcnt(0)" ::: "memory");
        } else {
            XB_SPIN(xb_ld(&bar[XB_XGEN(b.x)]) == gen, bar);
            __builtin_amdgcn_fence(__ATOMIC_ACQUIRE, "agent");
            asm volatile("s_waitcnt vmcnt(0)" ::: "memory");
        }
    }
    __syncthreads();
}

constexpr int NWAVES = 8, NTHREADS = 512;
constexpr int RING_BYTES = 131072, TAB_OFF = RING_BYTES, TAB_BYTES = 8192, LDS_BYTES = 163840, MISC_OFF = LDS_BYTES - 512, VEC_OFF = RING_BYTES;
constexpr int CW_BAR = 4096;
#define LDS_WAIT() asm volatile("s_waitcnt lgkmcnt(0)" ::: "memory")
typedef unsigned v4u __attribute__((ext_vector_type(4)));
__device__ __forceinline__ unsigned pk2(float lo, float hi) { return (unsigned)f2bf(lo) | ((unsigned)f2bf(hi) << 16); }

__device__ __forceinline__ void p0_mod_item(const Ptrs& p, int it, int lane) {
    const int kc = it / 48, cc = it - kc * 48, k0 = kc * 64, c0 = cc * 256 + lane * 4;
    float sv[5];
#pragma unroll
    for (int r = 0; r < 5; ++r) { const float* cv = r < 4 ? p.c + r * D : p.c_ctx; sv[r] = silu_f(cv[k0 + lane]); }
    f32x4 acc[5];
#pragma unroll
    for (int r = 0; r < 5; ++r) acc[r] = (f32x4){0.f, 0.f, 0.f, 0.f};
    const float* w = p.w_ada + (size_t)k0 * 12288 + c0;
#pragma unroll 8
    for (int k = 0; k < 64; ++k) { const f32x4 wv = *(const f32x4*)(w + (size_t)k * 12288);
#pragma unroll
        for (int r = 0; r < 5; ++r) acc[r] += __int_as_float(__builtin_amdgcn_readlane(__float_as_int(sv[r]), k)) * wv; }
    float* part = (float*)(p.ws + WS_PART) + (size_t)kc * 5 * 12288 + c0;
#pragma unroll
    for (int r = 0; r < 5; ++r) *(f32x4*)(part + (size_t)r * 12288) = acc[r];
}
__device__ __forceinline__ void cvt_load(const float* src, int ldw, int lane, f32x4 (&v)[8]) {
    const int kr = lane >> 3, nq = lane & 7;
#pragma unroll
    for (int i = 0; i < 8; ++i) v[i] = *(const f32x4*)(src + (size_t)(8 * i + kr) * ldw + 4 * nq);
}
__device__ __forceinline__ void cvt_finish(const f32x4 (&v)[8], bf16* dst, int ldk, bool rope, const float* kscale, LAS float* scr, int lane) {
    const int kr = lane >> 3, nq = lane & 7;
#pragma unroll
    for (int i = 0; i < 8; ++i) { const int k = 8 * i + kr; const float sc = kscale ? kscale[k] : 1.f;
#pragma unroll
        for (int t = 0; t < 4; ++t) { const int cs = 4 * nq + t, nn = rope ? ((cs & 15) * 2 + (cs >> 4)) : cs; scr[k * 33 + nn] = v[i][t] * sc; } }
    LDS_WAIT(); asm volatile("" ::: "memory");
    const int c = lane & 7;
#pragma unroll
    for (int j = 0; j < 4; ++j) { const int n = (lane >> 3) + 8 * j; const LAS float* s = scr + (8 * c) * 33 + n;
        v4u o; o.x = pg8::cvt_pk_bf16(s[0 * 33], s[1 * 33]); o.y = pg8::cvt_pk_bf16(s[2 * 33], s[3 * 33]); o.z = pg8::cvt_pk_bf16(s[4 * 33], s[5 * 33]); o.w = pg8::cvt_pk_bf16(s[6 * 33], s[7 * 33]);
        *(v4u*)(dst + (size_t)n * ldk + 8 * c) = o; }
    LDS_WAIT(); asm volatile("" ::: "memory");
}
__device__ __forceinline__ void cvt_finish_fp8(const f32x4 (&v)[8], unsigned char* dst, int ldk, LAS float* scr, int lane) {
    const int kr = lane >> 3, nq = lane & 7;
#pragma unroll
    for (int i = 0; i < 8; ++i) { const int k = 8 * i + kr;
#pragma unroll
        for (int t = 0; t < 4; ++t) scr[k * 33 + 4 * nq + t] = v[i][t] * W8_SCALE; }
    LDS_WAIT(); asm volatile("" ::: "memory");
    const int c = lane & 3;
#pragma unroll
    for (int j = 0; j < 2; ++j) { const int n = (lane >> 2) + 16 * j; const LAS float* s = scr + (16 * c) * 33 + n;
        v4u o; o.x = pack4_fp8(s[0 * 33], s[1 * 33], s[2 * 33], s[3 * 33]); o.y = pack4_fp8(s[4 * 33], s[5 * 33], s[6 * 33], s[7 * 33]);
        o.z = pack4_fp8(s[8 * 33], s[9 * 33], s[10 * 33], s[11 * 33]); o.w = pack4_fp8(s[12 * 33], s[13 * 33], s[14 * 33], s[15 * 33]);
        *(v4u*)(dst + (size_t)n * ldk + 16 * c) = o; }
    LDS_WAIT(); asm volatile("" ::: "memory");
}
__device__ __forceinline__ void cvt_item(const float* src, int ldw, bf16* dst, int ldk, bool rope, const float* kscale, LAS float* scr, int lane) {
    f32x4 v[8]; cvt_load(src, ldw, lane, v); cvt_finish(v, dst, ldk, rope, kscale, scr, lane);
}
constexpr int I_MOD = 1536, I_WIN = 32 * 98, I_WQ = 8 * 48, I_WKV = 8 * 64, I_WOUT = 32 * 64, I_GU = 16 * 32 * 128, I_DN = 16 * 32 * 64, I_SGU = 256, I_ZERO = 768, I_ROPE = 1;
constexpr int P0_ITEMS = I_MOD + I_WIN + I_WQ + I_WKV + I_WOUT + I_SGU + I_ZERO + I_ROPE, PX_ITEMS = I_GU + I_DN;
__device__ __forceinline__ void p0_item(const Ptrs& p, int it, LAS float* scr, int lane) {
    if (it < I_MOD) { p0_mod_item(p, it, lane); return; } it -= I_MOD;
    if (it < I_WIN) { const int kb = it / 98, nb = it - kb * 98, n0 = nb * 32; int col0; bool rope = false;
        if (n0 < 1024) col0 = n0; else if (n0 < 3072) col0 = n0 + 64; else { col0 = OFF_KPE + (nb - 96) * 32; rope = true; }
        cvt_item(p.w_in + (size_t)kb * 64 * INC + col0, INC, (bf16*)(p.ws + WS_WIN_T) + (size_t)n0 * D + kb * 64, D, rope, nullptr, scr, lane); return; } it -= I_WIN;
    if (it < I_WQ) { const int kb = it / 48, nb = it - kb * 48, n0 = nb * 32; int col0; bool rope = false;
        if (n0 < 1024) col0 = (n0 >> 7) * DQK + (n0 & 127); else { const int jj = n0 - 1024; col0 = (jj >> 6) * DQK + 128 + ((jj & 63) >> 5) * 32; rope = true; }
        cvt_item(p.w_uq + (size_t)kb * 64 * 1536 + col0, 1536, (bf16*)(p.ws + WS_WQKV_T) + (size_t)n0 * 512 + kb * 64, 512, rope, p.q_norm_w + kb * 64, scr, lane); return; } it -= I_WQ;
    if (it < I_WKV) { const int kb = it / 64, nb = it - kb * 64, n0 = nb * 32;
        cvt_item(p.w_ukv + (size_t)kb * 64 * 2048 + n0, 2048, (bf16*)(p.ws + WS_WQKV_T) + (size_t)(1536 + n0) * 512 + kb * 64, 512, false, p.kv_norm_w + kb * 64, scr, lane); return; } it -= I_WKV;
    if (it < I_WOUT) { const int kb = it / 64, nb = it - kb * 64, n0 = nb * 32;
        cvt_item(p.w_out + (size_t)kb * 64 * D + n0, D, (bf16*)(p.ws + WS_WOUT_T) + (size_t)n0 * D + kb * 64, D, false, nullptr, scr, lane); return; } it -= I_WOUT;
    if (it < I_SGU) { const float* s = p.sgu_w + (size_t)it * 512 + lane * 8; const f32x4 a = *(const f32x4*)s, b = *(const f32x4*)(s + 4);
        v4u o; o.x = pk2(a[0], a[1]); o.y = pk2(a[2], a[3]); o.z = pk2(b[0], b[1]); o.w = pk2(b[2], b[3]); *(v4u*)((bf16*)(p.ws + WS_SGUW) + (size_t)it * 512 + lane * 8) = o; return; } it -= I_SGU;
    if (it < I_ZERO) { *(v4u*)((bf16*)(p.ws + WS_WIN_T) + (size_t)3136 * D + (size_t)it * 512 + lane * 8) = (v4u){0u, 0u, 0u, 0u}; return; }
    float* tab = (float*)(p.ws + WS_ROPE);
    for (int j = 0; j < 16; ++j) { const int idx = j * 64 + lane, ax = idx >> 4, ii = idx & 15; float s, c; sincosf((float)ax * rope_inv(ii), &s, &c); tab[idx * 2] = c; tab[idx * 2 + 1] = s; }
}
constexpr int PX_N3 = 0, PX_N4 = 0, PX_N8 = 48, PX_R3 = 0, PX_R4 = PX_R3 + 180 * PX_N3, PX_R8 = PX_R4 + 96 * PX_N4, PX_R5 = PX_R8 + 192 * PX_N8;
constexpr int WEL = FP8_MOE ? 1 : 2;
#if 0
#else
__device__ __forceinline__ void px_ptrs(const Ptrs& p, int it, const float*& src, unsigned char*& dst) {
    if (it < I_GU) { const int e = it >> 12, r = it & 4095, kb = r >> 7, nb = r & 127, n0 = nb * 32, pn = n0 >> 8, within = n0 & 255;
        src = (within < 128 ? p.w_e_gate : p.w_e_up) + ((size_t)e * D + kb * 64) * FF + pn * 128 + (within & 127);
        dst = p.ws + WS_WGU_T + (((size_t)e * 4096 + n0) * D + kb * 64) * WEL; }
    else { it -= I_GU; const int e = it >> 11, r = it & 2047, kb = r >> 6, nb = r & 63, n0 = nb * 32;
        src = p.w_e_down + ((size_t)e * FF + kb * 64) * D + n0; dst = p.ws + WS_WD_T + (((size_t)e * D + n0) * FF + kb * 64) * WEL; }
}
__device__ __forceinline__ void px_dma(const float* src, unsigned ldsbase, int lane) {
    typedef __attribute__((address_space(3))) unsigned* ldsp_t;
#pragma unroll
    for (int i = 0; i < 8; ++i) { const int k = 8 * i + (lane >> 3), nq = ((lane & 7) - 2 * (k >> 4)) & 7;
        __builtin_amdgcn_global_load_lds((const unsigned*)(src + (size_t)k * 2048 + 4 * nq), (ldsp_t)(ldsbase + i * 1024), 16, 0, 0); }
}
__device__ __forceinline__ void px_out(unsigned char* dst, const LAS float* t, int lane) {
    if constexpr (FP8_MOE) {
        const int c = lane & 3;
#pragma unroll
        for (int j = 0; j < 2; ++j) { const int n = (lane >> 2) + 16 * j; float v[16];
#pragma unroll
            for (int q = 0; q < 16; ++q) { const int k = 16 * c + q; v[q] = t[(k * 8 + (((n >> 2) + 2 * c) & 7)) * 4 + (n & 3)] * W8_SCALE; }
            v4u o; o.x = pack4_fp8(v[0], v[1], v[2], v[3]); o.y = pack4_fp8(v[4], v[5], v[6], v[7]); o.z = pack4_fp8(v[8], v[9], v[10], v[11]); o.w = pack4_fp8(v[12], v[13], v[14], v[15]);
            *(v4u*)(dst + (size_t)n * 2048 + 16 * c) = o; }
    } else {
        const int c = lane & 7;
#pragma unroll
        for (int j = 0; j < 4; ++j) { const int n = (lane >> 3) + 8 * j; float v[8];
#pragma unroll
            for (int q = 0; q < 8; ++q) { const int k = 8 * c + q; v[q] = t[(k * 8 + (((n >> 2) + 2 * (k >> 4)) & 7)) * 4 + (n & 3)]; }
            v4u o; o.x = pg8::cvt_pk_bf16(v[0], v[1]); o.y = pg8::cvt_pk_bf16(v[2], v[3]); o.z = pg8::cvt_pk_bf16(v[4], v[5]); o.w = pg8::cvt_pk_bf16(v[6], v[7]);
            *(v4u*)((bf16*)dst + (size_t)n * 2048 + 8 * c) = o; }
    }
}
__device__ __forceinline__ void px_convert(const Ptrs& p, int it0, int NGW, int PX_END, LAS float* scr, int lane) {
    const unsigned l0 = (unsigned)(uintptr_t)scr; const float* s_; unsigned char *da, *db;
    int it = it0;
    if (it < PX_END) { px_ptrs(p, it, s_, da); px_dma(s_, l0, lane); }
    while (it < PX_END) {
        const int i1 = it + NGW, i2 = it + 2 * NGW;
        if (i1 < PX_END) { px_ptrs(p, i1, s_, db); px_dma(s_, l0 + 8192, lane); asm volatile("s_waitcnt vmcnt(8)" ::: "memory"); } else asm volatile("s_waitcnt vmcnt(0)" ::: "memory");
        px_out(da, scr, lane);
        if (i1 >= PX_END) break;
        asm volatile("s_waitcnt lgkmcnt(0)" ::: "memory");
        if (i2 < PX_END) { px_ptrs(p, i2, s_, da); px_dma(s_, l0, lane); asm volatile("s_waitcnt vmcnt(8)" ::: "memory"); } else asm volatile("s_waitcnt vmcnt(0)" ::: "memory");
        px_out(db, scr + 2048, lane);
        asm volatile("s_waitcnt lgkmcnt(0)" ::: "memory");
        it = i2;
    }
}
#endif
__device__ __forceinline__ void p1_row(const Ptrs& p, int row, int lane, const LAS float* vg  , const LAS float* vs  ) {
    const float* src = row < M ? p.x + (size_t)row * D : p.ctx + (size_t)(row - M) * D;
    f32x4 v[8]; float s = 0.f;
#pragma unroll
    for (int j = 0; j < 8; ++j) { v[j] = *(const f32x4*)(src + j * 256 + lane * 4); s += dot4(v[j]); }
    const float rs = rsqrtf(wave_sum(s) * (1.f / D) + EPS);
    bf16* o = (bf16*)(p.ws + WS_H) + (size_t)row * D;
#pragma unroll
    for (int j = 0; j < 8; ++j) { const int c = j * 256 + lane * 4; const f32x4 h = v[j] * rs * *(const LAS f32x4*)(vg + c) + *(const LAS f32x4*)(vs + c);
        *(unsigned long long*)(o + c) = (unsigned long long)pk2(h[0], h[1]) | ((unsigned long long)pk2(h[2], h[3]) << 32); }
}
typedef float f32x16 __attribute__((ext_vector_type(16)));
typedef short bf16x8v __attribute__((ext_vector_type(8)));
__device__ __forceinline__ void sgu_unit(const Ptrs& p, int chunk, int g, LAS unsigned char* lds, int tid) {
    constexpr int VROW = 272;
    const int lane = tid & 63, wid = tid >> 6;
    {
        const int q = tid >> 2, cg = tid & 3;
        const bf16* src = (const bf16*)(p.ws + WS_VS) + (size_t)(chunk * 128 + q) * 1024 + g * 128 + cg * 32;
        float x[32];
#pragma unroll
        for (int j = 0; j < 4; ++j) { const v4u w = *(const v4u*)(src + j * 8);
#pragma unroll
            for (int t = 0; t < 4; ++t) { x[j * 8 + 2 * t] = __uint_as_float(w[t] << 16); x[j * 8 + 2 * t + 1] = __uint_as_float(w[t] & 0xffff0000u); } }
        float s = 0.f;
#pragma unroll
        for (int j = 0; j < 32; ++j) s += x[j];
        s += __shfl_xor(s, 1); s += __shfl_xor(s, 2);
        const float mu = s * (1.f / 128.f); float vq = 0.f;
#pragma unroll
        for (int j = 0; j < 32; ++j) { x[j] -= mu; vq += x[j] * x[j]; }
        vq += __shfl_xor(vq, 1); vq += __shfl_xor(vq, 2);
        const float rs = rsqrtf(vq * (1.f / 128.f) + EPS);
        const float* gw = p.sgu_norm_w + g * 128 + cg * 32;
#pragma unroll
        for (int j = 0; j < 32; ++j) *(LAS bf16*)(lds + (cg * 32 + j) * VROW + q * 2) = f2bf(x[j] * rs * gw[j]);
    }
    LDS_WAIT(); __syncthreads();
    const int pb = wid >> 1, ch = wid & 1, r32 = lane & 31, hi = lane >> 5;
    f32x16 acc0 = {}, acc1 = {};
    const bf16* wrow = (const bf16*)(p.ws + WS_SGUW) + ((size_t)g * 128 + pb * 32 + r32) * 128 + hi * 8;
#pragma unroll
    for (int ks = 0; ks < 8; ++ks) {
        const bf16x8v a = *(const bf16x8v*)(wrow + ks * 16);
        const bf16x8v b0 = *(const LAS bf16x8v*)(lds + (ch * 64 + r32) * VROW + (ks * 16 + hi * 8) * 2);
        const bf16x8v b1 = *(const LAS bf16x8v*)(lds + (ch * 64 + 32 + r32) * VROW + (ks * 16 + hi * 8) * 2);
        acc0 = __builtin_amdgcn_mfma_f32_32x32x16_bf16(a, b0, acc0, 0, 0, 0);
        acc1 = __builtin_amdgcn_mfma_f32_32x32x16_bf16(a, b1, acc1, 0, 0, 0);
    }
#pragma unroll
    for (int r = 0; r < 16; ++r) { const int pr = pb * 32 + (r & 3) + 8 * (r >> 2) + 4 * hi; const size_t tok = (size_t)chunk * 128 + pr; const float bias = p.sgu_b[g * 128 + pr];
        const bf16* ur = (const bf16*)(p.ws + WS_U) + tok * 1024 + g * 128 + ch * 64 + r32; bf16* orow = (bf16*)(p.ws + WS_CAT) + tok * D + 1024 + g * 128 + ch * 64 + r32;
        orow[0] = f2bf(bf2f(ur[0]) * (acc0[r] + bias)); orow[32] = f2bf(bf2f(ur[32]) * (acc1[r] + bias)); }
    __syncthreads();
}
__device__ __forceinline__ void topk_unit(const Ptrs& p, int e, int b, LAS unsigned* sh, int tid) {
    const int lane = tid & 63, wid = tid >> 6;
    const float* aff = (const float*)(p.ws + WS_AFF) + (size_t)b * L * 16 + e;
    unsigned key[8];
#pragma unroll
    for (int j = 0; j < 8; ++j) key[j] = __float_as_uint(aff[(size_t)(tid * 8 + j) * 16]);
    unsigned prefix = 0u, mask = 0u, need = CAP;
    for (int shift = 24; shift >= 0; shift -= 8) {
        if (tid < 256) sh[tid] = 0u;
        __syncthreads();
#pragma unroll
        for (int j = 0; j < 8; ++j) if ((key[j] & mask) == prefix) atomicAdd((unsigned*)&sh[(key[j] >> shift) & 255u], 1u);
        __syncthreads();
        if (wid == 0) {
            const unsigned c0 = sh[4 * lane], c1 = sh[4 * lane + 1], c2 = sh[4 * lane + 2], c3 = sh[4 * lane + 3];
            const unsigned s = c0 + c1 + c2 + c3; unsigned S = s;
#pragma unroll
            for (int d = 1; d < 64; d <<= 1) { const unsigned v = __shfl_down(S, d); if (lane + d < 64) S += v; }
            const unsigned above = S - s;
            if (S >= need && above < need) { unsigned cum = above, bin, nd;
                if (cum + c3 >= need) { bin = 3; nd = need - cum; } else { cum += c3;
                if (cum + c2 >= need) { bin = 2; nd = need - cum; } else { cum += c2;
                if (cum + c1 >= need) { bin = 1; nd = need - cum; } else { cum += c1; bin = 0; nd = need - cum; } } }
                sh[256] = 4u * lane + bin; sh[257] = nd; }
        }
        __syncthreads();
        prefix |= sh[256] << shift; mask |= 255u << shift; need = sh[257];
        __syncthreads();
    }
    unsigned cg = 0u, ce = 0u;
#pragma unroll
    for (int j = 0; j < 8; ++j) { cg += key[j] > prefix ? 1u : 0u; ce += key[j] == prefix ? 1u : 0u; }
    unsigned pk = (cg << 16) | ce, inc = pk;
#pragma unroll
    for (int d = 1; d < 64; d <<= 1) { const unsigned v = __shfl_up(inc, d); if (lane >= d) inc += v; }
    if (lane == 63) sh[264 + wid] = inc;
    __syncthreads();
    unsigned off = 0u;
#pragma unroll
    for (int w = 0; w < 8; ++w) off += (w < wid) ? sh[264 + w] : 0u;
    unsigned ex = off + inc - pk; unsigned gtb = ex >> 16, eqb = ex & 0xffffu;
    int* inv = (int*)(p.ws + WS_INV) + (size_t)(b * L + tid * 8) * 16 + e; int* idx = (int*)(p.ws + WS_IDX) + (size_t)(e * 4 + b) * CAP;
#pragma unroll
    for (int j = 0; j < 8; ++j) { const bool gt = key[j] > prefix, eq = key[j] == prefix; const bool sel = gt || (eq && eqb < need);
        const unsigned slot = gtb + (eqb < need ? eqb : need);
        inv[(size_t)j * 16] = sel ? (int)slot : -1; if (sel) idx[slot] = tid * 8 + j;
        gtb += gt ? 1u : 0u; eqb += eq ? 1u : 0u; }
    __syncthreads();
}

__device__ __forceinline__ f32x4 ld_bf16x4(const bf16* s) { const unsigned long long w = *(const unsigned long long*)s; const unsigned lo = (unsigned)w, hi2 = (unsigned)(w >> 32);
    return (f32x4){__uint_as_float(lo << 16), __uint_as_float(lo & 0xffff0000u), __uint_as_float(hi2 << 16), __uint_as_float(hi2 & 0xffff0000u)}; }
__device__ __forceinline__ void st_bf16x4(bf16* d, const f32x4& h) { *(unsigned long long*)d = (unsigned long long)pk2(h[0], h[1]) | ((unsigned long long)pk2(h[2], h[3]) << 32); }
struct P6In { f32x4 x[8]; unsigned long long y[8]; float ssq; };
__device__ __forceinline__ void p6_fetch(const Ptrs& p, int row, int lane, P6In& in) {
    const float* xr = p.x + (size_t)row * D + lane * 4; const bf16* y = (const bf16*)(p.ws + WS_Y) + (size_t)row * D + lane * 4;
#pragma unroll
    for (int j = 0; j < 8; ++j) { in.x[j] = *(const f32x4*)(xr + j * 256); in.y[j] = *(const unsigned long long*)(y + j * 256); }
    in.ssq = lane < 32 ? ((const float*)(p.ws + WS_SSQY))[(size_t)row * 32 + lane] : 0.f;
}
__device__ __forceinline__ f32x4 bf16x4_to_f32(unsigned long long w) { const unsigned lo = (unsigned)w, hi2 = (unsigned)(w >> 32);
    return (f32x4){__uint_as_float(lo << 16), __uint_as_float(lo & 0xffff0000u), __uint_as_float(hi2 << 16), __uint_as_float(hi2 & 0xffff0000u)}; }
__device__ __forceinline__ void p6_row(const Ptrs& p, int row, int lane, const LAS float* wt, const LAS float* vt, const P6In& in, int flags) {
    const float rsy = rsqrtf(wave_sum(in.ssq) * (1.f / D) + EPS);
    bf16* o = (bf16*)(p.ws + ((flags & 1) ? WS_VN : WS_XN)) + (size_t)row * D;
    f32x4 v[8]; float s = 0.f;
#pragma unroll
    for (int j = 0; j < 8; ++j) { const int c = j * 256 + lane * 4;
        v[j] = in.x[j] + (bf16x4_to_f32(in.y[j]) * rsy) * *(const LAS f32x4*)(vt + c);
        st_bf16x4(o + c, v[j]); s += dot4(v[j]); }
    const float rs = rsqrtf(wave_sum(s) * (1.f / D) + EPS);
    bf16* h2 = (bf16*)(p.ws + ((flags & 1) ? WS_VN : WS_H2)) + (size_t)row * D;
    float lg[16];
#pragma unroll
    for (int e = 0; e < 16; ++e) lg[e] = 0.f;
    f32x4 hv[8];
#pragma unroll
    for (int j = 0; j < 8; ++j) { const int c = j * 256 + lane * 4;
        hv[j] = v[j] * rs * *(const LAS f32x4*)(vt + 2048 + c) + *(const LAS f32x4*)(vt + 4096 + c);
        if constexpr (FP8_MOE) *(unsigned*)((unsigned char*)(p.ws + ((flags & 1) ? WS_VN : WS_H2)) + (size_t)row * D + c) = pack4_fp8(hv[j][0], hv[j][1], hv[j][2], hv[j][3]); else st_bf16x4(h2 + c, hv[j]); }
    if (!(flags & 2)) {
        f32x4 wa[8], wb[8];
#define RLOAD(dst, st) do { const LAS float* wp_ = wt + ((st) & 1) * 8 * 2048 + ((st) >> 1) * 256 + lane * 4; _Pragma("unroll") for (int e_ = 0; e_ < 8; ++e_) dst[e_] = *(const LAS f32x4*)(wp_ + e_ * 2048); } while (0)
#define RFMA(src, st) do { const f32x4 h_ = hv[(st) >> 1]; _Pragma("unroll") for (int e_ = 0; e_ < 8; ++e_) lg[((st) & 1) * 8 + e_] += (h_[0] * src[e_][0] + h_[1] * src[e_][1]) + (h_[2] * src[e_][2] + h_[3] * src[e_][3]); } while (0)
        RLOAD(wa, 0);
#pragma unroll
        for (int st = 0; st < 16; st += 2) {
            RLOAD(wb, st + 1); __builtin_amdgcn_sched_barrier(0); RFMA(wa, st); __builtin_amdgcn_sched_barrier(0);
            if (st + 2 < 16) RLOAD(wa, st + 2); __builtin_amdgcn_sched_barrier(0); RFMA(wb, st + 1); __builtin_amdgcn_sched_barrier(0);
        }
#undef RLOAD
#undef RFMA
    }
#define XSTEP(N, MASK) _Pragma("unroll") for (int i = 0; i < N; ++i) { const bool up = (lane & MASK) != 0; const float send = up ? lg[i] : lg[i + N]; const float keep = up ? lg[i + N] : lg[i]; lg[i] = keep + __shfl_xor(send, MASK); }
    XSTEP(8, 32) XSTEP(4, 16) XSTEP(2, 8) XSTEP(1, 4)
#undef XSTEP
    float lgt = lg[0]; lgt += __shfl_xor(lgt, 2); lgt += __shfl_xor(lgt, 1);
    lgt += p.b_router[lane >> 2];
    float mx = lgt;
#pragma unroll
    for (int o2 = 4; o2 < 64; o2 <<= 1) mx = fmaxf(mx, __shfl_xor(mx, o2));
    const float ex = __expf(lgt - mx); float se = ex;
#pragma unroll
    for (int o2 = 4; o2 < 64; o2 <<= 1) se += __shfl_xor(se, o2);
    if ((lane & 3) == 0 && !(flags & 1)) ((float*)(p.ws + WS_AFF))[(size_t)row * 16 + (lane >> 2)] = ex / se;
}
typedef unsigned u32x4v __attribute__((ext_vector_type(4)));
struct P11In { u32x4v x[4]; int inv; float aff; };
__device__ __forceinline__ void p11_fetch(const Ptrs& p, int row, int lane, P11In& in) {
    const bf16* xr = (const bf16*)(p.ws + WS_XN) + (size_t)row * D + lane * 8;
#pragma unroll
    for (int j = 0; j < 4; ++j) in.x[j] = *(const u32x4v*)(xr + j * 512);
    in.inv = ((const int*)(p.ws + WS_INV))[(size_t)row * 16 + (lane & 15)]; in.aff = ((const float*)(p.ws + WS_AFF))[(size_t)row * 16 + (lane & 15)];
}
__device__ __forceinline__ void acc_bf16x8(f32x4& a, f32x4& b, const u32x4v& w, float g) {
    a[0] += g * __uint_as_float(w[0] << 16); a[1] += g * __uint_as_float(w[0] & 0xffff0000u); a[2] += g * __uint_as_float(w[1] << 16); a[3] += g * __uint_as_float(w[1] & 0xffff0000u);
    b[0] += g * __uint_as_float(w[2] << 16); b[1] += g * __uint_as_float(w[2] & 0xffff0000u); b[2] += g * __uint_as_float(w[3] << 16); b[3] += g * __uint_as_float(w[3] & 0xffff0000u);
}
__device__ __forceinline__ void p11_row(const Ptrs& p, int row, int lane, float* dsto, const LAS float* vt, const P11In& in, int flags) {
    const int b = row >> 12;
    unsigned mask = (flags & 2) ? 0u : (unsigned)(__ballot(in.inv >= 0) & 0xffffull);
    f32x4 v[8];
#pragma unroll
    for (int j = 0; j < 8; ++j) v[j] = (f32x4){0.f, 0.f, 0.f, 0.f};
    while (mask) {
#if FP8_MOE
        unsigned long long r[4][4]; float g[4]; bool on[4];
#pragma unroll
        for (int k = 0; k < 4; ++k) { on[k] = mask != 0u; g[k] = 0.f;
            if (on[k]) { const int e = __builtin_ctz(mask); mask &= mask - 1u; const int sl = __builtin_amdgcn_readlane(in.inv, e); g[k] = __int_as_float(__builtin_amdgcn_readlane(__float_as_int(in.aff), e));
                const unsigned char* ye = p.ws + WS_YE + ((size_t)(e * 4 + b) * CAP + sl) * D + lane * 8;
#pragma unroll
                for (int j = 0; j < 4; ++j) r[k][j] = *(const unsigned long long*)(ye + j * 512); } }
#pragma unroll
        for (int k = 0; k < 4; ++k) if (on[k]) {
#pragma unroll
            for (int j = 0; j < 4; ++j) { const int lo32 = (int)(unsigned)r[k][j], hi32 = (int)(unsigned)(r[k][j] >> 32);
                const auto a0 = __builtin_amdgcn_cvt_pk_f32_fp8(lo32, false), a1 = __builtin_amdgcn_cvt_pk_f32_fp8(lo32, true), b0 = __builtin_amdgcn_cvt_pk_f32_fp8(hi32, false), b1 = __builtin_amdgcn_cvt_pk_f32_fp8(hi32, true);
                v[2 * j][0] += g[k] * a0[0]; v[2 * j][1] += g[k] * a0[1]; v[2 * j][2] += g[k] * a1[0]; v[2 * j][3] += g[k] * a1[1];
                v[2 * j + 1][0] += g[k] * b0[0]; v[2 * j + 1][1] += g[k] * b0[1]; v[2 * j + 1][2] += g[k] * b1[0]; v[2 * j + 1][3] += g[k] * b1[1]; } }
#else
        u32x4v r[4][4]; float g[4]; bool on[4];
#pragma unroll
        for (int k = 0; k < 4; ++k) { on[k] = mask != 0u; g[k] = 0.f;
            if (on[k]) { const int e = __builtin_ctz(mask); mask &= mask - 1u; const int sl = __builtin_amdgcn_readlane(in.inv, e); g[k] = __int_as_float(__builtin_amdgcn_readlane(__float_as_int(in.aff), e));
                const bf16* ye = (const bf16*)(p.ws + WS_YE) + ((size_t)(e * 4 + b) * CAP + sl) * D + lane * 8;
#pragma unroll
                for (int j = 0; j < 4; ++j) r[k][j] = *(const u32x4v*)(ye + j * 512); } }
#pragma unroll
        for (int k = 0; k < 4; ++k) if (on[k]) {
#pragma unroll
            for (int j = 0; j < 4; ++j) acc_bf16x8(v[2 * j], v[2 * j + 1], r[k][j], g[k]); }
#endif
    }
    float s = 0.f;
#pragma unroll
    for (int j = 0; j < 8; ++j) s += dot4(v[j]);
    const float rs = rsqrtf(wave_sum(s) * (1.f / D) + EPS);
    float* od = dsto + (size_t)row * D + lane * 8;
#pragma unroll
    for (int j = 0; j < 4; ++j) { const int c = j * 512 + lane * 8;
        const u32x4v xw = in.x[j];
        const f32x4 xa = (f32x4){__uint_as_float(xw[0] << 16), __uint_as_float(xw[0] & 0xffff0000u), __uint_as_float(xw[1] << 16), __uint_as_float(xw[1] & 0xffff0000u)};
        const f32x4 xb = (f32x4){__uint_as_float(xw[2] << 16), __uint_as_float(xw[2] & 0xffff0000u), __uint_as_float(xw[3] << 16), __uint_as_float(xw[3] & 0xffff0000u)};
        *(f32x4*)(od + j * 512) = xa + (v[2 * j] * rs) * *(const LAS f32x4*)(vt + c);
        *(f32x4*)(od + j * 512 + 4) = xb + (v[2 * j + 1] * rs) * *(const LAS f32x4*)(vt + c + 4); }
}

struct Args { Ptrs p; int ph_lo, ph_hi, bar_idx, pad; };
#ifdef DUP_PHASE
#define PROBE_FLAGS args.pad
#else
#define PROBE_FLAGS 0
#endif
__global__ void __launch_bounds__(NTHREADS, 2) fwd(Args args) {
    extern __shared__ __attribute__((aligned(16))) unsigned char lds_raw[];
    LAS unsigned char* lds = (LAS unsigned char*)lds_raw;
#if defined(__HIP_DEVICE_COMPILE__)
    typedef __attribute__((address_space(4))) const Args CArgs;
#define LOADP() Ptrs p; { const CArgs* kp_ = (const CArgs*)__builtin_amdgcn_kernarg_segment_ptr(); asm volatile("" : "+s"(kp_)); p = kp_->p; }
#else
#define LOADP() Ptrs p = args.p;
#endif
#define TIDS() int tid = threadIdx.x; asm volatile("" : "+v"(tid)); const int lane = tid & 63, wave = __builtin_amdgcn_readfirstlane(tid >> 6); \
    const int G = gridDim.x, bx = blockIdx.x, vcu = (G % 8 == 0) ? (bx % 8) * (G / 8) + bx / 8 : bx; const int gw = vcu * NWAVES + wave, NGW = G * NWAVES; (void)lane; (void)gw; (void)NGW; (void)vcu; (void)bx;
    volatile LAS unsigned* MISC = (volatile LAS unsigned*)(lds + MISC_OFF);
    if (threadIdx.x < 64) MISC[threadIdx.x] = 0u;
    __syncthreads();
#if defined(__HIP_DEVICE_COMPILE__)
#define ARGF(f) ([&]() { const CArgs* kq_ = (const CArgs*)__builtin_amdgcn_kernarg_segment_ptr(); asm volatile("" : "+s"(kq_)); return kq_->f; }())
#else
#define ARGF(f) (args.f)
#endif
    if (ARGF(ph_hi) - ARGF(ph_lo) > 1) { LOADP(); (void)xcd_barrier_post((unsigned*)(p.ws + WS_CTL) + CW_BAR + ARGF(bar_idx) * 4096, MISC + 8); }
#define GRID_BARRIER() do { LOADP(); XcdBarrier b_; b_.bar = (unsigned*)(p.ws + WS_CTL) + CW_BAR + ARGF(bar_idx) * 4096; b_.x = xb_xcc_id(); b_.st = (volatile LAS unsigned*)(lds + MISC_OFF) + 8; xcd_barrier(b_); } while (0)
#define lo ARGF(ph_lo)
#define hi ARGF(ph_hi)
#if defined(ONLY_SET)
#define IN(k) (((ONLY_SET >> (k)) & 1) && lo <= (k) && (k) < hi)
#elif defined(ONLY_PHASE)
#define IN(k) ((k) == ONLY_PHASE && lo <= (k) && (k) < hi)
#else
#define IN(k) (lo <= (k) && (k) < hi)
#endif
#define SEAM(k) do { if (IN(k) && IN((k) + 1)) GRID_BARRIER(); } while (0)

    if (IN(0)) { LOADP(); TIDS();
        LAS float* scr = (LAS float*)(lds + wave * 8448);
        for (int it = gw; it < P0_ITEMS; it += NGW) p0_item(p, it, scr, lane);
    }
    SEAM(0);
    if (IN(1)) { LOADP(); TIDS();
        const int gid = bx * NTHREADS + tid;
        if (gid < 5 * 12288) { const int r = gid / 12288, j = gid - r * 12288; float s = p.b_ada[j]; const float* part = (const float*)(p.ws + WS_PART) + (size_t)r * 12288 + j;
            for (int kc = 0; kc < 32; ++kc) s += part[(size_t)kc * 5 * 12288];
            ((float*)(p.ws + WS_MOD))[gid] = s; }
    }
    SEAM(1);
    if (IN(2)) { LOADP(); TIDS();
        const int bsel = vcu & 3, wsub = (vcu >> 2) * NWAVES + wave, nsub = ((G + 3 - bsel) >> 2) * NWAVES;
        LAS float* vt = (LAS float*)lds;
        for (int c = tid; c < D; c += NTHREADS) { const float* mb = (const float*)(p.ws + WS_MOD) + bsel * 12288; const float* mc = (const float*)(p.ws + WS_MOD) + 4 * 12288; const float g = p.pre_norm1[c];
            vt[c] = g * (1.f + mb[2048 + c]); vt[2048 + c] = mb[c]; vt[4096 + c] = g * (1.f + mc[2048 + c]); vt[6144 + c] = mc[c]; }
        LDS_WAIT(); __syncthreads();
        for (int r = wsub; r < L; r += nsub) p1_row(p, bsel * L + r, lane, vt, vt + 2048);
        for (int row = M + gw; row < MALL; row += NGW) p1_row(p, row, lane, vt + 4096, vt + 6144);
        __syncthreads();
    }
    SEAM(2);
    if (IN(3)) { LOADP(); TIDS();
        SchedIn S{(const char*)(p.ws + WS_H), (const char*)(p.ws + WS_WIN_T), G, bx}; EpiIn E{p.ws};
        pg8::gemm_phase<EpiIn, SchedIn>(lds, 2048, S, E);
        if (G == 256 && bx >= 76) { const int base = PX_R3 + (bx - 76) * PX_N3; px_convert(p, base + wave, NWAVES, base + PX_N3, (LAS float*)(lds + wave * 16384), lane); __syncthreads(); }
    }
    SEAM(3);
    if (IN(4)) { LOADP(); TIDS();
        SchedQKV S{(const char*)(p.ws + WS_CQKV), (const char*)(p.ws + WS_WQKV_T), G, bx};
        LAS float* rstab = (LAS float*)(lds + TAB_OFF);
        for (int q = tid; q < 2048; q += NTHREADS) { const int i = q >> 8, r = q & 255; Unit u;
            if (S.next(i, u)) { const float* sp = u.pm < 64 ? (const float*)(p.ws + WS_SSQQ) + (size_t)(u.pm * 256 + r) * 8 : (const float*)(p.ws + WS_SSQKV) + (size_t)((u.pm - 64) * 256 + r) * 8;
                const f32x4 s0 = *(const f32x4*)sp, s1 = *(const f32x4*)(sp + 4);
                rstab[q] = rsqrtf((((s0[0] + s0[1]) + (s0[2] + s0[3])) + ((s1[0] + s1[1]) + (s1[2] + s1[3]))) * (1.f / 512.f) + EPS); } }
        LDS_WAIT(); __syncthreads();
        EpiQKV E{p.ws, rstab};
        pg8::gemm_phase<EpiQKV, SchedQKV>(lds, 512, S, E);
        if (G == 256 && bx >= 160) { const int base = PX_R4 + (bx - 160) * PX_N4; px_convert(p, base + wave, NWAVES, base + PX_N4, (LAS float*)(lds + wave * 16384), lane); }
        __syncthreads();
        for (int u = vcu; u < 1024; u += G) sgu_unit(p, u >> 3, u & 7, lds, tid);
    }
    SEAM(4);
    if (IN(5)) { TIDS();
        const int grp = vcu % 3;
#ifdef PX_TWICE
#define PX_REP 2
#else
#define PX_REP 1
#endif
#define PX_CONV(g) do { if (grp == (g)) { LOADP(); __syncthreads(); for (int rep_ = 0; rep_ < PX_REP; ++rep_) px_convert(p, (G == 256 ? PX_R5 : 0) + gw, NGW, PX_ITEMS, (LAS float*)(lds + wave * 16384), lane); __syncthreads(); } } while (0)
#define ATT_UNIT(u_) do { const int u = (u_); if (u < 512) { LOADP(); const int bh = u >> 4, qb = u & 15; __syncthreads(); \
            att::attn_unit<0>((const bf16*)(p.ws + WS_Q) + ((size_t)bh * L + qb * 256) * DQK, (const bf16*)(p.ws + WS_K) + (size_t)bh * LK * DQK, (const bf16*)(p.ws + WS_V) + (size_t)bh * LK * VH, \
                           (bf16*)(p.ws + WS_CAT) + ((size_t)(bh >> 3) * L + qb * 256) * D + (bh & 7) * 128, LK, (char*)lds_raw); } } while (0)
        PX_CONV(0); ATT_UNIT(vcu); PX_CONV(1); ATT_UNIT(vcu + G); PX_CONV(2);
        for (int u = vcu + 2 * G; u < 512; u += G) ATT_UNIT(u);
#undef PX_CONV
#undef ATT_UNIT
        __syncthreads();
    }
    SEAM(5);
    if (IN(6)) { LOADP(); TIDS();
        typedef SchedDense<64, 8, 31, 2048> SD; SD S{(const char*)(p.ws + WS_CAT), (const char*)(p.ws + WS_WOUT_T), G, bx}; EpiY E{p.ws};
        pg8::gemm_phase<EpiY, SD>(lds, 2048, S, E);
    }
    SEAM(6);
    if (IN(7)) { LOADP(); TIDS();
        LAS float* wt = (LAS float*)lds;
        for (int c = tid; c < D; c += NTHREADS) { const float* wr = p.w_router + (size_t)c * 16;
#pragma unroll
            for (int q = 0; q < 4; ++q) { const f32x4 w = *(const f32x4*)(wr + q * 4);
#pragma unroll
                for (int t = 0; t < 4; ++t) wt[(q * 4 + t) * 2048 + c] = w[t]; } }
        LDS_WAIT(); __syncthreads();
        const int bsel = vcu & 3, wsub = (vcu >> 2) * NWAVES + wave, nsub = ((G + 3 - bsel) >> 2) * NWAVES;
        LAS float* vt = (LAS float*)(lds + VEC_OFF);
        for (int c = tid; c < D; c += NTHREADS) { const float* mb = (const float*)(p.ws + WS_MOD) + bsel * 12288;
            vt[c] = mb[4096 + c] * p.post_norm1[c]; vt[2048 + c] = p.pre_norm2[c] * (1.f + mb[8192 + c]); vt[4096 + c] = mb[6144 + c]; }
        LDS_WAIT(); __syncthreads();
        { P6In nxt; if (wsub < L) p6_fetch(p, bsel * L + wsub, lane, nxt);
          for (int r = wsub; r < L; r += nsub) { const P6In cur = nxt; if (r + nsub < L) p6_fetch(p, bsel * L + r + nsub, lane, nxt);
              p6_row(p, bsel * L + r, lane, wt, vt, cur, PROBE_FLAGS); } }
        __syncthreads();
    }
    SEAM(7);
    if (IN(8)) { LOADP(); TIDS(); for (int u = bx; u < 64; u += G) topk_unit(p, u >> 2, u & 3, (LAS unsigned*)lds, tid);
        if (G == 256 && bx >= 64) { const int base = PX_R8 + (bx - 64) * PX_N8; px_convert(p, base + wave, NWAVES, base + PX_N8, (LAS float*)(lds + wave * 16384), lane); } }
    SEAM(8);
    if (IN(9)) { LOADP(); TIDS();
        constexpr int KU = FP8_MOE ? 1024 : 2048;
        typedef SchedGather<KU> SG; SG S{(const char*)(p.ws + WS_H2), (const char*)(p.ws + WS_WGU_T), G, bx, (const LAS unsigned*)(lds + TAB_OFF)};
        for (int q = tid; q < 2048; q += NTHREADS) { const int i = q >> 8, r = q & 255; Unit u;
            if (S.next(i, u)) { const int e = u.pm >> 3, m = (u.pm & 7) * 256 + r, b = m >> 9; const int tok = ((const int*)(p.ws + WS_IDX))[(size_t)(e * 4 + b) * CAP + (m & 511)];
                ((LAS unsigned*)(lds + TAB_OFF))[q] = (unsigned)(b * L + tok) * (unsigned)(KU * 2); } }
        LDS_WAIT(); __syncthreads();
        if constexpr (FP8_MOE) { EpiAct8 E{p.ws}; pg8::gemm_phase<EpiAct8, SG, true>(lds, KU, S, E); }
        else { EpiAct E{p.ws}; pg8::gemm_phase<EpiAct, SG, false>(lds, KU, S, E); }
    }
    SEAM(9);
    if (IN(10)) { LOADP(); TIDS();
        constexpr int KU = FP8_MOE ? 1024 : 2048;
        typedef SchedDense<128, 8, 3, KU> SD; SD S{(const char*)(p.ws + WS_ACT), (const char*)(p.ws + WS_WD_T), G, bx};
        if constexpr (FP8_MOE) { EpiYE8 E{p.ws}; pg8::gemm_phase<EpiYE8, SD, true>(lds, KU, S, E); }
        else { EpiYE E{p.ws}; pg8::gemm_phase<EpiYE, SD, false>(lds, KU, S, E); }
    }
    SEAM(10);
    if (IN(11)) { LOADP(); TIDS(); float* dsto = p.out;
        const int bsel = vcu & 3, wsub = (vcu >> 2) * NWAVES + wave, nsub = ((G + 3 - bsel) >> 2) * NWAVES;
        LAS float* vt = (LAS float*)(lds + VEC_OFF);
        for (int c = tid; c < D; c += NTHREADS) vt[c] = ((const float*)(p.ws + WS_MOD))[bsel * 12288 + 10240 + c] * p.post_norm2[c];
        LDS_WAIT(); __syncthreads();
        P11In nxt; if (wsub < L) p11_fetch(p, bsel * L + wsub, lane, nxt);
        for (int r = wsub; r < L; r += nsub) { const P11In cur = nxt; if (r + nsub < L) p11_fetch(p, bsel * L + r + nsub, lane, nxt); p11_row(p, bsel * L + r, lane, dsto, vt, cur, PROBE_FLAGS); } }
#ifdef PROBE_ATTN
    if (IN(12)) { TIDS();
        for (int u = vcu; u < 512; u += G) { LOADP(); const int bh = u >> 4, qb = u & 15; __syncthreads();
            att::attn_unit<PROBE_ATTN>((const bf16*)(p.ws + WS_Q) + ((size_t)bh * L + qb * 256) * DQK, (const bf16*)(p.ws + WS_K) + (size_t)bh * LK * DQK, (const bf16*)(p.ws + WS_V) + (size_t)bh * LK * VH,
                           (bf16*)(p.ws + WS_S) + ((size_t)(bh >> 3) * L + qb * 256) * D + (bh & 7) * 128, LK, (char*)lds_raw); }
        __syncthreads(); }
#endif
#undef IN
#undef SEAM
#undef lo
#undef hi
}

#ifndef PHASE_MODE
#define PHASE_MODE "FFFFFFFFFFFF"
#endif
#ifndef DUP_FLAGS
#define DUP_FLAGS 0
#endif
#ifndef MERGE
#define MERGE 1
#endif
template <class P> static void launch_ngemm(const P& f, int Mr, int Nr, int Z, hipStream_t s) { hipLaunchKernelGGL((ngemm<P>), dim3(Nr / 64, Mr / 64, Z), dim3(256), 0, s, f); }
static void naive_phase(int ph, const Ptrs& p, hipStream_t stream) {
    switch (ph) {
    case 0: hipLaunchKernelGGL(n_mod, dim3(48, 5), dim3(256), 0, stream, p); break;
    case 1: break;
    case 2: hipLaunchKernelGGL(n_hrows, dim3(MALL / 4), dim3(256), 0, stream, p); break;
    case 3: launch_ngemm(GIn{p, D}, MALL, 3136, 1, stream);
        hipLaunchKernelGGL(n_ssq, dim3(M / 4), dim3(256), 0, stream, (const bf16*)(p.ws + WS_CQKV), M, 512, (float*)(p.ws + WS_SSQQ), 8);
        hipLaunchKernelGGL(n_ssq, dim3(MALL / 4), dim3(256), 0, stream, (const bf16*)(p.ws + WS_CQKV) + (size_t)M * 512, MALL, 512, (float*)(p.ws + WS_SSQKV), 8); break;
    case 4: launch_ngemm(GQ{p, 512}, M, 1536, 1, stream); launch_ngemm(GKV{p, 512}, MALL, 2048, 1, stream);
        hipLaunchKernelGGL(n_vn, dim3(M * 8 / 4), dim3(256), 0, stream, p); launch_ngemm(GSgu{p, 128}, 128, 128, 1024, stream); break;
    case 5: for (int bh = 0; bh < B * H; ++bh) { launch_ngemm(GScore{p, DQK, bh}, L, LK, 1, stream);
            hipLaunchKernelGGL(n_softmax, dim3(L), dim3(256), 0, stream, (float*)(p.ws + WS_S), LK); launch_ngemm(GPV{p, LK, bh}, L, VH, 1, stream); } break;
    case 6: launch_ngemm(GOut{p, D}, M, D, 1, stream);
        hipLaunchKernelGGL(n_ssq, dim3(M / 4), dim3(256), 0, stream, (const bf16*)(p.ws + WS_Y), M, D, (float*)(p.ws + WS_SSQY), 32); break;
    case 7: hipLaunchKernelGGL(n_rowmid, dim3(M / 4), dim3(256), 0, stream, p); break;
    case 8: hipLaunchKernelGGL(n_topk, dim3(64), dim3(1024), 0, stream, p); break;
    case 9: launch_ngemm(GE1{p, D}, 2048, 4096, 16, stream); break;
    case 10: launch_ngemm(GE2{p, FF}, 2048, 2048, 16, stream); break;
    case 11: hipLaunchKernelGGL(n_rowfinal, dim3(M / 4), dim3(256), 0, stream, p); break;
    }
}
extern "C" void kernel_launch(void* const* d_in, const int* in_sizes, int n_in, void* d_out, int out_size, void* d_ws, size_t ws_size, hipStream_t stream) {
    static int grid = 0;
    if (grid == 0) {
        if (n_in != 24 || ws_size < WS_END || out_size != M * D) { fprintf(stderr, "kernel_launch: unexpected shapes n_in %d ws %zu out %d\n", n_in, ws_size, out_size); grid = -1; return; }
        int dev = 0, cus = 0, per_cu = 0;
        if (hipGetDevice(&dev) != hipSuccess || hipDeviceGetAttribute(&cus, hipDeviceAttributeMultiprocessorCount, dev) != hipSuccess) { grid = -1; return; }
        if (hipFuncSetAttribute((const void*)fwd, hipFuncAttributeMaxDynamicSharedMemorySize, LDS_BYTES) != hipSuccess) { fprintf(stderr, "kernel_launch: hipFuncSetAttribute failed\n"); grid = -1; return; }
        if (hipOccupancyMaxActiveBlocksPerMultiprocessor(&per_cu, (const void*)fwd, NTHREADS, LDS_BYTES) != hipSuccess || per_cu < 1) fprintf(stderr, "kernel_launch: occupancy query says %d\n", per_cu);
        (void)hipGetLastError();
        grid = cus;
    }
    if (grid < 0) return;
    Ptrs p{};
    const float** f = (const float**)&p;
    for (int i = 0; i < 24; ++i) f[i] = (const float*)d_in[i];
    p.out = (float*)d_out; p.ws = (unsigned char*)d_ws;
    (void)hipMemsetAsync(p.ws + WS_CTL, 0, 1 * MiB, stream);
    const char* mode = PHASE_MODE; int nbar = 0;
    for (int ph = 0; ph < 12;) {
#ifdef DUP_PHASE
        if (ph == 11 && DUP_PHASE == 11) { Args a2{}; a2.p = p; a2.ph_lo = 11; a2.ph_hi = 12; a2.bar_idx = nbar++; a2.pad = 1 | DUP_FLAGS; hipLaunchKernelGGL(fwd, dim3(grid), dim3(NTHREADS), LDS_BYTES, stream, a2); }
#endif
        if (mode[ph] == 'F') { int e = ph + 1; if (MERGE) while (e < 12 && mode[e] == 'F') ++e;
            Args a{}; a.p = p; a.ph_lo = ph; a.ph_hi = e; a.bar_idx = nbar++; a.pad = 0;
            hipLaunchKernelGGL(fwd, dim3(grid), dim3(NTHREADS), LDS_BYTES, stream, a);
            const hipError_t le = hipPeekAtLastError(); if (le != hipSuccess) fprintf(stderr, "kernel_launch: launch failed: %s\n", hipGetErrorName(le));
#ifdef PROBE_ATTN
            if (ph == 5) { Args a3 = a; a3.ph_lo = 12; a3.ph_hi = 13; a3.bar_idx = nbar++; hipLaunchKernelGGL(fwd, dim3(grid), dim3(NTHREADS), LDS_BYTES, stream, a3); }
#endif
#ifdef DUP_PHASE
            if (ph == DUP_PHASE && ph != 11) { Args a2 = a; a2.bar_idx = nbar++; a2.pad = DUP_FLAGS; hipLaunchKernelGGL(fwd, dim3(grid), dim3(NTHREADS), LDS_BYTES, stream, a2);
                if (ph == 11) hipLaunchKernelGGL(fwd, dim3(grid), dim3(NTHREADS), LDS_BYTES, stream, a2); }
#endif
            ph = e; }
        else { naive_phase(ph, p, stream); ++ph; }
    }
}
```

```cpp
#define PHASE_MODE "FFFFFFFFFFFF"
#define MERGE 1
#define FINAL_BUILD 1
#include <hip/hip_runtime.h>
#include <cstdio>
#include <cstdint>

typedef unsigned short bf16;
#ifndef FP8_MOE
#define FP8_MOE 1
#endif
namespace cfg {
constexpr int B = 4, L = 4096, D = 2048, CTX = 256, H = 8, LK = L + CTX;
constexpr int M = B * L;
constexpr int MC = B * CTX;
constexpr int MALL = M + MC;
constexpr int QL = 512, KVL = 512, NOPE = 128, ROPE = 64, VH = 128, DQK = 192;
constexpr int SGW = 1024, INC = 3136, OFF_KPE = 1024, OFF_U = 1088, OFF_V = 2112;
constexpr int NE = 16, CAP = 512, FF = 2048;
constexpr float EPS = 1e-6f;
constexpr float ATT_SCALE = 0.07216878364870322f;
constexpr size_t MiB = 1u << 20;
constexpr size_t WS_CTL = 0;
constexpr size_t WS_MOD = 1 * MiB;
constexpr size_t WS_SSQQ = 2 * MiB;
constexpr size_t WS_SSQKV = 3 * MiB;
constexpr size_t WS_SSQY = 4 * MiB;
constexpr size_t WS_AFF = 6 * MiB;
constexpr size_t WS_INV = 7 * MiB;
constexpr size_t WS_IDX = 8 * MiB;
constexpr size_t WS_WIN_T = 16 * MiB;
constexpr size_t WS_WQKV_T = 30 * MiB;
constexpr size_t WS_WOUT_T = 34 * MiB;
constexpr size_t WS_SGUW = 42 * MiB;
constexpr size_t WS_WGU_T = 64 * MiB;
constexpr size_t WS_WD_T = 320 * MiB;
constexpr size_t WS_H = 448 * MiB;
constexpr size_t WS_CQKV = 516 * MiB;
constexpr size_t WS_U = 549 * MiB;
constexpr size_t WS_VS = 581 * MiB;
constexpr size_t WS_Q = 613 * MiB;
constexpr size_t WS_K = 661 * MiB;
constexpr size_t WS_V = 712 * MiB;
constexpr size_t WS_CAT = 746 * MiB;
constexpr size_t WS_Y = 810 * MiB;
constexpr size_t WS_H2 = WS_CAT;
constexpr size_t WS_ACT = WS_H;
constexpr size_t WS_YE = WS_Q;
constexpr size_t WS_S = 874 * MiB;
constexpr size_t WS_VN = 942 * MiB;
constexpr size_t WS_ROPE = 9 * MiB;
constexpr size_t WS_PART = WS_S;
constexpr size_t WS_XN = WS_S;
constexpr size_t WS_END = 974 * MiB;
}
using namespace cfg;

__device__ __forceinline__ float bf2f(bf16 v) { return __uint_as_float(((unsigned)v) << 16); }
__device__ __forceinline__ bf16 f2bf(float f) { unsigned u = __float_as_uint(f); return (bf16)((u + 0x7fffu + ((u >> 16) & 1u)) >> 16); }
__device__ __forceinline__ float silu_f(float x) { return x / (1.f + __expf(-x)); }
__device__ __forceinline__ float gelu_tanh(float x) { const float z = 0.7978845608028654f * (x + 0.044715f * x * x * x); return 0.5f * x * (1.f + tanhf(z)); }
__device__ __forceinline__ float wave_sum(float v) {
#pragma unroll
    for (int o = 1; o < 64; o <<= 1) v += __shfl_xor(v, o);
    return v;
}
__device__ __forceinline__ float rope_inv(int ii) { return __expf(-(float)ii * (9.210340371976184f / 16.f)); }

struct Ptrs {
    const float *x, *c, *ctx, *c_ctx, *w_ada, *b_ada, *pre_norm1, *w_in, *q_norm_w, *w_uq, *kv_norm_w, *w_ukv, *sgu_norm_w, *sgu_w, *sgu_b, *w_out,
        *post_norm1, *pre_norm2, *w_router, *b_router, *w_e_gate, *w_e_up, *w_e_down, *post_norm2;
    float* out; unsigned char* ws;
};

#if !defined(FINAL_BUILD)
__global__ void n_mod(Ptrs p) {
    const int j = blockIdx.x * 256 + threadIdx.x, r = blockIdx.y;
    const float* cv = r < 4 ? p.c + r * D : p.c_ctx;
    float s = 0.f;
    for (int k = 0; k < D; ++k) s += silu_f(cv[k]) * p.w_ada[(size_t)k * 12288 + j];
    ((float*)(p.ws + WS_MOD))[r * 12288 + j] = s + p.b_ada[j];
}
__global__ __launch_bounds__(256) void n_hrows(Ptrs p) {
    const int row = blockIdx.x * 4 + (threadIdx.x >> 6), lane = threadIdx.x & 63;
    if (row >= MALL) return;
    const float* src = row < M ? p.x + (size_t)row * D : p.ctx + (size_t)(row - M) * D;
    const int mr = row < M ? row >> 12 : 4;
    const float* mod = (const float*)(p.ws + WS_MOD) + mr * 12288;
    float v[32]; float s = 0.f;
    for (int j = 0; j < 32; ++j) { v[j] = src[j * 64 + lane]; s += v[j] * v[j]; }
    const float rs = rsqrtf(wave_sum(s) * (1.f / D) + EPS);
    bf16* o = (bf16*)(p.ws + WS_H) + (size_t)row * D;
    for (int j = 0; j < 32; ++j) { const int c = j * 64 + lane; o[c] = f2bf(v[j] * rs * p.pre_norm1[c] * (1.f + mod[2048 + c]) + mod[c]); }
}
template <class P> __global__ __launch_bounds__(256) void ngemm(P p) {
    __shared__ float As[16][65], Bs[16][65];
    const int tx = threadIdx.x & 15, ty = threadIdx.x >> 4, z = blockIdx.z;
    const int m0 = blockIdx.y * 64, n0 = blockIdx.x * 64;
    float acc[4][4] = {};
    for (int k0 = 0; k0 < p.K; k0 += 16) {
        for (int j = 0; j < 4; ++j) { const int idx = threadIdx.x + 256 * j; const int kk = idx & 15, mm = idx >> 4; As[kk][mm] = p.a(z, m0 + mm, k0 + kk); }
        for (int j = 0; j < 4; ++j) { const int idx = threadIdx.x + 256 * j; const int nn = idx & 63, kk = idx >> 6; Bs[kk][nn] = p.b(z, k0 + kk, n0 + nn); }
        __syncthreads();
#pragma unroll
        for (int kk = 0; kk < 16; ++kk) {
            float a[4], b[4];
#pragma unroll
            for (int i = 0; i < 4; ++i) { a[i] = As[kk][ty * 4 + i]; b[i] = Bs[kk][tx * 4 + i]; }
#pragma unroll
            for (int i = 0; i < 4; ++i)
#pragma unroll
                for (int j = 0; j < 4; ++j) acc[i][j] += a[i] * b[j];
        }
        __syncthreads();
    }
    for (int i = 0; i < 4; ++i) p.epi(z, m0 + ty * 4 + i, n0 + tx * 4, acc[i]);
}
__device__ __forceinline__ void rope_pair(float& x1, float& x2, int i, int pos) {
    const int ii = i & 15; const float ax = (float)((i >> 4) ? (pos & 63) : (pos >> 6));
    float s, c; sincosf(ax * rope_inv(ii), &s, &c);
    const float r1 = x1 * c - x2 * s, r2 = x2 * c + x1 * s; x1 = r1; x2 = r2;
}
struct GIn {
    Ptrs p; int K;
    __device__ float a(int, int m, int k) const { return bf2f(((const bf16*)(p.ws + WS_H))[(size_t)m * D + k]); }
    __device__ float b(int, int k, int n) const {
        int o; if (n < 1024) o = n; else if (n < 3072) o = n + 64; else { const int j = n - 3072, i = j >> 1, s = j & 1; o = OFF_KPE + (i >> 4) * 32 + s * 16 + (i & 15); }
        return p.w_in[(size_t)k * INC + o];
    }
    __device__ void epi(int, int m, int n0, const float* v) const {
        bf16* CQ = (bf16*)(p.ws + WS_CQKV); bf16* CKV = CQ + (size_t)M * 512;
        if (n0 < 512) { if (m < M) for (int j = 0; j < 4; ++j) CQ[(size_t)m * 512 + n0 + j] = f2bf(v[j]); }
        else if (n0 < 1024) { for (int j = 0; j < 4; ++j) CKV[(size_t)m * 512 + n0 - 512 + j] = f2bf(v[j]); }
        else if (n0 < 2048) { if (m < M) for (int j = 0; j < 4; ++j) ((bf16*)(p.ws + WS_U))[(size_t)m * 1024 + n0 - 1024 + j] = f2bf(gelu_tanh(v[j])); }
        else if (n0 < 3072) { if (m < M) for (int j = 0; j < 4; ++j) ((bf16*)(p.ws + WS_VS))[(size_t)m * 1024 + n0 - 2048 + j] = f2bf(gelu_tanh(v[j])); }
        else {
            const int jj = n0 - 3072; bf16* Kb = (bf16*)(p.ws + WS_K);
            for (int q = 0; q < 2; ++q) {
                const int i = (jj >> 1) + q; float x1 = v[2 * q], x2 = v[2 * q + 1]; int b, kpos;
                if (m < M) { b = m >> 12; kpos = m & 4095; rope_pair(x1, x2, i, kpos); } else { b = (m - M) >> 8; kpos = L + ((m - M) & 255); }
                for (int hh = 0; hh < H; ++hh) { bf16* d = Kb + ((size_t)(b * H + hh) * LK + kpos) * DQK + 128 + 2 * i; d[0] = f2bf(x1); d[1] = f2bf(x2); }
            }
        }
    }
};
__global__ void n_ssq(const bf16* T, int rows, int cols, float* out, int nslots) {
    const int row = blockIdx.x * 4 + (threadIdx.x >> 6), lane = threadIdx.x & 63;
    if (row >= rows) return;
    float s = 0.f; for (int c = lane; c < cols; c += 64) { const float v = bf2f(T[(size_t)row * cols + c]); s += v * v; }
    s = wave_sum(s);
    if (lane < nslots) out[(size_t)row * nslots + lane] = lane == 0 ? s : 0.f;
}
__device__ __forceinline__ float sum_slots(const float* s, int n) { float t = 0.f; for (int i = 0; i < n; ++i) t += s[i]; return t; }
struct GQ {
    Ptrs p; int K;
    __device__ float a(int, int m, int k) const { return bf2f(((const bf16*)(p.ws + WS_CQKV))[(size_t)m * 512 + k]); }
    __device__ float b(int, int k, int n) const {
        int o; if (n < 1024) o = (n >> 7) * DQK + (n & 127); else { const int jj = n - 1024, hd = jj >> 6, j6 = jj & 63, i = j6 >> 1, s = j6 & 1; o = hd * DQK + 128 + (i >> 4) * 32 + s * 16 + (i & 15); }
        return p.w_uq[(size_t)k * 1536 + o] * p.q_norm_w[k];
    }
    __device__ void epi(int, int m, int n0, const float* v) const {
        const float rs = rsqrtf(sum_slots((const float*)(p.ws + WS_SSQQ) + (size_t)m * 8, 8) * (1.f / 512.f) + EPS);
        const int b = m >> 12, t = m & 4095; bf16* Qb = (bf16*)(p.ws + WS_Q);
        if (n0 < 1024) { const int hd = n0 >> 7, d = n0 & 127; for (int j = 0; j < 4; ++j) Qb[((size_t)(b * H + hd) * L + t) * DQK + d + j] = f2bf(v[j] * rs); }
        else { const int jj = n0 - 1024, hd = jj >> 6, j6 = jj & 63;
            for (int q = 0; q < 2; ++q) { const int i = (j6 >> 1) + q; float x1 = v[2 * q] * rs, x2 = v[2 * q + 1] * rs; rope_pair(x1, x2, i, t);
                bf16* d = Qb + ((size_t)(b * H + hd) * L + t) * DQK + 128 + 2 * i; d[0] = f2bf(x1); d[1] = f2bf(x2); } }
    }
};
struct GKV {
    Ptrs p; int K;
    __device__ float a(int, int m, int k) const { return bf2f(((const bf16*)(p.ws + WS_CQKV))[(size_t)(M + m) * 512 + k]); }
    __device__ float b(int, int k, int n) const { return p.w_ukv[(size_t)k * 2048 + n] * p.kv_norm_w[k]; }
    __device__ void epi(int, int m, int n0, const float* v) const {
        const float rs = rsqrtf(sum_slots((const float*)(p.ws + WS_SSQKV) + (size_t)m * 8, 8) * (1.f / 512.f) + EPS);
        int b, kpos; if (m < M) { b = m >> 12; kpos = m & 4095; } else { b = (m - M) >> 8; kpos = L + ((m - M) & 255); }
        const int hd = n0 >> 8, c = n0 & 255;
        if (c < 128) { bf16* d = (bf16*)(p.ws + WS_K) + ((size_t)(b * H + hd) * LK + kpos) * DQK + c; for (int j = 0; j < 4; ++j) d[j] = f2bf(v[j] * rs); }
        else { bf16* d = (bf16*)(p.ws + WS_V) + ((size_t)(b * H + hd) * LK + kpos) * VH + c - 128; for (int j = 0; j < 4; ++j) d[j] = f2bf(v[j] * rs); }
    }
};
__global__ void n_vn(Ptrs p) {
    const int w = blockIdx.x * 4 + (threadIdx.x >> 6), lane = threadIdx.x & 63;
    const int tok = w >> 3, g = w & 7;
    const bf16* s = (const bf16*)(p.ws + WS_VS) + (size_t)tok * 1024 + g * 128;
    const float a = bf2f(s[lane]), b = bf2f(s[lane + 64]);
    const float mu = wave_sum(a + b) * (1.f / 128.f);
    const float da = a - mu, db = b - mu;
    const float rs = rsqrtf(wave_sum(da * da + db * db) * (1.f / 128.f) + EPS);
    bf16* o = (bf16*)(p.ws + WS_VN) + (size_t)tok * 1024 + g * 128;
    o[lane] = f2bf(da * rs * p.sgu_norm_w[g * 128 + lane]); o[lane + 64] = f2bf(db * rs * p.sgu_norm_w[g * 128 + lane + 64]);
}
struct GSgu {
    Ptrs p; int K;
    __device__ float a(int z, int m, int k) const { return p.sgu_w[((size_t)(z & 7) * 128 + m) * 128 + k]; }
    __device__ float b(int z, int k, int n) const { return bf2f(((const bf16*)(p.ws + WS_VN))[(size_t)((z >> 3) * 128 + k) * 1024 + (z & 7) * 128 + n]); }
    __device__ void epi(int z, int m, int n0, const float* v) const {
        const int g = z & 7; const size_t row = (size_t)(z >> 3) * 128 + m; const float bias = p.sgu_b[g * 128 + m];
        for (int j = 0; j < 4; ++j) { const float u = bf2f(((const bf16*)(p.ws + WS_U))[row * 1024 + g * 128 + n0 + j]);
            ((bf16*)(p.ws + WS_CAT))[row * D + 1024 + g * 128 + n0 + j] = f2bf(u * (v[j] + bias)); }
    }
};
struct GScore {
    Ptrs p; int K; int bh;
    __device__ float a(int, int m, int k) const { return bf2f(((const bf16*)(p.ws + WS_Q))[((size_t)bh * L + m) * DQK + k]); }
    __device__ float b(int, int k, int n) const { return bf2f(((const bf16*)(p.ws + WS_K))[((size_t)bh * LK + n) * DQK + k]); }
    __device__ void epi(int, int m, int n0, const float* v) const { float* S = (float*)(p.ws + WS_S) + (size_t)m * LK + n0; for (int j = 0; j < 4; ++j) S[j] = v[j] * ATT_SCALE; }
};
__global__ void n_softmax(float* S, int cols) {
    float* r = S + (size_t)blockIdx.x * cols; __shared__ float red[4];
    float mx = -1e30f; for (int c = threadIdx.x; c < cols; c += 256) mx = fmaxf(mx, r[c]);
    for (int o = 1; o < 64; o <<= 1) mx = fmaxf(mx, __shfl_xor(mx, o));
    if ((threadIdx.x & 63) == 0) red[threadIdx.x >> 6] = mx; __syncthreads();
    mx = fmaxf(fmaxf(red[0], red[1]), fmaxf(red[2], red[3])); __syncthreads();
    float s = 0.f; for (int c = threadIdx.x; c < cols; c += 256) { const float e = __expf(r[c] - mx); r[c] = e; s += e; }
    s = wave_sum(s); if ((threadIdx.x & 63) == 0) red[threadIdx.x >> 6] = s; __syncthreads();
    s = (red[0] + red[1]) + (red[2] + red[3]); const float inv = 1.f / s;
    for (int c = threadIdx.x; c < cols; c += 256) r[c] *= inv;
}
struct GPV {
    Ptrs p; int K; int bh;
    __device__ float a(int, int m, int k) const { return ((const float*)(p.ws + WS_S))[(size_t)m * LK + k]; }
    __device__ float b(int, int k, int n) const { return bf2f(((const bf16*)(p.ws + WS_V))[((size_t)bh * LK + k) * VH + n]); }
    __device__ void epi(int, int m, int n0, const float* v) const { bf16* d = (bf16*)(p.ws + WS_CAT) + ((size_t)(bh >> 3) * L + m) * D + (bh & 7) * 128 + n0; for (int j = 0; j < 4; ++j) d[j] = f2bf(v[j]); }
};
struct GOut {
    Ptrs p; int K;
    __device__ float a(int, int m, int k) const { return bf2f(((const bf16*)(p.ws + WS_CAT))[(size_t)m * D + k]); }
    __device__ float b(int, int k, int n) const { return p.w_out[(size_t)k * D + n]; }
    __device__ void epi(int, int m, int n0, const float* v) const { bf16* d = (bf16*)(p.ws + WS_Y) + (size_t)m * D + n0; for (int j = 0; j < 4; ++j) d[j] = f2bf(v[j]); }
};
__device__ __forceinline__ void row_pass_mid(const Ptrs& p, int row, int lane) {
    const int b = row >> 12; const float* mod = (const float*)(p.ws + WS_MOD) + b * 12288;
    const float ssq = wave_sum(lane < 32 ? ((const float*)(p.ws + WS_SSQY))[(size_t)row * 32 + lane] : 0.f);
    const float rsy = rsqrtf(ssq * (1.f / D) + EPS);
    const bf16* y = (const bf16*)(p.ws + WS_Y) + (size_t)row * D; const float* xr = p.x + (size_t)row * D; float* o = p.out + (size_t)row * D;
    float v[32]; float s = 0.f;
    for (int j = 0; j < 32; ++j) { const int c = j * 64 + lane; v[j] = xr[c] + mod[4096 + c] * (bf2f(y[c]) * rsy * p.post_norm1[c]); o[c] = v[j]; s += v[j] * v[j]; }
    const float rs = rsqrtf(wave_sum(s) * (1.f / D) + EPS);
    bf16* h2 = (bf16*)(p.ws + WS_H2) + (size_t)row * D; float lg[16];
    for (int e = 0; e < 16; ++e) lg[e] = 0.f;
    for (int j = 0; j < 32; ++j) { const int c = j * 64 + lane; const float h = v[j] * rs * p.pre_norm2[c] * (1.f + mod[8192 + c]) + mod[6144 + c]; h2[c] = f2bf(h);
        const float* wr = p.w_router + (size_t)c * 16; for (int e = 0; e < 16; ++e) lg[e] += h * wr[e]; }
    float mx = -1e30f;
    for (int e = 0; e < 16; ++e) { lg[e] = wave_sum(lg[e]) + p.b_router[e]; mx = fmaxf(mx, lg[e]); }
    float se = 0.f; for (int e = 0; e < 16; ++e) { lg[e] = __expf(lg[e] - mx); se += lg[e]; }
    const float inv = 1.f / se;
    if (lane < 16) { float val = 0.f; for (int e = 0; e < 16; ++e) val = (lane == e) ? lg[e] * inv : val; ((float*)(p.ws + WS_AFF))[(size_t)row * 16 + lane] = val; }
}
__global__ __launch_bounds__(256) void n_rowmid(Ptrs p) { const int row = blockIdx.x * 4 + (threadIdx.x >> 6); row_pass_mid(p, row, threadIdx.x & 63); }
__global__ void n_topk(Ptrs p) {
    __shared__ float vals[L];
    const int e = blockIdx.x >> 2, b = blockIdx.x & 3;
    const float* aff = (const float*)(p.ws + WS_AFF) + (size_t)b * L * 16 + e;
    for (int t = threadIdx.x; t < L; t += blockDim.x) vals[t] = aff[(size_t)t * 16];
    __syncthreads();
    for (int t = threadIdx.x; t < L; t += blockDim.x) {
        const float v = vals[t]; int rank = 0;
        for (int u = 0; u < L; ++u) { const float w = vals[u]; rank += (w > v || (w == v && u < t)) ? 1 : 0; }
        ((int*)(p.ws + WS_INV))[(size_t)(b * L + t) * 16 + e] = rank < CAP ? rank : -1;
        if (rank < CAP) ((int*)(p.ws + WS_IDX))[(size_t)(e * 4 + b) * CAP + rank] = t;
    }
}
struct GE1 {
    Ptrs p; int K;
    __device__ float a(int z, int m, int k) const { const int b = m >> 9; const int tok = ((const int*)(p.ws + WS_IDX))[(size_t)(z * 4 + b) * CAP + (m & 511)];
        return bf2f(((const bf16*)(p.ws + WS_H2))[((size_t)b * L + tok) * D + k]); }
    __device__ float b(int z, int k, int n) const { const float* w = (n & 1) ? p.w_e_up : p.w_e_gate; return w[((size_t)z * D + k) * FF + (n >> 1)]; }
    __device__ void epi(int z, int m, int n0, const float* v) const { bf16* d = (bf16*)(p.ws + WS_ACT) + ((size_t)z * 2048 + m) * FF + (n0 >> 1);
        d[0] = f2bf(silu_f(v[0]) * v[1]); d[1] = f2bf(silu_f(v[2]) * v[3]); }
};
struct GE2 {
    Ptrs p; int K;
    __device__ float a(int z, int m, int k) const { return bf2f(((const bf16*)(p.ws + WS_ACT))[((size_t)z * 2048 + m) * FF + k]); }
    __device__ float b(int z, int k, int n) const { return p.w_e_down[((size_t)z * FF + k) * D + n]; }
    __device__ void epi(int z, int m, int n0, const float* v) const { bf16* d = (bf16*)(p.ws + WS_YE) + ((size_t)z * 2048 + m) * D + n0; for (int j = 0; j < 4; ++j) d[j] = f2bf(v[j]); }
};
__device__ __forceinline__ void row_pass_final(const Ptrs& p, int row, int lane) {
    const int b = row >> 12; const float* mod = (const float*)(p.ws + WS_MOD) + b * 12288;
    const int* inv = (const int*)(p.ws + WS_INV) + (size_t)row * 16; const float* aff = (const float*)(p.ws + WS_AFF) + (size_t)row * 16;
    float v[32]; for (int j = 0; j < 32; ++j) v[j] = 0.f;
    for (int e = 0; e < 16; ++e) { const int sl = inv[e]; if (sl >= 0) { const float g = aff[e]; const bf16* ye = (const bf16*)(p.ws + WS_YE) + ((size_t)(e * 4 + b) * CAP + sl) * D;
            for (int j = 0; j < 32; ++j) v[j] += g * bf2f(ye[j * 64 + lane]); } }
    float s = 0.f; for (int j = 0; j < 32; ++j) s += v[j] * v[j];
    const float rs = rsqrtf(wave_sum(s) * (1.f / D) + EPS);
    float* o = p.out + (size_t)row * D;
    for (int j = 0; j < 32; ++j) { const int c = j * 64 + lane; o[c] = o[c] + mod[10240 + c] * (v[j] * rs * p.post_norm2[c]); }
}
__global__ __launch_bounds__(256) void n_rowfinal(Ptrs p) { const int row = blockIdx.x * 4 + (threadIdx.x >> 6); row_pass_final(p, row, threadIdx.x & 63); }

#endif

namespace pg8 {
#define PG8_LAS __attribute__((address_space(3)))
typedef short bf16x8 __attribute__((ext_vector_type(8)));
typedef float f32x4 __attribute__((ext_vector_type(4)));
typedef float f32x2 __attribute__((ext_vector_type(2)));
typedef unsigned u32x4 __attribute__((ext_vector_type(4)));
constexpr int BM = 256, BK = 64, HALF = 128, HTB = HALF * BK * 2, STAGE_BYTES = 8 * HTB, NXCD = 8, WGM = 8;

__host__ __device__ __forceinline__ int lds_byte(int r, int c) { const int st = (r >> 4) * 2 + (c >> 5), rr = r & 15, cc = c & 31, ob = rr * 64 + cc * 2; return st * 1024 + (ob ^ (((ob >> 9) & 1) << 5)); }
__host__ __device__ __forceinline__ void stage_rc(int b, int& R, int& C) { const int st = b / 1024, sb = b % 1024, swz = sb ^ (((sb >> 9) & 1) << 5); R = (st >> 1) * 16 + swz / 64; C = (st & 1) * 32 + (swz % 64) / 2; }
__host__ __device__ __forceinline__ int perm32(int rho) { const int n = rho >> 4, i = rho & 15; return 8 * (i >> 2) + 4 * n + (i & 3); }

struct Unit { int pm, pn, ui; };
__device__ __forceinline__ void rect_unit(int L, int nM, int nN, Unit& u) {
    const int nwg = nM * nN; int wgid = L;
    { const int q = nwg / NXCD, r = nwg % NXCD, xcd = wgid % NXCD, off = wgid / NXCD; wgid = (xcd < r ? xcd * (q + 1) : r * (q + 1) + (xcd - r) * q) + off; }
    const int nig = WGM * nN, gid = wgid / nig, fm = gid * WGM, gsz = (nM - fm) < WGM ? (nM - fm) : WGM;
    u.pm = fm + ((wgid % nig) % gsz); u.pn = (wgid % nig) / gsz;
}
__device__ __forceinline__ void dense_voff(int K, int tid, unsigned (&v)[2][2]) {
#pragma unroll
    for (int i = 0; i < 2; ++i) { int R, C; stage_rc(tid * 16 + i * 8192, R, C); v[0][i] = (unsigned)(R * K + C) * 2u; v[1][i] = (unsigned)((R + HALF) * K + C) * 2u; }
}

__device__ __forceinline__ unsigned cvt_pk_bf16(float lo, float hi) { unsigned r; asm volatile("v_cvt_pk_bf16_f32 %0, %1, %2" : "=v"(r) : "v"(lo), "v"(hi)); return r; }
__device__ __forceinline__ u32x4 pack8(const f32x4& a, const f32x4& b) { u32x4 w; w.x = cvt_pk_bf16(a[0], a[1]); w.y = cvt_pk_bf16(a[2], a[3]); w.z = cvt_pk_bf16(b[0], b[1]); w.w = cvt_pk_bf16(b[2], b[3]); return w; }

typedef int i32x4 __attribute__((ext_vector_type(4)));
typedef int i32x8 __attribute__((ext_vector_type(8)));
template <class Epi, class Sched, bool FP8 = false>
__device__ __forceinline__ void gemm_phase(PG8_LAS unsigned char* lds, const int K, const Sched& S, const Epi& E) {
    const int tid = threadIdx.x, wid = __builtin_amdgcn_readfirstlane(tid >> 6), lane = tid & 63, wr = wid >> 2, wc = wid & 3, fr = lane & 15, fq = lane >> 4;
    const int nt = K / BK;
    unsigned voffB[2];
#pragma unroll
    for (int i = 0; i < 2; ++i) { int R, C; stage_rc(tid * 16 + i * 8192, R, C); const int Rb = Epi::PERM ? ((R & ~31) + perm32(R & 31)) : R; voffB[i] = (unsigned)(Rb * K + C) * 2u; }
    const size_t kstep = (size_t)(BK * 2);
    const size_t hstep = (size_t)HALF * K * 2;
    const unsigned ldsw = (unsigned)wid * 1024u;
    const int aoff = lds_byte(wr * 64 + fr, fq * 8), boff = lds_byte(wc * 32 + fr, fq * 8);
#define PG8_SA(b, h) (((b) * 2 + (h)) * HTB)
#define PG8_SB(b, h) ((4 + (b) * 2 + (h)) * HTB)
#define PG8_STAGE(bufoff, gbase, voff) do { _Pragma("unroll") for (int _i = 0; _i < 2; ++_i) \
        __builtin_amdgcn_global_load_lds((const unsigned*)((const char*)(gbase) + (voff)[_i]), (PG8_LAS unsigned*)(lds + (bufoff) + ldsw + _i * 8192), 16, 0, 0); } while (0)
#define PG8_LDA(dst, b, h) do { _Pragma("unroll") for (int m = 0; m < 4; ++m) _Pragma("unroll") for (int k = 0; k < 2; ++k) dst[m][k] = *(const PG8_LAS bf16x8*)(lds + PG8_SA(b, h) + aoff + m * 2048 + k * 1024); } while (0)
#define PG8_LDB(dst, b, h) do { _Pragma("unroll") for (int n = 0; n < 2; ++n) _Pragma("unroll") for (int k = 0; k < 2; ++k) dst[n][k] = *(const PG8_LAS bf16x8*)(lds + PG8_SB(b, h) + boff + n * 2048 + k * 1024); } while (0)
#define PG8_MMA(ai, bj, At, Bt) do { __builtin_amdgcn_s_setprio(1); _Pragma("unroll") for (int m = 0; m < 4; ++m) _Pragma("unroll") for (int n = 0; n < 2; ++n) { \
        if constexpr (FP8) { const i32x8 fb = __builtin_shufflevector((i32x4)Bt[n][0], (i32x4)Bt[n][1], 0, 1, 2, 3, 4, 5, 6, 7), fa = __builtin_shufflevector((i32x4)At[m][0], (i32x4)At[m][1], 0, 1, 2, 3, 4, 5, 6, 7); \
            acc[ai][bj][m][n] = __builtin_amdgcn_mfma_scale_f32_16x16x128_f8f6f4(fb, fa, acc[ai][bj][m][n], 0, 0, 0, 0x7f7f7f7f, 0, 0x7f7f7f7f); } \
        else { _Pragma("unroll") for (int k = 0; k < 2; ++k) acc[ai][bj][m][n] = __builtin_amdgcn_mfma_f32_16x16x32_bf16(Bt[n][k], At[m][k], acc[ai][bj][m][n], 0, 0, 0); } } \
        __builtin_amdgcn_s_setprio(0); } while (0)
#define PG8_WAIT_V(n) asm volatile("s_waitcnt vmcnt(" #n ")" ::: "memory")
#define PG8_WAIT_L(n) asm volatile("s_waitcnt lgkmcnt(" #n ")" ::: "memory")
#define PG8_BAR __builtin_amdgcn_s_barrier()
#define PG8_SCHED __builtin_amdgcn_sched_barrier(0)
    Unit cur, nxt; int ui = 0;
    if (!S.next(0, cur)) return;
    f32x4 acc[2][2][4][2];
#pragma unroll
    for (int a = 0; a < 2; ++a)
#pragma unroll
        for (int b = 0; b < 2; ++b)
#pragma unroll
            for (int m = 0; m < 4; ++m)
#pragma unroll
                for (int n = 0; n < 2; ++n) acc[a][b][m][n] = (f32x4){0.f, 0.f, 0.f, 0.f};
    bf16x8 At[4][2], B0[2][2], B1[2][2];
    unsigned vA[2][2], vN[2][2];
    S.a_voff(0, cur, tid, vA);
    const char* cA = S.a_base(cur); const char* cB = S.b_base(cur);
    PG8_STAGE(PG8_SB(0, 0), cB, voffB); PG8_STAGE(PG8_SB(0, 1), cB + hstep, voffB); PG8_STAGE(PG8_SA(0, 0), cA, vA[0]); PG8_STAGE(PG8_SA(0, 1), cA, vA[1]);
    if (wr == 1) PG8_BAR;
    PG8_WAIT_V(2); PG8_BAR;
    PG8_STAGE(PG8_SB(1, 0), cB + kstep, voffB); PG8_STAGE(PG8_SA(1, 0), cA + kstep, vA[0]); PG8_STAGE(PG8_SB(1, 1), cB + hstep + kstep, voffB);
    PG8_WAIT_V(6); PG8_BAR;
    for (;;) {
        const bool has_next = S.next(ui + 1, nxt);
        if (has_next) S.a_voff(ui + 1, nxt, tid, vN);
        const char* nA = has_next ? S.a_base(nxt) : cA; const char* nB = has_next ? S.b_base(nxt) : cB;
        for (int t = 0; t < nt; t += 2) {
            const bool last = (t == nt - 2);
            const char* a1 = cA + (size_t)(t + 1) * kstep;
            const char* a2 = last ? nA : cA + (size_t)(t + 2) * kstep; const char* b2 = last ? nB : cB + (size_t)(t + 2) * kstep;
            const char* a3 = a2 + kstep; const char* b3 = b2 + kstep;
            PG8_LDB(B0, 0, 0); PG8_LDB(B1, 0, 1); PG8_SCHED; PG8_LDA(At, 0, 0); PG8_STAGE(PG8_SA(1, 1), a1, vA[1]);
            if (last && has_next) {
#pragma unroll
                for (int h = 0; h < 2; ++h)
#pragma unroll
                    for (int i = 0; i < 2; ++i) vA[h][i] = vN[h][i];
            }
            PG8_WAIT_V(8); PG8_WAIT_L(0); PG8_BAR; PG8_MMA(0, 0, At, B0); PG8_MMA(0, 1, At, B1); PG8_BAR; PG8_SCHED;
            PG8_LDA(At, 0, 1); PG8_STAGE(PG8_SB(0, 0), b2, voffB); PG8_STAGE(PG8_SB(0, 1), b2 + hstep, voffB); PG8_STAGE(PG8_SA(0, 0), a2, vA[0]);
            PG8_WAIT_V(8); PG8_WAIT_L(0); PG8_BAR; PG8_MMA(1, 0, At, B0); PG8_MMA(1, 1, At, B1); PG8_BAR; PG8_SCHED;
            PG8_LDB(B0, 1, 0); PG8_LDB(B1, 1, 1); PG8_SCHED; PG8_LDA(At, 1, 0); PG8_STAGE(PG8_SA(0, 1), a2, vA[1]);
            PG8_WAIT_V(8); PG8_WAIT_L(0); PG8_BAR; PG8_MMA(0, 0, At, B0); PG8_MMA(0, 1, At, B1); PG8_BAR; PG8_SCHED;
            PG8_LDA(At, 1, 1); PG8_STAGE(PG8_SB(1, 0), b3, voffB); PG8_STAGE(PG8_SB(1, 1), b3 + hstep, voffB); PG8_STAGE(PG8_SA(1, 0), a3, vA[0]);
            PG8_WAIT_V(8); PG8_WAIT_L(0); PG8_BAR; PG8_MMA(1, 0, At, B0); PG8_MMA(1, 1, At, B1); PG8_BAR; PG8_SCHED;
        }
        if (wr == 0) PG8_BAR;
        E(acc, cur, wr, wc, fr, fq);
        if (!has_next) break;
#pragma unroll
        for (int a = 0; a < 2; ++a)
#pragma unroll
            for (int b = 0; b < 2; ++b)
#pragma unroll
                for (int m = 0; m < 4; ++m)
#pragma unroll
                    for (int n = 0; n < 2; ++n) acc[a][b][m][n] = (f32x4){0.f, 0.f, 0.f, 0.f};
        cur = nxt; cA = nA; cB = nB; ++ui;
        if (wr == 1) PG8_BAR;
    }
    PG8_WAIT_V(0);
    PG8_BAR;
#undef PG8_SA
#undef PG8_SB
#undef PG8_STAGE
#undef PG8_LDA
#undef PG8_LDB
#undef PG8_MMA
#undef PG8_WAIT_V
#undef PG8_WAIT_L
#undef PG8_BAR
#undef PG8_SCHED
}
}

#define LAS __attribute__((address_space(3)))
typedef pg8::f32x4 f32x4; typedef pg8::u32x4 u32x4; typedef pg8::Unit Unit;
constexpr size_t TSTEP2K = (size_t)256 * 2048 * 2, TSTEP512 = (size_t)256 * 512 * 2;

struct SchedIn {
    static constexpr bool GATHER = false; const char *A, *Bt; int G, c;
    __device__ __forceinline__ bool next(int i, Unit& u) const { const int Lx = i * G + c; if (Lx >= 844) return false;
        if (Lx < 832) pg8::rect_unit(Lx, 64, 13, u); else { const int r = Lx - 832; u.pm = 64 + (r & 3); const int q = r >> 2; u.pn = q == 2 ? 12 : 2 + q; } return true; }
    __device__ __forceinline__ const char* a_base(const Unit& u) const { return A + (size_t)u.pm * TSTEP2K; }
    __device__ __forceinline__ const char* b_base(const Unit& u) const { return Bt + (size_t)u.pn * TSTEP2K; }
    __device__ __forceinline__ void a_voff(int, const Unit&, int tid, unsigned (&v)[2][2]) const { pg8::dense_voff(2048, tid, v); }
};
struct SchedQKV {
    static constexpr bool GATHER = false; const char *A, *Bt; int G, c;
    __device__ __forceinline__ bool next(int i, Unit& u) const { const int Lx = i * G + c; if (Lx >= 928) return false;
        if (Lx < 384) pg8::rect_unit(Lx, 64, 6, u); else { pg8::rect_unit(Lx - 384, 68, 8, u); u.pm += 64; u.pn += 6; } u.ui = i; return true; }
    __device__ __forceinline__ const char* a_base(const Unit& u) const { return A + (size_t)u.pm * TSTEP512; }
    __device__ __forceinline__ const char* b_base(const Unit& u) const { return Bt + (size_t)u.pn * TSTEP512; }
    __device__ __forceinline__ void a_voff(int, const Unit&, int tid, unsigned (&v)[2][2]) const { pg8::dense_voff(512, tid, v); }
};
template <int nM, int nN, int BSHIFT, int KU> struct SchedDense {
    static constexpr bool GATHER = false; const char *A, *Bt; int G, c;
    __device__ __forceinline__ bool next(int i, Unit& u) const { const int Lx = i * G + c; if (Lx >= nM * nN) return false; pg8::rect_unit(Lx, nM, nN, u); return true; }
    __device__ __forceinline__ const char* a_base(const Unit& u) const { return A + (size_t)u.pm * (512 * KU); }
    __device__ __forceinline__ const char* b_base(const Unit& u) const { return Bt + (size_t)((u.pm >> BSHIFT) * nN + u.pn) * (512 * KU); }
    __device__ __forceinline__ void a_voff(int, const Unit&, int tid, unsigned (&v)[2][2]) const { pg8::dense_voff(KU, tid, v); }
};
template <int KU> struct SchedGather {
    static constexpr bool GATHER = true; const char *A, *Bt; int G, c; const LAS unsigned* tab;
    __device__ __forceinline__ bool next(int i, Unit& u) const { const int Lx = i * G + c; if (Lx >= 2048) return false; pg8::rect_unit(Lx, 128, 16, u); return true; }
    __device__ __forceinline__ const char* a_base(const Unit&) const { return A; }
    __device__ __forceinline__ const char* b_base(const Unit& u) const { return Bt + (size_t)((u.pm >> 3) * 16 + u.pn) * (512 * KU); }
    __device__ __forceinline__ void a_voff(int i, const Unit&, int tid, unsigned (&v)[2][2]) const {
#pragma unroll
        for (int p = 0; p < 2; ++p) { int R, C; pg8::stage_rc(tid * 16 + p * 8192, R, C); v[0][p] = tab[i * 256 + R] + (unsigned)C * 2u; v[1][p] = tab[i * 256 + 128 + R] + (unsigned)C * 2u; }
    }
};

__device__ __forceinline__ float gelu_fast(float x) {
    const float z2 = -2.302208198f * (x + 0.044715f * x * x * x);
    return x * __builtin_amdgcn_rcpf(1.f + __builtin_amdgcn_exp2f(z2));
}
__device__ __forceinline__ float silu_fast(float x) { return x * __builtin_amdgcn_rcpf(1.f + __builtin_amdgcn_exp2f(-1.4426950408889634f * x)); }
__device__ __forceinline__ float dot4(const f32x4& a) { return (a[0] * a[0] + a[1] * a[1]) + (a[2] * a[2] + a[3] * a[3]); }
__device__ __forceinline__ void rope8(f32x4& a, f32x4& b, const float* tabrow  , int fq) {
    const f32x4 t0 = *(const f32x4*)(tabrow + 8 * fq), t1 = *(const f32x4*)(tabrow + 8 * fq + 4);
    f32x4 ra, rb;
    ra[0] = a[0] * t0[0] - a[1] * t0[1]; ra[1] = a[1] * t0[0] + a[0] * t0[1]; ra[2] = a[2] * t0[2] - a[3] * t0[3]; ra[3] = a[3] * t0[2] + a[2] * t0[3];
    rb[0] = b[0] * t1[0] - b[1] * t1[1]; rb[1] = b[1] * t1[0] + b[0] * t1[1]; rb[2] = b[2] * t1[2] - b[3] * t1[3]; rb[3] = b[3] * t1[2] + b[2] * t1[3];
    a = ra; b = rb;
}
struct EpiIn {
    static constexpr bool PERM = true; unsigned char* ws;
    __device__ __forceinline__ void operator()(const f32x4 (&acc)[2][2][4][2], const Unit& u, int wr, int wc, int fr, int fq) const {
        const int pn = u.pn, row0 = u.pm * 256 + wr * 64 + fr, c8 = wc * 32 + 8 * fq;
        if (pn < 4) {
            bf16* base = (bf16*)(ws + WS_CQKV) + (pn >= 2 ? (size_t)M * 512 : 0) + (pn & 1) * 256 + c8;
            float* ssq = (float*)(ws + (pn >= 2 ? WS_SSQKV : WS_SSQQ)) + (pn & 1) * 4 + wc;
#pragma unroll
            for (int ai = 0; ai < 2; ++ai)
#pragma unroll
                for (int m = 0; m < 4; ++m) { const int row = row0 + ai * 128 + m * 16; float s = 0.f;
#pragma unroll
                    for (int bj = 0; bj < 2; ++bj) { s += dot4(acc[ai][bj][m][0]) + dot4(acc[ai][bj][m][1]); *(u32x4*)(base + (size_t)row * 512 + bj * 128) = pg8::pack8(acc[ai][bj][m][0], acc[ai][bj][m][1]); }
                    s += __shfl_xor(s, 16); s += __shfl_xor(s, 32);
                    if (fq == 0) ssq[(size_t)row * 8] = s; }
        } else if (pn < 12) {
            bf16* base = (bf16*)(ws + (pn < 8 ? WS_U : WS_VS)) + ((pn - 4) & 3) * 256 + c8;
#pragma unroll
            for (int ai = 0; ai < 2; ++ai)
#pragma unroll
                for (int m = 0; m < 4; ++m) { const int row = row0 + ai * 128 + m * 16;
#pragma unroll
                    for (int bj = 0; bj < 2; ++bj) { f32x4 a = acc[ai][bj][m][0], b = acc[ai][bj][m][1];
#pragma unroll
                        for (int j = 0; j < 4; ++j) { a[j] = gelu_fast(a[j]); b[j] = gelu_fast(b[j]); }
                        *(u32x4*)(base + (size_t)row * 1024 + bj * 128) = pg8::pack8(a, b); } }
        } else if (wc < 2) {
            const float* tab = (const float*)(ws + WS_ROPE);
#pragma unroll
            for (int ai = 0; ai < 2; ++ai)
#pragma unroll
                for (int m = 0; m < 4; ++m) { const int row = row0 + ai * 128 + m * 16; f32x4 a = acc[ai][0][m][0], b = acc[ai][0][m][1]; int bb, kpos;
                    if (row < M) { bb = row >> 12; kpos = row & 4095; const int ax = wc ? (kpos & 63) : (kpos >> 6); rope8(a, b, tab + ax * 32, fq); }
                    else { bb = (row - M) >> 8; kpos = L + ((row - M) & 255); }
                    const u32x4 w = pg8::pack8(a, b); bf16* d = (bf16*)(ws + WS_K) + ((size_t)(bb * H) * LK + kpos) * DQK + 128 + c8;
#pragma unroll
                    for (int hh = 0; hh < H; ++hh) *(u32x4*)(d + (size_t)hh * LK * DQK) = w; }
        }
    }
};
struct EpiQKV {
    static constexpr bool PERM = true; unsigned char* ws; const LAS float* rstab;
    __device__ __forceinline__ void operator()(const f32x4 (&acc)[2][2][4][2], const Unit& u, int wr, int wc, int fr, int fq) const {
        const int c8 = wc * 32 + 8 * fq;
        if (u.pn < 6) {
            const int pn = u.pn, row0 = u.pm * 256 + wr * 64 + fr; const float* tab = (const float*)(ws + WS_ROPE);
#pragma unroll
            for (int ai = 0; ai < 2; ++ai)
#pragma unroll
                for (int m = 0; m < 4; ++m) { const int row = row0 + ai * 128 + m * 16; const int bb = row >> 12, t = row & 4095;
                    const float rs = rstab[u.ui * 256 + ai * 128 + wr * 64 + m * 16 + fr];
#pragma unroll
                    for (int bj = 0; bj < 2; ++bj) { f32x4 a = acc[ai][bj][m][0] * rs, b = acc[ai][bj][m][1] * rs; bf16* d;
                        if (pn < 4) d = (bf16*)(ws + WS_Q) + ((size_t)(bb * H + pn * 2 + bj) * L + t) * DQK + c8;
                        else { const int hd = (pn - 4) * 4 + bj * 2 + (wc >> 1), ax = (wc & 1) ? (t & 63) : (t >> 6); rope8(a, b, tab + ax * 32, fq);
                            d = (bf16*)(ws + WS_Q) + ((size_t)(bb * H + hd) * L + t) * DQK + 128 + (wc & 1) * 32 + 8 * fq; }
                        *(u32x4*)d = pg8::pack8(a, b); }
                    asm volatile("" ::: "memory"); }
        } else {
            const int hd = u.pn - 6, row0 = (u.pm - 64) * 256 + wr * 64 + fr;
#pragma unroll
            for (int ai = 0; ai < 2; ++ai)
#pragma unroll
                for (int m = 0; m < 4; ++m) { const int row = row0 + ai * 128 + m * 16; int bb, kpos;
                    if (row < M) { bb = row >> 12; kpos = row & 4095; } else { bb = (row - M) >> 8; kpos = L + ((row - M) & 255); }
                    const float rs = rstab[u.ui * 256 + ai * 128 + wr * 64 + m * 16 + fr];
                    const size_t kr = (size_t)(bb * H + hd) * LK + kpos;
                    *(u32x4*)((bf16*)(ws + WS_K) + kr * DQK + c8) = pg8::pack8(acc[ai][0][m][0] * rs, acc[ai][0][m][1] * rs);
                    *(u32x4*)((bf16*)(ws + WS_V) + kr * VH + c8) = pg8::pack8(acc[ai][1][m][0] * rs, acc[ai][1][m][1] * rs);
                    asm volatile("" ::: "memory"); }
        }
    }
};
struct EpiY {
    static constexpr bool PERM = true; unsigned char* ws;
    __device__ __forceinline__ void operator()(const f32x4 (&acc)[2][2][4][2], const Unit& u, int wr, int wc, int fr, int fq) const {
        const int row0 = u.pm * 256 + wr * 64 + fr; bf16* base = (bf16*)(ws + WS_Y) + u.pn * 256 + wc * 32 + 8 * fq; float* ssq = (float*)(ws + WS_SSQY) + u.pn * 4 + wc;
#pragma unroll
        for (int ai = 0; ai < 2; ++ai)
#pragma unroll
            for (int m = 0; m < 4; ++m) { const int row = row0 + ai * 128 + m * 16; float s = 0.f;
#pragma unroll
                for (int bj = 0; bj < 2; ++bj) { s += dot4(acc[ai][bj][m][0]) + dot4(acc[ai][bj][m][1]); *(u32x4*)(base + (size_t)row * D + bj * 128) = pg8::pack8(acc[ai][bj][m][0], acc[ai][bj][m][1]); }
                s += __shfl_xor(s, 16); s += __shfl_xor(s, 32);
                if (fq == 0) ssq[(size_t)row * 32] = s; }
    }
};
__device__ __forceinline__ unsigned pack4_fp8(float a, float b, float c, float d) { int w = 0; w = __builtin_amdgcn_cvt_pk_fp8_f32(a, b, w, false); w = __builtin_amdgcn_cvt_pk_fp8_f32(c, d, w, true); return (unsigned)w; }
constexpr float W8_SCALE = 64.f, W8_INV = 1.f / 64.f;
struct EpiAct8 {
    static constexpr bool PERM = true; unsigned char* ws;
    __device__ __forceinline__ void operator()(const f32x4 (&acc)[2][2][4][2], const Unit& u, int wr, int wc, int fr, int fq) const {
        const int row0 = u.pm * 256 + wr * 64 + fr; unsigned char* base = ws + WS_ACT + u.pn * 128 + wc * 32 + 8 * fq;
#pragma unroll
        for (int ai = 0; ai < 2; ++ai)
#pragma unroll
            for (int m = 0; m < 4; ++m) { const int row = row0 + ai * 128 + m * 16; f32x4 a, b;
#pragma unroll
                for (int j = 0; j < 4; ++j) { a[j] = silu_fast(acc[ai][0][m][0][j] * W8_INV) * (acc[ai][1][m][0][j] * W8_INV); b[j] = silu_fast(acc[ai][0][m][1][j] * W8_INV) * (acc[ai][1][m][1][j] * W8_INV); }
                *(unsigned long long*)(base + (size_t)row * FF) = (unsigned long long)pack4_fp8(a[0], a[1], a[2], a[3]) | ((unsigned long long)pack4_fp8(b[0], b[1], b[2], b[3]) << 32); }
    }
};
struct EpiYE8 {
    static constexpr bool PERM = true; unsigned char* ws;
    __device__ __forceinline__ void operator()(const f32x4 (&acc)[2][2][4][2], const Unit& u, int wr, int wc, int fr, int fq) const {
        const int row0 = u.pm * 256 + wr * 64 + fr; unsigned char* base = ws + WS_YE + u.pn * 256 + wc * 32 + 8 * fq;
#pragma unroll
        for (int ai = 0; ai < 2; ++ai)
#pragma unroll
            for (int m = 0; m < 4; ++m) { const int row = row0 + ai * 128 + m * 16;
#pragma unroll
                for (int bj = 0; bj < 2; ++bj) { const f32x4 a = acc[ai][bj][m][0] * W8_INV, b = acc[ai][bj][m][1] * W8_INV;
                    *(unsigned long long*)(base + (size_t)row * D + bj * 128) = (unsigned long long)pack4_fp8(a[0], a[1], a[2], a[3]) | ((unsigned long long)pack4_fp8(b[0], b[1], b[2], b[3]) << 32); } }
    }
};
struct EpiAct {
    static constexpr bool PERM = true; unsigned char* ws;
    __device__ __forceinline__ void operator()(const f32x4 (&acc)[2][2][4][2], const Unit& u, int wr, int wc, int fr, int fq) const {
        const int row0 = u.pm * 256 + wr * 64 + fr; bf16* base = (bf16*)(ws + WS_ACT) + u.pn * 128 + wc * 32 + 8 * fq;
#pragma unroll
        for (int ai = 0; ai < 2; ++ai)
#pragma unroll
            for (int m = 0; m < 4; ++m) { const int row = row0 + ai * 128 + m * 16; f32x4 a, b;
#pragma unroll
                for (int j = 0; j < 4; ++j) { a[j] = silu_fast(acc[ai][0][m][0][j]) * acc[ai][1][m][0][j]; b[j] = silu_fast(acc[ai][0][m][1][j]) * acc[ai][1][m][1][j]; }
                *(u32x4*)(base + (size_t)row * FF) = pg8::pack8(a, b); }
    }
};
struct EpiYE {
    static constexpr bool PERM = true; unsigned char* ws;
    __device__ __forceinline__ void operator()(const f32x4 (&acc)[2][2][4][2], const Unit& u, int wr, int wc, int fr, int fq) const {
        const int row0 = u.pm * 256 + wr * 64 + fr; bf16* base = (bf16*)(ws + WS_YE) + u.pn * 256 + wc * 32 + 8 * fq;
#pragma unroll
        for (int ai = 0; ai < 2; ++ai)
#pragma unroll
            for (int m = 0; m < 4; ++m) { const int row = row0 + ai * 128 + m * 16;
#pragma unroll
                for (int bj = 0; bj < 2; ++bj) *(u32x4*)(base + (size_t)row * D + bj * 128) = pg8::pack8(acc[ai][bj][m][0], acc[ai][bj][m][1]); }
    }
};

namespace att {
using bf16x8 = __attribute__((ext_vector_type(8))) short;
using s16x4  = __attribute__((ext_vector_type(4))) short;
using f32x16 = __attribute__((ext_vector_type(16))) float;
using u32x4  = __attribute__((ext_vector_type(4))) unsigned;
constexpr int QBLK = 32, KVBLK = 64, NW = 8;
constexpr float SCALE = cfg::ATT_SCALE, THR = 8.f;
constexpr int LDQ = 192, LDKK = 192, LDV = 128, LDO = 2048;
constexpr int KROW = 400, SHM_V = KVBLK * 128 * 2, SHM_K = KVBLK * KROW, SHM_QPE = 2 * SHM_V + 2 * SHM_K + NW * 64 * 4, SHM_ATTN = SHM_QPE + NW * 4096;
#define KSWZ(row, colB) ((row) * KROW + (colB))
#define SBAR() __builtin_amdgcn_sched_barrier(0)
__device__ __forceinline__ int crow(int r, int hi) { return (r & 3) + 8 * (r >> 2) + 4 * hi; }
__device__ __forceinline__ unsigned cvtpk(float lo, float hi) { unsigned r; asm volatile("v_cvt_pk_bf16_f32 %0, %1, %2" : "=v"(r) : "v"(lo), "v"(hi)); return r; }

__device__ __forceinline__ void partialSM(f32x16& p0, f32x16& p1, float& m_reg, float& mn, float& alpha) {
  constexpr float C = SCALE * 1.4426950408889634f;
  float pmax = p0[0];
#pragma unroll
  for (int r = 1; r < 16; ++r) pmax = fmaxf(pmax, p0[r]);
#pragma unroll
  for (int r = 0; r < 16; ++r) pmax = fmaxf(pmax, p1[r]);
  { auto rr = __builtin_amdgcn_permlane32_swap(__float_as_uint(pmax), __float_as_uint(pmax), false, false);
    pmax = fmaxf(__uint_as_float(rr[0]), __uint_as_float(rr[1])); }
  if (__builtin_expect(__all(pmax - m_reg <= THR / SCALE), 1)) { mn = m_reg; alpha = 1.f; }
  else { mn = fmaxf(m_reg, pmax); alpha = __builtin_amdgcn_exp2f((m_reg - mn) * C); m_reg = mn; }
  float mnC = -mn * C;
#pragma unroll
  for (int r = 0; r < 16; ++r) p0[r] = fmaf(p0[r], C, mnC);
#pragma unroll
  for (int r = 0; r < 16; ++r) p1[r] = fmaf(p1[r], C, mnC);
#pragma unroll
  for (int r = 0; r < 16; ++r) p0[r] = __builtin_amdgcn_exp2f(p0[r]);
}
__device__ __forceinline__ void finishSM(f32x16& p0, f32x16& p1, float alpha, float& l_reg, bf16x8& pa0, bf16x8& pa1, bf16x8& pa2, bf16x8& pa3) {
#pragma unroll
  for (int r = 0; r < 16; ++r) p1[r] = __builtin_amdgcn_exp2f(p1[r]);
  float ps = 0;
#pragma unroll
  for (int r = 0; r < 16; ++r) ps += p0[r];
#pragma unroll
  for (int r = 0; r < 16; ++r) ps += p1[r];
  { auto rr = __builtin_amdgcn_permlane32_swap(__float_as_uint(ps), __float_as_uint(ps), false, false);
    ps = __uint_as_float(rr[0]) + __uint_as_float(rr[1]); }
  l_reg = l_reg * alpha + ps;
#define PK4(P, BASE, OUT) do { unsigned a0 = cvtpk(P[BASE + 0], P[BASE + 1]), a1 = cvtpk(P[BASE + 2], P[BASE + 3]);   \
    unsigned b0 = cvtpk(P[BASE + 4], P[BASE + 5]), b1 = cvtpk(P[BASE + 6], P[BASE + 7]);                              \
    auto r0 = __builtin_amdgcn_permlane32_swap(a0, b0, false, false); auto r1 = __builtin_amdgcn_permlane32_swap(a1, b1, false, false); \
    u32x4 w = {r0[0], r1[0], r0[1], r1[1]}; OUT = *reinterpret_cast<bf16x8*>(&w); } while (0)
  PK4(p0, 0, pa0); PK4(p0, 8, pa1); PK4(p1, 0, pa2); PK4(p1, 8, pa3);
#undef PK4
}
__device__ __forceinline__ void qkt(f32x16& p0, f32x16& p1, const char* Ks, const bf16x8* qr, const char* qpe, int r32, int hi) {
  p0 = f32x16{}; p1 = f32x16{};
#pragma unroll
  for (int d0 = 0; d0 < 12; ++d0) { const int cb = (d0 * 16 + hi * 8) * 2;
    bf16x8 b0 = *reinterpret_cast<const bf16x8*>(Ks + KSWZ(r32, cb));
    bf16x8 b1 = *reinterpret_cast<const bf16x8*>(Ks + KSWZ(32 + r32, cb));
    const bf16x8 q = d0 < 8 ? qr[d0 < 8 ? d0 : 0] : *reinterpret_cast<const bf16x8*>(qpe + (d0 - 8) * 1024);
    p0 = __builtin_amdgcn_mfma_f32_32x32x16_bf16(b0, q, p0, 0, 0, 0);
    p1 = __builtin_amdgcn_mfma_f32_32x32x16_bf16(b1, q, p1, 0, 0, 0); }
}
__device__ __forceinline__ int v_st(int k, int c) { const int kk = (k & ~0xC) | ((k & 4) << 1) | ((k & 8) >> 1); return ((kk >> 3) * 4 + (c >> 5)) * 512 + ((kk & 7) * 32 + (c & 31)) * 2; }
__device__ __forceinline__ int v_rd_base(int lane) { return ((lane & 3) << 3) | (((lane >> 2) & 3) << 6) | (((lane >> 4) & 1) << 5) | (((lane >> 5) & 1) << 8); }
constexpr int v_rd_off(int d0, int ks, int half) { return d0 * 512 + ks * 4096 + half * 2048; }
template <int OFF> __device__ __forceinline__ s16x4 tr_read(int vb) {
  s16x4 r; asm volatile("ds_read_b64_tr_b16 %0, %1 offset:%2" : "=&v"(r) : "v"(vb), "i"(OFF) : "memory"); return r;
}
template <int D0> __device__ __forceinline__ void pv_one(f32x16& od, int vb, bf16x8 pa0, bf16x8 pa1, bf16x8 pa2, bf16x8 pa3) {
  const s16x4 l0 = tr_read<v_rd_off(D0, 0, 0)>(vb), h0 = tr_read<v_rd_off(D0, 0, 1)>(vb), l1 = tr_read<v_rd_off(D0, 1, 0)>(vb), h1 = tr_read<v_rd_off(D0, 1, 1)>(vb);
  const s16x4 l2 = tr_read<v_rd_off(D0, 2, 0)>(vb), h2 = tr_read<v_rd_off(D0, 2, 1)>(vb), l3 = tr_read<v_rd_off(D0, 3, 0)>(vb), h3 = tr_read<v_rd_off(D0, 3, 1)>(vb);
  asm volatile("s_waitcnt lgkmcnt(0)" ::: "memory"); SBAR();
#define PK(L, H) (bf16x8){L[0], L[1], L[2], L[3], H[0], H[1], H[2], H[3]}
  od = __builtin_amdgcn_mfma_f32_32x32x16_bf16(pa0, PK(l0, h0), od, 0, 0, 0);
  od = __builtin_amdgcn_mfma_f32_32x32x16_bf16(pa1, PK(l1, h1), od, 0, 0, 0);
  od = __builtin_amdgcn_mfma_f32_32x32x16_bf16(pa2, PK(l2, h2), od, 0, 0, 0);
  od = __builtin_amdgcn_mfma_f32_32x32x16_bf16(pa3, PK(l3, h3), od, 0, 0, 0);
#undef PK
}
__device__ __forceinline__ void pv_d0(f32x16* o, int vb, bf16x8 pa0, bf16x8 pa1, bf16x8 pa2, bf16x8 pa3) {
  pv_one<0>(o[0], vb, pa0, pa1, pa2, pa3); pv_one<1>(o[1], vb, pa0, pa1, pa2, pa3); pv_one<2>(o[2], vb, pa0, pa1, pa2, pa3); pv_one<3>(o[3], vb, pa0, pa1, pa2, pa3);
}
template <int V>
__device__ __forceinline__ void attn_unit(const bf16* __restrict__ Qb, const bf16* __restrict__ Kh, const bf16* __restrict__ Vh, bf16* __restrict__ Ob, int seq, char* lds) {
  const int tid = threadIdx.x, wid = tid >> 6, lane = tid & 63, r32 = lane & 31, hi = lane >> 5;
  char* V_lds = lds; char* K_lds = lds + 2 * SHM_V;
  float* ws = (float*)(lds + 2 * SHM_V + 2 * SHM_K) + wid * 64; float* li_l = ws; float* al_l = ws + 32;
  float m_reg = -1e30f, l_reg = 0; f32x16 o[4] = {}; bf16x8 qr[8];
  const bf16* Qw = Qb + (long)(wid * QBLK + r32) * LDQ + hi * 8;
  char* qpe = lds + SHM_QPE + wid * 4096 + lane * 16;
#pragma unroll
  for (int d0 = 0; d0 < 8; ++d0) qr[d0] = *reinterpret_cast<const bf16x8*>(Qw + d0 * 16);
#pragma unroll
  for (int d0 = 8; d0 < 12; ++d0) *reinterpret_cast<bf16x8*>(qpe + (d0 - 8) * 1024) = *reinterpret_cast<const bf16x8*>(Qw + d0 * 16);
  int kro[4], vro[2];
#pragma unroll
  for (int j = 0; j < 4; ++j) { const int o = (wid + 8 * j) * 1024 + lane * 16, row = o / KROW, c = (o - row * KROW) >> 4; kro[j] = row * 384 + (c < 24 ? c : 0) * 16; }
#pragma unroll
  for (int j = 0; j < 2; ++j) { const int o = (wid * 2 + j) * 1024 + lane * 16, st = o >> 9, within = (o & 511) >> 1, kk = (st >> 2) * 8 + (within >> 5), c = (st & 3) * 32 + (within & 31);
    const int k = (kk & ~0xC) | ((kk & 4) << 1) | ((kk & 8) >> 1); vro[j] = k * 256 + c * 2; }
  const unsigned klds = (unsigned)(uintptr_t)K_lds + wid * 1024, vlds = (unsigned)(uintptr_t)V_lds + wid * 2048;
  const int vb0 = (int)(uintptr_t)V_lds + v_rd_base(lane);
  typedef __attribute__((address_space(3))) unsigned* ldsp_t;
#define SDMA_K(k0, b) do { const char* kg = (const char*)Kh + (long)(k0) * (LDKK * 2); \
    _Pragma("unroll") for (int j_ = 0; j_ < 3; ++j_) __builtin_amdgcn_global_load_lds((const unsigned*)(kg + kro[j_]), (ldsp_t)(klds + (b) * SHM_K + j_ * 8192), 16, 0, 0); \
    if (wid == 0) __builtin_amdgcn_global_load_lds((const unsigned*)(kg + kro[3]), (ldsp_t)(klds + (b) * SHM_K + 3 * 8192), 16, 0, 0); } while (0)
#define SDMA_V(k0, b) do { const char* vg = (const char*)Vh + (long)(k0) * (LDV * 2); \
    _Pragma("unroll") for (int j_ = 0; j_ < 2; ++j_) __builtin_amdgcn_global_load_lds((const unsigned*)(vg + vro[j_]), (ldsp_t)(vlds + (b) * SHM_V + j_ * 1024), 16, 0, 0); } while (0)
#define RESC(a) do { if (__any((a) < 1.f)) { if (hi == 0) al_l[r32] = (a); asm volatile("s_waitcnt lgkmcnt(0)" ::: "memory"); \
    _Pragma("unroll") for (int d = 0; d < 4; ++d) _Pragma("unroll") for (int r = 0; r < 16; ++r) o[d][r] *= al_l[crow(r, hi)]; } } while (0)
#define PHASE_END() do { asm volatile("s_waitcnt vmcnt(0) lgkmcnt(0)" ::: "memory"); __builtin_amdgcn_s_barrier(); asm volatile("" ::: "memory"); } while (0)
  f32x16 pA0, pA1; float mnA, alA; bf16x8 pa0, pa1, pa2, pa3; const int NT = seq / KVBLK;
  SDMA_K(0, 0); SDMA_V(0, 0); PHASE_END();
  if (wid >= 4) { __builtin_amdgcn_s_barrier(); asm volatile("" ::: "memory"); }
  for (int j = 0; j < NT; ++j) {
    const int bsel = j & 1;
    if (!(V & 8)) if (j + 1 < NT) { if (bsel) SDMA_K((j + 1) * KVBLK, 0); else SDMA_K((j + 1) * KVBLK, 1); }
    SBAR(); if (!(V & 4)) qkt(pA0, pA1, K_lds + bsel * SHM_K, qr, qpe, r32, hi); else { pA0 = o[0]; pA1 = o[1]; }
    if (!(V & 1)) partialSM(pA0, pA1, m_reg, mnA, alA); else { mnA = 0.f; alA = 1.f; }
    PHASE_END();
    if (!(V & 8)) if (j + 1 < NT) { if (bsel) SDMA_V((j + 1) * KVBLK, 0); else SDMA_V((j + 1) * KVBLK, 1); }
    RESC(alA);
    if (!(V & 1)) finishSM(pA0, pA1, alA, l_reg, pa0, pa1, pa2, pa3); else { pa0 = (bf16x8){(short)__float_as_int(pA0[0])}; pa1 = (bf16x8){(short)__float_as_int(pA0[1])}; pa2 = (bf16x8){(short)__float_as_int(pA1[0])}; pa3 = (bf16x8){(short)__float_as_int(pA1[1])}; l_reg += pA0[2]; } SBAR();
    if (!(V & 2)) pv_d0(o, vb0 + bsel * (int)SHM_V, pa0, pa1, pa2, pa3); else { o[0][0] += __int_as_float(pa0[0]); o[1][0] += __int_as_float(pa1[0]); o[2][0] += __int_as_float(pa2[0]); o[3][0] += __int_as_float(pa3[0]); }
    PHASE_END();
  }
  if (wid < 4) { __builtin_amdgcn_s_barrier(); asm volatile("" ::: "memory"); }
  if (hi == 0) li_l[r32] = l_reg; asm volatile("s_waitcnt lgkmcnt(0)" ::: "memory");
  float rli[16];
#pragma unroll
  for (int r = 0; r < 16; ++r) rli[r] = __builtin_amdgcn_rcpf(li_l[crow(r, hi)]);
  bf16* Ow = Ob + (long)(wid * QBLK) * LDO;
#pragma unroll
  for (int r = 0; r < 16; ++r) { const int orow = crow(r, hi);
#pragma unroll
    for (int d0 = 0; d0 < 4; ++d0) Ow[(long)orow * LDO + d0 * 32 + r32] = f2bf(o[d0][r] * rli[r]); }
#undef SDMA_K
#undef SDMA_V
#undef PHASE_END
#undef RESC
}
#undef KSWZ
#undef SBAR
}

#define XB_TMO      128
#define XB_XCNT(j)  (256  + 64 * (j))
#define XB_XSUB(j)  (1280 + 64 * (j))
#define XB_XGEN(j)  (2304 + 64 * (j))
#define XB_TOP      3328
#define XB_TOPGEN   3392
#define XCD_BAR_WORDS 3456
#define XB_SPIN_CAP (1u << 18)
__device__ __forceinline__ unsigned xb_ld(unsigned* p)              { return __hip_atomic_load(p, __ATOMIC_RELAXED, __HIP_MEMORY_SCOPE_AGENT); }
__device__ __forceinline__ unsigned xb_add(unsigned* p, unsigned v) { return __hip_atomic_fetch_add(p, v, __ATOMIC_RELAXED, __HIP_MEMORY_SCOPE_AGENT); }
__device__ __forceinline__ unsigned xb_xcc_id() { return (unsigned)__builtin_amdgcn_s_getreg((3 << 11) | 20) & 0xFu; }
#define XB_SPIN(cond, bar) do { unsigned _sp = 0; while (cond) { __builtin_amdgcn_s_sleep(1); \
    if ((++_sp & 255u) == 0u) { if (xb_ld(&(bar)[XB_TMO])) break; if (_sp > XB_SPIN_CAP) { atomicAdd(&(bar)[XB_TMO], 1u); break; } } } } while (0)
struct XcdBarrier { unsigned* bar; unsigned x; volatile LAS unsigned* st; };
__device__ __forceinline__ XcdBarrier xcd_barrier_post(unsigned* bar, volatile LAS unsigned* st) {
    XcdBarrier b; b.bar = bar; b.x = xb_xcc_id(); b.st = st;
    if (threadIdx.x == 0) (void)xb_add(&bar[XB_XCNT(b.x)], 1u);
    return b;
}
__device__ __forceinline__ void xcd_barrier_complete(unsigned* bar, unsigned x, unsigned& nloc, unsigned& nx) {
    const unsigned G = gridDim.x * gridDim.y * gridDim.z;
    unsigned sum, cnt, mine, sp = 0u;
    for (;;) {
        sum = 0u; cnt = 0u; mine = 0u;
#pragma unroll
        for (unsigned j = 0; j < 16; ++j) { const unsigned c = xb_ld(&bar[XB_XCNT(j)]); sum += c; cnt += (c > 0u) ? 1u : 0u; mine = (j == x) ? c : mine; }
        if (sum == G) break;
        __builtin_amdgcn_s_sleep(1);
        if ((++sp & 255u) == 0u) { if (xb_ld(&bar[XB_TMO])) break; if (sp > XB_SPIN_CAP) { atomicAdd(&bar[XB_TMO], 1u); break; } }
    }
    nloc = mine > 0u ? mine : 1u; nx = cnt > 0u ? cnt : 1u;
}
__device__ __forceinline__ void xcd_barrier(const XcdBarrier& b) {
    asm volatile("s_waitcnt vmcnt(0)" ::: "memory");
    __syncthreads();
    if (threadIdx.x == 0) {
        unsigned* bar = b.bar;
        __builtin_amdgcn_s_waitcnt(0);
        unsigned nloc = b.st[0], nx = b.st[1];
        if (nloc == 0u) { xcd_barrier_complete(bar, b.x, nloc, nx); b.st[0] = nloc; b.st[1] = nx; }
        const unsigned old = xb_add(&bar[XB_XSUB(b.x)], 1u);
        const unsigned gen = old / nloc;
        if (old + 1u == (gen + 1u) * nloc) {
            __builtin_amdgcn_fence(__ATOMIC_RELEASE, "agent");
            asm volatile("s_waitcnt vmcnt(0)" ::: "memory");
            const unsigned og = xb_add(&bar[XB_TOP], 1u);
            const unsigned tg = og / nx;
            if (og + 1u == (tg + 1u) * nx) xb_add(&bar[XB_TOPGEN], 1u);
            else XB_SPIN(xb_ld(&bar[XB_TOPGEN]) == tg, bar);
            __builtin_amdgcn_fence(__ATOMIC_ACQUIRE, "agent");
            xb_add(&bar[XB_XGEN(b.x)], 1u);
            asm volatile("s_waitcnt vmcnt(0)" ::: "memory");
        } else {
            XB_SPIN(xb_ld(&bar[XB_XGEN(b.x)]) == gen, bar);
            __builtin_amdgcn_fence(__ATOMIC_ACQUIRE, "agent");
            asm volatile("s_waitcnt vmcnt(0)" ::: "memory");
        }
    }
    __syncthreads();
}

constexpr int NWAVES = 8, NTHREADS = 512;
constexpr int RING_BYTES = 131072, TAB_OFF = RING_BYTES, TAB_BYTES = 8192, LDS_BYTES = 163840, MISC_OFF = LDS_BYTES - 512, VEC_OFF = RING_BYTES;
constexpr int CW_BAR = 4096;
#define LDS_WAIT() asm volatile("s_waitcnt lgkmcnt(0)" ::: "memory")
typedef unsigned v4u __attribute__((ext_vector_type(4)));
__device__ __forceinline__ unsigned pk2(float lo, float hi) { return (unsigned)f2bf(lo) | ((unsigned)f2bf(hi) << 16); }

__device__ __forceinline__ void p0_mod_item(const Ptrs& p, int it, int lane) {
    const int kc = it / 48, cc = it - kc * 48, k0 = kc * 64, c0 = cc * 256 + lane * 4;
    float sv[5];
#pragma unroll
    for (int r = 0; r < 5; ++r) { const float* cv = r < 4 ? p.c + r * D : p.c_ctx; sv[r] = silu_f(cv[k0 + lane]); }
    f32x4 acc[5];
#pragma unroll
    for (int r = 0; r < 5; ++r) acc[r] = (f32x4){0.f, 0.f, 0.f, 0.f};
    const float* w = p.w_ada + (size_t)k0 * 12288 + c0;
#pragma unroll 8
    for (int k = 0; k < 64; ++k) { const f32x4 wv = *(const f32x4*)(w + (size_t)k * 12288);
#pragma unroll
        for (int r = 0; r < 5; ++r) acc[r] += __int_as_float(__builtin_amdgcn_readlane(__float_as_int(sv[r]), k)) * wv; }
    float* part = (float*)(p.ws + WS_PART) + (size_t)kc * 5 * 12288 + c0;
#pragma unroll
    for (int r = 0; r < 5; ++r) *(f32x4*)(part + (size_t)r * 12288) = acc[r];
}
__device__ __forceinline__ void cvt_load(const float* src, int ldw, int lane, f32x4 (&v)[8]) {
    const int kr = lane >> 3, nq = lane & 7;
#pragma unroll
    for (int i = 0; i < 8; ++i) v[i] = *(const f32x4*)(src + (size_t)(8 * i + kr) * ldw + 4 * nq);
}
__device__ __forceinline__ void cvt_finish(const f32x4 (&v)[8], bf16* dst, int ldk, bool rope, const float* kscale, LAS float* scr, int lane) {
    const int kr = lane >> 3, nq = lane & 7;
#pragma unroll
    for (int i = 0; i < 8; ++i) { const int k = 8 * i + kr; const float sc = kscale ? kscale[k] : 1.f;
#pragma unroll
        for (int t = 0; t < 4; ++t) { const int cs = 4 * nq + t, nn = rope ? ((cs & 15) * 2 + (cs >> 4)) : cs; scr[k * 33 + nn] = v[i][t] * sc; } }
    LDS_WAIT(); asm volatile("" ::: "memory");
    const int c = lane & 7;
#pragma unroll
    for (int j = 0; j < 4; ++j) { const int n = (lane >> 3) + 8 * j; const LAS float* s = scr + (8 * c) * 33 + n;
        v4u o; o.x = pg8::cvt_pk_bf16(s[0 * 33], s[1 * 33]); o.y = pg8::cvt_pk_bf16(s[2 * 33], s[3 * 33]); o.z = pg8::cvt_pk_bf16(s[4 * 33], s[5 * 33]); o.w = pg8::cvt_pk_bf16(s[6 * 33], s[7 * 33]);
        *(v4u*)(dst + (size_t)n * ldk + 8 * c) = o; }
    LDS_WAIT(); asm volatile("" ::: "memory");
}
__device__ __forceinline__ void cvt_finish_fp8(const f32x4 (&v)[8], unsigned char* dst, int ldk, LAS float* scr, int lane) {
    const int kr = lane >> 3, nq = lane & 7;
#pragma unroll
    for (int i = 0; i < 8; ++i) { const int k = 8 * i + kr;
#pragma unroll
        for (int t = 0; t < 4; ++t) scr[k * 33 + 4 * nq + t] = v[i][t] * W8_SCALE; }
    LDS_WAIT(); asm volatile("" ::: "memory");
    const int c = lane & 3;
#pragma unroll
    for (int j = 0; j < 2; ++j) { const int n = (lane >> 2) + 16 * j; const LAS float* s = scr + (16 * c) * 33 + n;
        v4u o; o.x = pack4_fp8(s[0 * 33], s[1 * 33], s[2 * 33], s[3 * 33]); o.y = pack4_fp8(s[4 * 33], s[5 * 33], s[6 * 33], s[7 * 33]);
        o.z = pack4_fp8(s[8 * 33], s[9 * 33], s[10 * 33], s[11 * 33]); o.w = pack4_fp8(s[12 * 33], s[13 * 33], s[14 * 33], s[15 * 33]);
        *(v4u*)(dst + (size_t)n * ldk + 16 * c) = o; }
    LDS_WAIT(); asm volatile("" ::: "memory");
}
__device__ __forceinline__ void cvt_item(const float* src, int ldw, bf16* dst, int ldk, bool rope, const float* kscale, LAS float* scr, int lane) {
    f32x4 v[8]; cvt_load(src, ldw, lane, v); cvt_finish(v, dst, ldk, rope, kscale, scr, lane);
}
constexpr int I_MOD = 1536, I_WIN = 32 * 98, I_WQ = 8 * 48, I_WKV = 8 * 64, I_WOUT = 32 * 64, I_GU = 16 * 32 * 128, I_DN = 16 * 32 * 64, I_SGU = 256, I_ZERO = 768, I_ROPE = 1;
constexpr int P0_ITEMS = I_MOD + I_WIN + I_WQ + I_WKV + I_WOUT + I_SGU + I_ZERO + I_ROPE, PX_ITEMS = I_GU + I_DN;
__device__ __forceinline__ void p0_item(const Ptrs& p, int it, LAS float* scr, int lane) {
    if (it < I_MOD) { p0_mod_item(p, it, lane); return; } it -= I_MOD;
    if (it < I_WIN) { const int kb = it / 98, nb = it - kb * 98, n0 = nb * 32; int col0; bool rope = false;
        if (n0 < 1024) col0 = n0; else if (n0 < 3072) col0 = n0 + 64; else { col0 = OFF_KPE + (nb - 96) * 32; rope = true; }
        cvt_item(p.w_in + (size_t)kb * 64 * INC + col0, INC, (bf16*)(p.ws + WS_WIN_T) + (size_t)n0 * D + kb * 64, D, rope, nullptr, scr, lane); return; } it -= I_WIN;
    if (it < I_WQ) { const int kb = it / 48, nb = it - kb * 48, n0 = nb * 32; int col0; bool rope = false;
        if (n0 < 1024) col0 = (n0 >> 7) * DQK + (n0 & 127); else { const int jj = n0 - 1024; col0 = (jj >> 6) * DQK + 128 + ((jj & 63) >> 5) * 32; rope = true; }
        cvt_item(p.w_uq + (size_t)kb * 64 * 1536 + col0, 1536, (bf16*)(p.ws + WS_WQKV_T) + (size_t)n0 * 512 + kb * 64, 512, rope, p.q_norm_w + kb * 64, scr, lane); return; } it -= I_WQ;
    if (it < I_WKV) { const int kb = it / 64, nb = it - kb * 64, n0 = nb * 32;
        cvt_item(p.w_ukv + (size_t)kb * 64 * 2048 + n0, 2048, (bf16*)(p.ws + WS_WQKV_T) + (size_t)(1536 + n0) * 512 + kb * 64, 512, false, p.kv_norm_w + kb * 64, scr, lane); return; } it -= I_WKV;
    if (it < I_WOUT) { const int kb = it / 64, nb = it - kb * 64, n0 = nb * 32;
        cvt_item(p.w_out + (size_t)kb * 64 * D + n0, D, (bf16*)(p.ws + WS_WOUT_T) + (size_t)n0 * D + kb * 64, D, false, nullptr, scr, lane); return; } it -= I_WOUT;
    if (it < I_SGU) { const float* s = p.sgu_w + (size_t)it * 512 + lane * 8; const f32x4 a = *(const f32x4*)s, b = *(const f32x4*)(s + 4);
        v4u o; o.x = pk2(a[0], a[1]); o.y = pk2(a[2], a[3]); o.z = pk2(b[0], b[1]); o.w = pk2(b[2], b[3]); *(v4u*)((bf16*)(p.ws + WS_SGUW) + (size_t)it * 512 + lane * 8) = o; return; } it -= I_SGU;
    if (it < I_ZERO) { *(v4u*)((bf16*)(p.ws + WS_WIN_T) + (size_t)3136 * D + (size_t)it * 512 + lane * 8) = (v4u){0u, 0u, 0u, 0u}; return; }
    float* tab = (float*)(p.ws + WS_ROPE);
    for (int j = 0; j < 16; ++j) { const int idx = j * 64 + lane, ax = idx >> 4, ii = idx & 15; float s, c; sincosf((float)ax * rope_inv(ii), &s, &c); tab[idx * 2] = c; tab[idx * 2 + 1] = s; }
}
constexpr int PX_N3 = 0, PX_N4 = 0, PX_N8 = 48, PX_R3 = 0, PX_R4 = PX_R3 + 180 * PX_N3, PX_R8 = PX_R4 + 96 * PX_N4, PX_R5 = PX_R8 + 192 * PX_N8;
constexpr int WEL = FP8_MOE ? 1 : 2;
#if 0
#else
__device__ __forceinline__ void px_ptrs(const Ptrs& p, int it, const float*& src, unsigned char*& dst) {
    if (it < I_GU) { const int e = it >> 12, r = it & 4095, kb = r >> 7, nb = r & 127, n0 = nb * 32, pn = n0 >> 8, within = n0 & 255;
        src = (within < 128 ? p.w_e_gate : p.w_e_up) + ((size_t)e * D + kb * 64) * FF + pn * 128 + (within & 127);
        dst = p.ws + WS_WGU_T + (((size_t)e * 4096 + n0) * D + kb * 64) * WEL; }
    else { it -= I_GU; const int e = it >> 11, r = it & 2047, kb = r >> 6, nb = r & 63, n0 = nb * 32;
        src = p.w_e_down + ((size_t)e * FF + kb * 64) * D + n0; dst = p.ws + WS_WD_T + (((size_t)e * D + n0) * FF + kb * 64) * WEL; }
}
__device__ __forceinline__ void px_dma(const float* src, unsigned ldsbase, int lane) {
    typedef __attribute__((address_space(3))) unsigned* ldsp_t;
#pragma unroll
    for (int i = 0; i < 8; ++i) { const int k = 8 * i + (lane >> 3), nq = ((lane & 7) - 2 * (k >> 4)) & 7;
        __builtin_amdgcn_global_load_lds((const unsigned*)(src + (size_t)k * 2048 + 4 * nq), (ldsp_t)(ldsbase + i * 1024), 16, 0, 0); }
}
__device__ __forceinline__ void px_out(unsigned char* dst, const LAS float* t, int lane) {
    if constexpr (FP8_MOE) {
        const int c = lane & 3;
#pragma unroll
        for (int j = 0; j < 2; ++j) { const int n = (lane >> 2) + 16 * j; float v[16];
#pragma unroll
            for (int q = 0; q < 16; ++q) { const int k = 16 * c + q; v[q] = t[(k * 8 + (((n >> 2) + 2 * c) & 7)) * 4 + (n & 3)] * W8_SCALE; }
            v4u o; o.x = pack4_fp8(v[0], v[1], v[2], v[3]); o.y = pack4_fp8(v[4], v[5], v[6], v[7]); o.z = pack4_fp8(v[8], v[9], v[10], v[11]); o.w = pack4_fp8(v[12], v[13], v[14], v[15]);
            *(v4u*)(dst + (size_t)n * 2048 + 16 * c) = o; }
    } else {
        const int c = lane & 7;
#pragma unroll
        for (int j = 0; j < 4; ++j) { const int n = (lane >> 3) + 8 * j; float v[8];
#pragma unroll
            for (int q = 0; q < 8; ++q) { const int k = 8 * c + q; v[q] = t[(k * 8 + (((n >> 2) + 2 * (k >> 4)) & 7)) * 4 + (n & 3)]; }
            v4u o; o.x = pg8::cvt_pk_bf16(v[0], v[1]); o.y = pg8::cvt_pk_bf16(v[2], v[3]); o.z = pg8::cvt_pk_bf16(v[4], v[5]); o.w = pg8::cvt_pk_bf16(v[6], v[7]);
            *(v4u*)((bf16*)dst + (size_t)n * 2048 + 8 * c) = o; }
    }
}
__device__ __forceinline__ void px_convert(const Ptrs& p, int it0, int NGW, int PX_END, LAS float* scr, int lane) {
    const unsigned l0 = (unsigned)(uintptr_t)scr; const float* s_; unsigned char *da, *db;
    int it = it0;
    if (it < PX_END) { px_ptrs(p, it, s_, da); px_dma(s_, l0, lane); }
    while (it < PX_END) {
        const int i1 = it + NGW, i2 = it + 2 * NGW;
        if (i1 < PX_END) { px_ptrs(p, i1, s_, db); px_dma(s_, l0 + 8192, lane); asm volatile("s_waitcnt vmcnt(8)" ::: "memory"); } else asm volatile("s_waitcnt vmcnt(0)" ::: "memory");
        px_out(da, scr, lane);
        if (i1 >= PX_END) break;
        asm volatile("s_waitcnt lgkmcnt(0)" ::: "memory");
        if (i2 < PX_END) { px_ptrs(p, i2, s_, da); px_dma(s_, l0, lane); asm volatile("s_waitcnt vmcnt(8)" ::: "memory"); } else asm volatile("s_waitcnt vmcnt(0)" ::: "memory");
        px_out(db, scr + 2048, lane);
        asm volatile("s_waitcnt lgkmcnt(0)" ::: "memory");
        it = i2;
    }
}
#endif
__device__ __forceinline__ void p1_row(const Ptrs& p, int row, int lane, const LAS float* vg  , const LAS float* vs  ) {
    const float* src = row < M ? p.x + (size_t)row * D : p.ctx + (size_t)(row - M) * D;
    f32x4 v[8]; float s = 0.f;
#pragma unroll
    for (int j = 0; j < 8; ++j) { v[j] = *(const f32x4*)(src + j * 256 + lane * 4); s += dot4(v[j]); }
    const float rs = rsqrtf(wave_sum(s) * (1.f / D) + EPS);
    bf16* o = (bf16*)(p.ws + WS_H) + (size_t)row * D;
#pragma unroll
    for (int j = 0; j < 8; ++j) { const int c = j * 256 + lane * 4; const f32x4 h = v[j] * rs * *(const LAS f32x4*)(vg + c) + *(const LAS f32x4*)(vs + c);
        *(unsigned long long*)(o + c) = (unsigned long long)pk2(h[0], h[1]) | ((unsigned long long)pk2(h[2], h[3]) << 32); }
}
typedef float f32x16 __attribute__((ext_vector_type(16)));
typedef short bf16x8v __attribute__((ext_vector_type(8)));
struct SguIn { v4u vs[4]; };
__device__ __forceinline__ void sgu_fetch(const Ptrs& p, int chunk, int g, int tid, SguIn& in) {
    const bf16* src = (const bf16*)(p.ws + WS_VS) + (size_t)(chunk * 128 + (tid >> 2)) * 1024 + g * 128 + (tid & 3) * 32;
#pragma unroll
    for (int j = 0; j < 4; ++j) in.vs[j] = *(const v4u*)(src + j * 8);
}
__device__ __forceinline__ void sgu_unit(const Ptrs& p, int chunk, int g, LAS unsigned char* lds, int tid, const SguIn& in) {
    constexpr int VROW = 272;
    const int lane = tid & 63, wid = tid >> 6;
    const int pb = wid >> 1, ch = wid & 1, r32 = lane & 31, hi = lane >> 5;
    v4u uw[4];
#pragma unroll
    for (int i = 0; i < 4; ++i) { const int id = tid + NTHREADS * i, pr = id >> 4, c8 = (id & 15) * 8; uw[i] = *(const v4u*)((const bf16*)(p.ws + WS_U) + ((size_t)chunk * 128 + pr) * 1024 + g * 128 + c8); }
    bf16x8v wa[8];
    { const bf16* wrow = (const bf16*)(p.ws + WS_SGUW) + ((size_t)g * 128 + pb * 32 + r32) * 128 + hi * 8;
#pragma unroll
      for (int ks = 0; ks < 8; ++ks) wa[ks] = *(const bf16x8v*)(wrow + ks * 16); }
    {
        const int q = tid >> 2, cg = tid & 3;
        float x[32];
#pragma unroll
        for (int j = 0; j < 4; ++j) { const v4u w = in.vs[j];
#pragma unroll
            for (int t = 0; t < 4; ++t) { x[j * 8 + 2 * t] = __uint_as_float(w[t] << 16); x[j * 8 + 2 * t + 1] = __uint_as_float(w[t] & 0xffff0000u); } }
        float s = 0.f;
#pragma unroll
        for (int j = 0; j < 32; ++j) s += x[j];
        s += __shfl_xor(s, 1); s += __shfl_xor(s, 2);
        const float mu = s * (1.f / 128.f); float vq = 0.f;
#pragma unroll
        for (int j = 0; j < 32; ++j) { x[j] -= mu; vq += x[j] * x[j]; }
        vq += __shfl_xor(vq, 1); vq += __shfl_xor(vq, 2);
        const float rs = rsqrtf(vq * (1.f / 128.f) + EPS);
        const float* gw = p.sgu_norm_w + g * 128 + cg * 32;
#pragma unroll
        for (int j = 0; j < 32; ++j) *(LAS bf16*)(lds + (cg * 32 + j) * VROW + q * 2) = f2bf(x[j] * rs * gw[j]);
    }
    LDS_WAIT(); __syncthreads();
    f32x16 acc0 = {}, acc1 = {};
#pragma unroll
    for (int ks = 0; ks < 8; ++ks) {
        const bf16x8v b0 = *(const LAS bf16x8v*)(lds + (ch * 64 + r32) * VROW + (ks * 16 + hi * 8) * 2);
        const bf16x8v b1 = *(const LAS bf16x8v*)(lds + (ch * 64 + 32 + r32) * VROW + (ks * 16 + hi * 8) * 2);
        acc0 = __builtin_amdgcn_mfma_f32_32x32x16_bf16(wa[ks], b0, acc0, 0, 0, 0);
        acc1 = __builtin_amdgcn_mfma_f32_32x32x16_bf16(wa[ks], b1, acc1, 0, 0, 0);
    }
    LAS float* T = (LAS float*)(lds + 36864);
#pragma unroll
    for (int r = 0; r < 16; ++r) { const int pr = pb * 32 + (r & 3) + 8 * (r >> 2) + 4 * hi; const float bias = p.sgu_b[g * 128 + pr];
        T[pr * 128 + ch * 64 + r32] = acc0[r] + bias; T[pr * 128 + ch * 64 + 32 + r32] = acc1[r] + bias; }
    LDS_WAIT(); __syncthreads();
#pragma unroll
    for (int i = 0; i < 4; ++i) { const int id = tid + NTHREADS * i, pr = id >> 4, c8 = (id & 15) * 8; const size_t tok = (size_t)chunk * 128 + pr;
        const f32x4 m0 = *(const LAS f32x4*)(T + pr * 128 + c8), m1 = *(const LAS f32x4*)(T + pr * 128 + c8 + 4); const v4u u4 = uw[i];
        v4u o; o.x = pg8::cvt_pk_bf16(__uint_as_float(u4.x << 16) * m0[0], __uint_as_float(u4.x & 0xffff0000u) * m0[1]); o.y = pg8::cvt_pk_bf16(__uint_as_float(u4.y << 16) * m0[2], __uint_as_float(u4.y & 0xffff0000u) * m0[3]);
        o.z = pg8::cvt_pk_bf16(__uint_as_float(u4.z << 16) * m1[0], __uint_as_float(u4.z & 0xffff0000u) * m1[1]); o.w = pg8::cvt_pk_bf16(__uint_as_float(u4.w << 16) * m1[2], __uint_as_float(u4.w & 0xffff0000u) * m1[3]);
        *(v4u*)((bf16*)(p.ws + WS_CAT) + tok * D + 1024 + g * 128 + c8) = o; }
    __syncthreads();
}
__device__ __forceinline__ void topk_unit(const Ptrs& p, int e, int b, LAS unsigned* sh, int tid) {
    const int lane = tid & 63, wid = tid >> 6;
    const float* aff = (const float*)(p.ws + WS_AFF) + (size_t)b * L * 16 + e;
    unsigned key[8];
#pragma unroll
    for (int j = 0; j < 8; ++j) key[j] = __float_as_uint(aff[(size_t)(tid * 8 + j) * 16]);
    unsigned prefix = 0u, mask = 0u, need = CAP;
    for (int shift = 24; shift >= 0; shift -= 8) {
        if (tid < 256) sh[tid] = 0u;
        __syncthreads();
#pragma unroll
        for (int j = 0; j < 8; ++j) if ((key[j] & mask) == prefix) atomicAdd((unsigned*)&sh[(key[j] >> shift) & 255u], 1u);
        __syncthreads();
        if (wid == 0) {
            const unsigned c0 = sh[4 * lane], c1 = sh[4 * lane + 1], c2 = sh[4 * lane + 2], c3 = sh[4 * lane + 3];
            const unsigned s = c0 + c1 + c2 + c3; unsigned S = s;
#pragma unroll
            for (int d = 1; d < 64; d <<= 1) { const unsigned v = __shfl_down(S, d); if (lane + d < 64) S += v; }
            const unsigned above = S - s;
            if (S >= need && above < need) { unsigned cum = above, bin, nd;
                if (cum + c3 >= need) { bin = 3; nd = need - cum; } else { cum += c3;
                if (cum + c2 >= need) { bin = 2; nd = need - cum; } else { cum += c2;
                if (cum + c1 >= need) { bin = 1; nd = need - cum; } else { cum += c1; bin = 0; nd = need - cum; } } }
                sh[256] = 4u * lane + bin; sh[257] = nd; }
        }
        __syncthreads();
        prefix |= sh[256] << shift; mask |= 255u << shift; need = sh[257];
        __syncthreads();
    }
    unsigned cg = 0u, ce = 0u;
#pragma unroll
    for (int j = 0; j < 8; ++j) { cg += key[j] > prefix ? 1u : 0u; ce += key[j] == prefix ? 1u : 0u; }
    unsigned pk = (cg << 16) | ce, inc = pk;
#pragma unroll
    for (int d = 1; d < 64; d <<= 1) { const unsigned v = __shfl_up(inc, d); if (lane >= d) inc += v; }
    if (lane == 63) sh[264 + wid] = inc;
    __syncthreads();
    unsigned off = 0u;
#pragma unroll
    for (int w = 0; w < 8; ++w) off += (w < wid) ? sh[264 + w] : 0u;
    unsigned ex = off + inc - pk; unsigned gtb = ex >> 16, eqb = ex & 0xffffu;
    int* inv = (int*)(p.ws + WS_INV) + (size_t)(b * L + tid * 8) * 16 + e; int* idx = (int*)(p.ws + WS_IDX) + (size_t)(e * 4 + b) * CAP;
#pragma unroll
    for (int j = 0; j < 8; ++j) { const bool gt = key[j] > prefix, eq = key[j] == prefix; const bool sel = gt || (eq && eqb < need);
        const unsigned slot = gtb + (eqb < need ? eqb : need);
        inv[(size_t)j * 16] = sel ? (int)slot : -1; if (sel) idx[slot] = tid * 8 + j;
        gtb += gt ? 1u : 0u; eqb += eq ? 1u : 0u; }
    __syncthreads();
}

__device__ __forceinline__ f32x4 ld_bf16x4(const bf16* s) { const unsigned long long w = *(const unsigned long long*)s; const unsigned lo = (unsigned)w, hi2 = (unsigned)(w >> 32);
    return (f32x4){__uint_as_float(lo << 16), __uint_as_float(lo & 0xffff0000u), __uint_as_float(hi2 << 16), __uint_as_float(hi2 & 0xffff0000u)}; }
__device__ __forceinline__ void st_bf16x4(bf16* d, const f32x4& h) { *(unsigned long long*)d = (unsigned long long)pk2(h[0], h[1]) | ((unsigned long long)pk2(h[2], h[3]) << 32); }
struct P6In { f32x4 x[8]; unsigned long long y[8]; float ssq; };
__device__ __forceinline__ void p6_fetch(const Ptrs& p, int row, int lane, P6In& in) {
    const float* xr = p.x + (size_t)row * D + lane * 4; const bf16* y = (const bf16*)(p.ws + WS_Y) + (size_t)row * D + lane * 4;
#pragma unroll
    for (int j = 0; j < 8; ++j) { in.x[j] = *(const f32x4*)(xr + j * 256); in.y[j] = *(const unsigned long long*)(y + j * 256); }
    in.ssq = lane < 32 ? ((const float*)(p.ws + WS_SSQY))[(size_t)row * 32 + lane] : 0.f;
}
__device__ __forceinline__ f32x4 bf16x4_to_f32(unsigned long long w) { const unsigned lo = (unsigned)w, hi2 = (unsigned)(w >> 32);
    return (f32x4){__uint_as_float(lo << 16), __uint_as_float(lo & 0xffff0000u), __uint_as_float(hi2 << 16), __uint_as_float(hi2 & 0xffff0000u)}; }
__device__ __forceinline__ void p6_row(const Ptrs& p, int row, int lane, const LAS float* wt, const LAS float* vt, const P6In& in, int flags) {
    const float rsy = rsqrtf(wave_sum(in.ssq) * (1.f / D) + EPS);
    bf16* o = (bf16*)(p.ws + ((flags & 1) ? WS_VN : WS_XN)) + (size_t)row * D;
    f32x4 v[8]; float s = 0.f;
#pragma unroll
    for (int j = 0; j < 8; ++j) { const int c = j * 256 + lane * 4;
        v[j] = in.x[j] + (bf16x4_to_f32(in.y[j]) * rsy) * *(const LAS f32x4*)(vt + c);
        st_bf16x4(o + c, v[j]); s += dot4(v[j]); }
    const float rs = rsqrtf(wave_sum(s) * (1.f / D) + EPS);
    bf16* h2 = (bf16*)(p.ws + ((flags & 1) ? WS_VN : WS_H2)) + (size_t)row * D;
    float lg[16];
#pragma unroll
    for (int e = 0; e < 16; ++e) lg[e] = 0.f;
    f32x4 hv[8];
#pragma unroll
    for (int j = 0; j < 8; ++j) { const int c = j * 256 + lane * 4;
        hv[j] = v[j] * rs * *(const LAS f32x4*)(vt + 2048 + c) + *(const LAS f32x4*)(vt + 4096 + c);
        if constexpr (FP8_MOE) *(unsigned*)((unsigned char*)(p.ws + ((flags & 1) ? WS_VN : WS_H2)) + (size_t)row * D + c) = pack4_fp8(hv[j][0], hv[j][1], hv[j][2], hv[j][3]); else st_bf16x4(h2 + c, hv[j]); }
    if (!(flags & 2)) {
        f32x4 wa[8], wb[8];
#define RLOAD(dst, st) do { const LAS float* wp_ = wt + ((st) & 1) * 8 * 2048 + ((st) >> 1) * 256 + lane * 4; _Pragma("unroll") for (int e_ = 0; e_ < 8; ++e_) dst[e_] = *(const LAS f32x4*)(wp_ + e_ * 2048); } while (0)
#define RFMA(src, st) do { const f32x4 h_ = hv[(st) >> 1]; _Pragma("unroll") for (int e_ = 0; e_ < 8; ++e_) lg[((st) & 1) * 8 + e_] += (h_[0] * src[e_][0] + h_[1] * src[e_][1]) + (h_[2] * src[e_][2] + h_[3] * src[e_][3]); } while (0)
        RLOAD(wa, 0);
#pragma unroll
        for (int st = 0; st < 16; st += 2) {
            RLOAD(wb, st + 1); __builtin_amdgcn_sched_barrier(0); RFMA(wa, st); __builtin_amdgcn_sched_barrier(0);
            if (st + 2 < 16) RLOAD(wa, st + 2); __builtin_amdgcn_sched_barrier(0); RFMA(wb, st + 1); __builtin_amdgcn_sched_barrier(0);
        }
#undef RLOAD
#undef RFMA
    }
#define XSTEP(N, MASK) _Pragma("unroll") for (int i = 0; i < N; ++i) { const bool up = (lane & MASK) != 0; const float send = up ? lg[i] : lg[i + N]; const float keep = up ? lg[i + N] : lg[i]; lg[i] = keep + __shfl_xor(send, MASK); }
    XSTEP(8, 32) XSTEP(4, 16) XSTEP(2, 8) XSTEP(1, 4)
#undef XSTEP
    float lgt = lg[0]; lgt += __shfl_xor(lgt, 2); lgt += __shfl_xor(lgt, 1);
    lgt += p.b_router[lane >> 2];
    float mx = lgt;
#pragma unroll
    for (int o2 = 4; o2 < 64; o2 <<= 1) mx = fmaxf(mx, __shfl_xor(mx, o2));
    const float ex = __expf(lgt - mx); float se = ex;
#pragma unroll
    for (int o2 = 4; o2 < 64; o2 <<= 1) se += __shfl_xor(se, o2);
    if ((lane & 3) == 0 && !(flags & 1)) ((float*)(p.ws + WS_AFF))[(size_t)row * 16 + (lane >> 2)] = ex / se;
}
typedef unsigned u32x4v __attribute__((ext_vector_type(4)));
struct P11In { u32x4v x[4]; int inv; float aff; };
__device__ __forceinline__ void p11_fetch(const Ptrs& p, int row, int lane, P11In& in) {
    const bf16* xr = (const bf16*)(p.ws + WS_XN) + (size_t)row * D + lane * 8;
#pragma unroll
    for (int j = 0; j < 4; ++j) in.x[j] = *(const u32x4v*)(xr + j * 512);
    in.inv = ((const int*)(p.ws + WS_INV))[(size_t)row * 16 + (lane & 15)]; in.aff = ((const float*)(p.ws + WS_AFF))[(size_t)row * 16 + (lane & 15)];
}
__device__ __forceinline__ void acc_bf16x8(f32x4& a, f32x4& b, const u32x4v& w, float g) {
    a[0] += g * __uint_as_float(w[0] << 16); a[1] += g * __uint_as_float(w[0] & 0xffff0000u); a[2] += g * __uint_as_float(w[1] << 16); a[3] += g * __uint_as_float(w[1] & 0xffff0000u);
    b[0] += g * __uint_as_float(w[2] << 16); b[1] += g * __uint_as_float(w[2] & 0xffff0000u); b[2] += g * __uint_as_float(w[3] << 16); b[3] += g * __uint_as_float(w[3] & 0xffff0000u);
}
__device__ __forceinline__ void p11_row(const Ptrs& p, int row, int lane, float* dsto, const LAS float* vt, const P11In& in, int flags) {
    const int b = row >> 12;
    unsigned mask = (flags & 2) ? 0u : (unsigned)(__ballot(in.inv >= 0) & 0xffffull);
    f32x4 v[8];
#pragma unroll
    for (int j = 0; j < 8; ++j) v[j] = (f32x4){0.f, 0.f, 0.f, 0.f};
    while (mask) {
#if FP8_MOE
        unsigned long long r[4][4]; float g[4]; bool on[4];
#pragma unroll
        for (int k = 0; k < 4; ++k) { on[k] = mask != 0u; g[k] = 0.f;
            if (on[k]) { const int e = __builtin_ctz(mask); mask &= mask - 1u; const int sl = __builtin_amdgcn_readlane(in.inv, e); g[k] = __int_as_float(__builtin_amdgcn_readlane(__float_as_int(in.aff), e));
                const unsigned char* ye = p.ws + WS_YE + ((size_t)(e * 4 + b) * CAP + sl) * D + lane * 8;
#pragma unroll
                for (int j = 0; j < 4; ++j) r[k][j] = *(const unsigned long long*)(ye + j * 512); } }
#pragma unroll
        for (int k = 0; k < 4; ++k) if (on[k]) {
#pragma unroll
            for (int j = 0; j < 4; ++j) { const int lo32 = (int)(unsigned)r[k][j], hi32 = (int)(unsigned)(r[k][j] >> 32);
                const auto a0 = __builtin_amdgcn_cvt_pk_f32_fp8(lo32, false), a1 = __builtin_amdgcn_cvt_pk_f32_fp8(lo32, true), b0 = __builtin_amdgcn_cvt_pk_f32_fp8(hi32, false), b1 = __builtin_amdgcn_cvt_pk_f32_fp8(hi32, true);
                v[2 * j][0] += g[k] * a0[0]; v[2 * j][1] += g[k] * a0[1]; v[2 * j][2] += g[k] * a1[0]; v[2 * j][3] += g[k] * a1[1];
                v[2 * j + 1][0] += g[k] * b0[0]; v[2 * j + 1][1] += g[k] * b0[1]; v[2 * j + 1][2] += g[k] * b1[0]; v[2 * j + 1][3] += g[k] * b1[1]; } }
#else
        u32x4v r[4][4]; float g[4]; bool on[4];
#pragma unroll
        for (int k = 0; k < 4; ++k) { on[k] = mask != 0u; g[k] = 0.f;
            if (on[k]) { const int e = __builtin_ctz(mask); mask &= mask - 1u; const int sl = __builtin_amdgcn_readlane(in.inv, e); g[k] = __int_as_float(__builtin_amdgcn_readlane(__float_as_int(in.aff), e));
                const bf16* ye = (const bf16*)(p.ws + WS_YE) + ((size_t)(e * 4 + b) * CAP + sl) * D + lane * 8;
#pragma unroll
                for (int j = 0; j < 4; ++j) r[k][j] = *(const u32x4v*)(ye + j * 512); } }
#pragma unroll
        for (int k = 0; k < 4; ++k) if (on[k]) {
#pragma unroll
            for (int j = 0; j < 4; ++j) acc_bf16x8(v[2 * j], v[2 * j + 1], r[k][j], g[k]); }
#endif
    }
    float s = 0.f;
#pragma unroll
    for (int j = 0; j < 8; ++j) s += dot4(v[j]);
    const float rs = rsqrtf(wave_sum(s) * (1.f / D) + EPS);
    float* od = dsto + (size_t)row * D + lane * 8;
#pragma unroll
    for (int j = 0; j < 4; ++j) { const int c = j * 512 + lane * 8;
        const u32x4v xw = in.x[j];
        const f32x4 xa = (f32x4){__uint_as_float(xw[0] << 16), __uint_as_float(xw[0] & 0xffff0000u), __uint_as_float(xw[1] << 16), __uint_as_float(xw[1] & 0xffff0000u)};
        const f32x4 xb = (f32x4){__uint_as_float(xw[2] << 16), __uint_as_float(xw[2] & 0xffff0000u), __uint_as_float(xw[3] << 16), __uint_as_float(xw[3] & 0xffff0000u)};
        *(f32x4*)(od + j * 512) = xa + (v[2 * j] * rs) * *(const LAS f32x4*)(vt + c);
        *(f32x4*)(od + j * 512 + 4) = xb + (v[2 * j + 1] * rs) * *(const LAS f32x4*)(vt + c + 4); }
}

struct Args { Ptrs p; int ph_lo, ph_hi, bar_idx, pad; };
#define PROBE_FLAGS 0
__global__ void __launch_bounds__(NTHREADS, 2) fwd(Args args) {
    extern __shared__ __attribute__((aligned(16))) unsigned char lds_raw[];
    LAS unsigned char* lds = (LAS unsigned char*)lds_raw;
#if defined(__HIP_DEVICE_COMPILE__)
    typedef __attribute__((address_space(4))) const Args CArgs;
#define LOADP() Ptrs p; { const CArgs* kp_ = (const CArgs*)__builtin_amdgcn_kernarg_segment_ptr(); asm volatile("" : "+s"(kp_)); p = kp_->p; }
#else
#define LOADP() Ptrs p = args.p;
#endif
#define TIDS() int tid = threadIdx.x; asm volatile("" : "+v"(tid)); const int lane = tid & 63, wave = __builtin_amdgcn_readfirstlane(tid >> 6); \
    const int G = gridDim.x, bx = blockIdx.x, vcu = (G % 8 == 0) ? (bx % 8) * (G / 8) + bx / 8 : bx; const int gw = vcu * NWAVES + wave, NGW = G * NWAVES; (void)lane; (void)gw; (void)NGW; (void)vcu; (void)bx;
    volatile LAS unsigned* MISC = (volatile LAS unsigned*)(lds + MISC_OFF);
    if (threadIdx.x < 64) MISC[threadIdx.x] = 0u;
    __syncthreads();
#if defined(__HIP_DEVICE_COMPILE__)
#define ARGF(f) ([&]() { const CArgs* kq_ = (const CArgs*)__builtin_amdgcn_kernarg_segment_ptr(); asm volatile("" : "+s"(kq_)); return kq_->f; }())
#else
#define ARGF(f) (args.f)
#endif
    if (ARGF(ph_hi) - ARGF(ph_lo) > 1) { LOADP(); (void)xcd_barrier_post((unsigned*)(p.ws + WS_CTL) + CW_BAR + ARGF(bar_idx) * 4096, MISC + 8); }
#define GRID_BARRIER() do { LOADP(); XcdBarrier b_; b_.bar = (unsigned*)(p.ws + WS_CTL) + CW_BAR + ARGF(bar_idx) * 4096; b_.x = xb_xcc_id(); b_.st = (volatile LAS unsigned*)(lds + MISC_OFF) + 8; xcd_barrier(b_); } while (0)
#define lo ARGF(ph_lo)
#define hi ARGF(ph_hi)
#if defined(ONLY_SET)
#define IN(k) (((ONLY_SET >> (k)) & 1) && lo <= (k) && (k) < hi)
#elif defined(ONLY_PHASE)
#define IN(k) ((k) == ONLY_PHASE && lo <= (k) && (k) < hi)
#else
#define IN(k) (lo <= (k) && (k) < hi)
#endif
#define SEAM(k) do { if (IN(k) && IN((k) + 1)) GRID_BARRIER(); } while (0)

    if (IN(0)) { LOADP(); TIDS();
        LAS float* scr = (LAS float*)(lds + wave * 8448);
        for (int it = gw; it < P0_ITEMS; it += NGW) p0_item(p, it, scr, lane);
    }
    SEAM(0);
    if (IN(1)) { LOADP(); TIDS();
        const int gid = bx * NTHREADS + tid;
        if (gid < 5 * 12288) { const int r = gid / 12288, j = gid - r * 12288; float s = p.b_ada[j]; const float* part = (const float*)(p.ws + WS_PART) + (size_t)r * 12288 + j;
            for (int kc = 0; kc < 32; ++kc) s += part[(size_t)kc * 5 * 12288];
            ((float*)(p.ws + WS_MOD))[gid] = s; }
    }
    SEAM(1);
    if (IN(2)) { LOADP(); TIDS();
        const int bsel = vcu & 3, wsub = (vcu >> 2) * NWAVES + wave, nsub = ((G + 3 - bsel) >> 2) * NWAVES;
        LAS float* vt = (LAS float*)lds;
        for (int c = tid; c < D; c += NTHREADS) { const float* mb = (const float*)(p.ws + WS_MOD) + bsel * 12288; const float* mc = (const float*)(p.ws + WS_MOD) + 4 * 12288; const float g = p.pre_norm1[c];
            vt[c] = g * (1.f + mb[2048 + c]); vt[2048 + c] = mb[c]; vt[4096 + c] = g * (1.f + mc[2048 + c]); vt[6144 + c] = mc[c]; }
        LDS_WAIT(); __syncthreads();
        for (int r = wsub; r < L; r += nsub) p1_row(p, bsel * L + r, lane, vt, vt + 2048);
        for (int row = M + gw; row < MALL; row += NGW) p1_row(p, row, lane, vt + 4096, vt + 6144);
        __syncthreads();
    }
    SEAM(2);
    if (IN(3)) { LOADP(); TIDS();
        SchedIn S{(const char*)(p.ws + WS_H), (const char*)(p.ws + WS_WIN_T), G, bx}; EpiIn E{p.ws};
        pg8::gemm_phase<EpiIn, SchedIn>(lds, 2048, S, E);
        if (G == 256 && bx >= 76) { const int base = PX_R3 + (bx - 76) * PX_N3; px_convert(p, base + wave, NWAVES, base + PX_N3, (LAS float*)(lds + wave * 16384), lane); __syncthreads(); }
    }
    SEAM(3);
    if (IN(4)) { LOADP(); TIDS();
        SchedQKV S{(const char*)(p.ws + WS_CQKV), (const char*)(p.ws + WS_WQKV_T), G, bx};
        LAS float* rstab = (LAS float*)(lds + TAB_OFF);
        for (int q = tid; q < 2048; q += NTHREADS) { const int i = q >> 8, r = q & 255; Unit u;
            if (S.next(i, u)) { const float* sp = u.pm < 64 ? (const float*)(p.ws + WS_SSQQ) + (size_t)(u.pm * 256 + r) * 8 : (const float*)(p.ws + WS_SSQKV) + (size_t)((u.pm - 64) * 256 + r) * 8;
                const f32x4 s0 = *(const f32x4*)sp, s1 = *(const f32x4*)(sp + 4);
                rstab[q] = rsqrtf((((s0[0] + s0[1]) + (s0[2] + s0[3])) + ((s1[0] + s1[1]) + (s1[2] + s1[3]))) * (1.f / 512.f) + EPS); } }
        LDS_WAIT(); __syncthreads();
        EpiQKV E{p.ws, rstab};
        pg8::gemm_phase<EpiQKV, SchedQKV>(lds, 512, S, E);
        if (G == 256 && bx >= 160) { const int base = PX_R4 + (bx - 160) * PX_N4; px_convert(p, base + wave, NWAVES, base + PX_N4, (LAS float*)(lds + wave * 16384), lane); }
        __syncthreads();
#ifdef SGU_REP
        for (int rep_ = 0; rep_ < SGU_REP; ++rep_)
#endif
        { SguIn nxt; if (vcu < 1024) sgu_fetch(p, vcu >> 3, vcu & 7, tid, nxt);
          for (int u = vcu; u < 1024; u += G) { const SguIn cur = nxt; if (u + G < 1024) sgu_fetch(p, (u + G) >> 3, (u + G) & 7, tid, nxt); sgu_unit(p, u >> 3, u & 7, lds, tid, cur); } }
    }
    SEAM(4);
    if (IN(5)) { TIDS();
        const int grp = vcu % 3;
#ifdef PX_TWICE
#define PX_REP 2
#else
#define PX_REP 1
#endif
#define PX_CONV(g) do { if (grp == (g)) { LOADP(); __syncthreads(); for (int rep_ = 0; rep_ < PX_REP; ++rep_) px_convert(p, (G == 256 ? PX_R5 : 0) + gw, NGW, PX_ITEMS, (LAS float*)(lds + wave * 16384), lane); __syncthreads(); } } while (0)
#define ATT_UNIT(u_) do { const int u = (u_); if (u < 512) { LOADP(); const int bh = u >> 4, qb = u & 15; __syncthreads(); \
            att::attn_unit<0>((const bf16*)(p.ws + WS_Q) + ((size_t)bh * L + qb * 256) * DQK, (const bf16*)(p.ws + WS_K) + (size_t)bh * LK * DQK, (const bf16*)(p.ws + WS_V) + (size_t)bh * LK * VH, \
                           (bf16*)(p.ws + WS_CAT) + ((size_t)(bh >> 3) * L + qb * 256) * D + (bh & 7) * 128, LK, (char*)lds_raw); } } while (0)
        PX_CONV(0); ATT_UNIT(vcu); PX_CONV(1); ATT_UNIT(vcu + G); PX_CONV(2);
        for (int u = vcu + 2 * G; u < 512; u += G) ATT_UNIT(u);
#undef PX_CONV
#undef ATT_UNIT
        __syncthreads();
    }
    SEAM(5);
    if (IN(6)) { LOADP(); TIDS();
        typedef SchedDense<64, 8, 31, 2048> SD; SD S{(const char*)(p.ws + WS_CAT), (const char*)(p.ws + WS_WOUT_T), G, bx}; EpiY E{p.ws};
        pg8::gemm_phase<EpiY, SD>(lds, 2048, S, E);
    }
    SEAM(6);
    if (IN(7)) { LOADP(); TIDS();
        LAS float* wt = (LAS float*)lds;
        for (int c = tid; c < D; c += NTHREADS) { const float* wr = p.w_router + (size_t)c * 16;
#pragma unroll
            for (int q = 0; q < 4; ++q) { const f32x4 w = *(const f32x4*)(wr + q * 4);
#pragma unroll
                for (int t = 0; t < 4; ++t) wt[(q * 4 + t) * 2048 + c] = w[t]; } }
        LDS_WAIT(); __syncthreads();
        const int bsel = vcu & 3, wsub = (vcu >> 2) * NWAVES + wave, nsub = ((G + 3 - bsel) >> 2) * NWAVES;
        LAS float* vt = (LAS float*)(lds + VEC_OFF);
        for (int c = tid; c < D; c += NTHREADS) { const float* mb = (const float*)(p.ws + WS_MOD) + bsel * 12288;
            vt[c] = mb[4096 + c] * p.post_norm1[c]; vt[2048 + c] = p.pre_norm2[c] * (1.f + mb[8192 + c]); vt[4096 + c] = mb[6144 + c]; }
        LDS_WAIT(); __syncthreads();
        { P6In nxt; if (wsub < L) p6_fetch(p, bsel * L + wsub, lane, nxt);
          for (int r = wsub; r < L; r += nsub) { const P6In cur = nxt; if (r + nsub < L) p6_fetch(p, bsel * L + r + nsub, lane, nxt);
              p6_row(p, bsel * L + r, lane, wt, vt, cur, PROBE_FLAGS); } }
        __syncthreads();
    }
    SEAM(7);
    if (IN(8)) { LOADP(); TIDS(); for (int u = bx; u < 64; u += G) topk_unit(p, u >> 2, u & 3, (LAS unsigned*)lds, tid);
        if (G == 256 && bx >= 64) { const int base = PX_R8 + (bx - 64) * PX_N8; px_convert(p, base + wave, NWAVES, base + PX_N8, (LAS float*)(lds + wave * 16384), lane); } }
    SEAM(8);
    if (IN(9)) { LOADP(); TIDS();
        constexpr int KU = FP8_MOE ? 1024 : 2048;
        typedef SchedGather<KU> SG; SG S{(const char*)(p.ws + WS_H2), (const char*)(p.ws + WS_WGU_T), G, bx, (const LAS unsigned*)(lds + TAB_OFF)};
        for (int q = tid; q < 2048; q += NTHREADS) { const int i = q >> 8, r = q & 255; Unit u;
            if (S.next(i, u)) { const int e = u.pm >> 3, m = (u.pm & 7) * 256 + r, b = m >> 9; const int tok = ((const int*)(p.ws + WS_IDX))[(size_t)(e * 4 + b) * CAP + (m & 511)];
                ((LAS unsigned*)(lds + TAB_OFF))[q] = (unsigned)(b * L + tok) * (unsigned)(KU * 2); } }
        LDS_WAIT(); __syncthreads();
        if constexpr (FP8_MOE) { EpiAct8 E{p.ws}; pg8::gemm_phase<EpiAct8, SG, true>(lds, KU, S, E); }
        else { EpiAct E{p.ws}; pg8::gemm_phase<EpiAct, SG, false>(lds, KU, S, E); }
    }
    SEAM(9);
    if (IN(10)) { LOADP(); TIDS();
        constexpr int KU = FP8_MOE ? 1024 : 2048;
        typedef SchedDense<128, 8, 3, KU> SD; SD S{(const char*)(p.ws + WS_ACT), (const char*)(p.ws + WS_WD_T), G, bx};
        if constexpr (FP8_MOE) { EpiYE8 E{p.ws}; pg8::gemm_phase<EpiYE8, SD, true>(lds, KU, S, E); }
        else { EpiYE E{p.ws}; pg8::gemm_phase<EpiYE, SD, false>(lds, KU, S, E); }
    }
    SEAM(10);
    if (IN(11)) { LOADP(); TIDS(); float* dsto = p.out;
        const int bsel = vcu & 3, wsub = (vcu >> 2) * NWAVES + wave, nsub = ((G + 3 - bsel) >> 2) * NWAVES;
        LAS float* vt = (LAS float*)(lds + VEC_OFF);
        for (int c = tid; c < D; c += NTHREADS) vt[c] = ((const float*)(p.ws + WS_MOD))[bsel * 12288 + 10240 + c] * p.post_norm2[c];
        LDS_WAIT(); __syncthreads();
        P11In nxt; if (wsub < L) p11_fetch(p, bsel * L + wsub, lane, nxt);
        for (int r = wsub; r < L; r += nsub) { const P11In cur = nxt; if (r + nsub < L) p11_fetch(p, bsel * L + r + nsub, lane, nxt); p11_row(p, bsel * L + r, lane, dsto, vt, cur, PROBE_FLAGS); } }
#ifdef PROBE_GEMM
    if (IN(13)) { LOADP(); TIDS();
        struct SP : SchedDense<64, 8, 31, 2048> { __device__ __forceinline__ const char* a_base(const Unit& u) const { return (PROBE_GEMM & 2) ? A : A + (size_t)u.pm * (512 * 2048); }
                                                   __device__ __forceinline__ const char* b_base(const Unit& u) const { return (PROBE_GEMM & 1) ? Bt : Bt + (size_t)u.pn * (512 * 2048); } };
        SP S; S.A = (const char*)(p.ws + WS_CAT); S.Bt = (const char*)(p.ws + WS_WOUT_T); S.G = G; S.c = bx; EpiY E{p.ws};
        pg8::gemm_phase<EpiY, SP>(lds, 2048, S, E); }
#endif
#ifdef PROBE_ATTN
    if (IN(12)) { TIDS();
        for (int u = vcu; u < 512; u += G) { LOADP(); const int bh = u >> 4, qb = u & 15; __syncthreads();
            att::attn_unit<PROBE_ATTN>((const bf16*)(p.ws + WS_Q) + ((size_t)bh * L + qb * 256) * DQK, (const bf16*)(p.ws + WS_K) + (size_t)bh * LK * DQK, (const bf16*)(p.ws + WS_V) + (size_t)bh * LK * VH,
                           (bf16*)(p.ws + WS_S) + ((size_t)(bh >> 3) * L + qb * 256) * D + (bh & 7) * 128, LK, (char*)lds_raw); }
        __syncthreads(); }
#endif
#undef IN
#undef SEAM
#undef lo
#undef hi
}

#ifndef PHASE_MODE
#define PHASE_MODE "FFFFFFFFFFFF"
#endif
#ifndef DUP_FLAGS
#define DUP_FLAGS 0
#endif
#ifndef MERGE
#define MERGE 1
#endif
#if !defined(FINAL_BUILD)
template <class P> static void launch_ngemm(const P& f, int Mr, int Nr, int Z, hipStream_t s) { hipLaunchKernelGGL((ngemm<P>), dim3(Nr / 64, Mr / 64, Z), dim3(256), 0, s, f); }
static void naive_phase(int ph, const Ptrs& p, hipStream_t stream) {
    switch (ph) {
    case 0: hipLaunchKernelGGL(n_mod, dim3(48, 5), dim3(256), 0, stream, p); break;
    case 1: break;
    case 2: hipLaunchKernelGGL(n_hrows, dim3(MALL / 4), dim3(256), 0, stream, p); break;
    case 3: launch_ngemm(GIn{p, D}, MALL, 3136, 1, stream);
        hipLaunchKernelGGL(n_ssq, dim3(M / 4), dim3(256), 0, stream, (const bf16*)(p.ws + WS_CQKV), M, 512, (float*)(p.ws + WS_SSQQ), 8);
        hipLaunchKernelGGL(n_ssq, dim3(MALL / 4), dim3(256), 0, stream, (const bf16*)(p.ws + WS_CQKV) + (size_t)M * 512, MALL, 512, (float*)(p.ws + WS_SSQKV), 8); break;
    case 4: launch_ngemm(GQ{p, 512}, M, 1536, 1, stream); launch_ngemm(GKV{p, 512}, MALL, 2048, 1, stream);
        hipLaunchKernelGGL(n_vn, dim3(M * 8 / 4), dim3(256), 0, stream, p); launch_ngemm(GSgu{p, 128}, 128, 128, 1024, stream); break;
    case 5: for (int bh = 0; bh < B * H; ++bh) { launch_ngemm(GScore{p, DQK, bh}, L, LK, 1, stream);
            hipLaunchKernelGGL(n_softmax, dim3(L), dim3(256), 0, stream, (float*)(p.ws + WS_S), LK); launch_ngemm(GPV{p, LK, bh}, L, VH, 1, stream); } break;
    case 6: launch_ngemm(GOut{p, D}, M, D, 1, stream);
        hipLaunchKernelGGL(n_ssq, dim3(M / 4), dim3(256), 0, stream, (const bf16*)(p.ws + WS_Y), M, D, (float*)(p.ws + WS_SSQY), 32); break;
    case 7: hipLaunchKernelGGL(n_rowmid, dim3(M / 4), dim3(256), 0, stream, p); break;
    case 8: hipLaunchKernelGGL(n_topk, dim3(64), dim3(1024), 0, stream, p); break;
    case 9: launch_ngemm(GE1{p, D}, 2048, 4096, 16, stream); break;
    case 10: launch_ngemm(GE2{p, FF}, 2048, 2048, 16, stream); break;
    case 11: hipLaunchKernelGGL(n_rowfinal, dim3(M / 4), dim3(256), 0, stream, p); break;
    }
}
#endif
extern "C" void kernel_launch(void* const* d_in, const int* in_sizes, int n_in, void* d_out, int out_size, void* d_ws, size_t ws_size, hipStream_t stream) {
    static int grid = 0;
    if (grid == 0) {
        if (n_in != 24 || ws_size < WS_END || out_size != M * D) { fprintf(stderr, "kernel_launch: unexpected shapes n_in %d ws %zu out %d\n", n_in, ws_size, out_size); grid = -1; return; }
        int dev = 0, cus = 0, per_cu = 0;
        if (hipGetDevice(&dev) != hipSuccess || hipDeviceGetAttribute(&cus, hipDeviceAttributeMultiprocessorCount, dev) != hipSuccess) { grid = -1; return; }
        if (hipFuncSetAttribute((const void*)fwd, hipFuncAttributeMaxDynamicSharedMemorySize, LDS_BYTES) != hipSuccess) { fprintf(stderr, "kernel_launch: hipFuncSetAttribute failed\n"); grid = -1; return; }
        if (hipOccupancyMaxActiveBlocksPerMultiprocessor(&per_cu, (const void*)fwd, NTHREADS, LDS_BYTES) != hipSuccess || per_cu < 1) fprintf(stderr, "kernel_launch: occupancy query says %d\n", per_cu);
        (void)hipGetLastError();
        grid = cus;
    }
    if (grid < 0) return;
    Ptrs p{};
    const float** f = (const float**)&p;
    for (int i = 0; i < 24; ++i) f[i] = (const float*)d_in[i];
    p.out = (float*)d_out; p.ws = (unsigned char*)d_ws;
    (void)hipMemsetAsync(p.ws + WS_CTL, 0, 1 * MiB, stream);
    const char* mode = PHASE_MODE; int nbar = 0;
    for (int ph = 0; ph < 12;) {
#ifdef DUP_PHASE
        if (ph == 11 && DUP_PHASE == 11) { Args a2{}; a2.p = p; a2.ph_lo = 11; a2.ph_hi = 12; a2.bar_idx = nbar++; a2.pad = 1 | DUP_FLAGS; hipLaunchKernelGGL(fwd, dim3(grid), dim3(NTHREADS), LDS_BYTES, stream, a2); }
#endif
#ifdef PROBE_GEMM
        if (ph == 6) { Args a3{}; a3.p = p; a3.ph_lo = 13; a3.ph_hi = 14; a3.bar_idx = nbar++; hipLaunchKernelGGL(fwd, dim3(grid), dim3(NTHREADS), LDS_BYTES, stream, a3); }
#endif
        if (mode[ph] == 'F') { int e = ph + 1; if (MERGE) while (e < 12 && mode[e] == 'F') ++e;
            Args a{}; a.p = p; a.ph_lo = ph; a.ph_hi = e; a.bar_idx = nbar++; a.pad = 0;
            hipLaunchKernelGGL(fwd, dim3(grid), dim3(NTHREADS), LDS_BYTES, stream, a);
            const hipError_t le = hipPeekAtLastError(); if (le != hipSuccess) fprintf(stderr, "kernel_launch: launch failed: %s\n", hipGetErrorName(le));
#ifdef PROBE_ATTN
            if (ph == 5) { Args a3 = a; a3.ph_lo = 12; a3.ph_hi = 13; a3.bar_idx = nbar++; hipLaunchKernelGGL(fwd, dim3(grid), dim3(NTHREADS), LDS_BYTES, stream, a3); }
#endif
#ifdef DUP_PHASE
            if (ph == DUP_PHASE && ph != 11) { Args a2 = a; a2.bar_idx = nbar++; a2.pad = DUP_FLAGS; hipLaunchKernelGGL(fwd, dim3(grid), dim3(NTHREADS), LDS_BYTES, stream, a2);
                if (ph == 11) hipLaunchKernelGGL(fwd, dim3(grid), dim3(NTHREADS), LDS_BYTES, stream, a2); }
#endif
            ph = e; }
#if !defined(FINAL_BUILD)
        else { naive_phase(ph, p, stream); ++ph; }
#else
        else ++ph;
#endif
    }
}
```

```cpp
#define PHASE_MODE "FFFFFFFFFFFF"
#define MERGE 1
#define FINAL_BUILD 1
#include <hip/hip_runtime.h>
#include <cstdio>
#include <cstdint>

typedef unsigned short bf16;
#ifndef FP8_MOE
#define FP8_MOE 1
#endif
namespace cfg {
constexpr int B = 4, L = 4096, D = 2048, CTX = 256, H = 8, LK = L + CTX;
constexpr int M = B * L;
constexpr int MC = B * CTX;
constexpr int MALL = M + MC;
constexpr int QL = 512, KVL = 512, NOPE = 128, ROPE = 64, VH = 128, DQK = 192;
constexpr int SGW = 1024, INC = 3136, OFF_KPE = 1024, OFF_U = 1088, OFF_V = 2112;
constexpr int NE = 16, CAP = 512, FF = 2048;
constexpr float EPS = 1e-6f;
constexpr float ATT_SCALE = 0.07216878364870322f;
constexpr size_t MiB = 1u << 20;
constexpr size_t WS_CTL = 0;
constexpr size_t WS_MOD = 1 * MiB;
constexpr size_t WS_SSQQ = 2 * MiB;
constexpr size_t WS_SSQKV = 3 * MiB;
constexpr size_t WS_SSQY = 4 * MiB;
constexpr size_t WS_AFF = 6 * MiB;
constexpr size_t WS_INV = 7 * MiB;
constexpr size_t WS_IDX = 8 * MiB;
constexpr size_t WS_WIN_T = 16 * MiB;
constexpr size_t WS_WQKV_T = 30 * MiB;
constexpr size_t WS_WOUT_T = 34 * MiB;
constexpr size_t WS_SGUW = 42 * MiB;
constexpr size_t WS_WGU_T = 64 * MiB;
constexpr size_t WS_WD_T = 320 * MiB;
constexpr size_t WS_H = 448 * MiB;
constexpr size_t WS_CQKV = 516 * MiB;
constexpr size_t WS_U = 549 * MiB;
constexpr size_t WS_VS = 581 * MiB;
constexpr size_t WS_Q = 613 * MiB;
constexpr size_t WS_K = 661 * MiB;
constexpr size_t WS_V = 712 * MiB;
constexpr size_t WS_CAT = 746 * MiB;
constexpr size_t WS_Y = 810 * MiB;
constexpr size_t WS_H2 = WS_CAT;
constexpr size_t WS_ACT = WS_H;
constexpr size_t WS_YE = WS_Q;
constexpr size_t WS_S = 874 * MiB;
constexpr size_t WS_VN = 942 * MiB;
constexpr size_t WS_ROPE = 9 * MiB;
constexpr size_t WS_PART = WS_S;
constexpr size_t WS_XN = WS_S;
constexpr size_t WS_END = 974 * MiB;
}
using namespace cfg;

__device__ __forceinline__ float bf2f(bf16 v) { return __uint_as_float(((unsigned)v) << 16); }
__device__ __forceinline__ bf16 f2bf(float f) { unsigned u = __float_as_uint(f); return (bf16)((u + 0x7fffu + ((u >> 16) & 1u)) >> 16); }
__device__ __forceinline__ float silu_f(float x) { return x / (1.f + __expf(-x)); }
__device__ __forceinline__ float gelu_tanh(float x) { const float z = 0.7978845608028654f * (x + 0.044715f * x * x * x); return 0.5f * x * (1.f + tanhf(z)); }
__device__ __forceinline__ float wave_sum(float v) {
#pragma unroll
    for (int o = 1; o < 64; o <<= 1) v += __shfl_xor(v, o);
    return v;
}
__device__ __forceinline__ float rope_inv(int ii) { return __expf(-(float)ii * (9.210340371976184f / 16.f)); }

struct Ptrs {
    const float *x, *c, *ctx, *c_ctx, *w_ada, *b_ada, *pre_norm1, *w_in, *q_norm_w, *w_uq, *kv_norm_w, *w_ukv, *sgu_norm_w, *sgu_w, *sgu_b, *w_out,
        *post_norm1, *pre_norm2, *w_router, *b_router, *w_e_gate, *w_e_up, *w_e_down, *post_norm2;
    float* out; unsigned char* ws;
};

#if !defined(FINAL_BUILD)
__global__ void n_mod(Ptrs p) {
    const int j = blockIdx.x * 256 + threadIdx.x, r = blockIdx.y;
    const float* cv = r < 4 ? p.c + r * D : p.c_ctx;
    float s = 0.f;
    for (int k = 0; k < D; ++k) s += silu_f(cv[k]) * p.w_ada[(size_t)k * 12288 + j];
    ((float*)(p.ws + WS_MOD))[r * 12288 + j] = s + p.b_ada[j];
}
__global__ __launch_bounds__(256) void n_hrows(Ptrs p) {
    const int row = blockIdx.x * 4 + (threadIdx.x >> 6), lane = threadIdx.x & 63;
    if (row >= MALL) return;
    const float* src = row < M ? p.x + (size_t)row * D : p.ctx + (size_t)(row - M) * D;
    const int mr = row < M ? row >> 12 : 4;
    const float* mod = (const float*)(p.ws + WS_MOD) + mr * 12288;
    float v[32]; float s = 0.f;
    for (int j = 0; j < 32; ++j) { v[j] = src[j * 64 + lane]; s += v[j] * v[j]; }
    const float rs = rsqrtf(wave_sum(s) * (1.f / D) + EPS);
    bf16* o = (bf16*)(p.ws + WS_H) + (size_t)row * D;
    for (int j = 0; j < 32; ++j) { const int c = j * 64 + lane; o[c] = f2bf(v[j] * rs * p.pre_norm1[c] * (1.f + mod[2048 + c]) + mod[c]); }
}
template <class P> __global__ __launch_bounds__(256) void ngemm(P p) {
    __shared__ float As[16][65], Bs[16][65];
    const int tx = threadIdx.x & 15, ty = threadIdx.x >> 4, z = blockIdx.z;
    const int m0 = blockIdx.y * 64, n0 = blockIdx.x * 64;
    float acc[4][4] = {};
    for (int k0 = 0; k0 < p.K; k0 += 16) {
        for (int j = 0; j < 4; ++j) { const int idx = threadIdx.x + 256 * j; const int kk = idx & 15, mm = idx >> 4; As[kk][mm] = p.a(z, m0 + mm, k0 + kk); }
        for (int j = 0; j < 4; ++j) { const int idx = threadIdx.x + 256 * j; const int nn = idx & 63, kk = idx >> 6; Bs[kk][nn] = p.b(z, k0 + kk, n0 + nn); }
        __syncthreads();
#pragma unroll
        for (int kk = 0; kk < 16; ++kk) {
            float a[4], b[4];
#pragma unroll
            for (int i = 0; i < 4; ++i) { a[i] = As[kk][ty * 4 + i]; b[i] = Bs[kk][tx * 4 + i]; }
#pragma unroll
            for (int i = 0; i < 4; ++i)
#pragma unroll
                for (int j = 0; j < 4; ++j) acc[i][j] += a[i] * b[j];
        }
        __syncthreads();
    }
    for (int i = 0; i < 4; ++i) p.epi(z, m0 + ty * 4 + i, n0 + tx * 4, acc[i]);
}
__device__ __forceinline__ void rope_pair(float& x1, float& x2, int i, int pos) {
    const int ii = i & 15; const float ax = (float)((i >> 4) ? (pos & 63) : (pos >> 6));
    float s, c; sincosf(ax * rope_inv(ii), &s, &c);
    const float r1 = x1 * c - x2 * s, r2 = x2 * c + x1 * s; x1 = r1; x2 = r2;
}
struct GIn {
    Ptrs p; int K;
    __device__ float a(int, int m, int k) const { return bf2f(((const bf16*)(p.ws + WS_H))[(size_t)m * D + k]); }
    __device__ float b(int, int k, int n) const {
        int o; if (n < 1024) o = n; else if (n < 3072) o = n + 64; else { const int j = n - 3072, i = j >> 1, s = j & 1; o = OFF_KPE + (i >> 4) * 32 + s * 16 + (i & 15); }
        return p.w_in[(size_t)k * INC + o];
    }
    __device__ void epi(int, int m, int n0, const float* v) const {
        bf16* CQ = (bf16*)(p.ws + WS_CQKV); bf16* CKV = CQ + (size_t)M * 512;
        if (n0 < 512) { if (m < M) for (int j = 0; j < 4; ++j) CQ[(size_t)m * 512 + n0 + j] = f2bf(v[j]); }
        else if (n0 < 1024) { for (int j = 0; j < 4; ++j) CKV[(size_t)m * 512 + n0 - 512 + j] = f2bf(v[j]); }
        else if (n0 < 2048) { if (m < M) for (int j = 0; j < 4; ++j) ((bf16*)(p.ws + WS_U))[(size_t)m * 1024 + n0 - 1024 + j] = f2bf(gelu_tanh(v[j])); }
        else if (n0 < 3072) { if (m < M) for (int j = 0; j < 4; ++j) ((bf16*)(p.ws + WS_VS))[(size_t)m * 1024 + n0 - 2048 + j] = f2bf(gelu_tanh(v[j])); }
        else {
            const int jj = n0 - 3072; bf16* Kb = (bf16*)(p.ws + WS_K);
            for (int q = 0; q < 2; ++q) {
                const int i = (jj >> 1) + q; float x1 = v[2 * q], x2 = v[2 * q + 1]; int b, kpos;
                if (m < M) { b = m >> 12; kpos = m & 4095; rope_pair(x1, x2, i, kpos); } else { b = (m - M) >> 8; kpos = L + ((m - M) & 255); }
                for (int hh = 0; hh < H; ++hh) { bf16* d = Kb + ((size_t)(b * H + hh) * LK + kpos) * DQK + 128 + 2 * i; d[0] = f2bf(x1); d[1] = f2bf(x2); }
            }
        }
    }
};
__global__ void n_ssq(const bf16* T, int rows, int cols, float* out, int nslots) {
    const int row = blockIdx.x * 4 + (threadIdx.x >> 6), lane = threadIdx.x & 63;
    if (row >= rows) return;
    float s = 0.f; for (int c = lane; c < cols; c += 64) { const float v = bf2f(T[(size_t)row * cols + c]); s += v * v; }
    s = wave_sum(s);
    if (lane < nslots) out[(size_t)row * nslots + lane] = lane == 0 ? s : 0.f;
}
__device__ __forceinline__ float sum_slots(const float* s, int n) { float t = 0.f; for (int i = 0; i < n; ++i) t += s[i]; return t; }
struct GQ {
    Ptrs p; int K;
    __device__ float a(int, int m, int k) const { return bf2f(((const bf16*)(p.ws + WS_CQKV))[(size_t)m * 512 + k]); }
    __device__ float b(int, int k, int n) const {
        int o; if (n < 1024) o = (n >> 7) * DQK + (n & 127); else { const int jj = n - 1024, hd = jj >> 6, j6 = jj & 63, i = j6 >> 1, s = j6 & 1; o = hd * DQK + 128 + (i >> 4) * 32 + s * 16 + (i & 15); }
        return p.w_uq[(size_t)k * 1536 + o] * p.q_norm_w[k];
    }
    __device__ void epi(int, int m, int n0, const float* v) const {
        const float rs = rsqrtf(sum_slots((const float*)(p.ws + WS_SSQQ) + (size_t)m * 8, 8) * (1.f / 512.f) + EPS);
        const int b = m >> 12, t = m & 4095; bf16* Qb = (bf16*)(p.ws + WS_Q);
        if (n0 < 1024) { const int hd = n0 >> 7, d = n0 & 127; for (int j = 0; j < 4; ++j) Qb[((size_t)(b * H + hd) * L + t) * DQK + d + j] = f2bf(v[j] * rs); }
        else { const int jj = n0 - 1024, hd = jj >> 6, j6 = jj & 63;
            for (int q = 0; q < 2; ++q) { const int i = (j6 >> 1) + q; float x1 = v[2 * q] * rs, x2 = v[2 * q + 1] * rs; rope_pair(x1, x2, i, t);
                bf16* d = Qb + ((size_t)(b * H + hd) * L + t) * DQK + 128 + 2 * i; d[0] = f2bf(x1); d[1] = f2bf(x2); } }
    }
};
struct GKV {
    Ptrs p; int K;
    __device__ float a(int, int m, int k) const { return bf2f(((const bf16*)(p.ws + WS_CQKV))[(size_t)(M + m) * 512 + k]); }
    __device__ float b(int, int k, int n) const { return p.w_ukv[(size_t)k * 2048 + n] * p.kv_norm_w[k]; }
    __device__ void epi(int, int m, int n0, const float* v) const {
        const float rs = rsqrtf(sum_slots((const float*)(p.ws + WS_SSQKV) + (size_t)m * 8, 8) * (1.f / 512.f) + EPS);
        int b, kpos; if (m < M) { b = m >> 12; kpos = m & 4095; } else { b = (m - M) >> 8; kpos = L + ((m - M) & 255); }
        const int hd = n0 >> 8, c = n0 & 255;
        if (c < 128) { bf16* d = (bf16*)(p.ws + WS_K) + ((size_t)(b * H + hd) * LK + kpos) * DQK + c; for (int j = 0; j < 4; ++j) d[j] = f2bf(v[j] * rs); }
        else { bf16* d = (bf16*)(p.ws + WS_V) + ((size_t)(b * H + hd) * LK + kpos) * VH + c - 128; for (int j = 0; j < 4; ++j) d[j] = f2bf(v[j] * rs); }
    }
};
__global__ void n_vn(Ptrs p) {
    const int w = blockIdx.x * 4 + (threadIdx.x >> 6), lane = threadIdx.x & 63;
    const int tok = w >> 3, g = w & 7;
    const bf16* s = (const bf16*)(p.ws + WS_VS) + (size_t)tok * 1024 + g * 128;
    const float a = bf2f(s[lane]), b = bf2f(s[lane + 64]);
    const float mu = wave_sum(a + b) * (1.f / 128.f);
    const float da = a - mu, db = b - mu;
    const float rs = rsqrtf(wave_sum(da * da + db * db) * (1.f / 128.f) + EPS);
    bf16* o = (bf16*)(p.ws + WS_VN) + (size_t)tok * 1024 + g * 128;
    o[lane] = f2bf(da * rs * p.sgu_norm_w[g * 128 + lane]); o[lane + 64] = f2bf(db * rs * p.sgu_norm_w[g * 128 + lane + 64]);
}
struct GSgu {
    Ptrs p; int K;
    __device__ float a(int z, int m, int k) const { return p.sgu_w[((size_t)(z & 7) * 128 + m) * 128 + k]; }
    __device__ float b(int z, int k, int n) const { return bf2f(((const bf16*)(p.ws + WS_VN))[(size_t)((z >> 3) * 128 + k) * 1024 + (z & 7) * 128 + n]); }
    __device__ void epi(int z, int m, int n0, const float* v) const {
        const int g = z & 7; const size_t row = (size_t)(z >> 3) * 128 + m; const float bias = p.sgu_b[g * 128 + m];
        for (int j = 0; j < 4; ++j) { const float u = bf2f(((const bf16*)(p.ws + WS_U))[row * 1024 + g * 128 + n0 + j]);
            ((bf16*)(p.ws + WS_CAT))[row * D + 1024 + g * 128 + n0 + j] = f2bf(u * (v[j] + bias)); }
    }
};
struct GScore {
    Ptrs p; int K; int bh;
    __device__ float a(int, int m, int k) const { return bf2f(((const bf16*)(p.ws + WS_Q))[((size_t)bh * L + m) * DQK + k]); }
    __device__ float b(int, int k, int n) const { return bf2f(((const bf16*)(p.ws + WS_K))[((size_t)bh * LK + n) * DQK + k]); }
    __device__ void epi(int, int m, int n0, const float* v) const { float* S = (float*)(p.ws + WS_S) + (size_t)m * LK + n0; for (int j = 0; j < 4; ++j) S[j] = v[j] * ATT_SCALE; }
};
__global__ void n_softmax(float* S, int cols) {
    float* r = S + (size_t)blockIdx.x * cols; __shared__ float red[4];
    float mx = -1e30f; for (int c = threadIdx.x; c < cols; c += 256) mx = fmaxf(mx, r[c]);
    for (int o = 1; o < 64; o <<= 1) mx = fmaxf(mx, __shfl_xor(mx, o));
    if ((threadIdx.x & 63) == 0) red[threadIdx.x >> 6] = mx; __syncthreads();
    mx = fmaxf(fmaxf(red[0], red[1]), fmaxf(red[2], red[3])); __syncthreads();
    float s = 0.f; for (int c = threadIdx.x; c < cols; c += 256) { const float e = __expf(r[c] - mx); r[c] = e; s += e; }
    s = wave_sum(s); if ((threadIdx.x & 63) == 0) red[threadIdx.x >> 6] = s; __syncthreads();
    s = (red[0] + red[1]) + (red[2] + red[3]); const float inv = 1.f / s;
    for (int c = threadIdx.x; c < cols; c += 256) r[c] *= inv;
}
struct GPV {
    Ptrs p; int K; int bh;
    __device__ float a(int, int m, int k) const { return ((const float*)(p.ws + WS_S))[(size_t)m * LK + k]; }
    __device__ float b(int, int k, int n) const { return bf2f(((const bf16*)(p.ws + WS_V))[((size_t)bh * LK + k) * VH + n]); }
    __device__ void epi(int, int m, int n0, const float* v) const { bf16* d = (bf16*)(p.ws + WS_CAT) + ((size_t)(bh >> 3) * L + m) * D + (bh & 7) * 128 + n0; for (int j = 0; j < 4; ++j) d[j] = f2bf(v[j]); }
};
struct GOut {
    Ptrs p; int K;
    __device__ float a(int, int m, int k) const { return bf2f(((const bf16*)(p.ws + WS_CAT))[(size_t)m * D + k]); }
    __device__ float b(int, int k, int n) const { return p.w_out[(size_t)k * D + n]; }
    __device__ void epi(int, int m, int n0, const float* v) const { bf16* d = (bf16*)(p.ws + WS_Y) + (size_t)m * D + n0; for (int j = 0; j < 4; ++j) d[j] = f2bf(v[j]); }
};
__device__ __forceinline__ void row_pass_mid(const Ptrs& p, int row, int lane) {
    const int b = row >> 12; const float* mod = (const float*)(p.ws + WS_MOD) + b * 12288;
    const float ssq = wave_sum(lane < 32 ? ((const float*)(p.ws + WS_SSQY))[(size_t)row * 32 + lane] : 0.f);
    const float rsy = rsqrtf(ssq * (1.f / D) + EPS);
    const bf16* y = (const bf16*)(p.ws + WS_Y) + (size_t)row * D; const float* xr = p.x + (size_t)row * D; float* o = p.out + (size_t)row * D;
    float v[32]; float s = 0.f;
    for (int j = 0; j < 32; ++j) { const int c = j * 64 + lane; v[j] = xr[c] + mod[4096 + c] * (bf2f(y[c]) * rsy * p.post_norm1[c]); o[c] = v[j]; s += v[j] * v[j]; }
    const float rs = rsqrtf(wave_sum(s) * (1.f / D) + EPS);
    bf16* h2 = (bf16*)(p.ws + WS_H2) + (size_t)row * D; float lg[16];
    for (int e = 0; e < 16; ++e) lg[e] = 0.f;
    for (int j = 0; j < 32; ++j) { const int c = j * 64 + lane; const float h = v[j] * rs * p.pre_norm2[c] * (1.f + mod[8192 + c]) + mod[6144 + c]; h2[c] = f2bf(h);
        const float* wr = p.w_router + (size_t)c * 16; for (int e = 0; e < 16; ++e) lg[e] += h * wr[e]; }
    float mx = -1e30f;
    for (int e = 0; e < 16; ++e) { lg[e] = wave_sum(lg[e]) + p.b_router[e]; mx = fmaxf(mx, lg[e]); }
    float se = 0.f; for (int e = 0; e < 16; ++e) { lg[e] = __expf(lg[e] - mx); se += lg[e]; }
    const float inv = 1.f / se;
    if (lane < 16) { float val = 0.f; for (int e = 0; e < 16; ++e) val = (lane == e) ? lg[e] * inv : val; ((float*)(p.ws + WS_AFF))[(size_t)row * 16 + lane] = val; }
}
__global__ __launch_bounds__(256) void n_rowmid(Ptrs p) { const int row = blockIdx.x * 4 + (threadIdx.x >> 6); row_pass_mid(p, row, threadIdx.x & 63); }
__global__ void n_topk(Ptrs p) {
    __shared__ float vals[L];
    const int e = blockIdx.x >> 2, b = blockIdx.x & 3;
    const float* aff = (const float*)(p.ws + WS_AFF) + (size_t)b * L * 16 + e;
    for (int t = threadIdx.x; t < L; t += blockDim.x) vals[t] = aff[(size_t)t * 16];
    __syncthreads();
    for (int t = threadIdx.x; t < L; t += blockDim.x) {
        const float v = vals[t]; int rank = 0;
        for (int u = 0; u < L; ++u) { const float w = vals[u]; rank += (w > v || (w == v && u < t)) ? 1 : 0; }
        ((int*)(p.ws + WS_INV))[(size_t)(b * L + t) * 16 + e] = rank < CAP ? rank : -1;
        if (rank < CAP) ((int*)(p.ws + WS_IDX))[(size_t)(e * 4 + b) * CAP + rank] = t;
    }
}
struct GE1 {
    Ptrs p; int K;
    __device__ float a(int z, int m, int k) const { const int b = m >> 9; const int tok = ((const int*)(p.ws + WS_IDX))[(size_t)(z * 4 + b) * CAP + (m & 511)];
        return bf2f(((const bf16*)(p.ws + WS_H2))[((size_t)b * L + tok) * D + k]); }
    __device__ float b(int z, int k, int n) const { const float* w = (n & 1) ? p.w_e_up : p.w_e_gate; return w[((size_t)z * D + k) * FF + (n >> 1)]; }
    __device__ void epi(int z, int m, int n0, const float* v) const { bf16* d = (bf16*)(p.ws + WS_ACT) + ((size_t)z * 2048 + m) * FF + (n0 >> 1);
        d[0] = f2bf(silu_f(v[0]) * v[1]); d[1] = f2bf(silu_f(v[2]) * v[3]); }
};
struct GE2 {
    Ptrs p; int K;
    __device__ float a(int z, int m, int k) const { return bf2f(((const bf16*)(p.ws + WS_ACT))[((size_t)z * 2048 + m) * FF + k]); }
    __device__ float b(int z, int k, int n) const { return p.w_e_down[((size_t)z * FF + k) * D + n]; }
    __device__ void epi(int z, int m, int n0, const float* v) const { bf16* d = (bf16*)(p.ws + WS_YE) + ((size_t)z * 2048 + m) * D + n0; for (int j = 0; j < 4; ++j) d[j] = f2bf(v[j]); }
};
__device__ __forceinline__ void row_pass_final(const Ptrs& p, int row, int lane) {
    const int b = row >> 12; const float* mod = (const float*)(p.ws + WS_MOD) + b * 12288;
    const int* inv = (const int*)(p.ws + WS_INV) + (size_t)row * 16; const float* aff = (const float*)(p.ws + WS_AFF) + (size_t)row * 16;
    float v[32]; for (int j = 0; j < 32; ++j) v[j] = 0.f;
    for (int e = 0; e < 16; ++e) { const int sl = inv[e]; if (sl >= 0) { const float g = aff[e]; const bf16* ye = (const bf16*)(p.ws + WS_YE) + ((size_t)(e * 4 + b) * CAP + sl) * D;
            for (int j = 0; j < 32; ++j) v[j] += g * bf2f(ye[j * 64 + lane]); } }
    float s = 0.f; for (int j = 0; j < 32; ++j) s += v[j] * v[j];
    const float rs = rsqrtf(wave_sum(s) * (1.f / D) + EPS);
    float* o = p.out + (size_t)row * D;
    for (int j = 0; j < 32; ++j) { const int c = j * 64 + lane; o[c] = o[c] + mod[10240 + c] * (v[j] * rs * p.post_norm2[c]); }
}
__global__ __launch_bounds__(256) void n_rowfinal(Ptrs p) { const int row = blockIdx.x * 4 + (threadIdx.x >> 6); row_pass_final(p, row, threadIdx.x & 63); }

#endif

namespace pg8 {
#define PG8_LAS __attribute__((address_space(3)))
typedef short bf16x8 __attribute__((ext_vector_type(8)));
typedef float f32x4 __attribute__((ext_vector_type(4)));
typedef float f32x2 __attribute__((ext_vector_type(2)));
typedef unsigned u32x4 __attribute__((ext_vector_type(4)));
constexpr int BM = 256, BK = 64, HALF = 128, HTB = HALF * BK * 2, STAGE_BYTES = 8 * HTB, NXCD = 8, WGM = 8;

__host__ __device__ __forceinline__ int lds_byte(int r, int c) { const int st = (r >> 4) * 2 + (c >> 5), rr = r & 15, cc = c & 31, ob = rr * 64 + cc * 2; return st * 1024 + (ob ^ (((ob >> 9) & 1) << 5)); }
__host__ __device__ __forceinline__ void stage_rc(int b, int& R, int& C) { const int st = b / 1024, sb = b % 1024, swz = sb ^ (((sb >> 9) & 1) << 5); R = (st >> 1) * 16 + swz / 64; C = (st & 1) * 32 + (swz % 64) / 2; }
__host__ __device__ __forceinline__ int perm32(int rho) { const int n = rho >> 4, i = rho & 15; return 8 * (i >> 2) + 4 * n + (i & 3); }

struct Unit { int pm, pn, ui; };
__device__ __forceinline__ void rect_unit(int L, int nM, int nN, Unit& u) {
    const int nwg = nM * nN; int wgid = L;
    { const int q = nwg / NXCD, r = nwg % NXCD, xcd = wgid % NXCD, off = wgid / NXCD; wgid = (xcd < r ? xcd * (q + 1) : r * (q + 1) + (xcd - r) * q) + off; }
    const int nig = WGM * nN, gid = wgid / nig, fm = gid * WGM, gsz = (nM - fm) < WGM ? (nM - fm) : WGM;
    u.pm = fm + ((wgid % nig) % gsz); u.pn = (wgid % nig) / gsz;
}
__device__ __forceinline__ void dense_voff(int K, int tid, unsigned (&v)[2][2]) {
#pragma unroll
    for (int i = 0; i < 2; ++i) { int R, C; stage_rc(tid * 16 + i * 8192, R, C); v[0][i] = (unsigned)(R * K + C) * 2u; v[1][i] = (unsigned)((R + HALF) * K + C) * 2u; }
}

__device__ __forceinline__ unsigned cvt_pk_bf16(float lo, float hi) { unsigned r; asm volatile("v_cvt_pk_bf16_f32 %0, %1, %2" : "=v"(r) : "v"(lo), "v"(hi)); return r; }
__device__ __forceinline__ u32x4 pack8(const f32x4& a, const f32x4& b) { u32x4 w; w.x = cvt_pk_bf16(a[0], a[1]); w.y = cvt_pk_bf16(a[2], a[3]); w.z = cvt_pk_bf16(b[0], b[1]); w.w = cvt_pk_bf16(b[2], b[3]); return w; }

typedef int i32x4 __attribute__((ext_vector_type(4)));
typedef int i32x8 __attribute__((ext_vector_type(8)));
template <class Epi, class Sched, bool FP8 = false>
__device__ __forceinline__ void gemm_phase(PG8_LAS unsigned char* lds, const int K, const Sched& S, const Epi& E) {
    const int tid = threadIdx.x, wid = __builtin_amdgcn_readfirstlane(tid >> 6), lane = tid & 63, wr = wid >> 2, wc = wid & 3, fr = lane & 15, fq = lane >> 4;
    const int nt = K / BK;
    unsigned voffB[2];
#pragma unroll
    for (int i = 0; i < 2; ++i) { int R, C; stage_rc(tid * 16 + i * 8192, R, C); const int Rb = Epi::PERM ? ((R & ~31) + perm32(R & 31)) : R; voffB[i] = (unsigned)(Rb * K + C) * 2u; }
    const size_t kstep = (size_t)(BK * 2);
    const size_t hstep = (size_t)HALF * K * 2;
    const unsigned ldsw = (unsigned)wid * 1024u;
    const int aoff = lds_byte(wr * 64 + fr, fq * 8), boff = lds_byte(wc * 32 + fr, fq * 8);
#define PG8_SA(b, h) (((b) * 2 + (h)) * HTB)
#define PG8_SB(b, h) ((4 + (b) * 2 + (h)) * HTB)
#define PG8_STAGE(bufoff, gbase, voff) do { _Pragma("unroll") for (int _i = 0; _i < 2; ++_i) \
        __builtin_amdgcn_global_load_lds((const unsigned*)((const char*)(gbase) + (voff)[_i]), (PG8_LAS unsigned*)(lds + (bufoff) + ldsw + _i * 8192), 16, 0, 0); } while (0)
#define PG8_LDA(dst, b, h) do { _Pragma("unroll") for (int m = 0; m < 4; ++m) _Pragma("unroll") for (int k = 0; k < 2; ++k) dst[m][k] = *(const PG8_LAS bf16x8*)(lds + PG8_SA(b, h) + aoff + m * 2048 + k * 1024); } while (0)
#define PG8_LDB(dst, b, h) do { _Pragma("unroll") for (int n = 0; n < 2; ++n) _Pragma("unroll") for (int k = 0; k < 2; ++k) dst[n][k] = *(const PG8_LAS bf16x8*)(lds + PG8_SB(b, h) + boff + n * 2048 + k * 1024); } while (0)
#define PG8_MMA(ai, bj, At, Bt) do { __builtin_amdgcn_s_setprio(1); _Pragma("unroll") for (int m = 0; m < 4; ++m) _Pragma("unroll") for (int n = 0; n < 2; ++n) { \
        if constexpr (FP8) { const i32x8 fb = __builtin_shufflevector((i32x4)Bt[n][0], (i32x4)Bt[n][1], 0, 1, 2, 3, 4, 5, 6, 7), fa = __builtin_shufflevector((i32x4)At[m][0], (i32x4)At[m][1], 0, 1, 2, 3, 4, 5, 6, 7); \
            acc[ai][bj][m][n] = __builtin_amdgcn_mfma_scale_f32_16x16x128_f8f6f4(fb, fa, acc[ai][bj][m][n], 0, 0, 0, 0x7f7f7f7f, 0, 0x7f7f7f7f); } \
        else { _Pragma("unroll") for (int k = 0; k < 2; ++k) acc[ai][bj][m][n] = __builtin_amdgcn_mfma_f32_16x16x32_bf16(Bt[n][k], At[m][k], acc[ai][bj][m][n], 0, 0, 0); } } \
        __builtin_amdgcn_s_setprio(0); } while (0)
#define PG8_WAIT_V(n) asm volatile("s_waitcnt vmcnt(" #n ")" ::: "memory")
#define PG8_WAIT_L(n) asm volatile("s_waitcnt lgkmcnt(" #n ")" ::: "memory")
#define PG8_BAR __builtin_amdgcn_s_barrier()
#define PG8_SCHED __builtin_amdgcn_sched_barrier(0)
    Unit cur, nxt; int ui = 0;
    if (!S.next(0, cur)) return;
    f32x4 acc[2][2][4][2];
#pragma unroll
    for (int a = 0; a < 2; ++a)
#pragma unroll
        for (int b = 0; b < 2; ++b)
#pragma unroll
            for (int m = 0; m < 4; ++m)
#pragma unroll
                for (int n = 0; n < 2; ++n) acc[a][b][m][n] = (f32x4){0.f, 0.f, 0.f, 0.f};
    bf16x8 At[4][2], B0[2][2], B1[2][2];
    unsigned vA[2][2], vN[2][2];
    S.a_voff(0, cur, tid, vA);
    const char* cA = S.a_base(cur); const char* cB = S.b_base(cur);
    PG8_STAGE(PG8_SB(0, 0), cB, voffB); PG8_STAGE(PG8_SB(0, 1), cB + hstep, voffB); PG8_STAGE(PG8_SA(0, 0), cA, vA[0]); PG8_STAGE(PG8_SA(0, 1), cA, vA[1]);
    if (wr == 1) PG8_BAR;
    PG8_WAIT_V(2); PG8_BAR;
    PG8_STAGE(PG8_SB(1, 0), cB + kstep, voffB); PG8_STAGE(PG8_SA(1, 0), cA + kstep, vA[0]); PG8_STAGE(PG8_SB(1, 1), cB + hstep + kstep, voffB);
    PG8_WAIT_V(6); PG8_BAR;
    for (;;) {
        const bool has_next = S.next(ui + 1, nxt);
        if (has_next) S.a_voff(ui + 1, nxt, tid, vN);
        const char* nA = has_next ? S.a_base(nxt) : cA; const char* nB = has_next ? S.b_base(nxt) : cB;
        for (int t = 0; t < nt; t += 2) {
            const bool last = (t == nt - 2);
            const char* a1 = cA + (size_t)(t + 1) * kstep;
            const char* a2 = last ? nA : cA + (size_t)(t + 2) * kstep; const char* b2 = last ? nB : cB + (size_t)(t + 2) * kstep;
            const char* a3 = a2 + kstep; const char* b3 = b2 + kstep;
            PG8_LDB(B0, 0, 0); PG8_LDB(B1, 0, 1); PG8_SCHED; PG8_LDA(At, 0, 0); PG8_STAGE(PG8_SA(1, 1), a1, vA[1]);
            if (last && has_next) {
#pragma unroll
                for (int h = 0; h < 2; ++h)
#pragma unroll
                    for (int i = 0; i < 2; ++i) vA[h][i] = vN[h][i];
            }
            PG8_WAIT_V(8); PG8_WAIT_L(0); PG8_BAR; PG8_MMA(0, 0, At, B0); PG8_MMA(0, 1, At, B1); PG8_BAR; PG8_SCHED;
            PG8_LDA(At, 0, 1); PG8_STAGE(PG8_SB(0, 0), b2, voffB); PG8_STAGE(PG8_SB(0, 1), b2 + hstep, voffB); PG8_STAGE(PG8_SA(0, 0), a2, vA[0]);
            PG8_WAIT_V(8); PG8_WAIT_L(0); PG8_BAR; PG8_MMA(1, 0, At, B0); PG8_MMA(1, 1, At, B1); PG8_BAR; PG8_SCHED;
            PG8_LDB(B0, 1, 0); PG8_LDB(B1, 1, 1); PG8_SCHED; PG8_LDA(At, 1, 0); PG8_STAGE(PG8_SA(0, 1), a2, vA[1]);
            PG8_WAIT_V(8); PG8_WAIT_L(0); PG8_BAR; PG8_MMA(0, 0, At, B0); PG8_MMA(0, 1, At, B1); PG8_BAR; PG8_SCHED;
            PG8_LDA(At, 1, 1); PG8_STAGE(PG8_SB(1, 0), b3, voffB); PG8_STAGE(PG8_SB(1, 1), b3 + hstep, voffB); PG8_STAGE(PG8_SA(1, 0), a3, vA[0]);
            PG8_WAIT_V(8); PG8_WAIT_L(0); PG8_BAR; PG8_MMA(1, 0, At, B0); PG8_MMA(1, 1, At, B1); PG8_BAR; PG8_SCHED;
        }
        if (wr == 0) PG8_BAR;
        E(acc, cur, wr, wc, fr, fq);
        if (!has_next) break;
#pragma unroll
        for (int a = 0; a < 2; ++a)
#pragma unroll
            for (int b = 0; b < 2; ++b)
#pragma unroll
                for (int m = 0; m < 4; ++m)
#pragma unroll
                    for (int n = 0; n < 2; ++n) acc[a][b][m][n] = (f32x4){0.f, 0.f, 0.f, 0.f};
        cur = nxt; cA = nA; cB = nB; ++ui;
        if (wr == 1) PG8_BAR;
    }
    PG8_WAIT_V(0);
    PG8_BAR;
#undef PG8_SA
#undef PG8_SB
#undef PG8_STAGE
#undef PG8_LDA
#undef PG8_LDB
#undef PG8_MMA
#undef PG8_WAIT_V
#undef PG8_WAIT_L
#undef PG8_BAR
#undef PG8_SCHED
}
}

#define LAS __attribute__((address_space(3)))
typedef pg8::f32x4 f32x4; typedef pg8::u32x4 u32x4; typedef pg8::Unit Unit;
constexpr size_t TSTEP2K = (size_t)256 * 2048 * 2, TSTEP512 = (size_t)256 * 512 * 2;

struct SchedIn {
    static constexpr bool GATHER = false; const char *A, *Bt; int G, c;
    __device__ __forceinline__ bool next(int i, Unit& u) const { const int Lx = i * G + c; if (Lx >= 844) return false;
        if (Lx < 832) pg8::rect_unit(Lx, 64, 13, u); else { const int r = Lx - 832; u.pm = 64 + (r & 3); const int q = r >> 2; u.pn = q == 2 ? 12 : 2 + q; } return true; }
    __device__ __forceinline__ const char* a_base(const Unit& u) const { return A + (size_t)u.pm * TSTEP2K; }
    __device__ __forceinline__ const char* b_base(const Unit& u) const { return Bt + (size_t)u.pn * TSTEP2K; }
    __device__ __forceinline__ void a_voff(int, const Unit&, int tid, unsigned (&v)[2][2]) const { pg8::dense_voff(2048, tid, v); }
};
struct SchedQKV {
    static constexpr bool GATHER = false; const char *A, *Bt; int G, c;
    __device__ __forceinline__ bool next(int i, Unit& u) const { const int Lx = i * G + c; if (Lx >= 928) return false;
        if (Lx < 384) pg8::rect_unit(Lx, 64, 6, u); else { pg8::rect_unit(Lx - 384, 68, 8, u); u.pm += 64; u.pn += 6; } u.ui = i; return true; }
    __device__ __forceinline__ const char* a_base(const Unit& u) const { return A + (size_t)u.pm * TSTEP512; }
    __device__ __forceinline__ const char* b_base(const Unit& u) const { return Bt + (size_t)u.pn * TSTEP512; }
    __device__ __forceinline__ void a_voff(int, const Unit&, int tid, unsigned (&v)[2][2]) const { pg8::dense_voff(512, tid, v); }
};
template <int nM, int nN, int BSHIFT, int KU> struct SchedDense {
    static constexpr bool GATHER = false; const char *A, *Bt; int G, c;
    __device__ __forceinline__ bool next(int i, Unit& u) const { const int Lx = i * G + c; if (Lx >= nM * nN) return false; pg8::rect_unit(Lx, nM, nN, u); return true; }
    __device__ __forceinline__ const char* a_base(const Unit& u) const { return A + (size_t)u.pm * (512 * KU); }
    __device__ __forceinline__ const char* b_base(const Unit& u) const { return Bt + (size_t)((u.pm >> BSHIFT) * nN + u.pn) * (512 * KU); }
    __device__ __forceinline__ void a_voff(int, const Unit&, int tid, unsigned (&v)[2][2]) const { pg8::dense_voff(KU, tid, v); }
};
template <int KU> struct SchedGather {
    static constexpr bool GATHER = true; const char *A, *Bt; int G, c; const LAS unsigned* tab;
    __device__ __forceinline__ bool next(int i, Unit& u) const { const int Lx = i * G + c; if (Lx >= 2048) return false; pg8::rect_unit(Lx, 128, 16, u); return true; }
    __device__ __forceinline__ const char* a_base(const Unit&) const { return A; }
    __device__ __forceinline__ const char* b_base(const Unit& u) const { return Bt + (size_t)((u.pm >> 3) * 16 + u.pn) * (512 * KU); }
    __device__ __forceinline__ void a_voff(int i, const Unit&, int tid, unsigned (&v)[2][2]) const {
#pragma unroll
        for (int p = 0; p < 2; ++p) { int R, C; pg8::stage_rc(tid * 16 + p * 8192, R, C); v[0][p] = tab[i * 256 + R] + (unsigned)C * 2u; v[1][p] = tab[i * 256 + 128 + R] + (unsigned)C * 2u; }
    }
};

__device__ __forceinline__ float gelu_fast(float x) {
    const float z2 = -2.302208198f * (x + 0.044715f * x * x * x);
    return x * __builtin_amdgcn_rcpf(1.f + __builtin_amdgcn_exp2f(z2));
}
__device__ __forceinline__ float silu_fast(float x) { return x * __builtin_amdgcn_rcpf(1.f + __builtin_amdgcn_exp2f(-1.4426950408889634f * x)); }
__device__ __forceinline__ float dot4(const f32x4& a) { return (a[0] * a[0] + a[1] * a[1]) + (a[2] * a[2] + a[3] * a[3]); }
__device__ __forceinline__ void rope8(f32x4& a, f32x4& b, const float* tabrow  , int fq) {
    const f32x4 t0 = *(const f32x4*)(tabrow + 8 * fq), t1 = *(const f32x4*)(tabrow + 8 * fq + 4);
    f32x4 ra, rb;
    ra[0] = a[0] * t0[0] - a[1] * t0[1]; ra[1] = a[1] * t0[0] + a[0] * t0[1]; ra[2] = a[2] * t0[2] - a[3] * t0[3]; ra[3] = a[3] * t0[2] + a[2] * t0[3];
    rb[0] = b[0] * t1[0] - b[1] * t1[1]; rb[1] = b[1] * t1[0] + b[0] * t1[1]; rb[2] = b[2] * t1[2] - b[3] * t1[3]; rb[3] = b[3] * t1[2] + b[2] * t1[3];
    a = ra; b = rb;
}
struct EpiIn {
    static constexpr bool PERM = true; unsigned char* ws;
    __device__ __forceinline__ void operator()(const f32x4 (&acc)[2][2][4][2], const Unit& u, int wr, int wc, int fr, int fq) const {
        const int pn = u.pn, row0 = u.pm * 256 + wr * 64 + fr, c8 = wc * 32 + 8 * fq;
        if (pn < 4) {
            bf16* base = (bf16*)(ws + WS_CQKV) + (pn >= 2 ? (size_t)M * 512 : 0) + (pn & 1) * 256 + c8;
            float* ssq = (float*)(ws + (pn >= 2 ? WS_SSQKV : WS_SSQQ)) + (pn & 1) * 4 + wc;
#pragma unroll
            for (int ai = 0; ai < 2; ++ai)
#pragma unroll
                for (int m = 0; m < 4; ++m) { const int row = row0 + ai * 128 + m * 16; float s = 0.f;
#pragma unroll
                    for (int bj = 0; bj < 2; ++bj) { s += dot4(acc[ai][bj][m][0]) + dot4(acc[ai][bj][m][1]); *(u32x4*)(base + (size_t)row * 512 + bj * 128) = pg8::pack8(acc[ai][bj][m][0], acc[ai][bj][m][1]); }
                    s += __shfl_xor(s, 16); s += __shfl_xor(s, 32);
                    if (fq == 0) ssq[(size_t)row * 8] = s; }
        } else if (pn < 12) {
            bf16* base = (bf16*)(ws + (pn < 8 ? WS_U : WS_VS)) + ((pn - 4) & 3) * 256 + c8;
#pragma unroll
            for (int ai = 0; ai < 2; ++ai)
#pragma unroll
                for (int m = 0; m < 4; ++m) { const int row = row0 + ai * 128 + m * 16;
#pragma unroll
                    for (int bj = 0; bj < 2; ++bj) { f32x4 a = acc[ai][bj][m][0], b = acc[ai][bj][m][1];
#pragma unroll
                        for (int j = 0; j < 4; ++j) { a[j] = gelu_fast(a[j]); b[j] = gelu_fast(b[j]); }
                        *(u32x4*)(base + (size_t)row * 1024 + bj * 128) = pg8::pack8(a, b); } }
        } else if (wc < 2) {
            const float* tab = (const float*)(ws + WS_ROPE);
#pragma unroll
            for (int ai = 0; ai < 2; ++ai)
#pragma unroll
                for (int m = 0; m < 4; ++m) { const int row = row0 + ai * 128 + m * 16; f32x4 a = acc[ai][0][m][0], b = acc[ai][0][m][1]; int bb, kpos;
                    if (row < M) { bb = row >> 12; kpos = row & 4095; const int ax = wc ? (kpos & 63) : (kpos >> 6); rope8(a, b, tab + ax * 32, fq); }
                    else { bb = (row - M) >> 8; kpos = L + ((row - M) & 255); }
                    const u32x4 w = pg8::pack8(a, b); bf16* d = (bf16*)(ws + WS_K) + ((size_t)(bb * H) * LK + kpos) * DQK + 128 + c8;
#pragma unroll
                    for (int hh = 0; hh < H; ++hh) *(u32x4*)(d + (size_t)hh * LK * DQK) = w; }
        }
    }
};
struct EpiQKV {
    static constexpr bool PERM = true; unsigned char* ws; const LAS float* rstab;
    __device__ __forceinline__ void operator()(const f32x4 (&acc)[2][2][4][2], const Unit& u, int wr, int wc, int fr, int fq) const {
        const int c8 = wc * 32 + 8 * fq;
        if (u.pn < 6) {
            const int pn = u.pn, row0 = u.pm * 256 + wr * 64 + fr; const float* tab = (const float*)(ws + WS_ROPE);
#pragma unroll
            for (int ai = 0; ai < 2; ++ai)
#pragma unroll
                for (int m = 0; m < 4; ++m) { const int row = row0 + ai * 128 + m * 16; const int bb = row >> 12, t = row & 4095;
                    const float rs = rstab[u.ui * 256 + ai * 128 + wr * 64 + m * 16 + fr];
#pragma unroll
                    for (int bj = 0; bj < 2; ++bj) { f32x4 a = acc[ai][bj][m][0] * rs, b = acc[ai][bj][m][1] * rs; bf16* d;
                        if (pn < 4) d = (bf16*)(ws + WS_Q) + ((size_t)(bb * H + pn * 2 + bj) * L + t) * DQK + c8;
                        else { const int hd = (pn - 4) * 4 + bj * 2 + (wc >> 1), ax = (wc & 1) ? (t & 63) : (t >> 6); rope8(a, b, tab + ax * 32, fq);
                            d = (bf16*)(ws + WS_Q) + ((size_t)(bb * H + hd) * L + t) * DQK + 128 + (wc & 1) * 32 + 8 * fq; }
                        *(u32x4*)d = pg8::pack8(a, b); }
                    asm volatile("" ::: "memory"); }
        } else {
            const int hd = u.pn - 6, row0 = (u.pm - 64) * 256 + wr * 64 + fr;
#pragma unroll
            for (int ai = 0; ai < 2; ++ai)
#pragma unroll
                for (int m = 0; m < 4; ++m) { const int row = row0 + ai * 128 + m * 16; int bb, kpos;
                    if (row < M) { bb = row >> 12; kpos = row & 4095; } else { bb = (row - M) >> 8; kpos = L + ((row - M) & 255); }
                    const float rs = rstab[u.ui * 256 + ai * 128 + wr * 64 + m * 16 + fr];
                    const size_t kr = (size_t)(bb * H + hd) * LK + kpos;
                    *(u32x4*)((bf16*)(ws + WS_K) + kr * DQK + c8) = pg8::pack8(acc[ai][0][m][0] * rs, acc[ai][0][m][1] * rs);
                    *(u32x4*)((bf16*)(ws + WS_V) + kr * VH + c8) = pg8::pack8(acc[ai][1][m][0] * rs, acc[ai][1][m][1] * rs);
                    asm volatile("" ::: "memory"); }
        }
    }
};
struct EpiY {
    static constexpr bool PERM = true; unsigned char* ws;
    __device__ __forceinline__ void operator()(const f32x4 (&acc)[2][2][4][2], const Unit& u, int wr, int wc, int fr, int fq) const {
        const int row0 = u.pm * 256 + wr * 64 + fr; bf16* base = (bf16*)(ws + WS_Y) + u.pn * 256 + wc * 32 + 8 * fq; float* ssq = (float*)(ws + WS_SSQY) + u.pn * 4 + wc;
#pragma unroll
        for (int ai = 0; ai < 2; ++ai)
#pragma unroll
            for (int m = 0; m < 4; ++m) { const int row = row0 + ai * 128 + m * 16; float s = 0.f;
#pragma unroll
                for (int bj = 0; bj < 2; ++bj) { s += dot4(acc[ai][bj][m][0]) + dot4(acc[ai][bj][m][1]); *(u32x4*)(base + (size_t)row * D + bj * 128) = pg8::pack8(acc[ai][bj][m][0], acc[ai][bj][m][1]); }
                s += __shfl_xor(s, 16); s += __shfl_xor(s, 32);
                if (fq == 0) ssq[(size_t)row * 32] = s; }
    }
};
__device__ __forceinline__ unsigned pack4_fp8(float a, float b, float c, float d) { int w = 0; w = __builtin_amdgcn_cvt_pk_fp8_f32(a, b, w, false); w = __builtin_amdgcn_cvt_pk_fp8_f32(c, d, w, true); return (unsigned)w; }
constexpr float W8_SCALE = 64.f, W8_INV = 1.f / 64.f;
struct EpiAct8 {
    static constexpr bool PERM = true; unsigned char* ws;
    __device__ __forceinline__ void operator()(const f32x4 (&acc)[2][2][4][2], const Unit& u, int wr, int wc, int fr, int fq) const {
        const int row0 = u.pm * 256 + wr * 64 + fr; unsigned char* base = ws + WS_ACT + u.pn * 128 + wc * 32 + 8 * fq;
#pragma unroll
        for (int ai = 0; ai < 2; ++ai)
#pragma unroll
            for (int m = 0; m < 4; ++m) { const int row = row0 + ai * 128 + m * 16; f32x4 a, b;
#pragma unroll
                for (int j = 0; j < 4; ++j) { a[j] = silu_fast(acc[ai][0][m][0][j] * W8_INV) * (acc[ai][1][m][0][j] * W8_INV); b[j] = silu_fast(acc[ai][0][m][1][j] * W8_INV) * (acc[ai][1][m][1][j] * W8_INV); }
                *(unsigned long long*)(base + (size_t)row * FF) = (unsigned long long)pack4_fp8(a[0], a[1], a[2], a[3]) | ((unsigned long long)pack4_fp8(b[0], b[1], b[2], b[3]) << 32); }
    }
};
struct EpiYE8 {
    static constexpr bool PERM = true; unsigned char* ws;
    __device__ __forceinline__ void operator()(const f32x4 (&acc)[2][2][4][2], const Unit& u, int wr, int wc, int fr, int fq) const {
        const int row0 = u.pm * 256 + wr * 64 + fr; unsigned char* base = ws + WS_YE + u.pn * 256 + wc * 32 + 8 * fq;
#pragma unroll
        for (int ai = 0; ai < 2; ++ai)
#pragma unroll
            for (int m = 0; m < 4; ++m) { const int row = row0 + ai * 128 + m * 16;
#pragma unroll
                for (int bj = 0; bj < 2; ++bj) { const f32x4 a = acc[ai][bj][m][0] * W8_INV, b = acc[ai][bj][m][1] * W8_INV;
                    *(unsigned long long*)(base + (size_t)row * D + bj * 128) = (unsigned long long)pack4_fp8(a[0], a[1], a[2], a[3]) | ((unsigned long long)pack4_fp8(b[0], b[1], b[2], b[3]) << 32); } }
    }
};
struct EpiAct {
    static constexpr bool PERM = true; unsigned char* ws;
    __device__ __forceinline__ void operator()(const f32x4 (&acc)[2][2][4][2], const Unit& u, int wr, int wc, int fr, int fq) const {
        const int row0 = u.pm * 256 + wr * 64 + fr; bf16* base = (bf16*)(ws + WS_ACT) + u.pn * 128 + wc * 32 + 8 * fq;
#pragma unroll
        for (int ai = 0; ai < 2; ++ai)
#pragma unroll
            for (int m = 0; m < 4; ++m) { const int row = row0 + ai * 128 + m * 16; f32x4 a, b;
#pragma unroll
                for (int j = 0; j < 4; ++j) { a[j] = silu_fast(acc[ai][0][m][0][j]) * acc[ai][1][m][0][j]; b[j] = silu_fast(acc[ai][0][m][1][j]) * acc[ai][1][m][1][j]; }
                *(u32x4*)(base + (size_t)row * FF) = pg8::pack8(a, b); }
    }
};
struct EpiYE {
    static constexpr bool PERM = true; unsigned char* ws;
    __device__ __forceinline__ void operator()(const f32x4 (&acc)[2][2][4][2], const Unit& u, int wr, int wc, int fr, int fq) const {
        const int row0 = u.pm * 256 + wr * 64 + fr; bf16* base = (bf16*)(ws + WS_YE) + u.pn * 256 + wc * 32 + 8 * fq;
#pragma unroll
        for (int ai = 0; ai < 2; ++ai)
#pragma unroll
            for (int m = 0; m < 4; ++m) { const int row = row0 + ai * 128 + m * 16;
#pragma unroll
                for (int bj = 0; bj < 2; ++bj) *(u32x4*)(base + (size_t)row * D + bj * 128) = pg8::pack8(acc[ai][bj][m][0], acc[ai][bj][m][1]); }
    }
};

namespace att {
using bf16x8 = __attribute__((ext_vector_type(8))) short;
using s16x4  = __attribute__((ext_vector_type(4))) short;
using f32x16 = __attribute__((ext_vector_type(16))) float;
using u32x4  = __attribute__((ext_vector_type(4))) unsigned;
constexpr int QBLK = 32, KVBLK = 64, NW = 8;
constexpr float SCALE = cfg::ATT_SCALE, THR = 8.f;
constexpr int LDQ = 192, LDKK = 192, LDV = 128, LDO = 2048;
constexpr int KROW = 400, SHM_V = KVBLK * 128 * 2, SHM_K = KVBLK * KROW, SHM_QPE = 2 * SHM_V + 2 * SHM_K + NW * 64 * 4, SHM_ATTN = SHM_QPE + NW * 4096;
#define KSWZ(row, colB) ((row) * KROW + (colB))
#define SBAR() __builtin_amdgcn_sched_barrier(0)
__device__ __forceinline__ int crow(int r, int hi) { return (r & 3) + 8 * (r >> 2) + 4 * hi; }
__device__ __forceinline__ unsigned cvtpk(float lo, float hi) { unsigned r; asm volatile("v_cvt_pk_bf16_f32 %0, %1, %2" : "=v"(r) : "v"(lo), "v"(hi)); return r; }

__device__ __forceinline__ void partialSM(f32x16& p0, f32x16& p1, float& m_reg, float& mn, float& alpha) {
  constexpr float C = SCALE * 1.4426950408889634f;
  float pmax = p0[0];
#pragma unroll
  for (int r = 1; r < 16; ++r) pmax = fmaxf(pmax, p0[r]);
#pragma unroll
  for (int r = 0; r < 16; ++r) pmax = fmaxf(pmax, p1[r]);
  { auto rr = __builtin_amdgcn_permlane32_swap(__float_as_uint(pmax), __float_as_uint(pmax), false, false);
    pmax = fmaxf(__uint_as_float(rr[0]), __uint_as_float(rr[1])); }
  if (__builtin_expect(__all(pmax - m_reg <= THR / SCALE), 1)) { mn = m_reg; alpha = 1.f; }
  else { mn = fmaxf(m_reg, pmax); alpha = __builtin_amdgcn_exp2f((m_reg - mn) * C); m_reg = mn; }
  float mnC = -mn * C;
#pragma unroll
  for (int r = 0; r < 16; ++r) p0[r] = fmaf(p0[r], C, mnC);
#pragma unroll
  for (int r = 0; r < 16; ++r) p1[r] = fmaf(p1[r], C, mnC);
#pragma unroll
  for (int r = 0; r < 16; ++r) p0[r] = __builtin_amdgcn_exp2f(p0[r]);
}
__device__ __forceinline__ void finishSM(f32x16& p0, f32x16& p1, float alpha, float& l_reg, bf16x8& pa0, bf16x8& pa1, bf16x8& pa2, bf16x8& pa3) {
#pragma unroll
  for (int r = 0; r < 16; ++r) p1[r] = __builtin_amdgcn_exp2f(p1[r]);
  float ps = 0;
#pragma unroll
  for (int r = 0; r < 16; ++r) ps += p0[r];
#pragma unroll
  for (int r = 0; r < 16; ++r) ps += p1[r];
  { auto rr = __builtin_amdgcn_permlane32_swap(__float_as_uint(ps), __float_as_uint(ps), false, false);
    ps = __uint_as_float(rr[0]) + __uint_as_float(rr[1]); }
  l_reg = l_reg * alpha + ps;
#define PK4(P, BASE, OUT) do { unsigned a0 = cvtpk(P[BASE + 0], P[BASE + 1]), a1 = cvtpk(P[BASE + 2], P[BASE + 3]);   \
    unsigned b0 = cvtpk(P[BASE + 4], P[BASE + 5]), b1 = cvtpk(P[BASE + 6], P[BASE + 7]);                              \
    auto r0 = __builtin_amdgcn_permlane32_swap(a0, b0, false, false); auto r1 = __builtin_amdgcn_permlane32_swap(a1, b1, false, false); \
    u32x4 w = {r0[0], r1[0], r0[1], r1[1]}; OUT = *reinterpret_cast<bf16x8*>(&w); } while (0)
  PK4(p0, 0, pa0); PK4(p0, 8, pa1); PK4(p1, 0, pa2); PK4(p1, 8, pa3);
#undef PK4
}
__device__ __forceinline__ void qkt(f32x16& p0, f32x16& p1, const char* Ks, const bf16x8* qr, const char* qpe, int r32, int hi) {
  p0 = f32x16{}; p1 = f32x16{};
#pragma unroll
  for (int d0 = 0; d0 < 12; ++d0) { const int cb = (d0 * 16 + hi * 8) * 2;
    bf16x8 b0 = *reinterpret_cast<const bf16x8*>(Ks + KSWZ(r32, cb));
    bf16x8 b1 = *reinterpret_cast<const bf16x8*>(Ks + KSWZ(32 + r32, cb));
    const bf16x8 q = d0 < 8 ? qr[d0 < 8 ? d0 : 0] : *reinterpret_cast<const bf16x8*>(qpe + (d0 - 8) * 1024);
    p0 = __builtin_amdgcn_mfma_f32_32x32x16_bf16(b0, q, p0, 0, 0, 0);
    p1 = __builtin_amdgcn_mfma_f32_32x32x16_bf16(b1, q, p1, 0, 0, 0); }
}
__device__ __forceinline__ int v_st(int k, int c) { const int kk = (k & ~0xC) | ((k & 4) << 1) | ((k & 8) >> 1); return ((kk >> 3) * 4 + (c >> 5)) * 512 + ((kk & 7) * 32 + (c & 31)) * 2; }
__device__ __forceinline__ int v_rd_base(int lane) { return ((lane & 3) << 3) | (((lane >> 2) & 3) << 6) | (((lane >> 4) & 1) << 5) | (((lane >> 5) & 1) << 8); }
constexpr int v_rd_off(int d0, int ks, int half) { return d0 * 512 + ks * 4096 + half * 2048; }
template <int OFF> __device__ __forceinline__ s16x4 tr_read(int vb) {
  s16x4 r; asm volatile("ds_read_b64_tr_b16 %0, %1 offset:%2" : "=&v"(r) : "v"(vb), "i"(OFF) : "memory"); return r;
}
template <int D0> __device__ __forceinline__ void pv_one(f32x16& od, int vb, bf16x8 pa0, bf16x8 pa1, bf16x8 pa2, bf16x8 pa3) {
  const s16x4 l0 = tr_read<v_rd_off(D0, 0, 0)>(vb), h0 = tr_read<v_rd_off(D0, 0, 1)>(vb), l1 = tr_read<v_rd_off(D0, 1, 0)>(vb), h1 = tr_read<v_rd_off(D0, 1, 1)>(vb);
  const s16x4 l2 = tr_read<v_rd_off(D0, 2, 0)>(vb), h2 = tr_read<v_rd_off(D0, 2, 1)>(vb), l3 = tr_read<v_rd_off(D0, 3, 0)>(vb), h3 = tr_read<v_rd_off(D0, 3, 1)>(vb);
  asm volatile("s_waitcnt lgkmcnt(0)" ::: "memory"); SBAR();
#define PK(L, H) (bf16x8){L[0], L[1], L[2], L[3], H[0], H[1], H[2], H[3]}
  od = __builtin_amdgcn_mfma_f32_32x32x16_bf16(pa0, PK(l0, h0), od, 0, 0, 0);
  od = __builtin_amdgcn_mfma_f32_32x32x16_bf16(pa1, PK(l1, h1), od, 0, 0, 0);
  od = __builtin_amdgcn_mfma_f32_32x32x16_bf16(pa2, PK(l2, h2), od, 0, 0, 0);
  od = __builtin_amdgcn_mfma_f32_32x32x16_bf16(pa3, PK(l3, h3), od, 0, 0, 0);
#undef PK
}
__device__ __forceinline__ void pv_d0(f32x16* o, int vb, bf16x8 pa0, bf16x8 pa1, bf16x8 pa2, bf16x8 pa3) {
  pv_one<0>(o[0], vb, pa0, pa1, pa2, pa3); pv_one<1>(o[1], vb, pa0, pa1, pa2, pa3); pv_one<2>(o[2], vb, pa0, pa1, pa2, pa3); pv_one<3>(o[3], vb, pa0, pa1, pa2, pa3);
}
struct CvStream { int it, end, step; const float *gate, *up, *down; unsigned char *wgu, *wd; };
constexpr int CV_GU = 16 * 64 * 128, CV_DN = 16 * 64 * 64, CV_ITEMS = CV_GU + CV_DN;
__device__ __forceinline__ void cv_ptrs(const CvStream& cv, int it, const float*& src, unsigned char*& dst) {
  if (it < CV_GU) { const int e = it >> 13, r = it & 8191, kb = r >> 7, nb = r & 127, n0 = nb * 32, pn = n0 >> 8, within = n0 & 255;
    src = (within < 128 ? cv.gate : cv.up) + ((size_t)e * 2048 + kb * 32) * 2048 + pn * 128 + (within & 127);
    dst = cv.wgu + ((size_t)e * 4096 + n0) * 2048 + kb * 32; }
  else { const int q = it - CV_GU, e = q >> 12, r = q & 4095, kb = r >> 6, nb = r & 63;
    src = cv.down + ((size_t)e * 2048 + kb * 32) * 2048 + nb * 32; dst = cv.wd + ((size_t)e * 2048 + nb * 32) * 2048 + kb * 32; }
}
__device__ __forceinline__ void cv_issue(const CvStream& cv, unsigned slot, int lane) {
  typedef __attribute__((address_space(3))) unsigned* ldsp_t;
  const float* src; unsigned char* dst; cv_ptrs(cv, cv.it, src, dst); (void)dst;
#pragma unroll
  for (int i = 0; i < 4; ++i) { const int k = 8 * i + (lane >> 3), nq = ((lane & 7) - 4 * (k >> 4)) & 7;
    __builtin_amdgcn_global_load_lds((const unsigned*)(src + (size_t)k * 2048 + 4 * nq), (ldsp_t)(slot + i * 1024), 16, 0, 0); }
}
__device__ __forceinline__ void cv_finish(CvStream& cv, const float* t, int lane) {
  const float* src; unsigned char* dst; cv_ptrs(cv, cv.it, src, dst); (void)src;
  const int n = lane >> 1, c = lane & 1; const float* tp = t + (16 * c * 8 + (((n >> 2) + 4 * c) & 7)) * 4 + (n & 3); float v[16];
#pragma unroll
  for (int q = 0; q < 16; ++q) v[q] = tp[q * 32] * 64.f;
  u32x4 o;
#pragma unroll
  for (int w = 0; w < 4; ++w) { int x = 0; x = __builtin_amdgcn_cvt_pk_fp8_f32(v[4 * w], v[4 * w + 1], x, false); x = __builtin_amdgcn_cvt_pk_fp8_f32(v[4 * w + 2], v[4 * w + 3], x, true); o[w] = (unsigned)x; }
  *reinterpret_cast<u32x4*>(dst + (size_t)n * 2048 + 16 * c) = o;
  cv.it += cv.step;
}
template <int V>
__device__ __forceinline__ void attn_unit(const bf16* __restrict__ Qb, const bf16* __restrict__ Kh, const bf16* __restrict__ Vh, bf16* __restrict__ Ob, int seq, char* lds, CvStream& cv) {
  const int tid = threadIdx.x, wid = tid >> 6, lane = tid & 63, r32 = lane & 31, hi = lane >> 5;
  char* V_lds = lds; char* K_lds = lds + 2 * SHM_V;
  float* ws = (float*)(lds + 2 * SHM_V + 2 * SHM_K) + wid * 64; float* li_l = ws; float* al_l = ws + 32;
  float m_reg = -1e30f, l_reg = 0; f32x16 o[4] = {}; bf16x8 qr[8];
  const bf16* Qw = Qb + (long)(wid * QBLK + r32) * LDQ + hi * 8;
  char* qpe = lds + SHM_QPE + wid * 4096 + lane * 16;
#pragma unroll
  for (int d0 = 0; d0 < 8; ++d0) qr[d0] = *reinterpret_cast<const bf16x8*>(Qw + d0 * 16);
#pragma unroll
  for (int d0 = 8; d0 < 12; ++d0) *reinterpret_cast<bf16x8*>(qpe + (d0 - 8) * 1024) = *reinterpret_cast<const bf16x8*>(Qw + d0 * 16);
  int kro[4], vro[2];
#pragma unroll
  for (int j = 0; j < 4; ++j) { const int o = (wid + 8 * j) * 1024 + lane * 16, row = o / KROW, c = (o - row * KROW) >> 4; kro[j] = row * 384 + (c < 24 ? c : 0) * 16; }
#pragma unroll
  for (int j = 0; j < 2; ++j) { const int o = (wid * 2 + j) * 1024 + lane * 16, st = o >> 9, within = (o & 511) >> 1, kk = (st >> 2) * 8 + (within >> 5), c = (st & 3) * 32 + (within & 31);
    const int k = (kk & ~0xC) | ((kk & 4) << 1) | ((kk & 8) >> 1); vro[j] = k * 256 + c * 2; }
  const unsigned klds = (unsigned)(uintptr_t)K_lds + wid * 1024, vlds = (unsigned)(uintptr_t)V_lds + wid * 2048;
  const int vb0 = (int)(uintptr_t)V_lds + v_rd_base(lane);
  typedef __attribute__((address_space(3))) unsigned* ldsp_t;
#define SDMA_K(k0, b) do { const char* kg = (const char*)Kh + (long)(k0) * (LDKK * 2); \
    _Pragma("unroll") for (int j_ = 0; j_ < 3; ++j_) __builtin_amdgcn_global_load_lds((const unsigned*)(kg + kro[j_]), (ldsp_t)(klds + (b) * SHM_K + j_ * 8192), 16, 0, 0); \
    if (wid == 0) __builtin_amdgcn_global_load_lds((const unsigned*)(kg + kro[3]), (ldsp_t)(klds + (b) * SHM_K + 3 * 8192), 16, 0, 0); } while (0)
#define SDMA_V(k0, b) do { const char* vg = (const char*)Vh + (long)(k0) * (LDV * 2); \
    _Pragma("unroll") for (int j_ = 0; j_ < 2; ++j_) __builtin_amdgcn_global_load_lds((const unsigned*)(vg + vro[j_]), (ldsp_t)(vlds + (b) * SHM_V + j_ * 1024), 16, 0, 0); } while (0)
#define RESC(a) do { if (__any((a) < 1.f)) { if (hi == 0) al_l[r32] = (a); asm volatile("s_waitcnt lgkmcnt(0)" ::: "memory"); \
    _Pragma("unroll") for (int d = 0; d < 4; ++d) _Pragma("unroll") for (int r = 0; r < 16; ++r) o[d][r] *= al_l[crow(r, hi)]; } } while (0)
#define PHASE_END() do { asm volatile("s_waitcnt vmcnt(0) lgkmcnt(0)" ::: "memory"); __builtin_amdgcn_s_barrier(); asm volatile("" ::: "memory"); } while (0)
  char* cvslot = lds + SHM_ATTN + wid * 4096; const unsigned cvslot_a = (unsigned)(uintptr_t)cvslot;
  f32x16 pA0, pA1; float mnA, alA; bf16x8 pa0, pa1, pa2, pa3; const int NT = seq / KVBLK;
  SDMA_K(0, 0); SDMA_V(0, 0); PHASE_END();
  if (wid >= 4) { __builtin_amdgcn_s_barrier(); asm volatile("" ::: "memory"); }
  for (int j = 0; j < NT; ++j) {
    const int bsel = j & 1;
    if (!(V & 8)) if (j + 1 < NT) { if (bsel) SDMA_K((j + 1) * KVBLK, 0); else SDMA_K((j + 1) * KVBLK, 1); }
    const bool cvon = cv.it < cv.end; if (cvon) cv_issue(cv, cvslot_a, lane);
    SBAR(); if (!(V & 4)) qkt(pA0, pA1, K_lds + bsel * SHM_K, qr, qpe, r32, hi); else { pA0 = o[0]; pA1 = o[1]; }
    if (!(V & 1)) partialSM(pA0, pA1, m_reg, mnA, alA); else { mnA = 0.f; alA = 1.f; }
    PHASE_END();
    if (!(V & 8)) if (j + 1 < NT) { if (bsel) SDMA_V((j + 1) * KVBLK, 0); else SDMA_V((j + 1) * KVBLK, 1); }
    if (cvon) cv_finish(cv, (const float*)cvslot, lane);
    RESC(alA);
    if (!(V & 1)) finishSM(pA0, pA1, alA, l_reg, pa0, pa1, pa2, pa3); else { pa0 = (bf16x8){(short)__float_as_int(pA0[0])}; pa1 = (bf16x8){(short)__float_as_int(pA0[1])}; pa2 = (bf16x8){(short)__float_as_int(pA1[0])}; pa3 = (bf16x8){(short)__float_as_int(pA1[1])}; l_reg += pA0[2]; } SBAR();
    if (!(V & 2)) pv_d0(o, vb0 + bsel * (int)SHM_V, pa0, pa1, pa2, pa3); else { o[0][0] += __int_as_float(pa0[0]); o[1][0] += __int_as_float(pa1[0]); o[2][0] += __int_as_float(pa2[0]); o[3][0] += __int_as_float(pa3[0]); }
    PHASE_END();
  }
  if (wid < 4) { __builtin_amdgcn_s_barrier(); asm volatile("" ::: "memory"); }
  if (hi == 0) li_l[r32] = l_reg; asm volatile("s_waitcnt lgkmcnt(0)" ::: "memory");
  float rli[16];
#pragma unroll
  for (int r = 0; r < 16; ++r) rli[r] = __builtin_amdgcn_rcpf(li_l[crow(r, hi)]);
  bf16* Ow = Ob + (long)(wid * QBLK) * LDO;
#pragma unroll
  for (int r = 0; r < 16; ++r) { const int orow = crow(r, hi);
#pragma unroll
    for (int d0 = 0; d0 < 4; ++d0) Ow[(long)orow * LDO + d0 * 32 + r32] = f2bf(o[d0][r] * rli[r]); }
#undef SDMA_K
#undef SDMA_V
#undef PHASE_END
#undef RESC
}
#undef KSWZ
#undef SBAR
}

#define XB_TMO      128
#define XB_XCNT(j)  (256  + 64 * (j))
#define XB_XSUB(j)  (1280 + 64 * (j))
#define XB_XGEN(j)  (2304 + 64 * (j))
#define XB_TOP      3328
#define XB_TOPGEN   3392
#define XCD_BAR_WORDS 3456
#define XB_SPIN_CAP (1u << 18)
__device__ __forceinline__ unsigned xb_ld(unsigned* p)              { return __hip_atomic_load(p, __ATOMIC_RELAXED, __HIP_MEMORY_SCOPE_AGENT); }
__device__ __forceinline__ unsigned xb_add(unsigned* p, unsigned v) { return __hip_atomic_fetch_add(p, v, __ATOMIC_RELAXED, __HIP_MEMORY_SCOPE_AGENT); }
__device__ __forceinline__ unsigned xb_xcc_id() { return (unsigned)__builtin_amdgcn_s_getreg((3 << 11) | 20) & 0xFu; }
#define XB_SPIN(cond, bar) do { unsigned _sp = 0; while (cond) { __builtin_amdgcn_s_sleep(1); \
    if ((++_sp & 255u) == 0u) { if (xb_ld(&(bar)[XB_TMO])) break; if (_sp > XB_SPIN_CAP) { atomicAdd(&(bar)[XB_TMO], 1u); break; } } } } while (0)
struct XcdBarrier { unsigned* bar; unsigned x; volatile LAS unsigned* st; };
__device__ __forceinline__ XcdBarrier xcd_barrier_post(unsigned* bar, volatile LAS unsigned* st) {
    XcdBarrier b; b.bar = bar; b.x = xb_xcc_id(); b.st = st;
    if (threadIdx.x == 0) (void)xb_add(&bar[XB_XCNT(b.x)], 1u);
    return b;
}
__device__ __forceinline__ void xcd_barrier_complete(unsigned* bar, unsigned x, unsigned& nloc, unsigned& nx) {
    const unsigned G = gridDim.x * gridDim.y * gridDim.z;
    unsigned sum, cnt, mine, sp = 0u;
    for (;;) {
        sum = 0u; cnt = 0u; mine = 0u;
#pragma unroll
        for (unsigned j = 0; j < 16; ++j) { const unsigned c = xb_ld(&bar[XB_XCNT(j)]); sum += c; cnt += (c > 0u) ? 1u : 0u; mine = (j == x) ? c : mine; }
        if (sum == G) break;
        __builtin_amdgcn_s_sleep(1);
        if ((++sp & 255u) == 0u) { if (xb_ld(&bar[XB_TMO])) break; if (sp > XB_SPIN_CAP) { atomicAdd(&bar[XB_TMO], 1u); break; } }
    }
    nloc = mine > 0u ? mine : 1u; nx = cnt > 0u ? cnt : 1u;
}
__device__ __forceinline__ void xcd_barrier(const XcdBarrier& b) {
    asm volatile("s_waitcnt vmcnt(0)" ::: "memory");
    __syncthreads();
    if (threadIdx.x == 0) {
        unsigned* bar = b.bar;
        __builtin_amdgcn_s_waitcnt(0);
        unsigned nloc = b.st[0], nx = b.st[1];
        if (nloc == 0u) { xcd_barrier_complete(bar, b.x, nloc, nx); b.st[0] = nloc; b.st[1] = nx; }
        const unsigned old = xb_add(&bar[XB_XSUB(b.x)], 1u);
        const unsigned gen = old / nloc;
        if (old + 1u == (gen + 1u) * nloc) {
            __builtin_amdgcn_fence(__ATOMIC_RELEASE, "agent");
            asm volatile("s_waitcnt vmcnt(0)" ::: "memory");
            const unsigned og = xb_add(&bar[XB_TOP], 1u);
            const unsigned tg = og / nx;
            if (og + 1u == (tg + 1u) * nx) xb_add(&bar[XB_TOPGEN], 1u);
            else XB_SPIN(xb_ld(&bar[XB_TOPGEN]) == tg, bar);
            __builtin_amdgcn_fence(__ATOMIC_ACQUIRE, "agent");
            xb_add(&bar[XB_XGEN(b.x)], 1u);
            asm volatile("s_waitcnt vmcnt(0)" ::: "memory");
        } else {
            XB_SPIN(xb_ld(&bar[XB_XGEN(b.x)]) == gen, bar);
            __builtin_amdgcn_fence(__ATOMIC_ACQUIRE, "agent");
            asm volatile("s_waitcnt vmcnt(0)" ::: "memory");
        }
    }
    __syncthreads();
}

constexpr int NWAVES = 8, NTHREADS = 512;
constexpr int RING_BYTES = 131072, TAB_OFF = RING_BYTES, TAB_BYTES = 8192, LDS_BYTES = 163840, MISC_OFF = LDS_BYTES - 512, VEC_OFF = RING_BYTES;
constexpr int CW_BAR = 4096;
#define LDS_WAIT() asm volatile("s_waitcnt lgkmcnt(0)" ::: "memory")
typedef unsigned v4u __attribute__((ext_vector_type(4)));
__device__ __forceinline__ unsigned pk2(float lo, float hi) { return (unsigned)f2bf(lo) | ((unsigned)f2bf(hi) << 16); }

__device__ __forceinline__ void p0_mod_item(const Ptrs& p, int it, int lane) {
    const int kc = it / 48, cc = it - kc * 48, k0 = kc * 64, c0 = cc * 256 + lane * 4;
    float sv[5];
#pragma unroll
    for (int r = 0; r < 5; ++r) { const float* cv = r < 4 ? p.c + r * D : p.c_ctx; sv[r] = silu_f(cv[k0 + lane]); }
    f32x4 acc[5];
#pragma unroll
    for (int r = 0; r < 5; ++r) acc[r] = (f32x4){0.f, 0.f, 0.f, 0.f};
    const float* w = p.w_ada + (size_t)k0 * 12288 + c0;
#pragma unroll 8
    for (int k = 0; k < 64; ++k) { const f32x4 wv = *(const f32x4*)(w + (size_t)k * 12288);
#pragma unroll
        for (int r = 0; r < 5; ++r) acc[r] += __int_as_float(__builtin_amdgcn_readlane(__float_as_int(sv[r]), k)) * wv; }
    float* part = (float*)(p.ws + WS_PART) + (size_t)kc * 5 * 12288 + c0;
#pragma unroll
    for (int r = 0; r < 5; ++r) *(f32x4*)(part + (size_t)r * 12288) = acc[r];
}
__device__ __forceinline__ void cvt_load(const float* src, int ldw, int lane, f32x4 (&v)[8]) {
    const int kr = lane >> 3, nq = lane & 7;
#pragma unroll
    for (int i = 0; i < 8; ++i) v[i] = *(const f32x4*)(src + (size_t)(8 * i + kr) * ldw + 4 * nq);
}
__device__ __forceinline__ void cvt_finish(const f32x4 (&v)[8], bf16* dst, int ldk, bool rope, const float* kscale, LAS float* scr, int lane) {
    const int kr = lane >> 3, nq = lane & 7;
#pragma unroll
    for (int i = 0; i < 8; ++i) { const int k = 8 * i + kr; const float sc = kscale ? kscale[k] : 1.f;
#pragma unroll
        for (int t = 0; t < 4; ++t) { const int cs = 4 * nq + t, nn = rope ? ((cs & 15) * 2 + (cs >> 4)) : cs; scr[k * 33 + nn] = v[i][t] * sc; } }
    LDS_WAIT(); asm volatile("" ::: "memory");
    const int c = lane & 7;
#pragma unroll
    for (int j = 0; j < 4; ++j) { const int n = (lane >> 3) + 8 * j; const LAS float* s = scr + (8 * c) * 33 + n;
        v4u o; o.x = pg8::cvt_pk_bf16(s[0 * 33], s[1 * 33]); o.y = pg8::cvt_pk_bf16(s[2 * 33], s[3 * 33]); o.z = pg8::cvt_pk_bf16(s[4 * 33], s[5 * 33]); o.w = pg8::cvt_pk_bf16(s[6 * 33], s[7 * 33]);
        *(v4u*)(dst + (size_t)n * ldk + 8 * c) = o; }
    LDS_WAIT(); asm volatile("" ::: "memory");
}
__device__ __forceinline__ void cvt_finish_fp8(const f32x4 (&v)[8], unsigned char* dst, int ldk, LAS float* scr, int lane) {
    const int kr = lane >> 3, nq = lane & 7;
#pragma unroll
    for (int i = 0; i < 8; ++i) { const int k = 8 * i + kr;
#pragma unroll
        for (int t = 0; t < 4; ++t) scr[k * 33 + 4 * nq + t] = v[i][t] * W8_SCALE; }
    LDS_WAIT(); asm volatile("" ::: "memory");
    const int c = lane & 3;
#pragma unroll
    for (int j = 0; j < 2; ++j) { const int n = (lane >> 2) + 16 * j; const LAS float* s = scr + (16 * c) * 33 + n;
        v4u o; o.x = pack4_fp8(s[0 * 33], s[1 * 33], s[2 * 33], s[3 * 33]); o.y = pack4_fp8(s[4 * 33], s[5 * 33], s[6 * 33], s[7 * 33]);
        o.z = pack4_fp8(s[8 * 33], s[9 * 33], s[10 * 33], s[11 * 33]); o.w = pack4_fp8(s[12 * 33], s[13 * 33], s[14 * 33], s[15 * 33]);
        *(v4u*)(dst + (size_t)n * ldk + 16 * c) = o; }
    LDS_WAIT(); asm volatile("" ::: "memory");
}
__device__ __forceinline__ void cvt_item(const float* src, int ldw, bf16* dst, int ldk, bool rope, const float* kscale, LAS float* scr, int lane) {
    f32x4 v[8]; cvt_load(src, ldw, lane, v); cvt_finish(v, dst, ldk, rope, kscale, scr, lane);
}
constexpr int I_MOD = 1536, I_WIN = 32 * 98, I_WQ = 8 * 48, I_WKV = 8 * 64, I_WOUT = 32 * 64, I_GU = 16 * 32 * 128, I_DN = 16 * 32 * 64, I_SGU = 256, I_ZERO = 768, I_ROPE = 1;
constexpr int P0_ITEMS = I_MOD + I_WIN + I_WQ + I_WKV + I_WOUT + I_SGU + I_ZERO + I_ROPE, PX_ITEMS = I_GU + I_DN;
__device__ __forceinline__ void p0_item(const Ptrs& p, int it, LAS float* scr, int lane) {
    if (it < I_MOD) { p0_mod_item(p, it, lane); return; } it -= I_MOD;
    if (it < I_WIN) { const int kb = it / 98, nb = it - kb * 98, n0 = nb * 32; int col0; bool rope = false;
        if (n0 < 1024) col0 = n0; else if (n0 < 3072) col0 = n0 + 64; else { col0 = OFF_KPE + (nb - 96) * 32; rope = true; }
        cvt_item(p.w_in + (size_t)kb * 64 * INC + col0, INC, (bf16*)(p.ws + WS_WIN_T) + (size_t)n0 * D + kb * 64, D, rope, nullptr, scr, lane); return; } it -= I_WIN;
    if (it < I_WQ) { const int kb = it / 48, nb = it - kb * 48, n0 = nb * 32; int col0; bool rope = false;
        if (n0 < 1024) col0 = (n0 >> 7) * DQK + (n0 & 127); else { const int jj = n0 - 1024; col0 = (jj >> 6) * DQK + 128 + ((jj & 63) >> 5) * 32; rope = true; }
        cvt_item(p.w_uq + (size_t)kb * 64 * 1536 + col0, 1536, (bf16*)(p.ws + WS_WQKV_T) + (size_t)n0 * 512 + kb * 64, 512, rope, p.q_norm_w + kb * 64, scr, lane); return; } it -= I_WQ;
    if (it < I_WKV) { const int kb = it / 64, nb = it - kb * 64, n0 = nb * 32;
        cvt_item(p.w_ukv + (size_t)kb * 64 * 2048 + n0, 2048, (bf16*)(p.ws + WS_WQKV_T) + (size_t)(1536 + n0) * 512 + kb * 64, 512, false, p.kv_norm_w + kb * 64, scr, lane); return; } it -= I_WKV;
    if (it < I_WOUT) { const int kb = it / 64, nb = it - kb * 64, n0 = nb * 32;
        cvt_item(p.w_out + (size_t)kb * 64 * D + n0, D, (bf16*)(p.ws + WS_WOUT_T) + (size_t)n0 * D + kb * 64, D, false, nullptr, scr, lane); return; } it -= I_WOUT;
    if (it < I_SGU) { const float* s = p.sgu_w + (size_t)it * 512 + lane * 8; const f32x4 a = *(const f32x4*)s, b = *(const f32x4*)(s + 4);
        v4u o; o.x = pk2(a[0], a[1]); o.y = pk2(a[2], a[3]); o.z = pk2(b[0], b[1]); o.w = pk2(b[2], b[3]); *(v4u*)((bf16*)(p.ws + WS_SGUW) + (size_t)it * 512 + lane * 8) = o; return; } it -= I_SGU;
    if (it < I_ZERO) { *(v4u*)((bf16*)(p.ws + WS_WIN_T) + (size_t)3136 * D + (size_t)it * 512 + lane * 8) = (v4u){0u, 0u, 0u, 0u}; return; }
    float* tab = (float*)(p.ws + WS_ROPE);
    for (int j = 0; j < 16; ++j) { const int idx = j * 64 + lane, ax = idx >> 4, ii = idx & 15; float s, c; sincosf((float)ax * rope_inv(ii), &s, &c); tab[idx * 2] = c; tab[idx * 2 + 1] = s; }
}
constexpr int PX_N3 = 0, PX_N4 = 0, PX_N8 = 0, PX_R3 = 0, PX_R4 = PX_R3 + 180 * PX_N3, PX_R8 = PX_R4 + 96 * PX_N4, PX_R5 = PX_R8 + 192 * PX_N8;
constexpr int WEL = FP8_MOE ? 1 : 2;
#if 0
#else
__device__ __forceinline__ void px_ptrs(const Ptrs& p, int it, const float*& src, unsigned char*& dst) {
    if (it < I_GU) { const int e = it >> 12, r = it & 4095, kb = r >> 7, nb = r & 127, n0 = nb * 32, pn = n0 >> 8, within = n0 & 255;
        src = (within < 128 ? p.w_e_gate : p.w_e_up) + ((size_t)e * D + kb * 64) * FF + pn * 128 + (within & 127);
        dst = p.ws + WS_WGU_T + (((size_t)e * 4096 + n0) * D + kb * 64) * WEL; }
    else { it -= I_GU; const int e = it >> 11, r = it & 2047, kb = r >> 6, nb = r & 63, n0 = nb * 32;
        src = p.w_e_down + ((size_t)e * FF + kb * 64) * D + n0; dst = p.ws + WS_WD_T + (((size_t)e * D + n0) * FF + kb * 64) * WEL; }
}
__device__ __forceinline__ void px_dma(const float* src, unsigned ldsbase, int lane) {
    typedef __attribute__((address_space(3))) unsigned* ldsp_t;
#pragma unroll
    for (int i = 0; i < 8; ++i) { const int k = 8 * i + (lane >> 3), nq = ((lane & 7) - 2 * (k >> 4)) & 7;
        __builtin_amdgcn_global_load_lds((const unsigned*)(src + (size_t)k * 2048 + 4 * nq), (ldsp_t)(ldsbase + i * 1024), 16, 0, 0); }
}
__device__ __forceinline__ void px_out(unsigned char* dst, const LAS float* t, int lane) {
    if constexpr (FP8_MOE) {
        const int c = lane & 3;
#pragma unroll
        for (int j = 0; j < 2; ++j) { const int n = (lane >> 2) + 16 * j; float v[16];
#pragma unroll
            for (int q = 0; q < 16; ++q) { const int k = 16 * c + q; v[q] = t[(k * 8 + (((n >> 2) + 2 * c) & 7)) * 4 + (n & 3)] * W8_SCALE; }
            v4u o; o.x = pack4_fp8(v[0], v[1], v[2], v[3]); o.y = pack4_fp8(v[4], v[5], v[6], v[7]); o.z = pack4_fp8(v[8], v[9], v[10], v[11]); o.w = pack4_fp8(v[12], v[13], v[14], v[15]);
            *(v4u*)(dst + (size_t)n * 2048 + 16 * c) = o; }
    } else {
        const int c = lane & 7;
#pragma unroll
        for (int j = 0; j < 4; ++j) { const int n = (lane >> 3) + 8 * j; float v[8];
#pragma unroll
            for (int q = 0; q < 8; ++q) { const int k = 8 * c + q; v[q] = t[(k * 8 + (((n >> 2) + 2 * (k >> 4)) & 7)) * 4 + (n & 3)]; }
            v4u o; o.x = pg8::cvt_pk_bf16(v[0], v[1]); o.y = pg8::cvt_pk_bf16(v[2], v[3]); o.z = pg8::cvt_pk_bf16(v[4], v[5]); o.w = pg8::cvt_pk_bf16(v[6], v[7]);
            *(v4u*)((bf16*)dst + (size_t)n * 2048 + 8 * c) = o; }
    }
}
__device__ __forceinline__ void px_convert(const Ptrs& p, int it0, int NGW, int PX_END, LAS float* scr, int lane) {
    const unsigned l0 = (unsigned)(uintptr_t)scr; const float* s_; unsigned char *da, *db;
    int it = it0;
    if (it < PX_END) { px_ptrs(p, it, s_, da); px_dma(s_, l0, lane); }
    while (it < PX_END) {
        const int i1 = it + NGW, i2 = it + 2 * NGW;
        if (i1 < PX_END) { px_ptrs(p, i1, s_, db); px_dma(s_, l0 + 8192, lane); asm volatile("s_waitcnt vmcnt(8)" ::: "memory"); } else asm volatile("s_waitcnt vmcnt(0)" ::: "memory");
        px_out(da, scr, lane);
        if (i1 >= PX_END) break;
        asm volatile("s_waitcnt lgkmcnt(0)" ::: "memory");
        if (i2 < PX_END) { px_ptrs(p, i2, s_, da); px_dma(s_, l0, lane); asm volatile("s_waitcnt vmcnt(8)" ::: "memory"); } else asm volatile("s_waitcnt vmcnt(0)" ::: "memory");
        px_out(db, scr + 2048, lane);
        asm volatile("s_waitcnt lgkmcnt(0)" ::: "memory");
        it = i2;
    }
}
#endif
__device__ __forceinline__ void p1_row(const Ptrs& p, int row, int lane, const LAS float* vg  , const LAS float* vs  ) {
    const float* src = row < M ? p.x + (size_t)row * D : p.ctx + (size_t)(row - M) * D;
    f32x4 v[8]; float s = 0.f;
#pragma unroll
    for (int j = 0; j < 8; ++j) { v[j] = *(const f32x4*)(src + j * 256 + lane * 4); s += dot4(v[j]); }
    const float rs = rsqrtf(wave_sum(s) * (1.f / D) + EPS);
    bf16* o = (bf16*)(p.ws + WS_H) + (size_t)row * D;
#pragma unroll
    for (int j = 0; j < 8; ++j) { const int c = j * 256 + lane * 4; const f32x4 h = v[j] * rs * *(const LAS f32x4*)(vg + c) + *(const LAS f32x4*)(vs + c);
        *(unsigned long long*)(o + c) = (unsigned long long)pk2(h[0], h[1]) | ((unsigned long long)pk2(h[2], h[3]) << 32); }
}
typedef float f32x16 __attribute__((ext_vector_type(16)));
typedef short bf16x8v __attribute__((ext_vector_type(8)));
struct SguIn { v4u vs[4]; };
__device__ __forceinline__ void sgu_fetch(const Ptrs& p, int chunk, int g, int tid, SguIn& in) {
    const bf16* src = (const bf16*)(p.ws + WS_VS) + (size_t)(chunk * 128 + (tid >> 2)) * 1024 + g * 128 + (tid & 3) * 32;
#pragma unroll
    for (int j = 0; j < 4; ++j) in.vs[j] = *(const v4u*)(src + j * 8);
}
__device__ __forceinline__ void sgu_unit(const Ptrs& p, int chunk, int g, LAS unsigned char* lds, int tid, const SguIn& in) {
    constexpr int VROW = 272;
    const int lane = tid & 63, wid = tid >> 6;
    const int pb = wid >> 1, ch = wid & 1, r32 = lane & 31, hi = lane >> 5;
    v4u uw[4];
#pragma unroll
    for (int i = 0; i < 4; ++i) { const int id = tid + NTHREADS * i, pr = id >> 4, c8 = (id & 15) * 8; uw[i] = *(const v4u*)((const bf16*)(p.ws + WS_U) + ((size_t)chunk * 128 + pr) * 1024 + g * 128 + c8); }
    bf16x8v wa[8];
    { const bf16* wrow = (const bf16*)(p.ws + WS_SGUW) + ((size_t)g * 128 + pb * 32 + r32) * 128 + hi * 8;
#pragma unroll
      for (int ks = 0; ks < 8; ++ks) wa[ks] = *(const bf16x8v*)(wrow + ks * 16); }
    {
        const int q = tid >> 2, cg = tid & 3;
        float x[32];
#pragma unroll
        for (int j = 0; j < 4; ++j) { const v4u w = in.vs[j];
#pragma unroll
            for (int t = 0; t < 4; ++t) { x[j * 8 + 2 * t] = __uint_as_float(w[t] << 16); x[j * 8 + 2 * t + 1] = __uint_as_float(w[t] & 0xffff0000u); } }
        float s = 0.f;
#pragma unroll
        for (int j = 0; j < 32; ++j) s += x[j];
        s += __shfl_xor(s, 1); s += __shfl_xor(s, 2);
        const float mu = s * (1.f / 128.f); float vq = 0.f;
#pragma unroll
        for (int j = 0; j < 32; ++j) { x[j] -= mu; vq += x[j] * x[j]; }
        vq += __shfl_xor(vq, 1); vq += __shfl_xor(vq, 2);
        const float rs = rsqrtf(vq * (1.f / 128.f) + EPS);
        const float* gw = p.sgu_norm_w + g * 128 + cg * 32;
#pragma unroll
        for (int j = 0; j < 32; ++j) *(LAS bf16*)(lds + (cg * 32 + j) * VROW + q * 2) = f2bf(x[j] * rs * gw[j]);
    }
    LDS_WAIT(); __syncthreads();
    f32x16 acc0 = {}, acc1 = {};
#pragma unroll
    for (int ks = 0; ks < 8; ++ks) {
        const bf16x8v b0 = *(const LAS bf16x8v*)(lds + (ch * 64 + r32) * VROW + (ks * 16 + hi * 8) * 2);
        const bf16x8v b1 = *(const LAS bf16x8v*)(lds + (ch * 64 + 32 + r32) * VROW + (ks * 16 + hi * 8) * 2);
        acc0 = __builtin_amdgcn_mfma_f32_32x32x16_bf16(wa[ks], b0, acc0, 0, 0, 0);
        acc1 = __builtin_amdgcn_mfma_f32_32x32x16_bf16(wa[ks], b1, acc1, 0, 0, 0);
    }
    LAS float* T = (LAS float*)(lds + 36864);
#pragma unroll
    for (int r = 0; r < 16; ++r) { const int pr = pb * 32 + (r & 3) + 8 * (r >> 2) + 4 * hi; const float bias = p.sgu_b[g * 128 + pr];
        T[pr * 128 + ch * 64 + r32] = acc0[r] + bias; T[pr * 128 + ch * 64 + 32 + r32] = acc1[r] + bias; }
    LDS_WAIT(); __syncthreads();
#pragma unroll
    for (int i = 0; i < 4; ++i) { const int id = tid + NTHREADS * i, pr = id >> 4, c8 = (id & 15) * 8; const size_t tok = (size_t)chunk * 128 + pr;
        const f32x4 m0 = *(const LAS f32x4*)(T + pr * 128 + c8), m1 = *(const LAS f32x4*)(T + pr * 128 + c8 + 4); const v4u u4 = uw[i];
        v4u o; o.x = pg8::cvt_pk_bf16(__uint_as_float(u4.x << 16) * m0[0], __uint_as_float(u4.x & 0xffff0000u) * m0[1]); o.y = pg8::cvt_pk_bf16(__uint_as_float(u4.y << 16) * m0[2], __uint_as_float(u4.y & 0xffff0000u) * m0[3]);
        o.z = pg8::cvt_pk_bf16(__uint_as_float(u4.z << 16) * m1[0], __uint_as_float(u4.z & 0xffff0000u) * m1[1]); o.w = pg8::cvt_pk_bf16(__uint_as_float(u4.w << 16) * m1[2], __uint_as_float(u4.w & 0xffff0000u) * m1[3]);
        *(v4u*)((bf16*)(p.ws + WS_CAT) + tok * D + 1024 + g * 128 + c8) = o; }
    __syncthreads();
}
__device__ __forceinline__ void topk_unit(const Ptrs& p, int e, int b, LAS unsigned* sh, int tid) {
    const int lane = tid & 63, wid = tid >> 6;
    const float* aff = (const float*)(p.ws + WS_AFF) + (size_t)b * L * 16 + e;
    unsigned key[8];
#pragma unroll
    for (int j = 0; j < 8; ++j) key[j] = __float_as_uint(aff[(size_t)(tid * 8 + j) * 16]);
    unsigned prefix = 0u, mask = 0u, need = CAP;
    for (int shift = 24; shift >= 0; shift -= 8) {
        if (tid < 256) sh[tid] = 0u;
        __syncthreads();
#pragma unroll
        for (int j = 0; j < 8; ++j) if ((key[j] & mask) == prefix) atomicAdd((unsigned*)&sh[(key[j] >> shift) & 255u], 1u);
        __syncthreads();
        if (wid == 0) {
            const unsigned c0 = sh[4 * lane], c1 = sh[4 * lane + 1], c2 = sh[4 * lane + 2], c3 = sh[4 * lane + 3];
            const unsigned s = c0 + c1 + c2 + c3; unsigned S = s;
#pragma unroll
            for (int d = 1; d < 64; d <<= 1) { const unsigned v = __shfl_down(S, d); if (lane + d < 64) S += v; }
            const unsigned above = S - s;
            if (S >= need && above < need) { unsigned cum = above, bin, nd;
                if (cum + c3 >= need) { bin = 3; nd = need - cum; } else { cum += c3;
                if (cum + c2 >= need) { bin = 2; nd = need - cum; } else { cum += c2;
                if (cum + c1 >= need) { bin = 1; nd = need - cum; } else { cum += c1; bin = 0; nd = need - cum; } } }
                sh[256] = 4u * lane + bin; sh[257] = nd; }
        }
        __syncthreads();
        prefix |= sh[256] << shift; mask |= 255u << shift; need = sh[257];
        __syncthreads();
    }
    unsigned cg = 0u, ce = 0u;
#pragma unroll
    for (int j = 0; j < 8; ++j) { cg += key[j] > prefix ? 1u : 0u; ce += key[j] == prefix ? 1u : 0u; }
    unsigned pk = (cg << 16) | ce, inc = pk;
#pragma unroll
    for (int d = 1; d < 64; d <<= 1) { const unsigned v = __shfl_up(inc, d); if (lane >= d) inc += v; }
    if (lane == 63) sh[264 + wid] = inc;
    __syncthreads();
    unsigned off = 0u;
#pragma unroll
    for (int w = 0; w < 8; ++w) off += (w < wid) ? sh[264 + w] : 0u;
    unsigned ex = off + inc - pk; unsigned gtb = ex >> 16, eqb = ex & 0xffffu;
    int* inv = (int*)(p.ws + WS_INV) + (size_t)(b * L + tid * 8) * 16 + e; int* idx = (int*)(p.ws + WS_IDX) + (size_t)(e * 4 + b) * CAP;
#pragma unroll
    for (int j = 0; j < 8; ++j) { const bool gt = key[j] > prefix, eq = key[j] == prefix; const bool sel = gt || (eq && eqb < need);
        const unsigned slot = gtb + (eqb < need ? eqb : need);
        inv[(size_t)j * 16] = sel ? (int)slot : -1; if (sel) idx[slot] = tid * 8 + j;
        gtb += gt ? 1u : 0u; eqb += eq ? 1u : 0u; }
    __syncthreads();
}

__device__ __forceinline__ f32x4 ld_bf16x4(const bf16* s) { const unsigned long long w = *(const unsigned long long*)s; const unsigned lo = (unsigned)w, hi2 = (unsigned)(w >> 32);
    return (f32x4){__uint_as_float(lo << 16), __uint_as_float(lo & 0xffff0000u), __uint_as_float(hi2 << 16), __uint_as_float(hi2 & 0xffff0000u)}; }
__device__ __forceinline__ void st_bf16x4(bf16* d, const f32x4& h) { *(unsigned long long*)d = (unsigned long long)pk2(h[0], h[1]) | ((unsigned long long)pk2(h[2], h[3]) << 32); }
struct P6In { f32x4 x[8]; unsigned long long y[8]; float ssq; };
__device__ __forceinline__ void p6_fetch(const Ptrs& p, int row, int lane, P6In& in) {
    const float* xr = p.x + (size_t)row * D + lane * 4; const bf16* y = (const bf16*)(p.ws + WS_Y) + (size_t)row * D + lane * 4;
#pragma unroll
    for (int j = 0; j < 8; ++j) { in.x[j] = *(const f32x4*)(xr + j * 256); in.y[j] = *(const unsigned long long*)(y + j * 256); }
    in.ssq = lane < 32 ? ((const float*)(p.ws + WS_SSQY))[(size_t)row * 32 + lane] : 0.f;
}
__device__ __forceinline__ f32x4 bf16x4_to_f32(unsigned long long w) { const unsigned lo = (unsigned)w, hi2 = (unsigned)(w >> 32);
    return (f32x4){__uint_as_float(lo << 16), __uint_as_float(lo & 0xffff0000u), __uint_as_float(hi2 << 16), __uint_as_float(hi2 & 0xffff0000u)}; }
__device__ __forceinline__ void p6_row(const Ptrs& p, int row, int lane, const LAS float* wt, const LAS float* vt, const P6In& in, int flags) {
    const float rsy = rsqrtf(wave_sum(in.ssq) * (1.f / D) + EPS);
    bf16* o = (bf16*)(p.ws + ((flags & 1) ? WS_VN : WS_XN)) + (size_t)row * D;
    f32x4 v[8]; float s = 0.f;
#pragma unroll
    for (int j = 0; j < 8; ++j) { const int c = j * 256 + lane * 4;
        v[j] = in.x[j] + (bf16x4_to_f32(in.y[j]) * rsy) * *(const LAS f32x4*)(vt + c);
        st_bf16x4(o + c, v[j]); s += dot4(v[j]); }
    const float rs = rsqrtf(wave_sum(s) * (1.f / D) + EPS);
    bf16* h2 = (bf16*)(p.ws + ((flags & 1) ? WS_VN : WS_H2)) + (size_t)row * D;
    float lg[16];
#pragma unroll
    for (int e = 0; e < 16; ++e) lg[e] = 0.f;
    f32x4 hv[8];
#pragma unroll
    for (int j = 0; j < 8; ++j) { const int c = j * 256 + lane * 4;
        hv[j] = v[j] * rs * *(const LAS f32x4*)(vt + 2048 + c) + *(const LAS f32x4*)(vt + 4096 + c);
        if constexpr (FP8_MOE) *(unsigned*)((unsigned char*)(p.ws + ((flags & 1) ? WS_VN : WS_H2)) + (size_t)row * D + c) = pack4_fp8(hv[j][0], hv[j][1], hv[j][2], hv[j][3]); else st_bf16x4(h2 + c, hv[j]); }
    if (!(flags & 2)) {
        f32x4 wa[8], wb[8];
#define RLOAD(dst, st) do { const LAS float* wp_ = wt + ((st) & 1) * 8 * 2048 + ((st) >> 1) * 256 + lane * 4; _Pragma("unroll") for (int e_ = 0; e_ < 8; ++e_) dst[e_] = *(const LAS f32x4*)(wp_ + e_ * 2048); } while (0)
#define RFMA(src, st) do { const f32x4 h_ = hv[(st) >> 1]; _Pragma("unroll") for (int e_ = 0; e_ < 8; ++e_) lg[((st) & 1) * 8 + e_] += (h_[0] * src[e_][0] + h_[1] * src[e_][1]) + (h_[2] * src[e_][2] + h_[3] * src[e_][3]); } while (0)
        RLOAD(wa, 0);
#pragma unroll
        for (int st = 0; st < 16; st += 2) {
            RLOAD(wb, st + 1); __builtin_amdgcn_sched_barrier(0); RFMA(wa, st); __builtin_amdgcn_sched_barrier(0);
            if (st + 2 < 16) RLOAD(wa, st + 2); __builtin_amdgcn_sched_barrier(0); RFMA(wb, st + 1); __builtin_amdgcn_sched_barrier(0);
        }
#undef RLOAD
#undef RFMA
    }
#define XSTEP(N, MASK) _Pragma("unroll") for (int i = 0; i < N; ++i) { const bool up = (lane & MASK) != 0; const float send = up ? lg[i] : lg[i + N]; const float keep = up ? lg[i + N] : lg[i]; lg[i] = keep + __shfl_xor(send, MASK); }
    XSTEP(8, 32) XSTEP(4, 16) XSTEP(2, 8) XSTEP(1, 4)
#undef XSTEP
    float lgt = lg[0]; lgt += __shfl_xor(lgt, 2); lgt += __shfl_xor(lgt, 1);
    lgt += p.b_router[lane >> 2];
    float mx = lgt;
#pragma unroll
    for (int o2 = 4; o2 < 64; o2 <<= 1) mx = fmaxf(mx, __shfl_xor(mx, o2));
    const float ex = __expf(lgt - mx); float se = ex;
#pragma unroll
    for (int o2 = 4; o2 < 64; o2 <<= 1) se += __shfl_xor(se, o2);
    if ((lane & 3) == 0 && !(flags & 1)) ((float*)(p.ws + WS_AFF))[(size_t)row * 16 + (lane >> 2)] = ex / se;
}
typedef unsigned u32x4v __attribute__((ext_vector_type(4)));
struct P11In { u32x4v x[4]; int inv; float aff; };
__device__ __forceinline__ void p11_fetch(const Ptrs& p, int row, int lane, P11In& in) {
    const bf16* xr = (const bf16*)(p.ws + WS_XN) + (size_t)row * D + lane * 8;
#pragma unroll
    for (int j = 0; j < 4; ++j) in.x[j] = *(const u32x4v*)(xr + j * 512);
    in.inv = ((const int*)(p.ws + WS_INV))[(size_t)row * 16 + (lane & 15)]; in.aff = ((const float*)(p.ws + WS_AFF))[(size_t)row * 16 + (lane & 15)];
}
__device__ __forceinline__ void acc_bf16x8(f32x4& a, f32x4& b, const u32x4v& w, float g) {
    a[0] += g * __uint_as_float(w[0] << 16); a[1] += g * __uint_as_float(w[0] & 0xffff0000u); a[2] += g * __uint_as_float(w[1] << 16); a[3] += g * __uint_as_float(w[1] & 0xffff0000u);
    b[0] += g * __uint_as_float(w[2] << 16); b[1] += g * __uint_as_float(w[2] & 0xffff0000u); b[2] += g * __uint_as_float(w[3] << 16); b[3] += g * __uint_as_float(w[3] & 0xffff0000u);
}
__device__ __forceinline__ void p11_row(const Ptrs& p, int row, int lane, float* dsto, const LAS float* vt, const P11In& in, int flags) {
    const int b = row >> 12;
    unsigned mask = (flags & 2) ? 0u : (unsigned)(__ballot(in.inv >= 0) & 0xffffull);
    f32x4 v[8];
#pragma unroll
    for (int j = 0; j < 8; ++j) v[j] = (f32x4){0.f, 0.f, 0.f, 0.f};
    while (mask) {
#if FP8_MOE
        unsigned long long r[4][4]; float g[4]; bool on[4];
#pragma unroll
        for (int k = 0; k < 4; ++k) { on[k] = mask != 0u; g[k] = 0.f;
            if (on[k]) { const int e = __builtin_ctz(mask); mask &= mask - 1u; const int sl = __builtin_amdgcn_readlane(in.inv, e); g[k] = __int_as_float(__builtin_amdgcn_readlane(__float_as_int(in.aff), e));
                const unsigned char* ye = p.ws + WS_YE + ((size_t)(e * 4 + b) * CAP + sl) * D + lane * 8;
#pragma unroll
                for (int j = 0; j < 4; ++j) r[k][j] = *(const unsigned long long*)(ye + j * 512); } }
#pragma unroll
        for (int k = 0; k < 4; ++k) if (on[k]) {
#pragma unroll
            for (int j = 0; j < 4; ++j) { const int lo32 = (int)(unsigned)r[k][j], hi32 = (int)(unsigned)(r[k][j] >> 32);
                const auto a0 = __builtin_amdgcn_cvt_pk_f32_fp8(lo32, false), a1 = __builtin_amdgcn_cvt_pk_f32_fp8(lo32, true), b0 = __builtin_amdgcn_cvt_pk_f32_fp8(hi32, false), b1 = __builtin_amdgcn_cvt_pk_f32_fp8(hi32, true);
                v[2 * j][0] += g[k] * a0[0]; v[2 * j][1] += g[k] * a0[1]; v[2 * j][2] += g[k] * a1[0]; v[2 * j][3] += g[k] * a1[1];
                v[2 * j + 1][0] += g[k] * b0[0]; v[2 * j + 1][1] += g[k] * b0[1]; v[2 * j + 1][2] += g[k] * b1[0]; v[2 * j + 1][3] += g[k] * b1[1]; } }
#else
        u32x4v r[4][4]; float g[4]; bool on[4];
#pragma unroll
        for (int k = 0; k < 4; ++k) { on[k] = mask != 0u; g[k] = 0.f;
            if (on[k]) { const int e = __builtin_ctz(mask); mask &= mask - 1u; const int sl = __builtin_amdgcn_readlane(in.inv, e); g[k] = __int_as_float(__builtin_amdgcn_readlane(__float_as_int(in.aff), e));
                const bf16* ye = (const bf16*)(p.ws + WS_YE) + ((size_t)(e * 4 + b) * CAP + sl) * D + lane * 8;
#pragma unroll
                for (int j = 0; j < 4; ++j) r[k][j] = *(const u32x4v*)(ye + j * 512); } }
#pragma unroll
        for (int k = 0; k < 4; ++k) if (on[k]) {
#pragma unroll
            for (int j = 0; j < 4; ++j) acc_bf16x8(v[2 * j], v[2 * j + 1], r[k][j], g[k]); }
#endif
    }
    float s = 0.f;
#pragma unroll
    for (int j = 0; j < 8; ++j) s += dot4(v[j]);
    const float rs = rsqrtf(wave_sum(s) * (1.f / D) + EPS);
    float* od = dsto + (size_t)row * D + lane * 8;
#pragma unroll
    for (int j = 0; j < 4; ++j) { const int c = j * 512 + lane * 8;
        const u32x4v xw = in.x[j];
        const f32x4 xa = (f32x4){__uint_as_float(xw[0] << 16), __uint_as_float(xw[0] & 0xffff0000u), __uint_as_float(xw[1] << 16), __uint_as_float(xw[1] & 0xffff0000u)};
        const f32x4 xb = (f32x4){__uint_as_float(xw[2] << 16), __uint_as_float(xw[2] & 0xffff0000u), __uint_as_float(xw[3] << 16), __uint_as_float(xw[3] & 0xffff0000u)};
        *(f32x4*)(od + j * 512) = xa + (v[2 * j] * rs) * *(const LAS f32x4*)(vt + c);
        *(f32x4*)(od + j * 512 + 4) = xb + (v[2 * j + 1] * rs) * *(const LAS f32x4*)(vt + c + 4); }
}

struct Args { Ptrs p; int ph_lo, ph_hi, bar_idx, pad; };
#define PROBE_FLAGS 0
__global__ void __launch_bounds__(NTHREADS, 2) fwd(Args args) {
    extern __shared__ __attribute__((aligned(16))) unsigned char lds_raw[];
    LAS unsigned char* lds = (LAS unsigned char*)lds_raw;
#if defined(__HIP_DEVICE_COMPILE__)
    typedef __attribute__((address_space(4))) const Args CArgs;
#define LOADP() Ptrs p; { const CArgs* kp_ = (const CArgs*)__builtin_amdgcn_kernarg_segment_ptr(); asm volatile("" : "+s"(kp_)); p = kp_->p; }
#else
#define LOADP() Ptrs p = args.p;
#endif
#define TIDS() int tid = threadIdx.x; asm volatile("" : "+v"(tid)); const int lane = tid & 63, wave = __builtin_amdgcn_readfirstlane(tid >> 6); \
    const int G = gridDim.x, bx = blockIdx.x, vcu = (G % 8 == 0) ? (bx % 8) * (G / 8) + bx / 8 : bx; const int gw = vcu * NWAVES + wave, NGW = G * NWAVES; (void)lane; (void)gw; (void)NGW; (void)vcu; (void)bx;
    volatile LAS unsigned* MISC = (volatile LAS unsigned*)(lds + MISC_OFF);
    if (threadIdx.x < 64) MISC[threadIdx.x] = 0u;
    __syncthreads();
#if defined(__HIP_DEVICE_COMPILE__)
#define ARGF(f) ([&]() { const CArgs* kq_ = (const CArgs*)__builtin_amdgcn_kernarg_segment_ptr(); asm volatile("" : "+s"(kq_)); return kq_->f; }())
#else
#define ARGF(f) (args.f)
#endif
    if (ARGF(ph_hi) - ARGF(ph_lo) > 1) { LOADP(); (void)xcd_barrier_post((unsigned*)(p.ws + WS_CTL) + CW_BAR + ARGF(bar_idx) * 4096, MISC + 8); }
#define GRID_BARRIER() do { LOADP(); XcdBarrier b_; b_.bar = (unsigned*)(p.ws + WS_CTL) + CW_BAR + ARGF(bar_idx) * 4096; b_.x = xb_xcc_id(); b_.st = (volatile LAS unsigned*)(lds + MISC_OFF) + 8; xcd_barrier(b_); } while (0)
#define lo ARGF(ph_lo)
#define hi ARGF(ph_hi)
#if defined(ONLY_SET)
#define IN(k) (((ONLY_SET >> (k)) & 1) && lo <= (k) && (k) < hi)
#elif defined(ONLY_PHASE)
#define IN(k) ((k) == ONLY_PHASE && lo <= (k) && (k) < hi)
#else
#define IN(k) (lo <= (k) && (k) < hi)
#endif
#define SEAM(k) do { if (IN(k) && IN((k) + 1)) GRID_BARRIER(); } while (0)

    if (IN(0)) { LOADP(); TIDS();
        LAS float* scr = (LAS float*)(lds + wave * 8448);
        for (int it = gw; it < P0_ITEMS; it += NGW) p0_item(p, it, scr, lane);
    }
    SEAM(0);
    if (IN(1)) { LOADP(); TIDS();
        const int gid = bx * NTHREADS + tid;
        if (gid < 5 * 12288) { const int r = gid / 12288, j = gid - r * 12288; float s = p.b_ada[j]; const float* part = (const float*)(p.ws + WS_PART) + (size_t)r * 12288 + j;
            for (int kc = 0; kc < 32; ++kc) s += part[(size_t)kc * 5 * 12288];
            ((float*)(p.ws + WS_MOD))[gid] = s; }
    }
    SEAM(1);
    if (IN(2)) { LOADP(); TIDS();
        const int bsel = vcu & 3, wsub = (vcu >> 2) * NWAVES + wave, nsub = ((G + 3 - bsel) >> 2) * NWAVES;
        LAS float* vt = (LAS float*)lds;
        for (int c = tid; c < D; c += NTHREADS) { const float* mb = (const float*)(p.ws + WS_MOD) + bsel * 12288; const float* mc = (const float*)(p.ws + WS_MOD) + 4 * 12288; const float g = p.pre_norm1[c];
            vt[c] = g * (1.f + mb[2048 + c]); vt[2048 + c] = mb[c]; vt[4096 + c] = g * (1.f + mc[2048 + c]); vt[6144 + c] = mc[c]; }
        LDS_WAIT(); __syncthreads();
        for (int r = wsub; r < L; r += nsub) p1_row(p, bsel * L + r, lane, vt, vt + 2048);
        for (int row = M + gw; row < MALL; row += NGW) p1_row(p, row, lane, vt + 4096, vt + 6144);
        __syncthreads();
    }
    SEAM(2);
    if (IN(3)) { LOADP(); TIDS();
        SchedIn S{(const char*)(p.ws + WS_H), (const char*)(p.ws + WS_WIN_T), G, bx}; EpiIn E{p.ws};
        pg8::gemm_phase<EpiIn, SchedIn>(lds, 2048, S, E);
        if (G == 256 && bx >= 76) { const int base = PX_R3 + (bx - 76) * PX_N3; px_convert(p, base + wave, NWAVES, base + PX_N3, (LAS float*)(lds + wave * 16384), lane); __syncthreads(); }
    }
    SEAM(3);
    if (IN(4)) { LOADP(); TIDS();
        SchedQKV S{(const char*)(p.ws + WS_CQKV), (const char*)(p.ws + WS_WQKV_T), G, bx};
        LAS float* rstab = (LAS float*)(lds + TAB_OFF);
        for (int q = tid; q < 2048; q += NTHREADS) { const int i = q >> 8, r = q & 255; Unit u;
            if (S.next(i, u)) { const float* sp = u.pm < 64 ? (const float*)(p.ws + WS_SSQQ) + (size_t)(u.pm * 256 + r) * 8 : (const float*)(p.ws + WS_SSQKV) + (size_t)((u.pm - 64) * 256 + r) * 8;
                const f32x4 s0 = *(const f32x4*)sp, s1 = *(const f32x4*)(sp + 4);
                rstab[q] = rsqrtf((((s0[0] + s0[1]) + (s0[2] + s0[3])) + ((s1[0] + s1[1]) + (s1[2] + s1[3]))) * (1.f / 512.f) + EPS); } }
        LDS_WAIT(); __syncthreads();
        EpiQKV E{p.ws, rstab};
        pg8::gemm_phase<EpiQKV, SchedQKV>(lds, 512, S, E);
        if (G == 256 && bx >= 160) { const int base = PX_R4 + (bx - 160) * PX_N4; px_convert(p, base + wave, NWAVES, base + PX_N4, (LAS float*)(lds + wave * 16384), lane); }
        __syncthreads();
#ifdef SGU_REP
        for (int rep_ = 0; rep_ < SGU_REP; ++rep_)
#endif
        { SguIn nxt; if (vcu < 1024) sgu_fetch(p, vcu >> 3, vcu & 7, tid, nxt);
          for (int u = vcu; u < 1024; u += G) { const SguIn cur = nxt; if (u + G < 1024) sgu_fetch(p, (u + G) >> 3, (u + G) & 7, tid, nxt); sgu_unit(p, u >> 3, u & 7, lds, tid, cur); } }
    }
    SEAM(4);
    if (IN(5)) { TIDS();
        att::CvStream cv; { LOADP(); cv.it = gw; cv.end = FP8_MOE ? att::CV_ITEMS : 0; cv.step = NGW; cv.gate = p.w_e_gate; cv.up = p.w_e_up; cv.down = p.w_e_down; cv.wgu = p.ws + WS_WGU_T; cv.wd = p.ws + WS_WD_T; }
#define ATT_UNIT(u_) do { const int u = (u_); if (u < 512) { LOADP(); const int bh = u >> 4, qb = u & 15; __syncthreads(); \
            att::attn_unit<0>((const bf16*)(p.ws + WS_Q) + ((size_t)bh * L + qb * 256) * DQK, (const bf16*)(p.ws + WS_K) + (size_t)bh * LK * DQK, (const bf16*)(p.ws + WS_V) + (size_t)bh * LK * VH, \
                           (bf16*)(p.ws + WS_CAT) + ((size_t)(bh >> 3) * L + qb * 256) * D + (bh & 7) * 128, LK, (char*)lds_raw, cv); } } while (0)
        ATT_UNIT(vcu); ATT_UNIT(vcu + G);
        for (int u = vcu + 2 * G; u < 512; u += G) ATT_UNIT(u);
#undef ATT_UNIT
        __syncthreads();
        while (cv.it < cv.end) {
            att::cv_issue(cv, (unsigned)(uintptr_t)((char*)lds_raw + att::SHM_ATTN + wave * 4096), lane); asm volatile("s_waitcnt vmcnt(0)" ::: "memory");
            att::cv_finish(cv, (const float*)((char*)lds_raw + att::SHM_ATTN + wave * 4096), lane); asm volatile("s_waitcnt lgkmcnt(0)" ::: "memory"); }
        __syncthreads();
    }
    SEAM(5);
    if (IN(6)) { LOADP(); TIDS();
        typedef SchedDense<64, 8, 31, 2048> SD; SD S{(const char*)(p.ws + WS_CAT), (const char*)(p.ws + WS_WOUT_T), G, bx}; EpiY E{p.ws};
        pg8::gemm_phase<EpiY, SD>(lds, 2048, S, E);
    }
    SEAM(6);
    if (IN(7)) { LOADP(); TIDS();
        LAS float* wt = (LAS float*)lds;
        for (int c = tid; c < D; c += NTHREADS) { const float* wr = p.w_router + (size_t)c * 16;
#pragma unroll
            for (int q = 0; q < 4; ++q) { const f32x4 w = *(const f32x4*)(wr + q * 4);
#pragma unroll
                for (int t = 0; t < 4; ++t) wt[(q * 4 + t) * 2048 + c] = w[t]; } }
        LDS_WAIT(); __syncthreads();
        const int bsel = vcu & 3, wsub = (vcu >> 2) * NWAVES + wave, nsub = ((G + 3 - bsel) >> 2) * NWAVES;
        LAS float* vt = (LAS float*)(lds + VEC_OFF);
        for (int c = tid; c < D; c += NTHREADS) { const float* mb = (const float*)(p.ws + WS_MOD) + bsel * 12288;
            vt[c] = mb[4096 + c] * p.post_norm1[c]; vt[2048 + c] = p.pre_norm2[c] * (1.f + mb[8192 + c]); vt[4096 + c] = mb[6144 + c]; }
        LDS_WAIT(); __syncthreads();
        { P6In nxt; if (wsub < L) p6_fetch(p, bsel * L + wsub, lane, nxt);
          for (int r = wsub; r < L; r += nsub) { const P6In cur = nxt; if (r + nsub < L) p6_fetch(p, bsel * L + r + nsub, lane, nxt);
              p6_row(p, bsel * L + r, lane, wt, vt, cur, PROBE_FLAGS); } }
        __syncthreads();
    }
    SEAM(7);
    if (IN(8)) { LOADP(); TIDS(); for (int u = bx; u < 64; u += G) topk_unit(p, u >> 2, u & 3, (LAS unsigned*)lds, tid);
        if (G == 256 && bx >= 64) { const int base = PX_R8 + (bx - 64) * PX_N8; px_convert(p, base + wave, NWAVES, base + PX_N8, (LAS float*)(lds + wave * 16384), lane); } }
    SEAM(8);
    if (IN(9)) { LOADP(); TIDS();
        constexpr int KU = FP8_MOE ? 1024 : 2048;
        typedef SchedGather<KU> SG; SG S{(const char*)(p.ws + WS_H2), (const char*)(p.ws + WS_WGU_T), G, bx, (const LAS unsigned*)(lds + TAB_OFF)};
        for (int q = tid; q < 2048; q += NTHREADS) { const int i = q >> 8, r = q & 255; Unit u;
            if (S.next(i, u)) { const int e = u.pm >> 3, m = (u.pm & 7) * 256 + r, b = m >> 9; const int tok = ((const int*)(p.ws + WS_IDX))[(size_t)(e * 4 + b) * CAP + (m & 511)];
                ((LAS unsigned*)(lds + TAB_OFF))[q] = (unsigned)(b * L + tok) * (unsigned)(KU * 2); } }
        LDS_WAIT(); __syncthreads();
        if constexpr (FP8_MOE) { EpiAct8 E{p.ws}; pg8::gemm_phase<EpiAct8, SG, true>(lds, KU, S, E); }
        else { EpiAct E{p.ws}; pg8::gemm_phase<EpiAct, SG, false>(lds, KU, S, E); }
    }
    SEAM(9);
    if (IN(10)) { LOADP(); TIDS();
        constexpr int KU = FP8_MOE ? 1024 : 2048;
        typedef SchedDense<128, 8, 3, KU> SD; SD S{(const char*)(p.ws + WS_ACT), (const char*)(p.ws + WS_WD_T), G, bx};
        if constexpr (FP8_MOE) { EpiYE8 E{p.ws}; pg8::gemm_phase<EpiYE8, SD, true>(lds, KU, S, E); }
        else { EpiYE E{p.ws}; pg8::gemm_phase<EpiYE, SD, false>(lds, KU, S, E); }
    }
    SEAM(10);
    if (IN(11)) { LOADP(); TIDS(); float* dsto = p.out;
        const int bsel = vcu & 3, wsub = (vcu >> 2) * NWAVES + wave, nsub = ((G + 3 - bsel) >> 2) * NWAVES;
        LAS float* vt = (LAS float*)(lds + VEC_OFF);
        for (int c = tid; c < D; c += NTHREADS) vt[c] = ((const float*)(p.ws + WS_MOD))[bsel * 12288 + 10240 + c] * p.post_norm2[c];
        LDS_WAIT(); __syncthreads();
        P11In nxt; if (wsub < L) p11_fetch(p, bsel * L + wsub, lane, nxt);
        for (int r = wsub; r < L; r += nsub) { const P11In cur = nxt; if (r + nsub < L) p11_fetch(p, bsel * L + r + nsub, lane, nxt); p11_row(p, bsel * L + r, lane, dsto, vt, cur, PROBE_FLAGS); } }
#ifdef PROBE_GEMM
    if (IN(13)) { LOADP(); TIDS();
        struct SP : SchedDense<64, 8, 31, 2048> { __device__ __forceinline__ const char* a_base(const Unit& u) const { return (PROBE_GEMM & 2) ? A : A + (size_t)u.pm * (512 * 2048); }
                                                   __device__ __forceinline__ const char* b_base(const Unit& u) const { return (PROBE_GEMM & 1) ? Bt : Bt + (size_t)u.pn * (512 * 2048); } };
        SP S; S.A = (const char*)(p.ws + WS_CAT); S.Bt = (const char*)(p.ws + WS_WOUT_T); S.G = G; S.c = bx; EpiY E{p.ws};
        pg8::gemm_phase<EpiY, SP>(lds, 2048, S, E); }
#endif
#ifdef PROBE_ATTN
    if (IN(12)) { TIDS();
        att::CvStream cvd; cvd.it = 0; cvd.end = 0; cvd.step = 1;
        for (int u = vcu; u < 512; u += G) { LOADP(); const int bh = u >> 4, qb = u & 15; __syncthreads();
            att::attn_unit<PROBE_ATTN>((const bf16*)(p.ws + WS_Q) + ((size_t)bh * L + qb * 256) * DQK, (const bf16*)(p.ws + WS_K) + (size_t)bh * LK * DQK, (const bf16*)(p.ws + WS_V) + (size_t)bh * LK * VH,
                           (bf16*)(p.ws + WS_S) + ((size_t)(bh >> 3) * L + qb * 256) * D + (bh & 7) * 128, LK, (char*)lds_raw, cvd); }
        __syncthreads(); }
#endif
#undef IN
#undef SEAM
#undef lo
#undef hi
}

#ifndef PHASE_MODE
#define PHASE_MODE "FFFFFFFFFFFF"
#endif
#ifndef DUP_FLAGS
#define DUP_FLAGS 0
#endif
#ifndef MERGE
#define MERGE 1
#endif
#if !defined(FINAL_BUILD)
template <class P> static void launch_ngemm(const P& f, int Mr, int Nr, int Z, hipStream_t s) { hipLaunchKernelGGL((ngemm<P>), dim3(Nr / 64, Mr / 64, Z), dim3(256), 0, s, f); }
static void naive_phase(int ph, const Ptrs& p, hipStream_t stream) {
    switch (ph) {
    case 0: hipLaunchKernelGGL(n_mod, dim3(48, 5), dim3(256), 0, stream, p); break;
    case 1: break;
    case 2: hipLaunchKernelGGL(n_hrows, dim3(MALL / 4), dim3(256), 0, stream, p); break;
    case 3: launch_ngemm(GIn{p, D}, MALL, 3136, 1, stream);
        hipLaunchKernelGGL(n_ssq, dim3(M / 4), dim3(256), 0, stream, (const bf16*)(p.ws + WS_CQKV), M, 512, (float*)(p.ws + WS_SSQQ), 8);
        hipLaunchKernelGGL(n_ssq, dim3(MALL / 4), dim3(256), 0, stream, (const bf16*)(p.ws + WS_CQKV) + (size_t)M * 512, MALL, 512, (float*)(p.ws + WS_SSQKV), 8); break;
    case 4: launch_ngemm(GQ{p, 512}, M, 1536, 1, stream); launch_ngemm(GKV{p, 512}, MALL, 2048, 1, stream);
        hipLaunchKernelGGL(n_vn, dim3(M * 8 / 4), dim3(256), 0, stream, p); launch_ngemm(GSgu{p, 128}, 128, 128, 1024, stream); break;
    case 5: for (int bh = 0; bh < B * H; ++bh) { launch_ngemm(GScore{p, DQK, bh}, L, LK, 1, stream);
            hipLaunchKernelGGL(n_softmax, dim3(L), dim3(256), 0, stream, (float*)(p.ws + WS_S), LK); launch_ngemm(GPV{p, LK, bh}, L, VH, 1, stream); } break;
    case 6: launch_ngemm(GOut{p, D}, M, D, 1, stream);
        hipLaunchKernelGGL(n_ssq, dim3(M / 4), dim3(256), 0, stream, (const bf16*)(p.ws + WS_Y), M, D, (float*)(p.ws + WS_SSQY), 32); break;
    case 7: hipLaunchKernelGGL(n_rowmid, dim3(M / 4), dim3(256), 0, stream, p); break;
    case 8: hipLaunchKernelGGL(n_topk, dim3(64), dim3(1024), 0, stream, p); break;
    case 9: launch_ngemm(GE1{p, D}, 2048, 4096, 16, stream); break;
    case 10: launch_ngemm(GE2{p, FF}, 2048, 2048, 16, stream); break;
    case 11: hipLaunchKernelGGL(n_rowfinal, dim3(M / 4), dim3(256), 0, stream, p); break;
    }
}
#endif
extern "C" void kernel_launch(void* const* d_in, const int* in_sizes, int n_in, void* d_out, int out_size, void* d_ws, size_t ws_size, hipStream_t stream) {
    static int grid = 0;
    if (grid == 0) {
        if (n_in != 24 || ws_size < WS_END || out_size != M * D) { fprintf(stderr, "kernel_launch: unexpected shapes n_in %d ws %zu out %d\n", n_in, ws_size, out_size); grid = -1; return; }
        int dev = 0, cus = 0, per_cu = 0;
        if (hipGetDevice(&dev) != hipSuccess || hipDeviceGetAttribute(&cus, hipDeviceAttributeMultiprocessorCount, dev) != hipSuccess) { grid = -1; return; }
        if (hipFuncSetAttribute((const void*)fwd, hipFuncAttributeMaxDynamicSharedMemorySize, LDS_BYTES) != hipSuccess) { fprintf(stderr, "kernel_launch: hipFuncSetAttribute failed\n"); grid = -1; return; }
        if (hipOccupancyMaxActiveBlocksPerMultiprocessor(&per_cu, (const void*)fwd, NTHREADS, LDS_BYTES) != hipSuccess || per_cu < 1) fprintf(stderr, "kernel_launch: occupancy query says %d\n", per_cu);
        (void)hipGetLastError();
        grid = cus;
    }
    if (grid < 0) return;
    Ptrs p{};
    const float** f = (const float**)&p;
    for (int i = 0; i < 24; ++i) f[i] = (const float*)d_in[i];
    p.out = (float*)d_out; p.ws = (unsigned char*)d_ws;
    (void)hipMemsetAsync(p.ws + WS_CTL, 0, 1 * MiB, stream);
    const char* mode = PHASE_MODE; int nbar = 0;
    for (int ph = 0; ph < 12;) {
#ifdef DUP_PHASE
        if (ph == 11 && DUP_PHASE == 11) { Args a2{}; a2.p = p; a2.ph_lo = 11; a2.ph_hi = 12; a2.bar_idx = nbar++; a2.pad = 1 | DUP_FLAGS; hipLaunchKernelGGL(fwd, dim3(grid), dim3(NTHREADS), LDS_BYTES, stream, a2); }
#endif
#ifdef PROBE_GEMM
        if (ph == 6) { Args a3{}; a3.p = p; a3.ph_lo = 13; a3.ph_hi = 14; a3.bar_idx = nbar++; hipLaunchKernelGGL(fwd, dim3(grid), dim3(NTHREADS), LDS_BYTES, stream, a3); }
#endif
        if (mode[ph] == 'F') { int e = ph + 1; if (MERGE) while (e < 12 && mode[e] == 'F') ++e;
            Args a{}; a.p = p; a.ph_lo = ph; a.ph_hi = e; a.bar_idx = nbar++; a.pad = 0;
            hipLaunchKernelGGL(fwd, dim3(grid), dim3(NTHREADS), LDS_BYTES, stream, a);
            const hipError_t le = hipPeekAtLastError(); if (le != hipSuccess) fprintf(stderr, "kernel_launch: launch failed: %s\n", hipGetErrorName(le));
#ifdef PROBE_ATTN
            if (ph == 5) { Args a3 = a; a3.ph_lo = 12; a3.ph_hi = 13; a3.bar_idx = nbar++; hipLaunchKernelGGL(fwd, dim3(grid), dim3(NTHREADS), LDS_BYTES, stream, a3); }
#endif
#ifdef DUP_PHASE
            if (ph == DUP_PHASE && ph != 11) { Args a2 = a; a2.bar_idx = nbar++; a2.pad = DUP_FLAGS; hipLaunchKernelGGL(fwd, dim3(grid), dim3(NTHREADS), LDS_BYTES, stream, a2);
                if (ph == 11) hipLaunchKernelGGL(fwd, dim3(grid), dim3(NTHREADS), LDS_BYTES, stream, a2); }
#endif
            ph = e; }
#if !defined(FINAL_BUILD)
        else { naive_phase(ph, p, stream); ++ph; }
#else
        else ++ph;
#endif
    }
}
```

```cpp
#define PHASE_MODE "FFFFFFFFFFFF"
#define MERGE 1
#define FINAL_BUILD 1
#include <hip/hip_runtime.h>
#include <cstdio>
#include <cstdint>

typedef unsigned short bf16;
#ifndef FP8_MOE
#define FP8_MOE 1
#endif
namespace cfg {
constexpr int B = 4, L = 4096, D = 2048, CTX = 256, H = 8, LK = L + CTX;
constexpr int M = B * L;
constexpr int MC = B * CTX;
constexpr int MALL = M + MC;
constexpr int QL = 512, KVL = 512, NOPE = 128, ROPE = 64, VH = 128, DQK = 192;
constexpr int SGW = 1024, INC = 3136, OFF_KPE = 1024, OFF_U = 1088, OFF_V = 2112;
constexpr int NE = 16, CAP = 512, FF = 2048;
constexpr float EPS = 1e-6f;
constexpr float ATT_SCALE = 0.07216878364870322f;
constexpr size_t MiB = 1u << 20;
constexpr size_t WS_CTL = 0;
constexpr size_t WS_MOD = 1 * MiB;
constexpr size_t WS_SSQQ = 2 * MiB;
constexpr size_t WS_SSQKV = 3 * MiB;
constexpr size_t WS_SSQY = 4 * MiB;
constexpr size_t WS_AFF = 6 * MiB;
constexpr size_t WS_INV = 7 * MiB;
constexpr size_t WS_IDX = 8 * MiB;
constexpr size_t WS_WIN_T = 16 * MiB;
constexpr size_t WS_WQKV_T = 30 * MiB;
constexpr size_t WS_WOUT_T = 34 * MiB;
constexpr size_t WS_SGUW = 42 * MiB;
constexpr size_t WS_WGU_T = 64 * MiB;
constexpr size_t WS_WD_T = 320 * MiB;
constexpr size_t WS_H = 448 * MiB;
constexpr size_t WS_CQKV = 516 * MiB;
constexpr size_t WS_U = 549 * MiB;
constexpr size_t WS_VS = 581 * MiB;
constexpr size_t WS_Q = 613 * MiB;
constexpr size_t WS_K = 661 * MiB;
constexpr size_t WS_V = 712 * MiB;
constexpr size_t WS_CAT = 746 * MiB;
constexpr size_t WS_Y = 810 * MiB;
constexpr size_t WS_H2 = WS_CAT;
constexpr size_t WS_ACT = WS_H;
constexpr size_t WS_YE = WS_Q;
constexpr size_t WS_S = 874 * MiB;
constexpr size_t WS_VN = 942 * MiB;
constexpr size_t WS_ROPE = 9 * MiB;
constexpr size_t WS_PART = WS_S;
constexpr size_t WS_XN = WS_S;
constexpr size_t WS_END = 974 * MiB;
}
using namespace cfg;

__device__ __forceinline__ float bf2f(bf16 v) { return __uint_as_float(((unsigned)v) << 16); }
__device__ __forceinline__ bf16 f2bf(float f) { unsigned u = __float_as_uint(f); return (bf16)((u + 0x7fffu + ((u >> 16) & 1u)) >> 16); }
__device__ __forceinline__ float silu_f(float x) { return x / (1.f + __expf(-x)); }
__device__ __forceinline__ float gelu_tanh(float x) { const float z = 0.7978845608028654f * (x + 0.044715f * x * x * x); return 0.5f * x * (1.f + tanhf(z)); }
__device__ __forceinline__ float wave_sum(float v) {
#pragma unroll
    for (int o = 1; o < 64; o <<= 1) v += __shfl_xor(v, o);
    return v;
}
__device__ __forceinline__ float rope_inv(int ii) { return __expf(-(float)ii * (9.210340371976184f / 16.f)); }

struct Ptrs {
    const float *x, *c, *ctx, *c_ctx, *w_ada, *b_ada, *pre_norm1, *w_in, *q_norm_w, *w_uq, *kv_norm_w, *w_ukv, *sgu_norm_w, *sgu_w, *sgu_b, *w_out,
        *post_norm1, *pre_norm2, *w_router, *b_router, *w_e_gate, *w_e_up, *w_e_down, *post_norm2;
    float* out; unsigned char* ws;
};

#if !defined(FINAL_BUILD)
__global__ void n_mod(Ptrs p) {
    const int j = blockIdx.x * 256 + threadIdx.x, r = blockIdx.y;
    const float* cv = r < 4 ? p.c + r * D : p.c_ctx;
    float s = 0.f;
    for (int k = 0; k < D; ++k) s += silu_f(cv[k]) * p.w_ada[(size_t)k * 12288 + j];
    ((float*)(p.ws + WS_MOD))[r * 12288 + j] = s + p.b_ada[j];
}
__global__ __launch_bounds__(256) void n_hrows(Ptrs p) {
    const int row = blockIdx.x * 4 + (threadIdx.x >> 6), lane = threadIdx.x & 63;
    if (row >= MALL) return;
    const float* src = row < M ? p.x + (size_t)row * D : p.ctx + (size_t)(row - M) * D;
    const int mr = row < M ? row >> 12 : 4;
    const float* mod = (const float*)(p.ws + WS_MOD) + mr * 12288;
    float v[32]; float s = 0.f;
    for (int j = 0; j < 32; ++j) { v[j] = src[j * 64 + lane]; s += v[j] * v[j]; }
    const float rs = rsqrtf(wave_sum(s) * (1.f / D) + EPS);
    bf16* o = (bf16*)(p.ws + WS_H) + (size_t)row * D;
    for (int j = 0; j < 32; ++j) { const int c = j * 64 + lane; o[c] = f2bf(v[j] * rs * p.pre_norm1[c] * (1.f + mod[2048 + c]) + mod[c]); }
}
template <class P> __global__ __launch_bounds__(256) void ngemm(P p) {
    __shared__ float As[16][65], Bs[16][65];
    const int tx = threadIdx.x & 15, ty = threadIdx.x >> 4, z = blockIdx.z;
    const int m0 = blockIdx.y * 64, n0 = blockIdx.x * 64;
    float acc[4][4] = {};
    for (int k0 = 0; k0 < p.K; k0 += 16) {
        for (int j = 0; j < 4; ++j) { const int idx = threadIdx.x + 256 * j; const int kk = idx & 15, mm = idx >> 4; As[kk][mm] = p.a(z, m0 + mm, k0 + kk); }
        for (int j = 0; j < 4; ++j) { const int idx = threadIdx.x + 256 * j; const int nn = idx & 63, kk = idx >> 6; Bs[kk][nn] = p.b(z, k0 + kk, n0 + nn); }
        __syncthreads();
#pragma unroll
        for (int kk = 0; kk < 16; ++kk) {
            float a[4], b[4];
#pragma unroll
            for (int i = 0; i < 4; ++i) { a[i] = As[kk][ty * 4 + i]; b[i] = Bs[kk][tx * 4 + i]; }
#pragma unroll
            for (int i = 0; i < 4; ++i)
#pragma unroll
                for (int j = 0; j < 4; ++j) acc[i][j] += a[i] * b[j];
        }
        __syncthreads();
    }
    for (int i = 0; i < 4; ++i) p.epi(z, m0 + ty * 4 + i, n0 + tx * 4, acc[i]);
}
__device__ __forceinline__ void rope_pair(float& x1, float& x2, int i, int pos) {
    const int ii = i & 15; const float ax = (float)((i >> 4) ? (pos & 63) : (pos >> 6));
    float s, c; sincosf(ax * rope_inv(ii), &s, &c);
    const float r1 = x1 * c - x2 * s, r2 = x2 * c + x1 * s; x1 = r1; x2 = r2;
}
struct GIn {
    Ptrs p; int K;
    __device__ float a(int, int m, int k) const { return bf2f(((const bf16*)(p.ws + WS_H))[(size_t)m * D + k]); }
    __device__ float b(int, int k, int n) const {
        int o; if (n < 1024) o = n; else if (n < 3072) o = n + 64; else { const int j = n - 3072, i = j >> 1, s = j & 1; o = OFF_KPE + (i >> 4) * 32 + s * 16 + (i & 15); }
        return p.w_in[(size_t)k * INC + o];
    }
    __device__ void epi(int, int m, int n0, const float* v) const {
        bf16* CQ = (bf16*)(p.ws + WS_CQKV); bf16* CKV = CQ + (size_t)M * 512;
        if (n0 < 512) { if (m < M) for (int j = 0; j < 4; ++j) CQ[(size_t)m * 512 + n0 + j] = f2bf(v[j]); }
        else if (n0 < 1024) { for (int j = 0; j < 4; ++j) CKV[(size_t)m * 512 + n0 - 512 + j] = f2bf(v[j]); }
        else if (n0 < 2048) { if (m < M) for (int j = 0; j < 4; ++j) ((bf16*)(p.ws + WS_U))[(size_t)m * 1024 + n0 - 1024 + j] = f2bf(gelu_tanh(v[j])); }
        else if (n0 < 3072) { if (m < M) for (int j = 0; j < 4; ++j) ((bf16*)(p.ws + WS_VS))[(size_t)m * 1024 + n0 - 2048 + j] = f2bf(gelu_tanh(v[j])); }
        else {
            const int jj = n0 - 3072; bf16* Kb = (bf16*)(p.ws + WS_K);
            for (int q = 0; q < 2; ++q) {
                const int i = (jj >> 1) + q; float x1 = v[2 * q], x2 = v[2 * q + 1]; int b, kpos;
                if (m < M) { b = m >> 12; kpos = m & 4095; rope_pair(x1, x2, i, kpos); } else { b = (m - M) >> 8; kpos = L + ((m - M) & 255); }
                for (int hh = 0; hh < H; ++hh) { bf16* d = Kb + ((size_t)(b * H + hh) * LK + kpos) * DQK + 128 + 2 * i; d[0] = f2bf(x1); d[1] = f2bf(x2); }
            }
        }
    }
};
__global__ void n_ssq(const bf16* T, int rows, int cols, float* out, int nslots) {
    const int row = blockIdx.x * 4 + (threadIdx.x >> 6), lane = threadIdx.x & 63;
    if (row >= rows) return;
    float s = 0.f; for (int c = lane; c < cols; c += 64) { const float v = bf2f(T[(size_t)row * cols + c]); s += v * v; }
    s = wave_sum(s);
    if (lane < nslots) out[(size_t)row * nslots + lane] = lane == 0 ? s : 0.f;
}
__device__ __forceinline__ float sum_slots(const float* s, int n) { float t = 0.f; for (int i = 0; i < n; ++i) t += s[i]; return t; }
struct GQ {
    Ptrs p; int K;
    __device__ float a(int, int m, int k) const { return bf2f(((const bf16*)(p.ws + WS_CQKV))[(size_t)m * 512 + k]); }
    __device__ float b(int, int k, int n) const {
        int o; if (n < 1024) o = (n >> 7) * DQK + (n & 127); else { const int jj = n - 1024, hd = jj >> 6, j6 = jj & 63, i = j6 >> 1, s = j6 & 1; o = hd * DQK + 128 + (i >> 4) * 32 + s * 16 + (i & 15); }
        return p.w_uq[(size_t)k * 1536 + o] * p.q_norm_w[k];
    }
    __device__ void epi(int, int m, int n0, const float* v) const {
        const float rs = rsqrtf(sum_slots((const float*)(p.ws + WS_SSQQ) + (size_t)m * 8, 8) * (1.f / 512.f) + EPS);
        const int b = m >> 12, t = m & 4095; bf16* Qb = (bf16*)(p.ws + WS_Q);
        if (n0 < 1024) { const int hd = n0 >> 7, d = n0 & 127; for (int j = 0; j < 4; ++j) Qb[((size_t)(b * H + hd) * L + t) * DQK + d + j] = f2bf(v[j] * rs); }
        else { const int jj = n0 - 1024, hd = jj >> 6, j6 = jj & 63;
            for (int q = 0; q < 2; ++q) { const int i = (j6 >> 1) + q; float x1 = v[2 * q] * rs, x2 = v[2 * q + 1] * rs; rope_pair(x1, x2, i, t);
                bf16* d = Qb + ((size_t)(b * H + hd) * L + t) * DQK + 128 + 2 * i; d[0] = f2bf(x1); d[1] = f2bf(x2); } }
    }
};
struct GKV {
    Ptrs p; int K;
    __device__ float a(int, int m, int k) const { return bf2f(((const bf16*)(p.ws + WS_CQKV))[(size_t)(M + m) * 512 + k]); }
    __device__ float b(int, int k, int n) const { return p.w_ukv[(size_t)k * 2048 + n] * p.kv_norm_w[k]; }
    __device__ void epi(int, int m, int n0, const float* v) const {
        const float rs = rsqrtf(sum_slots((const float*)(p.ws + WS_SSQKV) + (size_t)m * 8, 8) * (1.f / 512.f) + EPS);
        int b, kpos; if (m < M) { b = m >> 12; kpos = m & 4095; } else { b = (m - M) >> 8; kpos = L + ((m - M) & 255); }
        const int hd = n0 >> 8, c = n0 & 255;
        if (c < 128) { bf16* d = (bf16*)(p.ws + WS_K) + ((size_t)(b * H + hd) * LK + kpos) * DQK + c; for (int j = 0; j < 4; ++j) d[j] = f2bf(v[j] * rs); }
        else { bf16* d = (bf16*)(p.ws + WS_V) + ((size_t)(b * H + hd) * LK + kpos) * VH + c - 128; for (int j = 0; j < 4; ++j) d[j] = f2bf(v[j] * rs); }
    }
};
__global__ void n_vn(Ptrs p) {
    const int w = blockIdx.x * 4 + (threadIdx.x >> 6), lane = threadIdx.x & 63;
    const int tok = w >> 3, g = w & 7;
    const bf16* s = (const bf16*)(p.ws + WS_VS) + (size_t)tok * 1024 + g * 128;
    const float a = bf2f(s[lane]), b = bf2f(s[lane + 64]);
    const float mu = wave_sum(a + b) * (1.f / 128.f);
    const float da = a - mu, db = b - mu;
    const float rs = rsqrtf(wave_sum(da * da + db * db) * (1.f / 128.f) + EPS);
    bf16* o = (bf16*)(p.ws + WS_VN) + (size_t)tok * 1024 + g * 128;
    o[lane] = f2bf(da * rs * p.sgu_norm_w[g * 128 + lane]); o[lane + 64] = f2bf(db * rs * p.sgu_norm_w[g * 128 + lane + 64]);
}
struct GSgu {
    Ptrs p; int K;
    __device__ float a(int z, int m, int k) const { return p.sgu_w[((size_t)(z & 7) * 128 + m) * 128 + k]; }
    __device__ float b(int z, int k, int n) const { return bf2f(((const bf16*)(p.ws + WS_VN))[(size_t)((z >> 3) * 128 + k) * 1024 + (z & 7) * 128 + n]); }
    __device__ void epi(int z, int m, int n0, const float* v) const {
        const int g = z & 7; const size_t row = (size_t)(z >> 3) * 128 + m; const float bias = p.sgu_b[g * 128 + m];
        for (int j = 0; j < 4; ++j) { const float u = bf2f(((const bf16*)(p.ws + WS_U))[row * 1024 + g * 128 + n0 + j]);
            ((bf16*)(p.ws + WS_CAT))[row * D + 1024 + g * 128 + n0 + j] = f2bf(u * (v[j] + bias)); }
    }
};
struct GScore {
    Ptrs p; int K; int bh;
    __device__ float a(int, int m, int k) const { return bf2f(((const bf16*)(p.ws + WS_Q))[((size_t)bh * L + m) * DQK + k]); }
    __device__ float b(int, int k, int n) const { return bf2f(((const bf16*)(p.ws + WS_K))[((size_t)bh * LK + n) * DQK + k]); }
    __device__ void epi(int, int m, int n0, const float* v) const { float* S = (float*)(p.ws + WS_S) + (size_t)m * LK + n0; for (int j = 0; j < 4; ++j) S[j] = v[j] * ATT_SCALE; }
};
__global__ void n_softmax(float* S, int cols) {
    float* r = S + (size_t)blockIdx.x * cols; __shared__ float red[4];
    float mx = -1e30f; for (int c = threadIdx.x; c < cols; c += 256) mx = fmaxf(mx, r[c]);
    for (int o = 1; o < 64; o <<= 1) mx = fmaxf(mx, __shfl_xor(mx, o));
    if ((threadIdx.x & 63) == 0) red[threadIdx.x >> 6] = mx; __syncthreads();
    mx = fmaxf(fmaxf(red[0], red[1]), fmaxf(red[2], red[3])); __syncthreads();
    float s = 0.f; for (int c = threadIdx.x; c < cols; c += 256) { const float e = __expf(r[c] - mx); r[c] = e; s += e; }
    s = wave_sum(s); if ((threadIdx.x & 63) == 0) red[threadIdx.x >> 6] = s; __syncthreads();
    s = (red[0] + red[1]) + (red[2] + red[3]); const float inv = 1.f / s;
    for (int c = threadIdx.x; c < cols; c += 256) r[c] *= inv;
}
struct GPV {
    Ptrs p; int K; int bh;
    __device__ float a(int, int m, int k) const { return ((const float*)(p.ws + WS_S))[(size_t)m * LK + k]; }
    __device__ float b(int, int k, int n) const { return bf2f(((const bf16*)(p.ws + WS_V))[((size_t)bh * LK + k) * VH + n]); }
    __device__ void epi(int, int m, int n0, const float* v) const { bf16* d = (bf16*)(p.ws + WS_CAT) + ((size_t)(bh >> 3) * L + m) * D + (bh & 7) * 128 + n0; for (int j = 0; j < 4; ++j) d[j] = f2bf(v[j]); }
};
struct GOut {
    Ptrs p; int K;
    __device__ float a(int, int m, int k) const { return bf2f(((const bf16*)(p.ws + WS_CAT))[(size_t)m * D + k]); }
    __device__ float b(int, int k, int n) const { return p.w_out[(size_t)k * D + n]; }
    __device__ void epi(int, int m, int n0, const float* v) const { bf16* d = (bf16*)(p.ws + WS_Y) + (size_t)m * D + n0; for (int j = 0; j < 4; ++j) d[j] = f2bf(v[j]); }
};
__device__ __forceinline__ void row_pass_mid(const Ptrs& p, int row, int lane) {
    const int b = row >> 12; const float* mod = (const float*)(p.ws + WS_MOD) + b * 12288;
    const float ssq = wave_sum(lane < 32 ? ((const float*)(p.ws + WS_SSQY))[(size_t)row * 32 + lane] : 0.f);
    const float rsy = rsqrtf(ssq * (1.f / D) + EPS);
    const bf16* y = (const bf16*)(p.ws + WS_Y) + (size_t)row * D; const float* xr = p.x + (size_t)row * D; float* o = p.out + (size_t)row * D;
    float v[32]; float s = 0.f;
    for (int j = 0; j < 32; ++j) { const int c = j * 64 + lane; v[j] = xr[c] + mod[4096 + c] * (bf2f(y[c]) * rsy * p.post_norm1[c]); o[c] = v[j]; s += v[j] * v[j]; }
    const float rs = rsqrtf(wave_sum(s) * (1.f / D) + EPS);
    bf16* h2 = (bf16*)(p.ws + WS_H2) + (size_t)row * D; float lg[16];
    for (int e = 0; e < 16; ++e) lg[e] = 0.f;
    for (int j = 0; j < 32; ++j) { const int c = j * 64 + lane; const float h = v[j] * rs * p.pre_norm2[c] * (1.f + mod[8192 + c]) + mod[6144 + c]; h2[c] = f2bf(h);
        const float* wr = p.w_router + (size_t)c * 16; for (int e = 0; e < 16; ++e) lg[e] += h * wr[e]; }
    float mx = -1e30f;
    for (int e = 0; e < 16; ++e) { lg[e] = wave_sum(lg[e]) + p.b_router[e]; mx = fmaxf(mx, lg[e]); }
    float se = 0.f; for (int e = 0; e < 16; ++e) { lg[e] = __expf(lg[e] - mx); se += lg[e]; }
    const float inv = 1.f / se;
    if (lane < 16) { float val = 0.f; for (int e = 0; e < 16; ++e) val = (lane == e) ? lg[e] * inv : val; ((float*)(p.ws + WS_AFF))[(size_t)row * 16 + lane] = val; }
}
__global__ __launch_bounds__(256) void n_rowmid(Ptrs p) { const int row = blockIdx.x * 4 + (threadIdx.x >> 6); row_pass_mid(p, row, threadIdx.x & 63); }
__global__ void n_topk(Ptrs p) {
    __shared__ float vals[L];
    const int e = blockIdx.x >> 2, b = blockIdx.x & 3;
    const float* aff = (const float*)(p.ws + WS_AFF) + (size_t)b * L * 16 + e;
    for (int t = threadIdx.x; t < L; t += blockDim.x) vals[t] = aff[(size_t)t * 16];
    __syncthreads();
    for (int t = threadIdx.x; t < L; t += blockDim.x) {
        const float v = vals[t]; int rank = 0;
        for (int u = 0; u < L; ++u) { const float w = vals[u]; rank += (w > v || (w == v && u < t)) ? 1 : 0; }
        ((int*)(p.ws + WS_INV))[(size_t)(b * L + t) * 16 + e] = rank < CAP ? rank : -1;
        if (rank < CAP) ((int*)(p.ws + WS_IDX))[(size_t)(e * 4 + b) * CAP + rank] = t;
    }
}
struct GE1 {
    Ptrs p; int K;
    __device__ float a(int z, int m, int k) const { const int b = m >> 9; const int tok = ((const int*)(p.ws + WS_IDX))[(size_t)(z * 4 + b) * CAP + (m & 511)];
        return bf2f(((const bf16*)(p.ws + WS_H2))[((size_t)b * L + tok) * D + k]); }
    __device__ float b(int z, int k, int n) const { const float* w = (n & 1) ? p.w_e_up : p.w_e_gate; return w[((size_t)z * D + k) * FF + (n >> 1)]; }
    __device__ void epi(int z, int m, int n0, const float* v) const { bf16* d = (bf16*)(p.ws + WS_ACT) + ((size_t)z * 2048 + m) * FF + (n0 >> 1);
        d[0] = f2bf(silu_f(v[0]) * v[1]); d[1] = f2bf(silu_f(v[2]) * v[3]); }
};
struct GE2 {
    Ptrs p; int K;
    __device__ float a(int z, int m, int k) const { return bf2f(((const bf16*)(p.ws + WS_ACT))[((size_t)z * 2048 + m) * FF + k]); }
    __device__ float b(int z, int k, int n) const { return p.w_e_down[((size_t)z * FF + k) * D + n]; }
    __device__ void epi(int z, int m, int n0, const float* v) const { bf16* d = (bf16*)(p.ws + WS_YE) + ((size_t)z * 2048 + m) * D + n0; for (int j = 0; j < 4; ++j) d[j] = f2bf(v[j]); }
};
__device__ __forceinline__ void row_pass_final(const Ptrs& p, int row, int lane) {
    const int b = row >> 12; const float* mod = (const float*)(p.ws + WS_MOD) + b * 12288;
    const int* inv = (const int*)(p.ws + WS_INV) + (size_t)row * 16; const float* aff = (const float*)(p.ws + WS_AFF) + (size_t)row * 16;
    float v[32]; for (int j = 0; j < 32; ++j) v[j] = 0.f;
    for (int e = 0; e < 16; ++e) { const int sl = inv[e]; if (sl >= 0) { const float g = aff[e]; const bf16* ye = (const bf16*)(p.ws + WS_YE) + ((size_t)(e * 4 + b) * CAP + sl) * D;
            for (int j = 0; j < 32; ++j) v[j] += g * bf2f(ye[j * 64 + lane]); } }
    float s = 0.f; for (int j = 0; j < 32; ++j) s += v[j] * v[j];
    const float rs = rsqrtf(wave_sum(s) * (1.f / D) + EPS);
    float* o = p.out + (size_t)row * D;
    for (int j = 0; j < 32; ++j) { const int c = j * 64 + lane; o[c] = o[c] + mod[10240 + c] * (v[j] * rs * p.post_norm2[c]); }
}
__global__ __launch_bounds__(256) void n_rowfinal(Ptrs p) { const int row = blockIdx.x * 4 + (threadIdx.x >> 6); row_pass_final(p, row, threadIdx.x & 63); }

#endif

namespace pg8 {
#define PG8_LAS __attribute__((address_space(3)))
typedef short bf16x8 __attribute__((ext_vector_type(8)));
typedef float f32x4 __attribute__((ext_vector_type(4)));
typedef float f32x2 __attribute__((ext_vector_type(2)));
typedef unsigned u32x4 __attribute__((ext_vector_type(4)));
constexpr int BM = 256, BK = 64, HALF = 128, HTB = HALF * BK * 2, STAGE_BYTES = 8 * HTB, NXCD = 8, WGM = 4;

__host__ __device__ __forceinline__ int lds_byte(int r, int c) { const int st = (r >> 4) * 2 + (c >> 5), rr = r & 15, cc = c & 31, ob = rr * 64 + cc * 2; return st * 1024 + (ob ^ (((ob >> 9) & 1) << 5)); }
__host__ __device__ __forceinline__ void stage_rc(int b, int& R, int& C) { const int st = b / 1024, sb = b % 1024, swz = sb ^ (((sb >> 9) & 1) << 5); R = (st >> 1) * 16 + swz / 64; C = (st & 1) * 32 + (swz % 64) / 2; }
__host__ __device__ __forceinline__ int perm32(int rho) { const int n = rho >> 4, i = rho & 15; return 8 * (i >> 2) + 4 * n + (i & 3); }

struct Unit { int pm, pn, ui; };
__device__ __forceinline__ void rect_unit(int L, int nM, int nN, Unit& u) {
    const int nwg = nM * nN; int wgid = L;
    { const int q = nwg / NXCD, r = nwg % NXCD, xcd = wgid % NXCD, off = wgid / NXCD; wgid = (xcd < r ? xcd * (q + 1) : r * (q + 1) + (xcd - r) * q) + off; }
    const int nig = WGM * nN, gid = wgid / nig, fm = gid * WGM, gsz = (nM - fm) < WGM ? (nM - fm) : WGM;
    u.pm = fm + ((wgid % nig) % gsz); u.pn = (wgid % nig) / gsz;
}
__device__ __forceinline__ void dense_voff(int K, int tid, unsigned (&v)[2][2]) {
#pragma unroll
    for (int i = 0; i < 2; ++i) { int R, C; stage_rc(tid * 16 + i * 8192, R, C); v[0][i] = (unsigned)(R * K + C) * 2u; v[1][i] = (unsigned)((R + HALF) * K + C) * 2u; }
}

__device__ __forceinline__ unsigned cvt_pk_bf16(float lo, float hi) { unsigned r; asm volatile("v_cvt_pk_bf16_f32 %0, %1, %2" : "=v"(r) : "v"(lo), "v"(hi)); return r; }
__device__ __forceinline__ u32x4 pack8(const f32x4& a, const f32x4& b) { u32x4 w; w.x = cvt_pk_bf16(a[0], a[1]); w.y = cvt_pk_bf16(a[2], a[3]); w.z = cvt_pk_bf16(b[0], b[1]); w.w = cvt_pk_bf16(b[2], b[3]); return w; }

typedef int i32x4 __attribute__((ext_vector_type(4)));
typedef int i32x8 __attribute__((ext_vector_type(8)));
template <class Epi, class Sched, bool FP8 = false>
__device__ __forceinline__ void gemm_phase(PG8_LAS unsigned char* lds, const int K, const Sched& S, const Epi& E) {
    const int tid = threadIdx.x, wid = __builtin_amdgcn_readfirstlane(tid >> 6), lane = tid & 63, wr = wid >> 2, wc = wid & 3, fr = lane & 15, fq = lane >> 4;
    const int nt = K / BK;
    unsigned voffB[2];
#pragma unroll
    for (int i = 0; i < 2; ++i) { int R, C; stage_rc(tid * 16 + i * 8192, R, C); const int Rb = Epi::PERM ? ((R & ~31) + perm32(R & 31)) : R; voffB[i] = (unsigned)(Rb * K + C) * 2u; }
    const size_t kstep = (size_t)(BK * 2);
    const size_t hstep = (size_t)HALF * K * 2;
    const unsigned ldsw = (unsigned)wid * 1024u;
    const int aoff = lds_byte(wr * 64 + fr, fq * 8), boff = lds_byte(wc * 32 + fr, fq * 8);
#define PG8_SA(b, h) (((b) * 2 + (h)) * HTB)
#define PG8_SB(b, h) ((4 + (b) * 2 + (h)) * HTB)
#define PG8_STAGE(bufoff, gbase, voff) do { _Pragma("unroll") for (int _i = 0; _i < 2; ++_i) \
        __builtin_amdgcn_global_load_lds((const unsigned*)((const char*)(gbase) + (voff)[_i]), (PG8_LAS unsigned*)(lds + (bufoff) + ldsw + _i * 8192), 16, 0, 0); } while (0)
#define PG8_LDA(dst, b, h) do { _Pragma("unroll") for (int m = 0; m < 4; ++m) _Pragma("unroll") for (int k = 0; k < 2; ++k) dst[m][k] = *(const PG8_LAS bf16x8*)(lds + PG8_SA(b, h) + aoff + m * 2048 + k * 1024); } while (0)
#define PG8_LDB(dst, b, h) do { _Pragma("unroll") for (int n = 0; n < 2; ++n) _Pragma("unroll") for (int k = 0; k < 2; ++k) dst[n][k] = *(const PG8_LAS bf16x8*)(lds + PG8_SB(b, h) + boff + n * 2048 + k * 1024); } while (0)
#define PG8_MMA(ai, bj, At, Bt) do { __builtin_amdgcn_s_setprio(1); _Pragma("unroll") for (int m = 0; m < 4; ++m) _Pragma("unroll") for (int n = 0; n < 2; ++n) { \
        if constexpr (FP8) { const i32x8 fb = __builtin_shufflevector((i32x4)Bt[n][0], (i32x4)Bt[n][1], 0, 1, 2, 3, 4, 5, 6, 7), fa = __builtin_shufflevector((i32x4)At[m][0], (i32x4)At[m][1], 0, 1, 2, 3, 4, 5, 6, 7); \
            acc[ai][bj][m][n] = __builtin_amdgcn_mfma_scale_f32_16x16x128_f8f6f4(fb, fa, acc[ai][bj][m][n], 0, 0, 0, 0x7f7f7f7f, 0, 0x7f7f7f7f); } \
        else { _Pragma("unroll") for (int k = 0; k < 2; ++k) acc[ai][bj][m][n] = __builtin_amdgcn_mfma_f32_16x16x32_bf16(Bt[n][k], At[m][k], acc[ai][bj][m][n], 0, 0, 0); } } \
        __builtin_amdgcn_s_setprio(0); } while (0)
#define PG8_WAIT_V(n) asm volatile("s_waitcnt vmcnt(" #n ")" ::: "memory")
#define PG8_WAIT_L(n) asm volatile("s_waitcnt lgkmcnt(" #n ")" ::: "memory")
#define PG8_BAR __builtin_amdgcn_s_barrier()
#define PG8_SCHED __builtin_amdgcn_sched_barrier(0)
    Unit cur, nxt; int ui = 0;
    if (!S.next(0, cur)) return;
    f32x4 acc[2][2][4][2];
#pragma unroll
    for (int a = 0; a < 2; ++a)
#pragma unroll
        for (int b = 0; b < 2; ++b)
#pragma unroll
            for (int m = 0; m < 4; ++m)
#pragma unroll
                for (int n = 0; n < 2; ++n) acc[a][b][m][n] = (f32x4){0.f, 0.f, 0.f, 0.f};
    bf16x8 At[4][2], B0[2][2], B1[2][2];
    unsigned vA[2][2], vN[2][2];
    S.a_voff(0, cur, tid, vA);
    const char* cA = S.a_base(cur); const char* cB = S.b_base(cur);
    PG8_STAGE(PG8_SB(0, 0), cB, voffB); PG8_STAGE(PG8_SB(0, 1), cB + hstep, voffB); PG8_STAGE(PG8_SA(0, 0), cA, vA[0]); PG8_STAGE(PG8_SA(0, 1), cA, vA[1]);
    if (wr == 1) PG8_BAR;
    PG8_WAIT_V(2); PG8_BAR;
    PG8_STAGE(PG8_SB(1, 0), cB + kstep, voffB); PG8_STAGE(PG8_SA(1, 0), cA + kstep, vA[0]); PG8_STAGE(PG8_SB(1, 1), cB + hstep + kstep, voffB);
    PG8_WAIT_V(6); PG8_BAR;
    for (;;) {
        const bool has_next = S.next(ui + 1, nxt);
        if (has_next) S.a_voff(ui + 1, nxt, tid, vN);
        const char* nA = has_next ? S.a_base(nxt) : cA; const char* nB = has_next ? S.b_base(nxt) : cB;
        for (int t = 0; t < nt; t += 2) {
            const bool last = (t == nt - 2);
            const char* a1 = cA + (size_t)(t + 1) * kstep;
            const char* a2 = last ? nA : cA + (size_t)(t + 2) * kstep; const char* b2 = last ? nB : cB + (size_t)(t + 2) * kstep;
            const char* a3 = a2 + kstep; const char* b3 = b2 + kstep;
            PG8_LDB(B0, 0, 0); PG8_LDB(B1, 0, 1); PG8_SCHED; PG8_LDA(At, 0, 0); PG8_STAGE(PG8_SA(1, 1), a1, vA[1]);
            if (last && has_next) {
#pragma unroll
                for (int h = 0; h < 2; ++h)
#pragma unroll
                    for (int i = 0; i < 2; ++i) vA[h][i] = vN[h][i];
            }
            PG8_WAIT_V(8); PG8_WAIT_L(0); PG8_BAR; PG8_MMA(0, 0, At, B0); PG8_MMA(0, 1, At, B1); PG8_BAR; PG8_SCHED;
            PG8_LDA(At, 0, 1); PG8_STAGE(PG8_SB(0, 0), b2, voffB); PG8_STAGE(PG8_SB(0, 1), b2 + hstep, voffB); PG8_STAGE(PG8_SA(0, 0), a2, vA[0]);
            PG8_WAIT_V(8); PG8_WAIT_L(0); PG8_BAR; PG8_MMA(1, 0, At, B0); PG8_MMA(1, 1, At, B1); PG8_BAR; PG8_SCHED;
            PG8_LDB(B0, 1, 0); PG8_LDB(B1, 1, 1); PG8_SCHED; PG8_LDA(At, 1, 0); PG8_STAGE(PG8_SA(0, 1), a2, vA[1]);
            PG8_WAIT_V(8); PG8_WAIT_L(0); PG8_BAR; PG8_MMA(0, 0, At, B0); PG8_MMA(0, 1, At, B1); PG8_BAR; PG8_SCHED;
            PG8_LDA(At, 1, 1); PG8_STAGE(PG8_SB(1, 0), b3, voffB); PG8_STAGE(PG8_SB(1, 1), b3 + hstep, voffB); PG8_STAGE(PG8_SA(1, 0), a3, vA[0]);
            PG8_WAIT_V(8); PG8_WAIT_L(0); PG8_BAR; PG8_MMA(1, 0, At, B0); PG8_MMA(1, 1, At, B1); PG8_BAR; PG8_SCHED;
        }
        if (wr == 0) PG8_BAR;
        E(acc, cur, wr, wc, fr, fq);
        if (!has_next) break;
#pragma unroll
        for (int a = 0; a < 2; ++a)
#pragma unroll
            for (int b = 0; b < 2; ++b)
#pragma unroll
                for (int m = 0; m < 4; ++m)
#pragma unroll
                    for (int n = 0; n < 2; ++n) acc[a][b][m][n] = (f32x4){0.f, 0.f, 0.f, 0.f};
        cur = nxt; cA = nA; cB = nB; ++ui;
        if (wr == 1) PG8_BAR;
    }
    PG8_WAIT_V(0);
    PG8_BAR;
#undef PG8_SA
#undef PG8_SB
#undef PG8_STAGE
#undef PG8_LDA
#undef PG8_LDB
#undef PG8_MMA
#undef PG8_WAIT_V
#undef PG8_WAIT_L
#undef PG8_BAR
#undef PG8_SCHED
}
}

#define LAS __attribute__((address_space(3)))
typedef pg8::f32x4 f32x4; typedef pg8::u32x4 u32x4; typedef pg8::Unit Unit;
constexpr size_t TSTEP2K = (size_t)256 * 2048 * 2, TSTEP512 = (size_t)256 * 512 * 2;

struct SchedIn {
    static constexpr bool GATHER = false; const char *A, *Bt; int G, c;
    __device__ __forceinline__ bool next(int i, Unit& u) const { const int Lx = i * G + c; if (Lx >= 844) return false;
        if (Lx < 832) pg8::rect_unit(Lx, 64, 13, u); else { const int r = Lx - 832; u.pm = 64 + (r & 3); const int q = r >> 2; u.pn = q == 2 ? 12 : 2 + q; } return true; }
    __device__ __forceinline__ const char* a_base(const Unit& u) const { return A + (size_t)u.pm * TSTEP2K; }
    __device__ __forceinline__ const char* b_base(const Unit& u) const { return Bt + (size_t)u.pn * TSTEP2K; }
    __device__ __forceinline__ void a_voff(int, const Unit&, int tid, unsigned (&v)[2][2]) const { pg8::dense_voff(2048, tid, v); }
};
struct SchedQKV {
    static constexpr bool GATHER = false; const char *A, *Bt; int G, c;
    __device__ __forceinline__ bool next(int i, Unit& u) const { const int Lx = i * G + c; if (Lx >= 928) return false;
        if (Lx < 384) pg8::rect_unit(Lx, 64, 6, u); else { pg8::rect_unit(Lx - 384, 68, 8, u); u.pm += 64; u.pn += 6; } u.ui = i; return true; }
    __device__ __forceinline__ const char* a_base(const Unit& u) const { return A + (size_t)u.pm * TSTEP512; }
    __device__ __forceinline__ const char* b_base(const Unit& u) const { return Bt + (size_t)u.pn * TSTEP512; }
    __device__ __forceinline__ void a_voff(int, const Unit&, int tid, unsigned (&v)[2][2]) const { pg8::dense_voff(512, tid, v); }
};
template <int nM, int nN, int BSHIFT, int KU> struct SchedDense {
    static constexpr bool GATHER = false; const char *A, *Bt; int G, c;
    __device__ __forceinline__ bool next(int i, Unit& u) const { const int Lx = i * G + c; if (Lx >= nM * nN) return false; pg8::rect_unit(Lx, nM, nN, u); return true; }
    __device__ __forceinline__ const char* a_base(const Unit& u) const { return A + (size_t)u.pm * (512 * KU); }
    __device__ __forceinline__ const char* b_base(const Unit& u) const { return Bt + (size_t)((u.pm >> BSHIFT) * nN + u.pn) * (512 * KU); }
    __device__ __forceinline__ void a_voff(int, const Unit&, int tid, unsigned (&v)[2][2]) const { pg8::dense_voff(KU, tid, v); }
};
template <int KU> struct SchedGather {
    static constexpr bool GATHER = true; const char *A, *Bt; int G, c; const LAS unsigned* tab;
    __device__ __forceinline__ bool next(int i, Unit& u) const { const int Lx = i * G + c; if (Lx >= 2048) return false; pg8::rect_unit(Lx, 128, 16, u); return true; }
    __device__ __forceinline__ const char* a_base(const Unit&) const { return A; }
    __device__ __forceinline__ const char* b_base(const Unit& u) const { return Bt + (size_t)((u.pm >> 3) * 16 + u.pn) * (512 * KU); }
    __device__ __forceinline__ void a_voff(int i, const Unit&, int tid, unsigned (&v)[2][2]) const {
#pragma unroll
        for (int p = 0; p < 2; ++p) { int R, C; pg8::stage_rc(tid * 16 + p * 8192, R, C); v[0][p] = tab[i * 256 + R] + (unsigned)C * 2u; v[1][p] = tab[i * 256 + 128 + R] + (unsigned)C * 2u; }
    }
};

__device__ __forceinline__ float gelu_fast(float x) {
    const float z2 = -2.302208198f * (x + 0.044715f * x * x * x);
    return x * __builtin_amdgcn_rcpf(1.f + __builtin_amdgcn_exp2f(z2));
}
__device__ __forceinline__ float silu_fast(float x) { return x * __builtin_amdgcn_rcpf(1.f + __builtin_amdgcn_exp2f(-1.4426950408889634f * x)); }
__device__ __forceinline__ float dot4(const f32x4& a) { return (a[0] * a[0] + a[1] * a[1]) + (a[2] * a[2] + a[3] * a[3]); }
__device__ __forceinline__ void rope8(f32x4& a, f32x4& b, const float* tabrow  , int fq) {
    const f32x4 t0 = *(const f32x4*)(tabrow + 8 * fq), t1 = *(const f32x4*)(tabrow + 8 * fq + 4);
    f32x4 ra, rb;
    ra[0] = a[0] * t0[0] - a[1] * t0[1]; ra[1] = a[1] * t0[0] + a[0] * t0[1]; ra[2] = a[2] * t0[2] - a[3] * t0[3]; ra[3] = a[3] * t0[2] + a[2] * t0[3];
    rb[0] = b[0] * t1[0] - b[1] * t1[1]; rb[1] = b[1] * t1[0] + b[0] * t1[1]; rb[2] = b[2] * t1[2] - b[3] * t1[3]; rb[3] = b[3] * t1[2] + b[2] * t1[3];
    a = ra; b = rb;
}
struct EpiIn {
    static constexpr bool PERM = true; unsigned char* ws;
    __device__ __forceinline__ void operator()(const f32x4 (&acc)[2][2][4][2], const Unit& u, int wr, int wc, int fr, int fq) const {
        const int pn = u.pn, row0 = u.pm * 256 + wr * 64 + fr, c8 = wc * 32 + 8 * fq;
        if (pn < 4) {
            bf16* base = (bf16*)(ws + WS_CQKV) + (pn >= 2 ? (size_t)M * 512 : 0) + (pn & 1) * 256 + c8;
            float* ssq = (float*)(ws + (pn >= 2 ? WS_SSQKV : WS_SSQQ)) + (pn & 1) * 4 + wc;
#pragma unroll
            for (int ai = 0; ai < 2; ++ai)
#pragma unroll
                for (int m = 0; m < 4; ++m) { const int row = row0 + ai * 128 + m * 16; float s = 0.f;
#pragma unroll
                    for (int bj = 0; bj < 2; ++bj) { s += dot4(acc[ai][bj][m][0]) + dot4(acc[ai][bj][m][1]); *(u32x4*)(base + (size_t)row * 512 + bj * 128) = pg8::pack8(acc[ai][bj][m][0], acc[ai][bj][m][1]); }
                    s += __shfl_xor(s, 16); s += __shfl_xor(s, 32);
                    if (fq == 0) ssq[(size_t)row * 8] = s; }
        } else if (pn < 12) {
            bf16* base = (bf16*)(ws + (pn < 8 ? WS_U : WS_VS)) + ((pn - 4) & 3) * 256 + c8;
#pragma unroll
            for (int ai = 0; ai < 2; ++ai)
#pragma unroll
                for (int m = 0; m < 4; ++m) { const int row = row0 + ai * 128 + m * 16;
#pragma unroll
                    for (int bj = 0; bj < 2; ++bj) { f32x4 a = acc[ai][bj][m][0], b = acc[ai][bj][m][1];
#pragma unroll
                        for (int j = 0; j < 4; ++j) { a[j] = gelu_fast(a[j]); b[j] = gelu_fast(b[j]); }
                        *(u32x4*)(base + (size_t)row * 1024 + bj * 128) = pg8::pack8(a, b); } }
        } else if (wc < 2) {
            const float* tab = (const float*)(ws + WS_ROPE);
#pragma unroll
            for (int ai = 0; ai < 2; ++ai)
#pragma unroll
                for (int m = 0; m < 4; ++m) { const int row = row0 + ai * 128 + m * 16; f32x4 a = acc[ai][0][m][0], b = acc[ai][0][m][1]; int bb, kpos;
                    if (row < M) { bb = row >> 12; kpos = row & 4095; const int ax = wc ? (kpos & 63) : (kpos >> 6); rope8(a, b, tab + ax * 32, fq); }
                    else { bb = (row - M) >> 8; kpos = L + ((row - M) & 255); }
                    const u32x4 w = pg8::pack8(a, b); bf16* d = (bf16*)(ws + WS_K) + ((size_t)(bb * H) * LK + kpos) * DQK + 128 + c8;
#pragma unroll
                    for (int hh = 0; hh < H; ++hh) *(u32x4*)(d + (size_t)hh * LK * DQK) = w; }
        }
    }
};
struct EpiQKV {
    static constexpr bool PERM = true; unsigned char* ws; const LAS float* rstab;
    __device__ __forceinline__ void operator()(const f32x4 (&acc)[2][2][4][2], const Unit& u, int wr, int wc, int fr, int fq) const {
        const int c8 = wc * 32 + 8 * fq;
        if (u.pn < 6) {
            const int pn = u.pn, row0 = u.pm * 256 + wr * 64 + fr; const float* tab = (const float*)(ws + WS_ROPE);
#pragma unroll
            for (int ai = 0; ai < 2; ++ai)
#pragma unroll
                for (int m = 0; m < 4; ++m) { const int row = row0 + ai * 128 + m * 16; const int bb = row >> 12, t = row & 4095;
                    const float rs = rstab[u.ui * 256 + ai * 128 + wr * 64 + m * 16 + fr];
#pragma unroll
                    for (int bj = 0; bj < 2; ++bj) { f32x4 a = acc[ai][bj][m][0] * rs, b = acc[ai][bj][m][1] * rs; bf16* d;
                        if (pn < 4) d = (bf16*)(ws + WS_Q) + ((size_t)(bb * H + pn * 2 + bj) * L + t) * DQK + c8;
                        else { const int hd = (pn - 4) * 4 + bj * 2 + (wc >> 1), ax = (wc & 1) ? (t & 63) : (t >> 6); rope8(a, b, tab + ax * 32, fq);
                            d = (bf16*)(ws + WS_Q) + ((size_t)(bb * H + hd) * L + t) * DQK + 128 + (wc & 1) * 32 + 8 * fq; }
                        *(u32x4*)d = pg8::pack8(a, b); }
                    asm volatile("" ::: "memory"); }
        } else {
            const int hd = u.pn - 6, row0 = (u.pm - 64) * 256 + wr * 64 + fr;
#pragma unroll
            for (int ai = 0; ai < 2; ++ai)
#pragma unroll
                for (int m = 0; m < 4; ++m) { const int row = row0 + ai * 128 + m * 16; int bb, kpos;
                    if (row < M) { bb = row >> 12; kpos = row & 4095; } else { bb = (row - M) >> 8; kpos = L + ((row - M) & 255); }
                    const float rs = rstab[u.ui * 256 + ai * 128 + wr * 64 + m * 16 + fr];
                    const size_t kr = (size_t)(bb * H + hd) * LK + kpos;
                    *(u32x4*)((bf16*)(ws + WS_K) + kr * DQK + c8) = pg8::pack8(acc[ai][0][m][0] * rs, acc[ai][0][m][1] * rs);
                    *(u32x4*)((bf16*)(ws + WS_V) + kr * VH + c8) = pg8::pack8(acc[ai][1][m][0] * rs, acc[ai][1][m][1] * rs);
                    asm volatile("" ::: "memory"); }
        }
    }
};
struct EpiY {
    static constexpr bool PERM = true; unsigned char* ws;
    __device__ __forceinline__ void operator()(const f32x4 (&acc)[2][2][4][2], const Unit& u, int wr, int wc, int fr, int fq) const {
        const int row0 = u.pm * 256 + wr * 64 + fr; bf16* base = (bf16*)(ws + WS_Y) + u.pn * 256 + wc * 32 + 8 * fq; float* ssq = (float*)(ws + WS_SSQY) + u.pn * 4 + wc;
#pragma unroll
        for (int ai = 0; ai < 2; ++ai)
#pragma unroll
            for (int m = 0; m < 4; ++m) { const int row = row0 + ai * 128 + m * 16; float s = 0.f;
#pragma unroll
                for (int bj = 0; bj < 2; ++bj) { s += dot4(acc[ai][bj][m][0]) + dot4(acc[ai][bj][m][1]); *(u32x4*)(base + (size_t)row * D + bj * 128) = pg8::pack8(acc[ai][bj][m][0], acc[ai][bj][m][1]); }
                s += __shfl_xor(s, 16); s += __shfl_xor(s, 32);
                if (fq == 0) ssq[(size_t)row * 32] = s; }
    }
};
__device__ __forceinline__ unsigned pack4_fp8(float a, float b, float c, float d) { int w = 0; w = __builtin_amdgcn_cvt_pk_fp8_f32(a, b, w, false); w = __builtin_amdgcn_cvt_pk_fp8_f32(c, d, w, true); return (unsigned)w; }
constexpr float W8_SCALE = 64.f, W8_INV = 1.f / 64.f;
struct EpiAct8 {
    static constexpr bool PERM = true; unsigned char* ws;
    __device__ __forceinline__ void operator()(const f32x4 (&acc)[2][2][4][2], const Unit& u, int wr, int wc, int fr, int fq) const {
        const int row0 = u.pm * 256 + wr * 64 + fr; unsigned char* base = ws + WS_ACT + u.pn * 128 + wc * 32 + 8 * fq;
#pragma unroll
        for (int ai = 0; ai < 2; ++ai)
#pragma unroll
            for (int m = 0; m < 4; ++m) { const int row = row0 + ai * 128 + m * 16; f32x4 a, b;
#pragma unroll
                for (int j = 0; j < 4; ++j) { a[j] = silu_fast(acc[ai][0][m][0][j] * W8_INV) * (acc[ai][1][m][0][j] * W8_INV); b[j] = silu_fast(acc[ai][0][m][1][j] * W8_INV) * (acc[ai][1][m][1][j] * W8_INV); }
                *(unsigned long long*)(base + (size_t)row * FF) = (unsigned long long)pack4_fp8(a[0], a[1], a[2], a[3]) | ((unsigned long long)pack4_fp8(b[0], b[1], b[2], b[3]) << 32); }
    }
};
struct EpiYE8 {
    static constexpr bool PERM = true; unsigned char* ws;
    __device__ __forceinline__ void operator()(const f32x4 (&acc)[2][2][4][2], const Unit& u, int wr, int wc, int fr, int fq) const {
        const int row0 = u.pm * 256 + wr * 64 + fr; unsigned char* base = ws + WS_YE + u.pn * 256 + wc * 32 + 8 * fq;
#pragma unroll
        for (int ai = 0; ai < 2; ++ai)
#pragma unroll
            for (int m = 0; m < 4; ++m) { const int row = row0 + ai * 128 + m * 16;
#pragma unroll
                for (int bj = 0; bj < 2; ++bj) { const f32x4 a = acc[ai][bj][m][0] * W8_INV, b = acc[ai][bj][m][1] * W8_INV;
                    *(unsigned long long*)(base + (size_t)row * D + bj * 128) = (unsigned long long)pack4_fp8(a[0], a[1], a[2], a[3]) | ((unsigned long long)pack4_fp8(b[0], b[1], b[2], b[3]) << 32); } }
    }
};
struct EpiAct {
    static constexpr bool PERM = true; unsigned char* ws;
    __device__ __forceinline__ void operator()(const f32x4 (&acc)[2][2][4][2], const Unit& u, int wr, int wc, int fr, int fq) const {
        const int row0 = u.pm * 256 + wr * 64 + fr; bf16* base = (bf16*)(ws + WS_ACT) + u.pn * 128 + wc * 32 + 8 * fq;
#pragma unroll
        for (int ai = 0; ai < 2; ++ai)
#pragma unroll
            for (int m = 0; m < 4; ++m) { const int row = row0 + ai * 128 + m * 16; f32x4 a, b;
#pragma unroll
                for (int j = 0; j < 4; ++j) { a[j] = silu_fast(acc[ai][0][m][0][j]) * acc[ai][1][m][0][j]; b[j] = silu_fast(acc[ai][0][m][1][j]) * acc[ai][1][m][1][j]; }
                *(u32x4*)(base + (size_t)row * FF) = pg8::pack8(a, b); }
    }
};
struct EpiYE {
    static constexpr bool PERM = true; unsigned char* ws;
    __device__ __forceinline__ void operator()(const f32x4 (&acc)[2][2][4][2], const Unit& u, int wr, int wc, int fr, int fq) const {
        const int row0 = u.pm * 256 + wr * 64 + fr; bf16* base = (bf16*)(ws + WS_YE) + u.pn * 256 + wc * 32 + 8 * fq;
#pragma unroll
        for (int ai = 0; ai < 2; ++ai)
#pragma unroll
            for (int m = 0; m < 4; ++m) { const int row = row0 + ai * 128 + m * 16;
#pragma unroll
                for (int bj = 0; bj < 2; ++bj) *(u32x4*)(base + (size_t)row * D + bj * 128) = pg8::pack8(acc[ai][bj][m][0], acc[ai][bj][m][1]); }
    }
};

namespace att {
using bf16x8 = __attribute__((ext_vector_type(8))) short;
using s16x4  = __attribute__((ext_vector_type(4))) short;
using f32x16 = __attribute__((ext_vector_type(16))) float;
using u32x4  = __attribute__((ext_vector_type(4))) unsigned;
constexpr int QBLK = 32, KVBLK = 64, NW = 8;
constexpr float SCALE = cfg::ATT_SCALE, THR = 8.f;
constexpr int LDQ = 192, LDKK = 192, LDV = 128, LDO = 2048;
constexpr int KROW = 400, SHM_V = KVBLK * 128 * 2, SHM_K = KVBLK * KROW, SHM_QPE = 2 * SHM_V + 2 * SHM_K + NW * 64 * 4, SHM_ATTN = SHM_QPE + NW * 4096;
#define KSWZ(row, colB) ((row) * KROW + (colB))
#define SBAR() __builtin_amdgcn_sched_barrier(0)
__device__ __forceinline__ int crow(int r, int hi) { return (r & 3) + 8 * (r >> 2) + 4 * hi; }
__device__ __forceinline__ unsigned cvtpk(float lo, float hi) { unsigned r; asm volatile("v_cvt_pk_bf16_f32 %0, %1, %2" : "=v"(r) : "v"(lo), "v"(hi)); return r; }

__device__ __forceinline__ void partialSM(f32x16& p0, f32x16& p1, float& m_reg, float& mn, float& alpha) {
  constexpr float C = SCALE * 1.4426950408889634f;
  float pmax = p0[0];
#pragma unroll
  for (int r = 1; r < 16; ++r) pmax = fmaxf(pmax, p0[r]);
#pragma unroll
  for (int r = 0; r < 16; ++r) pmax = fmaxf(pmax, p1[r]);
  { auto rr = __builtin_amdgcn_permlane32_swap(__float_as_uint(pmax), __float_as_uint(pmax), false, false);
    pmax = fmaxf(__uint_as_float(rr[0]), __uint_as_float(rr[1])); }
  if (__builtin_expect(__all(pmax - m_reg <= THR / SCALE), 1)) { mn = m_reg; alpha = 1.f; }
  else { mn = fmaxf(m_reg, pmax); alpha = __builtin_amdgcn_exp2f((m_reg - mn) * C); m_reg = mn; }
  float mnC = -mn * C;
#pragma unroll
  for (int r = 0; r < 16; ++r) p0[r] = fmaf(p0[r], C, mnC);
#pragma unroll
  for (int r = 0; r < 16; ++r) p1[r] = fmaf(p1[r], C, mnC);
#pragma unroll
  for (int r = 0; r < 16; ++r) p0[r] = __builtin_amdgcn_exp2f(p0[r]);
}
__device__ __forceinline__ void finishSM(f32x16& p0, f32x16& p1, float alpha, float& l_reg, bf16x8& pa0, bf16x8& pa1, bf16x8& pa2, bf16x8& pa3) {
#pragma unroll
  for (int r = 0; r < 16; ++r) p1[r] = __builtin_amdgcn_exp2f(p1[r]);
  float ps = 0;
#pragma unroll
  for (int r = 0; r < 16; ++r) ps += p0[r];
#pragma unroll
  for (int r = 0; r < 16; ++r) ps += p1[r];
  { auto rr = __builtin_amdgcn_permlane32_swap(__float_as_uint(ps), __float_as_uint(ps), false, false);
    ps = __uint_as_float(rr[0]) + __uint_as_float(rr[1]); }
  l_reg = l_reg * alpha + ps;
#define PK4(P, BASE, OUT) do { unsigned a0 = cvtpk(P[BASE + 0], P[BASE + 1]), a1 = cvtpk(P[BASE + 2], P[BASE + 3]);   \
    unsigned b0 = cvtpk(P[BASE + 4], P[BASE + 5]), b1 = cvtpk(P[BASE + 6], P[BASE + 7]);                              \
    auto r0 = __builtin_amdgcn_permlane32_swap(a0, b0, false, false); auto r1 = __builtin_amdgcn_permlane32_swap(a1, b1, false, false); \
    u32x4 w = {r0[0], r1[0], r0[1], r1[1]}; OUT = *reinterpret_cast<bf16x8*>(&w); } while (0)
  PK4(p0, 0, pa0); PK4(p0, 8, pa1); PK4(p1, 0, pa2); PK4(p1, 8, pa3);
#undef PK4
}
__device__ __forceinline__ void qkt(f32x16& p0, f32x16& p1, const char* Ks, const bf16x8* qr, const char* qpe, int r32, int hi) {
  p0 = f32x16{}; p1 = f32x16{};
#pragma unroll
  for (int d0 = 0; d0 < 12; ++d0) { const int cb = (d0 * 16 + hi * 8) * 2;
    bf16x8 b0 = *reinterpret_cast<const bf16x8*>(Ks + KSWZ(r32, cb));
    bf16x8 b1 = *reinterpret_cast<const bf16x8*>(Ks + KSWZ(32 + r32, cb));
    const bf16x8 q = d0 < 8 ? qr[d0 < 8 ? d0 : 0] : *reinterpret_cast<const bf16x8*>(qpe + (d0 - 8) * 1024);
    p0 = __builtin_amdgcn_mfma_f32_32x32x16_bf16(b0, q, p0, 0, 0, 0);
    p1 = __builtin_amdgcn_mfma_f32_32x32x16_bf16(b1, q, p1, 0, 0, 0); }
}
__device__ __forceinline__ int v_st(int k, int c) { const int kk = (k & ~0xC) | ((k & 4) << 1) | ((k & 8) >> 1); return ((kk >> 3) * 4 + (c >> 5)) * 512 + ((kk & 7) * 32 + (c & 31)) * 2; }
__device__ __forceinline__ int v_rd_base(int lane) { return ((lane & 3) << 3) | (((lane >> 2) & 3) << 6) | (((lane >> 4) & 1) << 5) | (((lane >> 5) & 1) << 8); }
constexpr int v_rd_off(int d0, int ks, int half) { return d0 * 512 + ks * 4096 + half * 2048; }
template <int OFF> __device__ __forceinline__ s16x4 tr_read(int vb) {
  s16x4 r; asm volatile("ds_read_b64_tr_b16 %0, %1 offset:%2" : "=&v"(r) : "v"(vb), "i"(OFF) : "memory"); return r;
}
template <int D0> __device__ __forceinline__ void pv_one(f32x16& od, int vb, bf16x8 pa0, bf16x8 pa1, bf16x8 pa2, bf16x8 pa3) {
  const s16x4 l0 = tr_read<v_rd_off(D0, 0, 0)>(vb), h0 = tr_read<v_rd_off(D0, 0, 1)>(vb), l1 = tr_read<v_rd_off(D0, 1, 0)>(vb), h1 = tr_read<v_rd_off(D0, 1, 1)>(vb);
  const s16x4 l2 = tr_read<v_rd_off(D0, 2, 0)>(vb), h2 = tr_read<v_rd_off(D0, 2, 1)>(vb), l3 = tr_read<v_rd_off(D0, 3, 0)>(vb), h3 = tr_read<v_rd_off(D0, 3, 1)>(vb);
  asm volatile("s_waitcnt lgkmcnt(0)" ::: "memory"); SBAR();
#define PK(L, H) (bf16x8){L[0], L[1], L[2], L[3], H[0], H[1], H[2], H[3]}
  od = __builtin_amdgcn_mfma_f32_32x32x16_bf16(pa0, PK(l0, h0), od, 0, 0, 0);
  od = __builtin_amdgcn_mfma_f32_32x32x16_bf16(pa1, PK(l1, h1), od, 0, 0, 0);
  od = __builtin_amdgcn_mfma_f32_32x32x16_bf16(pa2, PK(l2, h2), od, 0, 0, 0);
  od = __builtin_amdgcn_mfma_f32_32x32x16_bf16(pa3, PK(l3, h3), od, 0, 0, 0);
#undef PK
}
__device__ __forceinline__ void pv_d0(f32x16* o, int vb, bf16x8 pa0, bf16x8 pa1, bf16x8 pa2, bf16x8 pa3) {
  pv_one<0>(o[0], vb, pa0, pa1, pa2, pa3); pv_one<1>(o[1], vb, pa0, pa1, pa2, pa3); pv_one<2>(o[2], vb, pa0, pa1, pa2, pa3); pv_one<3>(o[3], vb, pa0, pa1, pa2, pa3);
}
struct CvStream { int it, end, step; const float *gate, *up, *down; unsigned char *wgu, *wd; };
constexpr int CV_GU = 16 * 64 * 128, CV_DN = 16 * 64 * 64, CV_ITEMS = CV_GU + CV_DN;
__device__ __forceinline__ void cv_ptrs(const CvStream& cv, int it, const float*& src, unsigned char*& dst) {
  if (it < CV_GU) { const int e = it >> 13, r = it & 8191, kb = r >> 7, nb = r & 127, n0 = nb * 32, pn = n0 >> 8, within = n0 & 255;
    src = (within < 128 ? cv.gate : cv.up) + ((size_t)e * 2048 + kb * 32) * 2048 + pn * 128 + (within & 127);
    dst = cv.wgu + ((size_t)e * 4096 + n0) * 2048 + kb * 32; }
  else { const int q = it - CV_GU, e = q >> 12, r = q & 4095, kb = r >> 6, nb = r & 63;
    src = cv.down + ((size_t)e * 2048 + kb * 32) * 2048 + nb * 32; dst = cv.wd + ((size_t)e * 2048 + nb * 32) * 2048 + kb * 32; }
}
__device__ __forceinline__ void cv_issue(const CvStream& cv, unsigned slot, int lane) {
  typedef __attribute__((address_space(3))) unsigned* ldsp_t;
  const float* src; unsigned char* dst; cv_ptrs(cv, cv.it, src, dst); (void)dst;
#pragma unroll
  for (int i = 0; i < 4; ++i) { const int k = 8 * i + (lane >> 3), nq = ((lane & 7) - 4 * (k >> 4)) & 7;
    __builtin_amdgcn_global_load_lds((const unsigned*)(src + (size_t)k * 2048 + 4 * nq), (ldsp_t)(slot + i * 1024), 16, 0, 0); }
}
__device__ __forceinline__ void cv_finish(CvStream& cv, const float* t, int lane) {
  const float* src; unsigned char* dst; cv_ptrs(cv, cv.it, src, dst); (void)src;
  const int n = lane >> 1, c = lane & 1; const float* tp = t + (16 * c * 8 + (((n >> 2) + 4 * c) & 7)) * 4 + (n & 3); float v[16];
#pragma unroll
  for (int q = 0; q < 16; ++q) v[q] = tp[q * 32] * 64.f;
  u32x4 o;
#pragma unroll
  for (int w = 0; w < 4; ++w) { int x = 0; x = __builtin_amdgcn_cvt_pk_fp8_f32(v[4 * w], v[4 * w + 1], x, false); x = __builtin_amdgcn_cvt_pk_fp8_f32(v[4 * w + 2], v[4 * w + 3], x, true); o[w] = (unsigned)x; }
  *reinterpret_cast<u32x4*>(dst + (size_t)n * 2048 + 16 * c) = o;
  cv.it += cv.step;
}
template <int V>
__device__ __forceinline__ void attn_unit(const bf16* __restrict__ Qb, const bf16* __restrict__ Kh, const bf16* __restrict__ Vh, bf16* __restrict__ Ob, int seq, char* lds, CvStream& cv) {
  const int tid = threadIdx.x, wid = tid >> 6, lane = tid & 63, r32 = lane & 31, hi = lane >> 5;
  char* V_lds = lds; char* K_lds = lds + 2 * SHM_V;
  float* ws = (float*)(lds + 2 * SHM_V + 2 * SHM_K) + wid * 64; float* li_l = ws; float* al_l = ws + 32;
  float m_reg = -1e30f, l_reg = 0; f32x16 o[4] = {}; bf16x8 qr[8];
  const bf16* Qw = Qb + (long)(wid * QBLK + r32) * LDQ + hi * 8;
  char* qpe = lds + SHM_QPE + wid * 4096 + lane * 16;
#pragma unroll
  for (int d0 = 0; d0 < 8; ++d0) qr[d0] = *reinterpret_cast<const bf16x8*>(Qw + d0 * 16);
#pragma unroll
  for (int d0 = 8; d0 < 12; ++d0) *reinterpret_cast<bf16x8*>(qpe + (d0 - 8) * 1024) = *reinterpret_cast<const bf16x8*>(Qw + d0 * 16);
  int kro[4], vro[2];
#pragma unroll
  for (int j = 0; j < 4; ++j) { const int o = (wid + 8 * j) * 1024 + lane * 16, row = o / KROW, c = (o - row * KROW) >> 4; kro[j] = row * 384 + (c < 24 ? c : 0) * 16; }
#pragma unroll
  for (int j = 0; j < 2; ++j) { const int o = (wid * 2 + j) * 1024 + lane * 16, st = o >> 9, within = (o & 511) >> 1, kk = (st >> 2) * 8 + (within >> 5), c = (st & 3) * 32 + (within & 31);
    const int k = (kk & ~0xC) | ((kk & 4) << 1) | ((kk & 8) >> 1); vro[j] = k * 256 + c * 2; }
  const unsigned klds = (unsigned)(uintptr_t)K_lds + wid * 1024, vlds = (unsigned)(uintptr_t)V_lds + wid * 2048;
  const int vb0 = (int)(uintptr_t)V_lds + v_rd_base(lane);
  typedef __attribute__((address_space(3))) unsigned* ldsp_t;
#define SDMA_K(k0, b) do { const char* kg = (const char*)Kh + (long)(k0) * (LDKK * 2); \
    _Pragma("unroll") for (int j_ = 0; j_ < 3; ++j_) __builtin_amdgcn_global_load_lds((const unsigned*)(kg + kro[j_]), (ldsp_t)(klds + (b) * SHM_K + j_ * 8192), 16, 0, 0); \
    if (wid == 0) __builtin_amdgcn_global_load_lds((const unsigned*)(kg + kro[3]), (ldsp_t)(klds + (b) * SHM_K + 3 * 8192), 16, 0, 0); } while (0)
#define SDMA_V(k0, b) do { const char* vg = (const char*)Vh + (long)(k0) * (LDV * 2); \
    _Pragma("unroll") for (int j_ = 0; j_ < 2; ++j_) __builtin_amdgcn_global_load_lds((const unsigned*)(vg + vro[j_]), (ldsp_t)(vlds + (b) * SHM_V + j_ * 1024), 16, 0, 0); } while (0)
#define RESC(a) do { if (__any((a) < 1.f)) { if (hi == 0) al_l[r32] = (a); asm volatile("s_waitcnt lgkmcnt(0)" ::: "memory"); \
    _Pragma("unroll") for (int d = 0; d < 4; ++d) _Pragma("unroll") for (int r = 0; r < 16; ++r) o[d][r] *= al_l[crow(r, hi)]; } } while (0)
#define PHASE_END() do { asm volatile("s_waitcnt vmcnt(0) lgkmcnt(0)" ::: "memory"); __builtin_amdgcn_s_barrier(); asm volatile("" ::: "memory"); } while (0)
  char* cvslot = lds + SHM_ATTN + wid * 4096; const unsigned cvslot_a = (unsigned)(uintptr_t)cvslot;
  f32x16 pA0, pA1; float mnA, alA; bf16x8 pa0, pa1, pa2, pa3; const int NT = seq / KVBLK;
  SDMA_K(0, 0); SDMA_V(0, 0); PHASE_END();
  if (wid >= 4) { __builtin_amdgcn_s_barrier(); asm volatile("" ::: "memory"); }
  for (int j = 0; j < NT; ++j) {
    const int bsel = j & 1;
    if (!(V & 8)) if (j + 1 < NT) { if (bsel) SDMA_K((j + 1) * KVBLK, 0); else SDMA_K((j + 1) * KVBLK, 1); }
    const bool cvon = cv.it < cv.end; if (cvon) cv_issue(cv, cvslot_a, lane);
    SBAR(); if (!(V & 4)) qkt(pA0, pA1, K_lds + bsel * SHM_K, qr, qpe, r32, hi); else { pA0 = o[0]; pA1 = o[1]; }
    if (!(V & 1)) partialSM(pA0, pA1, m_reg, mnA, alA); else { mnA = 0.f; alA = 1.f; }
    PHASE_END();
    if (!(V & 8)) if (j + 1 < NT) { if (bsel) SDMA_V((j + 1) * KVBLK, 0); else SDMA_V((j + 1) * KVBLK, 1); }
    if (cvon) cv_finish(cv, (const float*)cvslot, lane);
    RESC(alA);
    if (!(V & 1)) finishSM(pA0, pA1, alA, l_reg, pa0, pa1, pa2, pa3); else { pa0 = (bf16x8){(short)__float_as_int(pA0[0])}; pa1 = (bf16x8){(short)__float_as_int(pA0[1])}; pa2 = (bf16x8){(short)__float_as_int(pA1[0])}; pa3 = (bf16x8){(short)__float_as_int(pA1[1])}; l_reg += pA0[2]; } SBAR();
    if (!(V & 2)) pv_d0(o, vb0 + bsel * (int)SHM_V, pa0, pa1, pa2, pa3); else { o[0][0] += __int_as_float(pa0[0]); o[1][0] += __int_as_float(pa1[0]); o[2][0] += __int_as_float(pa2[0]); o[3][0] += __int_as_float(pa3[0]); }
    PHASE_END();
  }
  if (wid < 4) { __builtin_amdgcn_s_barrier(); asm volatile("" ::: "memory"); }
  if (hi == 0) li_l[r32] = l_reg; asm volatile("s_waitcnt lgkmcnt(0)" ::: "memory");
  float rli[16];
#pragma unroll
  for (int r = 0; r < 16; ++r) rli[r] = __builtin_amdgcn_rcpf(li_l[crow(r, hi)]);
  bf16* Ow = Ob + (long)(wid * QBLK) * LDO;
#pragma unroll
  for (int r = 0; r < 16; ++r) { const int orow = crow(r, hi);
#pragma unroll
    for (int d0 = 0; d0 < 4; ++d0) Ow[(long)orow * LDO + d0 * 32 + r32] = f2bf(o[d0][r] * rli[r]); }
#undef SDMA_K
#undef SDMA_V
#undef PHASE_END
#undef RESC
}
#undef KSWZ
#undef SBAR
}

#define XB_TMO      128
#define XB_XCNT(j)  (256  + 64 * (j))
#define XB_XSUB(j)  (1280 + 64 * (j))
#define XB_XGEN(j)  (2304 + 64 * (j))
#define XB_TOP      3328
#define XB_TOPGEN   3392
#define XCD_BAR_WORDS 3456
#define XB_SPIN_CAP (1u << 18)
__device__ __forceinline__ unsigned xb_ld(unsigned* p)              { return __hip_atomic_load(p, __ATOMIC_RELAXED, __HIP_MEMORY_SCOPE_AGENT); }
__device__ __forceinline__ unsigned xb_add(unsigned* p, unsigned v) { return __hip_atomic_fetch_add(p, v, __ATOMIC_RELAXED, __HIP_MEMORY_SCOPE_AGENT); }
__device__ __forceinline__ unsigned xb_xcc_id() { return (unsigned)__builtin_amdgcn_s_getreg((3 << 11) | 20) & 0xFu; }
#define XB_SPIN(cond, bar) do { unsigned _sp = 0; while (cond) { __builtin_amdgcn_s_sleep(1); \
    if ((++_sp & 255u) == 0u) { if (xb_ld(&(bar)[XB_TMO])) break; if (_sp > XB_SPIN_CAP) { atomicAdd(&(bar)[XB_TMO], 1u); break; } } } } while (0)
struct XcdBarrier { unsigned* bar; unsigned x; volatile LAS unsigned* st; };
__device__ __forceinline__ XcdBarrier xcd_barrier_post(unsigned* bar, volatile LAS unsigned* st) {
    XcdBarrier b; b.bar = bar; b.x = xb_xcc_id(); b.st = st;
    if (threadIdx.x == 0) (void)xb_add(&bar[XB_XCNT(b.x)], 1u);
    return b;
}
__device__ __forceinline__ void xcd_barrier_complete(unsigned* bar, unsigned x, unsigned& nloc, unsigned& nx) {
    const unsigned G = gridDim.x * gridDim.y * gridDim.z;
    unsigned sum, cnt, mine, sp = 0u;
    for (;;) {
        sum = 0u; cnt = 0u; mine = 0u;
#pragma unroll
        for (unsigned j = 0; j < 16; ++j) { const unsigned c = xb_ld(&bar[XB_XCNT(j)]); sum += c; cnt += (c > 0u) ? 1u : 0u; mine = (j == x) ? c : mine; }
        if (sum == G) break;
        __builtin_amdgcn_s_sleep(1);
        if ((++sp & 255u) == 0u) { if (xb_ld(&bar[XB_TMO])) break; if (sp > XB_SPIN_CAP) { atomicAdd(&bar[XB_TMO], 1u); break; } }
    }
    nloc = mine > 0u ? mine : 1u; nx = cnt > 0u ? cnt : 1u;
}
__device__ __forceinline__ void xcd_barrier(const XcdBarrier& b) {
    asm volatile("s_waitcnt vmcnt(0)" ::: "memory");
    __syncthreads();
    if (threadIdx.x == 0) {
        unsigned* bar = b.bar;
        __builtin_amdgcn_s_waitcnt(0);
        unsigned nloc = b.st[0], nx = b.st[1];
        if (nloc == 0u) { xcd_barrier_complete(bar, b.x, nloc, nx); b.st[0] = nloc; b.st[1] = nx; }
        const unsigned old = xb_add(&bar[XB_XSUB(b.x)], 1u);
        const unsigned gen = old / nloc;
        if (old + 1u == (gen + 1u) * nloc) {
            __builtin_amdgcn_fence(__ATOMIC_RELEASE, "agent");
            asm volatile("s_waitcnt vmcnt(0)" ::: "memory");
            const unsigned og = xb_add(&bar[XB_TOP], 1u);
            const unsigned tg = og / nx;
            if (og + 1u == (tg + 1u) * nx) xb_add(&bar[XB_TOPGEN], 1u);
            else XB_SPIN(xb_ld(&bar[XB_TOPGEN]) == tg, bar);
            __builtin_amdgcn_fence(__ATOMIC_ACQUIRE, "agent");
            xb_add(&bar[XB_XGEN(b.x)], 1u);
            asm volatile("s_waitcnt vmcnt(0)" ::: "memory");
        } else {
            XB_SPIN(xb_ld(&bar[XB_XGEN(b.x)]) == gen, bar);
            __builtin_amdgcn_fence(__ATOMIC_ACQUIRE, "agent");
            asm volatile("s_waitcnt vmcnt(0)" ::: "memory");
        }
    }
    __syncthreads();
}

constexpr int NWAVES = 8, NTHREADS = 512;
constexpr int RING_BYTES = 131072, TAB_OFF = RING_BYTES, TAB_BYTES = 8192, LDS_BYTES = 163840, MISC_OFF = LDS_BYTES - 512, VEC_OFF = RING_BYTES;
constexpr int CW_BAR = 4096;
#define LDS_WAIT() asm volatile("s_waitcnt lgkmcnt(0)" ::: "memory")
typedef unsigned v4u __attribute__((ext_vector_type(4)));
__device__ __forceinline__ unsigned pk2(float lo, float hi) { return (unsigned)f2bf(lo) | ((unsigned)f2bf(hi) << 16); }

__device__ __forceinline__ void p0_mod_item(const Ptrs& p, int it, int lane) {
    const int kc = it / 48, cc = it - kc * 48, k0 = kc * 64, c0 = cc * 256 + lane * 4;
    float sv[5];
#pragma unroll
    for (int r = 0; r < 5; ++r) { const float* cv = r < 4 ? p.c + r * D : p.c_ctx; sv[r] = silu_f(cv[k0 + lane]); }
    f32x4 acc[5];
#pragma unroll
    for (int r = 0; r < 5; ++r) acc[r] = (f32x4){0.f, 0.f, 0.f, 0.f};
    const float* w = p.w_ada + (size_t)k0 * 12288 + c0;
#pragma unroll 8
    for (int k = 0; k < 64; ++k) { const f32x4 wv = *(const f32x4*)(w + (size_t)k * 12288);
#pragma unroll
        for (int r = 0; r < 5; ++r) acc[r] += __int_as_float(__builtin_amdgcn_readlane(__float_as_int(sv[r]), k)) * wv; }
    float* part = (float*)(p.ws + WS_PART) + (size_t)kc * 5 * 12288 + c0;
#pragma unroll
    for (int r = 0; r < 5; ++r) *(f32x4*)(part + (size_t)r * 12288) = acc[r];
}
__device__ __forceinline__ void cvt_load(const float* src, int ldw, int lane, f32x4 (&v)[8]) {
    const int kr = lane >> 3, nq = lane & 7;
#pragma unroll
    for (int i = 0; i < 8; ++i) v[i] = *(const f32x4*)(src + (size_t)(8 * i + kr) * ldw + 4 * nq);
}
__device__ __forceinline__ void cvt_finish(const f32x4 (&v)[8], bf16* dst, int ldk, bool rope, const float* kscale, LAS float* scr, int lane) {
    const int kr = lane >> 3, nq = lane & 7;
#pragma unroll
    for (int i = 0; i < 8; ++i) { const int k = 8 * i + kr; const float sc = kscale ? kscale[k] : 1.f;
#pragma unroll
        for (int t = 0; t < 4; ++t) { const int cs = 4 * nq + t, nn = rope ? ((cs & 15) * 2 + (cs >> 4)) : cs; scr[k * 33 + nn] = v[i][t] * sc; } }
    LDS_WAIT(); asm volatile("" ::: "memory");
    const int c = lane & 7;
#pragma unroll
    for (int j = 0; j < 4; ++j) { const int n = (lane >> 3) + 8 * j; const LAS float* s = scr + (8 * c) * 33 + n;
        v4u o; o.x = pg8::cvt_pk_bf16(s[0 * 33], s[1 * 33]); o.y = pg8::cvt_pk_bf16(s[2 * 33], s[3 * 33]); o.z = pg8::cvt_pk_bf16(s[4 * 33], s[5 * 33]); o.w = pg8::cvt_pk_bf16(s[6 * 33], s[7 * 33]);
        *(v4u*)(dst + (size_t)n * ldk + 8 * c) = o; }
    LDS_WAIT(); asm volatile("" ::: "memory");
}
__device__ __forceinline__ void cvt_finish_fp8(const f32x4 (&v)[8], unsigned char* dst, int ldk, LAS float* scr, int lane) {
    const int kr = lane >> 3, nq = lane & 7;
#pragma unroll
    for (int i = 0; i < 8; ++i) { const int k = 8 * i + kr;
#pragma unroll
        for (int t = 0; t < 4; ++t) scr[k * 33 + 4 * nq + t] = v[i][t] * W8_SCALE; }
    LDS_WAIT(); asm volatile("" ::: "memory");
    const int c = lane & 3;
#pragma unroll
    for (int j = 0; j < 2; ++j) { const int n = (lane >> 2) + 16 * j; const LAS float* s = scr + (16 * c) * 33 + n;
        v4u o; o.x = pack4_fp8(s[0 * 33], s[1 * 33], s[2 * 33], s[3 * 33]); o.y = pack4_fp8(s[4 * 33], s[5 * 33], s[6 * 33], s[7 * 33]);
        o.z = pack4_fp8(s[8 * 33], s[9 * 33], s[10 * 33], s[11 * 33]); o.w = pack4_fp8(s[12 * 33], s[13 * 33], s[14 * 33], s[15 * 33]);
        *(v4u*)(dst + (size_t)n * ldk + 16 * c) = o; }
    LDS_WAIT(); asm volatile("" ::: "memory");
}
__device__ __forceinline__ void cvt_item(const float* src, int ldw, bf16* dst, int ldk, bool rope, const float* kscale, LAS float* scr, int lane) {
    f32x4 v[8]; cvt_load(src, ldw, lane, v); cvt_finish(v, dst, ldk, rope, kscale, scr, lane);
}
constexpr int I_MOD = 1536, I_WIN = 32 * 98, I_WQ = 8 * 48, I_WKV = 8 * 64, I_WOUT = 32 * 64, I_GU = 16 * 32 * 128, I_DN = 16 * 32 * 64, I_SGU = 256, I_ZERO = 768, I_ROPE = 1;
constexpr int P0_ITEMS = I_MOD + I_WIN + I_WQ + I_WKV + I_WOUT + I_SGU + I_ZERO + I_ROPE, PX_ITEMS = I_GU + I_DN;
__device__ __forceinline__ void p0_item(const Ptrs& p, int it, LAS float* scr, int lane) {
    if (it < I_MOD) { p0_mod_item(p, it, lane); return; } it -= I_MOD;
    if (it < I_WIN) { const int kb = it / 98, nb = it - kb * 98, n0 = nb * 32; int col0; bool rope = false;
        if (n0 < 1024) col0 = n0; else if (n0 < 3072) col0 = n0 + 64; else { col0 = OFF_KPE + (nb - 96) * 32; rope = true; }
        cvt_item(p.w_in + (size_t)kb * 64 * INC + col0, INC, (bf16*)(p.ws + WS_WIN_T) + (size_t)n0 * D + kb * 64, D, rope, nullptr, scr, lane); return; } it -= I_WIN;
    if (it < I_WQ) { const int kb = it / 48, nb = it - kb * 48, n0 = nb * 32; int col0; bool rope = false;
        if (n0 < 1024) col0 = (n0 >> 7) * DQK + (n0 & 127); else { const int jj = n0 - 1024; col0 = (jj >> 6) * DQK + 128 + ((jj & 63) >> 5) * 32; rope = true; }
        cvt_item(p.w_uq + (size_t)kb * 64 * 1536 + col0, 1536, (bf16*)(p.ws + WS_WQKV_T) + (size_t)n0 * 512 + kb * 64, 512, rope, p.q_norm_w + kb * 64, scr, lane); return; } it -= I_WQ;
    if (it < I_WKV) { const int kb = it / 64, nb = it - kb * 64, n0 = nb * 32;
        cvt_item(p.w_ukv + (size_t)kb * 64 * 2048 + n0, 2048, (bf16*)(p.ws + WS_WQKV_T) + (size_t)(1536 + n0) * 512 + kb * 64, 512, false, p.kv_norm_w + kb * 64, scr, lane); return; } it -= I_WKV;
    if (it < I_WOUT) { const int kb = it / 64, nb = it - kb * 64, n0 = nb * 32;
        cvt_item(p.w_out + (size_t)kb * 64 * D + n0, D, (bf16*)(p.ws + WS_WOUT_T) + (size_t)n0 * D + kb * 64, D, false, nullptr, scr, lane); return; } it -= I_WOUT;
    if (it < I_SGU) { const float* s = p.sgu_w + (size_t)it * 512 + lane * 8; const f32x4 a = *(const f32x4*)s, b = *(const f32x4*)(s + 4);
        v4u o; o.x = pk2(a[0], a[1]); o.y = pk2(a[2], a[3]); o.z = pk2(b[0], b[1]); o.w = pk2(b[2], b[3]); *(v4u*)((bf16*)(p.ws + WS_SGUW) + (size_t)it * 512 + lane * 8) = o; return; } it -= I_SGU;
    if (it < I_ZERO) { *(v4u*)((bf16*)(p.ws + WS_WIN_T) + (size_t)3136 * D + (size_t)it * 512 + lane * 8) = (v4u){0u, 0u, 0u, 0u}; return; }
    float* tab = (float*)(p.ws + WS_ROPE);
    for (int j = 0; j < 16; ++j) { const int idx = j * 64 + lane, ax = idx >> 4, ii = idx & 15; float s, c; sincosf((float)ax * rope_inv(ii), &s, &c); tab[idx * 2] = c; tab[idx * 2 + 1] = s; }
}
constexpr int PX_N3 = 0, PX_N4 = 0, PX_N8 = 0, PX_R3 = 0, PX_R4 = PX_R3 + 180 * PX_N3, PX_R8 = PX_R4 + 96 * PX_N4, PX_R5 = PX_R8 + 192 * PX_N8;
constexpr int WEL = FP8_MOE ? 1 : 2;
#if 0
#else
__device__ __forceinline__ void px_ptrs(const Ptrs& p, int it, const float*& src, unsigned char*& dst) {
    if (it < I_GU) { const int e = it >> 12, r = it & 4095, kb = r >> 7, nb = r & 127, n0 = nb * 32, pn = n0 >> 8, within = n0 & 255;
        src = (within < 128 ? p.w_e_gate : p.w_e_up) + ((size_t)e * D + kb * 64) * FF + pn * 128 + (within & 127);
        dst = p.ws + WS_WGU_T + (((size_t)e * 4096 + n0) * D + kb * 64) * WEL; }
    else { it -= I_GU; const int e = it >> 11, r = it & 2047, kb = r >> 6, nb = r & 63, n0 = nb * 32;
        src = p.w_e_down + ((size_t)e * FF + kb * 64) * D + n0; dst = p.ws + WS_WD_T + (((size_t)e * D + n0) * FF + kb * 64) * WEL; }
}
__device__ __forceinline__ void px_dma(const float* src, unsigned ldsbase, int lane) {
    typedef __attribute__((address_space(3))) unsigned* ldsp_t;
#pragma unroll
    for (int i = 0; i < 8; ++i) { const int k = 8 * i + (lane >> 3), nq = ((lane & 7) - 2 * (k >> 4)) & 7;
        __builtin_amdgcn_global_load_lds((const unsigned*)(src + (size_t)k * 2048 + 4 * nq), (ldsp_t)(ldsbase + i * 1024), 16, 0, 0); }
}
__device__ __forceinline__ void px_out(unsigned char* dst, const LAS float* t, int lane) {
    if constexpr (FP8_MOE) {
        const int c = lane & 3;
#pragma unroll
        for (int j = 0; j < 2; ++j) { const int n = (lane >> 2) + 16 * j; float v[16];
#pragma unroll
            for (int q = 0; q < 16; ++q) { const int k = 16 * c + q; v[q] = t[(k * 8 + (((n >> 2) + 2 * c) & 7)) * 4 + (n & 3)] * W8_SCALE; }
            v4u o; o.x = pack4_fp8(v[0], v[1], v[2], v[3]); o.y = pack4_fp8(v[4], v[5], v[6], v[7]); o.z = pack4_fp8(v[8], v[9], v[10], v[11]); o.w = pack4_fp8(v[12], v[13], v[14], v[15]);
            *(v4u*)(dst + (size_t)n * 2048 + 16 * c) = o; }
    } else {
        const int c = lane & 7;
#pragma unroll
        for (int j = 0; j < 4; ++j) { const int n = (lane >> 3) + 8 * j; float v[8];
#pragma unroll
            for (int q = 0; q < 8; ++q) { const int k = 8 * c + q; v[q] = t[(k * 8 + (((n >> 2) + 2 * (k >> 4)) & 7)) * 4 + (n & 3)]; }
            v4u o; o.x = pg8::cvt_pk_bf16(v[0], v[1]); o.y = pg8::cvt_pk_bf16(v[2], v[3]); o.z = pg8::cvt_pk_bf16(v[4], v[5]); o.w = pg8::cvt_pk_bf16(v[6], v[7]);
            *(v4u*)((bf16*)dst + (size_t)n * 2048 + 8 * c) = o; }
    }
}
__device__ __forceinline__ void px_convert(const Ptrs& p, int it0, int NGW, int PX_END, LAS float* scr, int lane) {
    const unsigned l0 = (unsigned)(uintptr_t)scr; const float* s_; unsigned char *da, *db;
    int it = it0;
    if (it < PX_END) { px_ptrs(p, it, s_, da); px_dma(s_, l0, lane); }
    while (it < PX_END) {
        const int i1 = it + NGW, i2 = it + 2 * NGW;
        if (i1 < PX_END) { px_ptrs(p, i1, s_, db); px_dma(s_, l0 + 8192, lane); asm volatile("s_waitcnt vmcnt(8)" ::: "memory"); } else asm volatile("s_waitcnt vmcnt(0)" ::: "memory");
        px_out(da, scr, lane);
        if (i1 >= PX_END) break;
        asm volatile("s_waitcnt lgkmcnt(0)" ::: "memory");
        if (i2 < PX_END) { px_ptrs(p, i2, s_, da); px_dma(s_, l0, lane); asm volatile("s_waitcnt vmcnt(8)" ::: "memory"); } else asm volatile("s_waitcnt vmcnt(0)" ::: "memory");
        px_out(db, scr + 2048, lane);
        asm volatile("s_waitcnt lgkmcnt(0)" ::: "memory");
        it = i2;
    }
}
#endif
__device__ __forceinline__ void p1_row(const Ptrs& p, int row, int lane, const LAS float* vg  , const LAS float* vs  ) {
    const float* src = row < M ? p.x + (size_t)row * D : p.ctx + (size_t)(row - M) * D;
    f32x4 v[8]; float s = 0.f;
#pragma unroll
    for (int j = 0; j < 8; ++j) { v[j] = *(const f32x4*)(src + j * 256 + lane * 4); s += dot4(v[j]); }
    const float rs = rsqrtf(wave_sum(s) * (1.f / D) + EPS);
    bf16* o = (bf16*)(p.ws + WS_H) + (size_t)row * D;
#pragma unroll
    for (int j = 0; j < 8; ++j) { const int c = j * 256 + lane * 4; const f32x4 h = v[j] * rs * *(const LAS f32x4*)(vg + c) + *(const LAS f32x4*)(vs + c);
        *(unsigned long long*)(o + c) = (unsigned long long)pk2(h[0], h[1]) | ((unsigned long long)pk2(h[2], h[3]) << 32); }
}
typedef float f32x16 __attribute__((ext_vector_type(16)));
typedef short bf16x8v __attribute__((ext_vector_type(8)));
struct SguIn { v4u vs[4]; };
__device__ __forceinline__ void sgu_fetch(const Ptrs& p, int chunk, int g, int tid, SguIn& in) {
    const bf16* src = (const bf16*)(p.ws + WS_VS) + (size_t)(chunk * 128 + (tid >> 2)) * 1024 + g * 128 + (tid & 3) * 32;
#pragma unroll
    for (int j = 0; j < 4; ++j) in.vs[j] = *(const v4u*)(src + j * 8);
}
__device__ __forceinline__ void sgu_unit(const Ptrs& p, int chunk, int g, LAS unsigned char* lds, int tid, const SguIn& in) {
    constexpr int VROW = 272;
    const int lane = tid & 63, wid = tid >> 6;
    const int pb = wid >> 1, ch = wid & 1, r32 = lane & 31, hi = lane >> 5;
    v4u uw[4];
#pragma unroll
    for (int i = 0; i < 4; ++i) { const int id = tid + NTHREADS * i, pr = id >> 4, c8 = (id & 15) * 8; uw[i] = *(const v4u*)((const bf16*)(p.ws + WS_U) + ((size_t)chunk * 128 + pr) * 1024 + g * 128 + c8); }
    bf16x8v wa[8];
    { const bf16* wrow = (const bf16*)(p.ws + WS_SGUW) + ((size_t)g * 128 + pb * 32 + r32) * 128 + hi * 8;
#pragma unroll
      for (int ks = 0; ks < 8; ++ks) wa[ks] = *(const bf16x8v*)(wrow + ks * 16); }
    {
        const int q = tid >> 2, cg = tid & 3;
        float x[32];
#pragma unroll
        for (int j = 0; j < 4; ++j) { const v4u w = in.vs[j];
#pragma unroll
            for (int t = 0; t < 4; ++t) { x[j * 8 + 2 * t] = __uint_as_float(w[t] << 16); x[j * 8 + 2 * t + 1] = __uint_as_float(w[t] & 0xffff0000u); } }
        float s = 0.f;
#pragma unroll
        for (int j = 0; j < 32; ++j) s += x[j];
        s += __shfl_xor(s, 1); s += __shfl_xor(s, 2);
        const float mu = s * (1.f / 128.f); float vq = 0.f;
#pragma unroll
        for (int j = 0; j < 32; ++j) { x[j] -= mu; vq += x[j] * x[j]; }
        vq += __shfl_xor(vq, 1); vq += __shfl_xor(vq, 2);
        const float rs = rsqrtf(vq * (1.f / 128.f) + EPS);
        const float* gw = p.sgu_norm_w + g * 128 + cg * 32;
#pragma unroll
        for (int j = 0; j < 32; ++j) *(LAS bf16*)(lds + (cg * 32 + j) * VROW + q * 2) = f2bf(x[j] * rs * gw[j]);
    }
    LDS_WAIT(); __syncthreads();
    f32x16 acc0 = {}, acc1 = {};
#pragma unroll
    for (int ks = 0; ks < 8; ++ks) {
        const bf16x8v b0 = *(const LAS bf16x8v*)(lds + (ch * 64 + r32) * VROW + (ks * 16 + hi * 8) * 2);
        const bf16x8v b1 = *(const LAS bf16x8v*)(lds + (ch * 64 + 32 + r32) * VROW + (ks * 16 + hi * 8) * 2);
        acc0 = __builtin_amdgcn_mfma_f32_32x32x16_bf16(wa[ks], b0, acc0, 0, 0, 0);
        acc1 = __builtin_amdgcn_mfma_f32_32x32x16_bf16(wa[ks], b1, acc1, 0, 0, 0);
    }
    LAS float* T = (LAS float*)(lds + 36864);
#pragma unroll
    for (int r = 0; r < 16; ++r) { const int pr = pb * 32 + (r & 3) + 8 * (r >> 2) + 4 * hi; const float bias = p.sgu_b[g * 128 + pr];
        T[pr * 128 + ch * 64 + r32] = acc0[r] + bias; T[pr * 128 + ch * 64 + 32 + r32] = acc1[r] + bias; }
    LDS_WAIT(); __syncthreads();
#pragma unroll
    for (int i = 0; i < 4; ++i) { const int id = tid + NTHREADS * i, pr = id >> 4, c8 = (id & 15) * 8; const size_t tok = (size_t)chunk * 128 + pr;
        const f32x4 m0 = *(const LAS f32x4*)(T + pr * 128 + c8), m1 = *(const LAS f32x4*)(T + pr * 128 + c8 + 4); const v4u u4 = uw[i];
        v4u o; o.x = pg8::cvt_pk_bf16(__uint_as_float(u4.x << 16) * m0[0], __uint_as_float(u4.x & 0xffff0000u) * m0[1]); o.y = pg8::cvt_pk_bf16(__uint_as_float(u4.y << 16) * m0[2], __uint_as_float(u4.y & 0xffff0000u) * m0[3]);
        o.z = pg8::cvt_pk_bf16(__uint_as_float(u4.z << 16) * m1[0], __uint_as_float(u4.z & 0xffff0000u) * m1[1]); o.w = pg8::cvt_pk_bf16(__uint_as_float(u4.w << 16) * m1[2], __uint_as_float(u4.w & 0xffff0000u) * m1[3]);
        *(v4u*)((bf16*)(p.ws + WS_CAT) + tok * D + 1024 + g * 128 + c8) = o; }
    __syncthreads();
}
__device__ __forceinline__ void topk_unit(const Ptrs& p, int e, int b, LAS unsigned* sh, int tid) {
    const int lane = tid & 63, wid = tid >> 6;
    const float* aff = (const float*)(p.ws + WS_AFF) + (size_t)b * L * 16 + e;
    unsigned key[8];
#pragma unroll
    for (int j = 0; j < 8; ++j) key[j] = __float_as_uint(aff[(size_t)(tid * 8 + j) * 16]);
    unsigned prefix = 0u, mask = 0u, need = CAP;
    for (int shift = 24; shift >= 0; shift -= 8) {
        if (tid < 256) sh[tid] = 0u;
        __syncthreads();
#pragma unroll
        for (int j = 0; j < 8; ++j) if ((key[j] & mask) == prefix) atomicAdd((unsigned*)&sh[(key[j] >> shift) & 255u], 1u);
        __syncthreads();
        if (wid == 0) {
            const unsigned c0 = sh[4 * lane], c1 = sh[4 * lane + 1], c2 = sh[4 * lane + 2], c3 = sh[4 * lane + 3];
            const unsigned s = c0 + c1 + c2 + c3; unsigned S = s;
#pragma unroll
            for (int d = 1; d < 64; d <<= 1) { const unsigned v = __shfl_down(S, d); if (lane + d < 64) S += v; }
            const unsigned above = S - s;
            if (S >= need && above < need) { unsigned cum = above, bin, nd;
                if (cum + c3 >= need) { bin = 3; nd = need - cum; } else { cum += c3;
                if (cum + c2 >= need) { bin = 2; nd = need - cum; } else { cum += c2;
                if (cum + c1 >= need) { bin = 1; nd = need - cum; } else { cum += c1; bin = 0; nd = need - cum; } } }
                sh[256] = 4u * lane + bin; sh[257] = nd; }
        }
        __syncthreads();
        prefix |= sh[256] << shift; mask |= 255u << shift; need = sh[257];
        __syncthreads();
    }
    unsigned cg = 0u, ce = 0u;
#pragma unroll
    for (int j = 0; j < 8; ++j) { cg += key[j] > prefix ? 1u : 0u; ce += key[j] == prefix ? 1u : 0u; }
    unsigned pk = (cg << 16) | ce, inc = pk;
#pragma unroll
    for (int d = 1; d < 64; d <<= 1) { const unsigned v = __shfl_up(inc, d); if (lane >= d) inc += v; }
    if (lane == 63) sh[264 + wid] = inc;
    __syncthreads();
    unsigned off = 0u;
#pragma unroll
    for (int w = 0; w < 8; ++w) off += (w < wid) ? sh[264 + w] : 0u;
    unsigned ex = off + inc - pk; unsigned gtb = ex >> 16, eqb = ex & 0xffffu;
    int* inv = (int*)(p.ws + WS_INV) + (size_t)(b * L + tid * 8) * 16 + e; int* idx = (int*)(p.ws + WS_IDX) + (size_t)(e * 4 + b) * CAP;
#pragma unroll
    for (int j = 0; j < 8; ++j) { const bool gt = key[j] > prefix, eq = key[j] == prefix; const bool sel = gt || (eq && eqb < need);
        const unsigned slot = gtb + (eqb < need ? eqb : need);
        inv[(size_t)j * 16] = sel ? (int)slot : -1; if (sel) idx[slot] = tid * 8 + j;
        gtb += gt ? 1u : 0u; eqb += eq ? 1u : 0u; }
    __syncthreads();
}

__device__ __forceinline__ f32x4 ld_bf16x4(const bf16* s) { const unsigned long long w = *(const unsigned long long*)s; const unsigned lo = (unsigned)w, hi2 = (unsigned)(w >> 32);
    return (f32x4){__uint_as_float(lo << 16), __uint_as_float(lo & 0xffff0000u), __uint_as_float(hi2 << 16), __uint_as_float(hi2 & 0xffff0000u)}; }
__device__ __forceinline__ void st_bf16x4(bf16* d, const f32x4& h) { *(unsigned long long*)d = (unsigned long long)pk2(h[0], h[1]) | ((unsigned long long)pk2(h[2], h[3]) << 32); }
struct P6In { f32x4 x[8]; unsigned long long y[8]; float ssq; };
__device__ __forceinline__ void p6_fetch(const Ptrs& p, int row, int lane, P6In& in) {
    const float* xr = p.x + (size_t)row * D + lane * 4; const bf16* y = (const bf16*)(p.ws + WS_Y) + (size_t)row * D + lane * 4;
#pragma unroll
    for (int j = 0; j < 8; ++j) { in.x[j] = *(const f32x4*)(xr + j * 256); in.y[j] = *(const unsigned long long*)(y + j * 256); }
    in.ssq = lane < 32 ? ((const float*)(p.ws + WS_SSQY))[(size_t)row * 32 + lane] : 0.f;
}
__device__ __forceinline__ f32x4 bf16x4_to_f32(unsigned long long w) { const unsigned lo = (unsigned)w, hi2 = (unsigned)(w >> 32);
    return (f32x4){__uint_as_float(lo << 16), __uint_as_float(lo & 0xffff0000u), __uint_as_float(hi2 << 16), __uint_as_float(hi2 & 0xffff0000u)}; }
__device__ __forceinline__ void p6_row(const Ptrs& p, int row, int lane, const LAS float* wt, const LAS float* vt, const P6In& in, int flags) {
    const float rsy = rsqrtf(wave_sum(in.ssq) * (1.f / D) + EPS);
    bf16* o = (bf16*)(p.ws + ((flags & 1) ? WS_VN : WS_XN)) + (size_t)row * D;
    f32x4 v[8]; float s = 0.f;
#pragma unroll
    for (int j = 0; j < 8; ++j) { const int c = j * 256 + lane * 4;
        v[j] = in.x[j] + (bf16x4_to_f32(in.y[j]) * rsy) * *(const LAS f32x4*)(vt + c);
        st_bf16x4(o + c, v[j]); s += dot4(v[j]); }
    const float rs = rsqrtf(wave_sum(s) * (1.f / D) + EPS);
    bf16* h2 = (bf16*)(p.ws + ((flags & 1) ? WS_VN : WS_H2)) + (size_t)row * D;
    float lg[16];
#pragma unroll
    for (int e = 0; e < 16; ++e) lg[e] = 0.f;
    f32x4 hv[8];
#pragma unroll
    for (int j = 0; j < 8; ++j) { const int c = j * 256 + lane * 4;
        hv[j] = v[j] * rs * *(const LAS f32x4*)(vt + 2048 + c) + *(const LAS f32x4*)(vt + 4096 + c);
        if constexpr (FP8_MOE) *(unsigned*)((unsigned char*)(p.ws + ((flags & 1) ? WS_VN : WS_H2)) + (size_t)row * D + c) = pack4_fp8(hv[j][0], hv[j][1], hv[j][2], hv[j][3]); else st_bf16x4(h2 + c, hv[j]); }
    if (!(flags & 2)) {
        f32x4 wa[8], wb[8];
#define RLOAD(dst, st) do { const LAS float* wp_ = wt + ((st) & 1) * 8 * 2048 + ((st) >> 1) * 256 + lane * 4; _Pragma("unroll") for (int e_ = 0; e_ < 8; ++e_) dst[e_] = *(const LAS f32x4*)(wp_ + e_ * 2048); } while (0)
#define RFMA(src, st) do { const f32x4 h_ = hv[(st) >> 1]; _Pragma("unroll") for (int e_ = 0; e_ < 8; ++e_) lg[((st) & 1) * 8 + e_] += (h_[0] * src[e_][0] + h_[1] * src[e_][1]) + (h_[2] * src[e_][2] + h_[3] * src[e_][3]); } while (0)
        RLOAD(wa, 0);
#pragma unroll
        for (int st = 0; st < 16; st += 2) {
            RLOAD(wb, st + 1); __builtin_amdgcn_sched_barrier(0); RFMA(wa, st); __builtin_amdgcn_sched_barrier(0);
            if (st + 2 < 16) RLOAD(wa, st + 2); __builtin_amdgcn_sched_barrier(0); RFMA(wb, st + 1); __builtin_amdgcn_sched_barrier(0);
        }
#undef RLOAD
#undef RFMA
    }
#define XSTEP(N, MASK) _Pragma("unroll") for (int i = 0; i < N; ++i) { const bool up = (lane & MASK) != 0; const float send = up ? lg[i] : lg[i + N]; const float keep = up ? lg[i + N] : lg[i]; lg[i] = keep + __shfl_xor(send, MASK); }
    XSTEP(8, 32) XSTEP(4, 16) XSTEP(2, 8) XSTEP(1, 4)
#undef XSTEP
    float lgt = lg[0]; lgt += __shfl_xor(lgt, 2); lgt += __shfl_xor(lgt, 1);
    lgt += p.b_router[lane >> 2];
    float mx = lgt;
#pragma unroll
    for (int o2 = 4; o2 < 64; o2 <<= 1) mx = fmaxf(mx, __shfl_xor(mx, o2));
    const float ex = __expf(lgt - mx); float se = ex;
#pragma unroll
    for (int o2 = 4; o2 < 64; o2 <<= 1) se += __shfl_xor(se, o2);
    if ((lane & 3) == 0 && !(flags & 1)) ((float*)(p.ws + WS_AFF))[(size_t)row * 16 + (lane >> 2)] = ex / se;
}
typedef unsigned u32x4v __attribute__((ext_vector_type(4)));
struct P11In { u32x4v x[4]; int inv; float aff; };
__device__ __forceinline__ void p11_fetch(const Ptrs& p, int row, int lane, P11In& in) {
    const bf16* xr = (const bf16*)(p.ws + WS_XN) + (size_t)row * D + lane * 8;
#pragma unroll
    for (int j = 0; j < 4; ++j) in.x[j] = *(const u32x4v*)(xr + j * 512);
    in.inv = ((const int*)(p.ws + WS_INV))[(size_t)row * 16 + (lane & 15)]; in.aff = ((const float*)(p.ws + WS_AFF))[(size_t)row * 16 + (lane & 15)];
}
__device__ __forceinline__ void acc_bf16x8(f32x4& a, f32x4& b, const u32x4v& w, float g) {
    a[0] += g * __uint_as_float(w[0] << 16); a[1] += g * __uint_as_float(w[0] & 0xffff0000u); a[2] += g * __uint_as_float(w[1] << 16); a[3] += g * __uint_as_float(w[1] & 0xffff0000u);
    b[0] += g * __uint_as_float(w[2] << 16); b[1] += g * __uint_as_float(w[2] & 0xffff0000u); b[2] += g * __uint_as_float(w[3] << 16); b[3] += g * __uint_as_float(w[3] & 0xffff0000u);
}
__device__ __forceinline__ void p11_row(const Ptrs& p, int row, int lane, float* dsto, const LAS float* vt, const P11In& in, int flags) {
    const int b = row >> 12;
    unsigned mask = (flags & 2) ? 0u : (unsigned)(__ballot(in.inv >= 0) & 0xffffull);
    f32x4 v[8];
#pragma unroll
    for (int j = 0; j < 8; ++j) v[j] = (f32x4){0.f, 0.f, 0.f, 0.f};
    while (mask) {
#if FP8_MOE
        unsigned long long r[4][4]; float g[4]; bool on[4];
#pragma unroll
        for (int k = 0; k < 4; ++k) { on[k] = mask != 0u; g[k] = 0.f;
            if (on[k]) { const int e = __builtin_ctz(mask); mask &= mask - 1u; const int sl = __builtin_amdgcn_readlane(in.inv, e); g[k] = __int_as_float(__builtin_amdgcn_readlane(__float_as_int(in.aff), e));
                const unsigned char* ye = p.ws + WS_YE + ((size_t)(e * 4 + b) * CAP + sl) * D + lane * 8;
#pragma unroll
                for (int j = 0; j < 4; ++j) r[k][j] = *(const unsigned long long*)(ye + j * 512); } }
#pragma unroll
        for (int k = 0; k < 4; ++k) if (on[k]) {
#pragma unroll
            for (int j = 0; j < 4; ++j) { const int lo32 = (int)(unsigned)r[k][j], hi32 = (int)(unsigned)(r[k][j] >> 32);
                const auto a0 = __builtin_amdgcn_cvt_pk_f32_fp8(lo32, false), a1 = __builtin_amdgcn_cvt_pk_f32_fp8(lo32, true), b0 = __builtin_amdgcn_cvt_pk_f32_fp8(hi32, false), b1 = __builtin_amdgcn_cvt_pk_f32_fp8(hi32, true);
                v[2 * j][0] += g[k] * a0[0]; v[2 * j][1] += g[k] * a0[1]; v[2 * j][2] += g[k] * a1[0]; v[2 * j][3] += g[k] * a1[1];
                v[2 * j + 1][0] += g[k] * b0[0]; v[2 * j + 1][1] += g[k] * b0[1]; v[2 * j + 1][2] += g[k] * b1[0]; v[2 * j + 1][3] += g[k] * b1[1]; } }
#else
        u32x4v r[4][4]; float g[4]; bool on[4];
#pragma unroll
        for (int k = 0; k < 4; ++k) { on[k] = mask != 0u; g[k] = 0.f;
            if (on[k]) { const int e = __builtin_ctz(mask); mask &= mask - 1u; const int sl = __builtin_amdgcn_readlane(in.inv, e); g[k] = __int_as_float(__builtin_amdgcn_readlane(__float_as_int(in.aff), e));
                const bf16* ye = (const bf16*)(p.ws + WS_YE) + ((size_t)(e * 4 + b) * CAP + sl) * D + lane * 8;
#pragma unroll
                for (int j = 0; j < 4; ++j) r[k][j] = *(const u32x4v*)(ye + j * 512); } }
#pragma unroll
        for (int k = 0; k < 4; ++k) if (on[k]) {
#pragma unroll
            for (int j = 0; j < 4; ++j) acc_bf16x8(v[2 * j], v[2 * j + 1], r[k][j], g[k]); }
#endif
    }
    float s = 0.f;
#pragma unroll
    for (int j = 0; j < 8; ++j) s += dot4(v[j]);
    const float rs = rsqrtf(wave_sum(s) * (1.f / D) + EPS);
    float* od = dsto + (size_t)row * D + lane * 8;
#pragma unroll
    for (int j = 0; j < 4; ++j) { const int c = j * 512 + lane * 8;
        const u32x4v xw = in.x[j];
        const f32x4 xa = (f32x4){__uint_as_float(xw[0] << 16), __uint_as_float(xw[0] & 0xffff0000u), __uint_as_float(xw[1] << 16), __uint_as_float(xw[1] & 0xffff0000u)};
        const f32x4 xb = (f32x4){__uint_as_float(xw[2] << 16), __uint_as_float(xw[2] & 0xffff0000u), __uint_as_float(xw[3] << 16), __uint_as_float(xw[3] & 0xffff0000u)};
        *(f32x4*)(od + j * 512) = xa + (v[2 * j] * rs) * *(const LAS f32x4*)(vt + c);
        *(f32x4*)(od + j * 512 + 4) = xb + (v[2 * j + 1] * rs) * *(const LAS f32x4*)(vt + c + 4); }
}

struct Args { Ptrs p; int ph_lo, ph_hi, bar_idx, pad; };
#define PROBE_FLAGS 0
__global__ void __launch_bounds__(NTHREADS, 2) fwd(Args args) {
    extern __shared__ __attribute__((aligned(16))) unsigned char lds_raw[];
    LAS unsigned char* lds = (LAS unsigned char*)lds_raw;
#if defined(__HIP_DEVICE_COMPILE__)
    typedef __attribute__((address_space(4))) const Args CArgs;
#define LOADP() Ptrs p; { const CArgs* kp_ = (const CArgs*)__builtin_amdgcn_kernarg_segment_ptr(); asm volatile("" : "+s"(kp_)); p = kp_->p; }
#else
#define LOADP() Ptrs p = args.p;
#endif
#define TIDS() int tid = threadIdx.x; asm volatile("" : "+v"(tid)); const int lane = tid & 63, wave = __builtin_amdgcn_readfirstlane(tid >> 6); \
    const int G = gridDim.x, bx = blockIdx.x, vcu = (G % 8 == 0) ? (bx % 8) * (G / 8) + bx / 8 : bx; const int gw = vcu * NWAVES + wave, NGW = G * NWAVES; (void)lane; (void)gw; (void)NGW; (void)vcu; (void)bx;
    volatile LAS unsigned* MISC = (volatile LAS unsigned*)(lds + MISC_OFF);
    if (threadIdx.x < 64) MISC[threadIdx.x] = 0u;
    __syncthreads();
#if defined(__HIP_DEVICE_COMPILE__)
#define ARGF(f) ([&]() { const CArgs* kq_ = (const CArgs*)__builtin_amdgcn_kernarg_segment_ptr(); asm volatile("" : "+s"(kq_)); return kq_->f; }())
#else
#define ARGF(f) (args.f)
#endif
    if (ARGF(ph_hi) - ARGF(ph_lo) > 1) { LOADP(); (void)xcd_barrier_post((unsigned*)(p.ws + WS_CTL) + CW_BAR + ARGF(bar_idx) * 4096, MISC + 8); }
#define GRID_BARRIER() do { LOADP(); XcdBarrier b_; b_.bar = (unsigned*)(p.ws + WS_CTL) + CW_BAR + ARGF(bar_idx) * 4096; b_.x = xb_xcc_id(); b_.st = (volatile LAS unsigned*)(lds + MISC_OFF) + 8; xcd_barrier(b_); } while (0)
#define lo ARGF(ph_lo)
#define hi ARGF(ph_hi)
#if defined(ONLY_SET)
#define IN(k) (((ONLY_SET >> (k)) & 1) && lo <= (k) && (k) < hi)
#elif defined(ONLY_PHASE)
#define IN(k) ((k) == ONLY_PHASE && lo <= (k) && (k) < hi)
#else
#define IN(k) (lo <= (k) && (k) < hi)
#endif
#define SEAM(k) do { if (IN(k) && IN((k) + 1)) GRID_BARRIER(); } while (0)

    if (IN(0)) { LOADP(); TIDS();
        LAS float* scr = (LAS float*)(lds + wave * 8448);
        for (int it = gw; it < P0_ITEMS; it += NGW) p0_item(p, it, scr, lane);
    }
    SEAM(0);
    if (IN(1)) { LOADP(); TIDS();
        const int gid = bx * NTHREADS + tid;
        if (gid < 5 * 12288) { const int r = gid / 12288, j = gid - r * 12288; float s = p.b_ada[j]; const float* part = (const float*)(p.ws + WS_PART) + (size_t)r * 12288 + j;
            for (int kc = 0; kc < 32; ++kc) s += part[(size_t)kc * 5 * 12288];
            ((float*)(p.ws + WS_MOD))[gid] = s; }
    }
    SEAM(1);
    if (IN(2)) { LOADP(); TIDS();
        const int bsel = vcu & 3, wsub = (vcu >> 2) * NWAVES + wave, nsub = ((G + 3 - bsel) >> 2) * NWAVES;
        LAS float* vt = (LAS float*)lds;
        for (int c = tid; c < D; c += NTHREADS) { const float* mb = (const float*)(p.ws + WS_MOD) + bsel * 12288; const float* mc = (const float*)(p.ws + WS_MOD) + 4 * 12288; const float g = p.pre_norm1[c];
            vt[c] = g * (1.f + mb[2048 + c]); vt[2048 + c] = mb[c]; vt[4096 + c] = g * (1.f + mc[2048 + c]); vt[6144 + c] = mc[c]; }
        LDS_WAIT(); __syncthreads();
        for (int r = wsub; r < L; r += nsub) p1_row(p, bsel * L + r, lane, vt, vt + 2048);
        for (int row = M + gw; row < MALL; row += NGW) p1_row(p, row, lane, vt + 4096, vt + 6144);
        __syncthreads();
    }
    SEAM(2);
    if (IN(3)) { LOADP(); TIDS();
        SchedIn S{(const char*)(p.ws + WS_H), (const char*)(p.ws + WS_WIN_T), G, bx}; EpiIn E{p.ws};
        pg8::gemm_phase<EpiIn, SchedIn>(lds, 2048, S, E);
        if (G == 256 && bx >= 76) { const int base = PX_R3 + (bx - 76) * PX_N3; px_convert(p, base + wave, NWAVES, base + PX_N3, (LAS float*)(lds + wave * 16384), lane); __syncthreads(); }
    }
    SEAM(3);
    if (IN(4)) { LOADP(); TIDS();
        SchedQKV S{(const char*)(p.ws + WS_CQKV), (const char*)(p.ws + WS_WQKV_T), G, bx};
        LAS float* rstab = (LAS float*)(lds + TAB_OFF);
        for (int q = tid; q < 2048; q += NTHREADS) { const int i = q >> 8, r = q & 255; Unit u;
            if (S.next(i, u)) { const float* sp = u.pm < 64 ? (const float*)(p.ws + WS_SSQQ) + (size_t)(u.pm * 256 + r) * 8 : (const float*)(p.ws + WS_SSQKV) + (size_t)((u.pm - 64) * 256 + r) * 8;
                const f32x4 s0 = *(const f32x4*)sp, s1 = *(const f32x4*)(sp + 4);
                rstab[q] = rsqrtf((((s0[0] + s0[1]) + (s0[2] + s0[3])) + ((s1[0] + s1[1]) + (s1[2] + s1[3]))) * (1.f / 512.f) + EPS); } }
        LDS_WAIT(); __syncthreads();
        EpiQKV E{p.ws, rstab};
        pg8::gemm_phase<EpiQKV, SchedQKV>(lds, 512, S, E);
        if (G == 256 && bx >= 160) { const int base = PX_R4 + (bx - 160) * PX_N4; px_convert(p, base + wave, NWAVES, base + PX_N4, (LAS float*)(lds + wave * 16384), lane); }
        __syncthreads();
#ifdef SGU_REP
        for (int rep_ = 0; rep_ < SGU_REP; ++rep_)
#endif
        { SguIn nxt; if (vcu < 1024) sgu_fetch(p, vcu >> 3, vcu & 7, tid, nxt);
          for (int u = vcu; u < 1024; u += G) { const SguIn cur = nxt; if (u + G < 1024) sgu_fetch(p, (u + G) >> 3, (u + G) & 7, tid, nxt); sgu_unit(p, u >> 3, u & 7, lds, tid, cur); } }
    }
    SEAM(4);
    if (IN(5)) { TIDS();
        att::CvStream cv; { LOADP(); cv.it = gw; cv.end = FP8_MOE ? att::CV_ITEMS : 0; cv.step = NGW; cv.gate = p.w_e_gate; cv.up = p.w_e_up; cv.down = p.w_e_down; cv.wgu = p.ws + WS_WGU_T; cv.wd = p.ws + WS_WD_T; }
#define ATT_UNIT(u_) do { const int u = (u_); if (u < 512) { LOADP(); const int bh = u >> 4, qb = u & 15; __syncthreads(); \
            att::attn_unit<0>((const bf16*)(p.ws + WS_Q) + ((size_t)bh * L + qb * 256) * DQK, (const bf16*)(p.ws + WS_K) + (size_t)bh * LK * DQK, (const bf16*)(p.ws + WS_V) + (size_t)bh * LK * VH, \
                           (bf16*)(p.ws + WS_CAT) + ((size_t)(bh >> 3) * L + qb * 256) * D + (bh & 7) * 128, LK, (char*)lds_raw, cv); } } while (0)
        ATT_UNIT(vcu); ATT_UNIT(vcu + G);
        for (int u = vcu + 2 * G; u < 512; u += G) ATT_UNIT(u);
#undef ATT_UNIT
        __syncthreads();
        while (cv.it < cv.end) {
            att::cv_issue(cv, (unsigned)(uintptr_t)((char*)lds_raw + att::SHM_ATTN + wave * 4096), lane); asm volatile("s_waitcnt vmcnt(0)" ::: "memory");
            att::cv_finish(cv, (const float*)((char*)lds_raw + att::SHM_ATTN + wave * 4096), lane); asm volatile("s_waitcnt lgkmcnt(0)" ::: "memory"); }
        __syncthreads();
    }
    SEAM(5);
    if (IN(6)) { LOADP(); TIDS();
        typedef SchedDense<64, 8, 31, 2048> SD; SD S{(const char*)(p.ws + WS_CAT), (const char*)(p.ws + WS_WOUT_T), G, bx}; EpiY E{p.ws};
        pg8::gemm_phase<EpiY, SD>(lds, 2048, S, E);
    }
    SEAM(6);
    if (IN(7)) { LOADP(); TIDS();
        LAS float* wt = (LAS float*)lds;
        for (int c = tid; c < D; c += NTHREADS) { const float* wr = p.w_router + (size_t)c * 16;
#pragma unroll
            for (int q = 0; q < 4; ++q) { const f32x4 w = *(const f32x4*)(wr + q * 4);
#pragma unroll
                for (int t = 0; t < 4; ++t) wt[(q * 4 + t) * 2048 + c] = w[t]; } }
        LDS_WAIT(); __syncthreads();
        const int bsel = vcu & 3, wsub = (vcu >> 2) * NWAVES + wave, nsub = ((G + 3 - bsel) >> 2) * NWAVES;
        LAS float* vt = (LAS float*)(lds + VEC_OFF);
        for (int c = tid; c < D; c += NTHREADS) { const float* mb = (const float*)(p.ws + WS_MOD) + bsel * 12288;
            vt[c] = mb[4096 + c] * p.post_norm1[c]; vt[2048 + c] = p.pre_norm2[c] * (1.f + mb[8192 + c]); vt[4096 + c] = mb[6144 + c]; }
        LDS_WAIT(); __syncthreads();
        { P6In nxt; if (wsub < L) p6_fetch(p, bsel * L + wsub, lane, nxt);
          for (int r = wsub; r < L; r += nsub) { const P6In cur = nxt; if (r + nsub < L) p6_fetch(p, bsel * L + r + nsub, lane, nxt);
              p6_row(p, bsel * L + r, lane, wt, vt, cur, PROBE_FLAGS); } }
        __syncthreads();
    }
    SEAM(7);
    if (IN(8)) { LOADP(); TIDS(); for (int u = bx; u < 64; u += G) topk_unit(p, u >> 2, u & 3, (LAS unsigned*)lds, tid);
        if (G == 256 && bx >= 64) { const int base = PX_R8 + (bx - 64) * PX_N8; px_convert(p, base + wave, NWAVES, base + PX_N8, (LAS float*)(lds + wave * 16384), lane); } }
    SEAM(8);
    if (IN(9)) { LOADP(); TIDS();
        constexpr int KU = FP8_MOE ? 1024 : 2048;
        typedef SchedGather<KU> SG; SG S{(const char*)(p.ws + WS_H2), (const char*)(p.ws + WS_WGU_T), G, bx, (const LAS unsigned*)(lds + TAB_OFF)};
        for (int q = tid; q < 2048; q += NTHREADS) { const int i = q >> 8, r = q & 255; Unit u;
            if (S.next(i, u)) { const int e = u.pm >> 3, m = (u.pm & 7) * 256 + r, b = m >> 9; const int tok = ((const int*)(p.ws + WS_IDX))[(size_t)(e * 4 + b) * CAP + (m & 511)];
                ((LAS unsigned*)(lds + TAB_OFF))[q] = (unsigned)(b * L + tok) * (unsigned)(KU * 2); } }
        LDS_WAIT(); __syncthreads();
        if constexpr (FP8_MOE) { EpiAct8 E{p.ws}; pg8::gemm_phase<EpiAct8, SG, true>(lds, KU, S, E); }
        else { EpiAct E{p.ws}; pg8::gemm_phase<EpiAct, SG, false>(lds, KU, S, E); }
    }
    SEAM(9);
    if (IN(10)) { LOADP(); TIDS();
        constexpr int KU = FP8_MOE ? 1024 : 2048;
        typedef SchedDense<128, 8, 3, KU> SD; SD S{(const char*)(p.ws + WS_ACT), (const char*)(p.ws + WS_WD_T), G, bx};
        if constexpr (FP8_MOE) { EpiYE8 E{p.ws}; pg8::gemm_phase<EpiYE8, SD, true>(lds, KU, S, E); }
        else { EpiYE E{p.ws}; pg8::gemm_phase<EpiYE, SD, false>(lds, KU, S, E); }
    }
    SEAM(10);
    if (IN(11)) { LOADP(); TIDS(); float* dsto = p.out;
        const int bsel = vcu & 3, wsub = (vcu >> 2) * NWAVES + wave, nsub = ((G + 3 - bsel) >> 2) * NWAVES;
        LAS float* vt = (LAS float*)(lds + VEC_OFF);
        for (int c = tid; c < D; c += NTHREADS) vt[c] = ((const float*)(p.ws + WS_MOD))[bsel * 12288 + 10240 + c] * p.post_norm2[c];
        LDS_WAIT(); __syncthreads();
        P11In nxt; if (wsub < L) p11_fetch(p, bsel * L + wsub, lane, nxt);
        for (int r = wsub; r < L; r += nsub) { const P11In cur = nxt; if (r + nsub < L) p11_fetch(p, bsel * L + r + nsub, lane, nxt); p11_row(p, bsel * L + r, lane, dsto, vt, cur, PROBE_FLAGS); } }
#ifdef PROBE_GEMM
    if (IN(13)) { LOADP(); TIDS();
        struct SP : SchedDense<64, 8, 31, 2048> { __device__ __forceinline__ const char* a_base(const Unit& u) const { return (PROBE_GEMM & 2) ? A : A + (size_t)u.pm * (512 * 2048); }
                                                   __device__ __forceinline__ const char* b_base(const Unit& u) const { return (PROBE_GEMM & 1) ? Bt : Bt + (size_t)u.pn * (512 * 2048); } };
        SP S; S.A = (const char*)(p.ws + WS_CAT); S.Bt = (const char*)(p.ws + WS_WOUT_T); S.G = G; S.c = bx; EpiY E{p.ws};
        pg8::gemm_phase<EpiY, SP>(lds, 2048, S, E); }
#endif
#ifdef PROBE_ATTN
    if (IN(12)) { TIDS();
        att::CvStream cvd; cvd.it = 0; cvd.end = 0; cvd.step = 1;
        for (int u = vcu; u < 512; u += G) { LOADP(); const int bh = u >> 4, qb = u & 15; __syncthreads();
            att::attn_unit<PROBE_ATTN>((const bf16*)(p.ws + WS_Q) + ((size_t)bh * L + qb * 256) * DQK, (const bf16*)(p.ws + WS_K) + (size_t)bh * LK * DQK, (const bf16*)(p.ws + WS_V) + (size_t)bh * LK * VH,
                           (bf16*)(p.ws + WS_S) + ((size_t)(bh >> 3) * L + qb * 256) * D + (bh & 7) * 128, LK, (char*)lds_raw, cvd); }
        __syncthreads(); }
#endif
#undef IN
#undef SEAM
#undef lo
#undef hi
}

#ifndef PHASE_MODE
#define PHASE_MODE "FFFFFFFFFFFF"
#endif
#ifndef DUP_FLAGS
#define DUP_FLAGS 0
#endif
#ifndef MERGE
#define MERGE 1
#endif
#if !defined(FINAL_BUILD)
template <class P> static void launch_ngemm(const P& f, int Mr, int Nr, int Z, hipStream_t s) { hipLaunchKernelGGL((ngemm<P>), dim3(Nr / 64, Mr / 64, Z), dim3(256), 0, s, f); }
static void naive_phase(int ph, const Ptrs& p, hipStream_t stream) {
    switch (ph) {
    case 0: hipLaunchKernelGGL(n_mod, dim3(48, 5), dim3(256), 0, stream, p); break;
    case 1: break;
    case 2: hipLaunchKernelGGL(n_hrows, dim3(MALL / 4), dim3(256), 0, stream, p); break;
    case 3: launch_ngemm(GIn{p, D}, MALL, 3136, 1, stream);
        hipLaunchKernelGGL(n_ssq, dim3(M / 4), dim3(256), 0, stream, (const bf16*)(p.ws + WS_CQKV), M, 512, (float*)(p.ws + WS_SSQQ), 8);
        hipLaunchKernelGGL(n_ssq, dim3(MALL / 4), dim3(256), 0, stream, (const bf16*)(p.ws + WS_CQKV) + (size_t)M * 512, MALL, 512, (float*)(p.ws + WS_SSQKV), 8); break;
    case 4: launch_ngemm(GQ{p, 512}, M, 1536, 1, stream); launch_ngemm(GKV{p, 512}, MALL, 2048, 1, stream);
        hipLaunchKernelGGL(n_vn, dim3(M * 8 / 4), dim3(256), 0, stream, p); launch_ngemm(GSgu{p, 128}, 128, 128, 1024, stream); break;
    case 5: for (int bh = 0; bh < B * H; ++bh) { launch_ngemm(GScore{p, DQK, bh}, L, LK, 1, stream);
            hipLaunchKernelGGL(n_softmax, dim3(L), dim3(256), 0, stream, (float*)(p.ws + WS_S), LK); launch_ngemm(GPV{p, LK, bh}, L, VH, 1, stream); } break;
    case 6: launch_ngemm(GOut{p, D}, M, D, 1, stream);
        hipLaunchKernelGGL(n_ssq, dim3(M / 4), dim3(256), 0, stream, (const bf16*)(p.ws + WS_Y), M, D, (float*)(p.ws + WS_SSQY), 32); break;
    case 7: hipLaunchKernelGGL(n_rowmid, dim3(M / 4), dim3(256), 0, stream, p); break;
    case 8: hipLaunchKernelGGL(n_topk, dim3(64), dim3(1024), 0, stream, p); break;
    case 9: launch_ngemm(GE1{p, D}, 2048, 4096, 16, stream); break;
    case 10: launch_ngemm(GE2{p, FF}, 2048, 2048, 16, stream); break;
    case 11: hipLaunchKernelGGL(n_rowfinal, dim3(M / 4), dim3(256), 0, stream, p); break;
    }
}
#endif
extern "C" void kernel_launch(void* const* d_in, const int* in_sizes, int n_in, void* d_out, int out_size, void* d_ws, size_t ws_size, hipStream_t stream) {
    static int grid = 0;
    if (grid == 0) {
        if (n_in != 24 || ws_size < WS_END || out_size != M * D) { fprintf(stderr, "kernel_launch: unexpected shapes n_in %d ws %zu out %d\n", n_in, ws_size, out_size); grid = -1; return; }
        int dev = 0, cus = 0, per_cu = 0;
        if (hipGetDevice(&dev) != hipSuccess || hipDeviceGetAttribute(&cus, hipDeviceAttributeMultiprocessorCount, dev) != hipSuccess) { grid = -1; return; }
        if (hipFuncSetAttribute((const void*)fwd, hipFuncAttributeMaxDynamicSharedMemorySize, LDS_BYTES) != hipSuccess) { fprintf(stderr, "kernel_launch: hipFuncSetAttribute failed\n"); grid = -1; return; }
        if (hipOccupancyMaxActiveBlocksPerMultiprocessor(&per_cu, (const void*)fwd, NTHREADS, LDS_BYTES) != hipSuccess || per_cu < 1) fprintf(stderr, "kernel_launch: occupancy query says %d\n", per_cu);
        (void)hipGetLastError();
        grid = cus;
    }
    if (grid < 0) return;
    Ptrs p{};
    const float** f = (const float**)&p;
    for (int i = 0; i < 24; ++i) f[i] = (const float*)d_in[i];
    p.out = (float*)d_out; p.ws = (unsigned char*)d_ws;
    (void)hipMemsetAsync(p.ws + WS_CTL, 0, 1 * MiB, stream);
    const char* mode = PHASE_MODE; int nbar = 0;
    for (int ph = 0; ph < 12;) {
#ifdef DUP_PHASE
        if (ph == 11 && DUP_PHASE == 11) { Args a2{}; a2.p = p; a2.ph_lo = 11; a2.ph_hi = 12; a2.bar_idx = nbar++; a2.pad = 1 | DUP_FLAGS; hipLaunchKernelGGL(fwd, dim3(grid), dim3(NTHREADS), LDS_BYTES, stream, a2); }
#endif
#ifdef PROBE_GEMM
        if (ph == 6) { Args a3{}; a3.p = p; a3.ph_lo = 13; a3.ph_hi = 14; a3.bar_idx = nbar++; hipLaunchKernelGGL(fwd, dim3(grid), dim3(NTHREADS), LDS_BYTES, stream, a3); }
#endif
        if (mode[ph] == 'F') { int e = ph + 1; if (MERGE) while (e < 12 && mode[e] == 'F') ++e;
            Args a{}; a.p = p; a.ph_lo = ph; a.ph_hi = e; a.bar_idx = nbar++; a.pad = 0;
            hipLaunchKernelGGL(fwd, dim3(grid), dim3(NTHREADS), LDS_BYTES, stream, a);
            const hipError_t le = hipPeekAtLastError(); if (le != hipSuccess) fprintf(stderr, "kernel_launch: launch failed: %s\n", hipGetErrorName(le));
#ifdef PROBE_ATTN
            if (ph == 5) { Args a3 = a; a3.ph_lo = 12; a3.ph_hi = 13; a3.bar_idx = nbar++; hipLaunchKernelGGL(fwd, dim3(grid), dim3(NTHREADS), LDS_BYTES, stream, a3); }
#endif
#ifdef DUP_PHASE
            if (ph == DUP_PHASE && ph != 11) { Args a2 = a; a2.bar_idx = nbar++; a2.pad = DUP_FLAGS; hipLaunchKernelGGL(fwd, dim3(grid), dim3(NTHREADS), LDS_BYTES, stream, a2);
                if (ph == 11) hipLaunchKernelGGL(fwd, dim3(grid), dim3(NTHREADS), LDS_BYTES, stream, a2); }
#endif
            ph = e; }
#if !defined(FINAL_BUILD)
        else { naive_phase(ph, p, stream); ++ph; }
#else
        else ++ph;
#endif
    }
}
```
